# Optimizing an MI355X kernel written in HIP

```python
import math
import jax
import jax.numpy as jnp
from jax import lax
import numpy as np

D_MODEL = 1024
BATCH = 32
SEQ = 256
DEPTH = 2
DEC_BATCH = 8
DEC_SEQ = 1024
PAST_LEN = 256

GRID_W = 64
N_EVEN = (DEPTH + 1) // 2
N_ODD = DEPTH // 2
MIX_A = D_MODEL // 2
H_B = D_MODEL // 256
DH_B = 64
W_B = H_B * 2 * DH_B
H_C = D_MODEL // 128
DH_C = 64
W_C = H_C * DH_C
H_D = D_MODEL // 128
KV_D = H_D // 4
DH_D = 64
W_D = H_D * DH_D
MIX_WIDTH = MIX_A + W_B
IN_EVEN = 3 * MIX_A + 3 * W_B
IN_ODD = 3 * W_C + W_D + 2 * KV_D * DH_D
D_FF = 4 * D_MODEL
CONV_W = 3
NA_WIN_R = 8
NA_WIN_C = 16
SWA_WINDOW = 128
SWA_BLOCK = 128
Q_BLOCK = 128
DENSE_KEY_LIMIT = 2048
ROPE_BASE = 10000.0
EPS = 1e-6
NEG = -1e30

kernel_name = 'hybrid_diffusion_ctx_prefix_step'


def rmsnorm(x, g):
    xf = x.astype(jnp.float32)
    y = xf * lax.rsqrt(jnp.mean(xf * xf, axis=-1, keepdims=True) + EPS)
    return (y * g.astype(jnp.float32)).astype(x.dtype)


def to_heads(x, n):
    b, t, _ = x.shape
    return x.reshape(b, t, n, -1).transpose(0, 2, 1, 3)


def from_heads(x):
    b, h, t, d = x.shape
    return x.transpose(0, 2, 1, 3).reshape(b, t, h * d)


def axial_rope(x):
    t_len, dh = x.shape[1], x.shape[-1]
    q4 = dh // 4
    t = jnp.arange(t_len)
    rows = (t // GRID_W).astype(jnp.float32)
    cols = (t % GRID_W).astype(jnp.float32)
    inv = 1.0 / (ROPE_BASE ** (jnp.arange(q4, dtype=jnp.float32) / q4))
    ang = jnp.stack([rows[:, None] * inv, cols[:, None] * inv], axis=1)
    cos = jnp.cos(ang)[None, :, None].astype(x.dtype)
    sin = jnp.sin(ang)[None, :, None].astype(x.dtype)
    xs = x.reshape(x.shape[:-1] + (2, 2, q4))
    a, b = xs[..., 0, :], xs[..., 1, :]
    return jnp.stack([a * cos - b * sin, b * cos + a * sin], axis=-2).reshape(x.shape)


def short_conv(u, w):
    return lax.conv_general_dilated(u, w[:, None, :].astype(u.dtype), window_strides=(1,), padding=[(1, 1)], dimension_numbers=('NWC', 'WIO', 'NWC'), feature_group_count=u.shape[-1])


def sweep_queries(core, q, q_axis, out_axis, n_keys):
    if n_keys < DENSE_KEY_LIMIT:
        return core(q)
    t_q = q.shape[q_axis]
    nb = t_q // Q_BLOCK
    qb = q.reshape(q.shape[:q_axis] + (nb, Q_BLOCK) + q.shape[q_axis + 1:])
    ob = jnp.moveaxis(lax.map(core, jnp.moveaxis(qb, q_axis, 0)), 0, out_axis)
    return ob.reshape(ob.shape[:out_axis] + (t_q,) + ob.shape[out_axis + 2:])


def diff_attention(q, k, v, lam, lam_init, subln):
    scale = q.shape[-1] ** -0.5

    def core(qb):
        s = jnp.einsum('bhmqd,bhmkd->bhmqk', qb, k).astype(jnp.float32) * scale
        p = jax.nn.softmax(s, axis=-1)
        pd = (p[:, :, 0] - lam * p[:, :, 1]).astype(v.dtype)
        return rmsnorm(jnp.einsum('bhqk,bhkd->bhqd', pd, v), subln) * (1.0 - lam_init)

    return sweep_queries(core, q, 3, 2, k.shape[3])


def full_attention(q, k, v, sink):
    scale = q.shape[-1] ** -0.5

    def core(qb):
        s = jnp.einsum('bgmqd,bgkd->bgmqk', qb, k).astype(jnp.float32) * scale
        if sink is None:
            p = jax.nn.softmax(s, axis=-1)
        else:
            sk = jnp.broadcast_to(sink.astype(jnp.float32).reshape(1, s.shape[1], s.shape[2], 1, 1), s.shape[:-1] + (1,))
            p = jax.nn.softmax(jnp.concatenate([s, sk], axis=-1), axis=-1)[..., :-1]
        return jnp.einsum('bgmqk,bgkd->bgmqd', p.astype(v.dtype), v)

    return sweep_queries(core, q, 3, 3, k.shape[2])


def neighbourhood_attention(q, k, v, kc, vc, rpb):
    bn, h, t, dh = q.shape
    rows = t // GRID_W
    wr = min(NA_WIN_R, rows)
    wc = NA_WIN_C
    scale = dh ** -0.5
    qg = q.reshape(bn, h, rows, GRID_W, dh)
    r = jnp.arange(rows)
    row_idx = jnp.clip(r - wr // 2, 0, rows - wr)[:, None] + jnp.arange(wr)
    k_rows = k.reshape(bn, h, rows, GRID_W, dh)[:, :, row_idx]
    v_rows = v.reshape(bn, h, rows, GRID_W, dh)[:, :, row_idx]
    col = jnp.arange(GRID_W)
    col_start = jnp.clip(col - wc // 2, 0, GRID_W - wc)
    col_ok = (col[None, :] >= col_start[:, None]) & (col[None, :] < col_start[:, None] + wc)
    dr = row_idx - r[:, None] + NA_WIN_R - 1
    dc = jnp.clip(col[None, :] - col[:, None] + NA_WIN_C - 1, 0, 2 * NA_WIN_C - 2)
    bias = rpb[:, dr[:, None, :, None], dc[None, :, None, :]].astype(jnp.float32)
    s = jnp.einsum('bhrqd,bhrjkd->bhrqjk', qg, k_rows).astype(jnp.float32) * scale + bias[None]
    s = jnp.where(col_ok[:, None, :], s, NEG).reshape(bn, h, rows, GRID_W, wr * GRID_W)
    sc = jnp.einsum('bhrqd,bhcd->bhrqc', qg, kc).astype(jnp.float32) * scale
    p = jax.nn.softmax(jnp.concatenate([s, sc], axis=-1), axis=-1)
    n_lat = wr * GRID_W
    p_lat = p[..., :n_lat].reshape(bn, h, rows, GRID_W, wr, GRID_W).astype(v.dtype)
    o = jnp.einsum('bhrqjk,bhrjkd->bhrqd', p_lat, v_rows) + jnp.einsum('bhrqc,bhcd->bhrqd', p[..., n_lat:].astype(v.dtype), vc)
    return o.reshape(bn, h, t, dh)


def window_attention(q, k, v, kc, vc, sink):
    bn, g, m, t, dh = q.shape
    nb = t // SWA_BLOCK
    scale = dh ** -0.5
    qb = q.reshape(bn, g, m, nb, SWA_BLOCK, dh)

    def band(x):
        xb = jnp.pad(x, ((0, 0), (0, 0), (SWA_BLOCK, SWA_BLOCK), (0, 0))).reshape(bn, g, nb + 2, SWA_BLOCK, dh)
        return jnp.concatenate([xb[:, :, 0:nb], xb[:, :, 1:nb + 1], xb[:, :, 2:nb + 2]], axis=3)

    kb, vb = band(k), band(v)
    blk = jnp.arange(nb)
    qpos = blk[:, None] * SWA_BLOCK + jnp.arange(SWA_BLOCK)
    kpos = (blk[:, None] - 1) * SWA_BLOCK + jnp.arange(3 * SWA_BLOCK)
    ok = (jnp.abs(qpos[:, :, None] - kpos[:, None, :]) <= SWA_WINDOW) & (kpos[:, None, :] >= 0) & (kpos[:, None, :] < t)
    s = jnp.einsum('bgmnqd,bgnkd->bgmnqk', qb, kb).astype(jnp.float32) * scale
    s = jnp.where(ok, s, NEG)
    sc = jnp.einsum('bgmnqd,bgcd->bgmnqc', qb, kc).astype(jnp.float32) * scale
    sk = jnp.broadcast_to(sink.astype(jnp.float32).reshape(1, g, m, 1, 1, 1), s.shape[:-1] + (1,))
    p = jax.nn.softmax(jnp.concatenate([s, sc, sk], axis=-1), axis=-1)
    n_lat = 3 * SWA_BLOCK
    n_ctx = kc.shape[2]
    o = jnp.einsum('bgmnqk,bgnkd->bgmnqd', p[..., :n_lat].astype(v.dtype), vb) + jnp.einsum('bgmnqc,bgcd->bgmnqd', p[..., n_lat:n_lat + n_ctx].astype(v.dtype), vc)
    return o.reshape(bn, g, m, t, dh)


def even_mixer(h, w_in, conv_w, lam, lam_init, subln, w_out, ctx_kv):
    bn, t, _ = h.shape
    a_b, a_c, a_x, q, k, v = jnp.split(h @ w_in, [MIX_A, 2 * MIX_A, 3 * MIX_A, 3 * MIX_A + W_B, 3 * MIX_A + 2 * W_B], axis=-1)
    y_a = a_b * short_conv(a_c * a_x, conv_w)
    q = q.reshape(bn, t, 2 * H_B, DH_B)
    k = k.reshape(bn, t, 2 * H_B, DH_B)
    if ctx_kv is not None:
        q, k = axial_rope(q), axial_rope(k)
    q = q.reshape(bn, t, H_B, 2, DH_B).transpose(0, 2, 3, 1, 4)
    k = k.reshape(bn, t, H_B, 2, DH_B).transpose(0, 2, 3, 1, 4)
    v = to_heads(v, H_B)
    if ctx_kv is None:
        k_all, v_all = k, v
    else:
        k_all = jnp.concatenate([k, ctx_kv[0]], axis=3)
        v_all = jnp.concatenate([v, ctx_kv[1]], axis=2)
    y_b = diff_attention(q, k_all, v_all, lam, lam_init, subln)
    y = jnp.concatenate([y_a, from_heads(y_b)], axis=-1) @ w_out
    return y, (k, v)


def odd_mixer(h, w_in, rpb, sink, w_out, ctx_kv):
    bn, t, _ = h.shape
    cq, ck, cv, dq, dk, dv = jnp.split(h @ w_in, [W_C, 2 * W_C, 3 * W_C, 3 * W_C + W_D, 3 * W_C + W_D + KV_D * DH_D], axis=-1)
    cq, ck, cv = to_heads(cq, H_C), to_heads(ck, H_C), to_heads(cv, H_C)
    dq = dq.reshape(bn, t, H_D, DH_D)
    dk = dk.reshape(bn, t, KV_D, DH_D)
    dv = to_heads(dv, KV_D)
    if ctx_kv is None:
        dk = dk.transpose(0, 2, 1, 3)
        y_c = full_attention(cq[:, :, None], ck, cv, None)[:, :, 0]
        y_d = full_attention(dq.transpose(0, 2, 1, 3).reshape(bn, KV_D, H_D // KV_D, t, DH_D), dk, dv, sink)
    else:
        ck_ctx, cv_ctx, dk_ctx, dv_ctx = ctx_kv
        y_c = neighbourhood_attention(cq, ck, cv, ck_ctx, cv_ctx, rpb)
        dq = axial_rope(dq)
        dk = axial_rope(dk).transpose(0, 2, 1, 3)
        y_d = window_attention(dq.transpose(0, 2, 1, 3).reshape(bn, KV_D, H_D // KV_D, t, DH_D), dk, dv, dk_ctx, dv_ctx, sink)
    y_d = y_d.reshape(bn, H_D, t, DH_D)
    y = jnp.concatenate([from_heads(y_c), from_heads(y_d)], axis=-1) @ w_out
    return y, (ck, cv, dk, dv)


def setup_inputs(seed: int = 0) -> dict:
    key = jax.random.key(seed)
    ks = iter(jax.random.split(key, 40))

    def nrm(shape, scale):
        return jax.random.normal(next(ks), shape, jnp.float32) * scale

    def gain(shape):
        return 1.0 + nrm(shape, 0.05)

    return {
        'x_prompt': nrm((BATCH, SEQ, D_MODEL), 1.0),
        'x_sample': nrm((DEC_BATCH, DEC_SEQ, D_MODEL), 1.0),
        'cache_diff_k': nrm((DEC_BATCH, N_EVEN, H_B, 2, PAST_LEN, DH_B), 1.0),
        'cache_diff_v': nrm((DEC_BATCH, N_EVEN, H_B, PAST_LEN, 2 * DH_B), 1.0),
        'cache_na_k': nrm((DEC_BATCH, N_ODD, H_C, PAST_LEN, DH_C), 1.0),
        'cache_na_v': nrm((DEC_BATCH, N_ODD, H_C, PAST_LEN, DH_C), 1.0),
        'cache_swa_k': nrm((DEC_BATCH, N_ODD, KV_D, PAST_LEN, DH_D), 1.0),
        'cache_swa_v': nrm((DEC_BATCH, N_ODD, KV_D, PAST_LEN, DH_D), 1.0),
        'c': nrm((DEC_BATCH, D_MODEL), 1.0),
        'c_ctx': nrm((D_MODEL,), 1.0),
        'mod_w': nrm((DEPTH, D_MODEL, 6 * D_MODEL), D_MODEL ** -0.5),
        'mod_b': nrm((DEPTH, 6 * D_MODEL), 0.02),
        'norm_mix_pre': gain((DEPTH, D_MODEL)),
        'norm_mix_post': gain((DEPTH, D_MODEL)),
        'norm_mlp_pre': gain((DEPTH, D_MODEL)),
        'norm_mlp_post': gain((DEPTH, D_MODEL)),
        'w_in_even': nrm((N_EVEN, D_MODEL, IN_EVEN), D_MODEL ** -0.5),
        'conv_w': nrm((N_EVEN, CONV_W, MIX_A), CONV_W ** -0.5),
        'lambda_q1': nrm((N_EVEN, DH_B), 0.1),
        'lambda_k1': nrm((N_EVEN, DH_B), 0.1),
        'lambda_q2': nrm((N_EVEN, DH_B), 0.1),
        'lambda_k2': nrm((N_EVEN, DH_B), 0.1),
        'subln': gain((N_EVEN, 2 * DH_B)),
        'w_in_odd': nrm((N_ODD, D_MODEL, IN_ODD), D_MODEL ** -0.5),
        'rpb': nrm((N_ODD, H_C, 2 * NA_WIN_R - 1, 2 * NA_WIN_C - 1), 0.1),
        'sink': nrm((N_ODD, H_D), 0.5),
        'w_out': nrm((DEPTH, MIX_WIDTH, D_MODEL), MIX_WIDTH ** -0.5),
        'mlp_w1': nrm((DEPTH, D_MODEL, D_FF), D_MODEL ** -0.5),
        'mlp_w2': nrm((DEPTH, D_FF, D_MODEL), D_FF ** -0.5),
    }


def reference(x_prompt, x_sample, cache_diff_k, cache_diff_v, cache_na_k, cache_na_v, cache_swa_k, cache_swa_v, c, c_ctx, mod_w, mod_b, norm_mix_pre, norm_mix_post, norm_mlp_pre, norm_mlp_post, w_in_even, conv_w, lambda_q1, lambda_k1, lambda_q2, lambda_k2, subln, w_in_odd, rpb, sink, w_out, mlp_w1, mlp_w2):
    def layer(x, cond, li, ctx_kv):
        mod = (jax.nn.silu(cond) @ mod_w[li] + mod_b[li])[:, None, :]
        sh1, sc1, g1, sh2, sc2, g2 = jnp.split(mod, 6, axis=-1)
        h = rmsnorm(x, norm_mix_pre[li]) * (1.0 + sc1) + sh1
        if li % 2 == 0:
            e = li // 2
            lam_init = 0.8 - 0.6 * math.exp(-0.3 * li)
            lam = (jnp.exp(jnp.sum(lambda_q1[e].astype(jnp.float32) * lambda_k1[e].astype(jnp.float32)))
                   - jnp.exp(jnp.sum(lambda_q2[e].astype(jnp.float32) * lambda_k2[e].astype(jnp.float32))) + lam_init)
            y, kv = even_mixer(h, w_in_even[e], conv_w[e], lam, lam_init, subln[e], w_out[li], ctx_kv)
        else:
            o = li // 2
            y, kv = odd_mixer(h, w_in_odd[o], rpb[o], sink[o], w_out[li], ctx_kv)
        x = x + g1 * rmsnorm(y, norm_mix_post[li])
        h = rmsnorm(x, norm_mlp_pre[li]) * (1.0 + sc2) + sh2
        y = jnp.square(jax.nn.relu(h @ mlp_w1[li])) @ mlp_w2[li]
        x = x + g2 * rmsnorm(y, norm_mlp_post[li])
        return x, kv

    xp = x_prompt
    diff_k, diff_v, na_k, na_v, swa_k, swa_v = [], [], [], [], [], []
    for li in range(DEPTH):
        xp, kv = layer(xp, c_ctx[None, :], li, None)
        if li % 2 == 0:
            diff_k.append(kv[0])
            diff_v.append(kv[1])
        else:
            na_k.append(kv[0])
            na_v.append(kv[1])
            swa_k.append(kv[2])
            swa_v.append(kv[3])
    y_prompt = xp
    new_diff_k = jnp.stack(diff_k, axis=1)
    new_diff_v = jnp.stack(diff_v, axis=1)
    new_na_k = jnp.stack(na_k, axis=1)
    new_na_v = jnp.stack(na_v, axis=1)
    new_swa_k = jnp.stack(swa_k, axis=1)
    new_swa_v = jnp.stack(swa_v, axis=1)

    xs = x_sample
    for li in range(DEPTH):
        if li % 2 == 0:
            e = li // 2
            ctx = (cache_diff_k[:, e], cache_diff_v[:, e])
        else:
            o = li // 2
            ctx = (cache_na_k[:, o], cache_na_v[:, o], cache_swa_k[:, o], cache_swa_v[:, o])
        xs, _ = layer(xs, c, li, ctx)
    y_sample = xs

    return (y_prompt, y_sample, new_diff_k, new_diff_v, new_na_k, new_na_v, new_swa_k, new_swa_v)
```

```cpp
#include <hip/hip_runtime.h>
#include <hip/hip_cooperative_groups.h>
#include <cstdio>
#include <cstdint>
namespace cg = cooperative_groups;

#ifndef ONE_LAUNCH
#define ONE_LAUNCH 1
#endif

typedef unsigned short bf16_t;
typedef short bf16x8 __attribute__((ext_vector_type(8)));
typedef float f32x4 __attribute__((ext_vector_type(4)));
typedef float f32x2 __attribute__((ext_vector_type(2)));
typedef float f32x16 __attribute__((ext_vector_type(16)));
typedef unsigned u32x4 __attribute__((ext_vector_type(4)));
typedef unsigned u32x2 __attribute__((ext_vector_type(2)));
typedef __bf16 bfv2 __attribute__((ext_vector_type(2)));
#define DI __device__ __forceinline__
#define MFMA32(a, b, c) __builtin_amdgcn_mfma_f32_32x32x16_bf16((a), (b), (c), 0, 0, 0)
#define MFMA16(a, b, c) __builtin_amdgcn_mfma_f32_16x16x32_bf16((a), (b), (c), 0, 0, 0)

constexpr float LOG2E = 1.4426950408889634f;
constexpr float EPSN = 1e-6f;

struct Params {
    const float *x_prompt, *x_sample, *cache_diff_k, *cache_diff_v, *cache_na_k, *cache_na_v, *cache_swa_k, *cache_swa_v, *c, *c_ctx;
    const float *mod_w, *mod_b, *norm_mix_pre, *norm_mix_post, *norm_mlp_pre, *norm_mlp_post, *w_in_even, *conv_w, *lq1, *lk1, *lq2, *lk2, *subln;
    const float *w_in_odd, *rpb, *sink, *w_out, *mlp_w1, *mlp_w2;
    float* out;
    char* ws;
};

constexpr size_t OFF_MOD = 0;
constexpr size_t OFF_WINE = 524288;
constexpr size_t OFF_WINO = OFF_WINE + 6291456;
constexpr size_t OFF_WOUT = OFF_WINO + 4718592;
constexpr size_t OFF_W1 = OFF_WOUT + 4194304;
constexpr size_t OFF_W2 = OFF_W1 + 16777216;
constexpr size_t OFF_CDK = OFF_W2 + 16777216;
constexpr size_t OFF_CDVT = OFF_CDK + 2097152;
constexpr size_t OFF_CNK = OFF_CDVT + 2097152;
constexpr size_t OFF_CNVT = OFF_CNK + 2097152;
constexpr size_t OFF_CSK = OFF_CNVT + 2097152;
constexpr size_t OFF_CSVT = OFF_CSK + 524288;
constexpr size_t OFF_HY = OFF_CSVT + 524288;
constexpr size_t OFF_BIG = OFF_HY + 67108864;
constexpr size_t WS_NEEDED = OFF_BIG + 134217728;
constexpr size_t BIG_VT_E = 83886080;
constexpr size_t BIG_VT_C = 54525952;
constexpr size_t BIG_VT_D = BIG_VT_C + 16777216;
constexpr size_t BIG_MIXIN = 100663296;
constexpr int LDE = 2560, LDO = 1664;
constexpr size_t OUT_DIFFK = 16777216, OUT_DIFFV = 20971520, OUT_NAK = 25165824, OUT_NAV = 29360128, OUT_SWAK = 33554432, OUT_SWAV = 34603008;

constexpr int LDS_BYTES = 65536 + 4096;

DI unsigned pk2(float a, float b) { f32x2 v = {a, b}; bfv2 r = __builtin_convertvector(v, bfv2); return __builtin_bit_cast(unsigned, r); }
DI float bflo(unsigned u) { return __uint_as_float(u << 16); }
DI float bfhi(unsigned u) { return __uint_as_float(u & 0xffff0000u); }
DI float wave_sum(float v) {
#pragma unroll
    for (int o = 1; o < 64; o <<= 1) v += __shfl_xor(v, o);
    return v;
}
DI int swz128(int r, int c) { return r * 128 + ((c ^ ((r >> 1) & 7)) << 4); }
DI int swz256(int r, int c) { return r * 256 + ((c ^ (r & 15)) << 4); }

DI void p0_mod_item(const Params& p, int item, char* lds) {
    const int li = item / 96, cb = item % 96;
    const int tid = threadIdx.x, lane = tid & 63, w = tid >> 6;
    const float* W = p.mod_w + (size_t)li * 1024 * 6144 + cb * 64 + lane;
    float acc[9];
#pragma unroll
    for (int v = 0; v < 9; ++v) acc[v] = 0.f;
    for (int kc = 0; kc < 4; ++kc) {
        const int kb = w * 256 + kc * 64;
        float s[9];
        { const float cv = p.c_ctx[kb + lane]; s[0] = cv / (1.f + __expf(-cv)); }
#pragma unroll
        for (int v = 1; v < 9; ++v) { const float cv = p.c[(v - 1) * 1024 + kb + lane]; s[v] = cv / (1.f + __expf(-cv)); }
#pragma unroll
        for (int kk = 0; kk < 64; ++kk) {
            const float wv = W[(size_t)(kb + kk) * 6144];
#pragma unroll
            for (int v = 0; v < 9; ++v) acc[v] += __int_as_float(__builtin_amdgcn_readlane(__float_as_int(s[v]), kk)) * wv;
        }
    }
    float* red = (float*)lds;
#pragma unroll
    for (int v = 0; v < 9; ++v) red[(w * 9 + v) * 64 + lane] = acc[v];
    __syncthreads();
    float* mod = (float*)(p.ws + OFF_MOD);
    for (int idx = tid; idx < 576; idx += 256) {
        const int v = idx >> 6, col = idx & 63;
        const float sum = red[(0 * 9 + v) * 64 + col] + red[(1 * 9 + v) * 64 + col] + red[(2 * 9 + v) * 64 + col] + red[(3 * 9 + v) * 64 + col];
        mod[(li * 9 + v) * 6144 + cb * 64 + col] = sum + p.mod_b[li * 6144 + cb * 64 + col];
    }
    __syncthreads();
}

DI void p0_transpose_tile(const float* __restrict__ in, bf16_t* __restrict__ out, int R, int C, int tr, int tc, char* lds) {
    const int tid = threadIdx.x;
    const int cl = (tid & 15) * 4, rl = (tid >> 4) * 2, sw = tid & 7;
#pragma unroll
    for (int i = 0; i < 2; ++i) {
        const int r = rl + 32 * i;
        const f32x4 a = *(const f32x4*)(in + (size_t)(tr * 64 + r) * C + tc * 64 + cl);
        const f32x4 b = *(const f32x4*)(in + (size_t)(tr * 64 + r + 1) * C + tc * 64 + cl);
#pragma unroll
        for (int j = 0; j < 4; ++j) *(unsigned*)(lds + (cl + j) * 128 + (((r >> 3) ^ sw) << 4) + (r & 7) * 2) = pk2(a[j], b[j]);
    }
    __syncthreads();
#pragma unroll
    for (int i = 0; i < 2; ++i) {
        const int idx = tid + 256 * i, c = idx >> 3, q = idx & 7;
        const u32x4 v = *(const u32x4*)(lds + c * 128 + ((q ^ ((c >> 2) & 7)) << 4));
        *(u32x4*)(out + (size_t)(tc * 64 + c) * R + tr * 64 + q * 8) = v;
    }
    __syncthreads();
}

DI void p0_kreorder(const float* __restrict__ in, bf16_t* __restrict__ out, int logH, int item) {
    const int tid = threadIdx.x, H = 1 << logH;
#pragma unroll
    for (int i = 0; i < 4; ++i) {
        const int f = item * 1024 + tid + 256 * i;
        const int d4 = f & 15, key = (f >> 4) & 255, hh = (f >> 12) & (H - 1), b = f >> (12 + logH);
        const f32x4 v = *(const f32x4*)(in + (size_t)f * 4);
        u32x2 o = {pk2(v[0], v[1]), pk2(v[2], v[3])};
        *(u32x2*)(out + ((size_t)(b * 256 + key) * H + hh) * 64 + d4 * 4) = o;
    }
}

constexpr int P0_ITEMS = 192 + 768 + 576 + 512 + 2048 + 2048 + 256 + 256 + 64 + 256 + 256 + 64;
DI void p0_item(const Params& p, int item, char* lds) {
    if (item < 192) { p0_mod_item(p, item, lds); return; }
    item -= 192;
    const float* in; bf16_t* out; int R, C;
    if (item < 768) { in = p.w_in_even; out = (bf16_t*)(p.ws + OFF_WINE); R = 1024; C = 3072; }
    else if ((item -= 768) < 576) { in = p.w_in_odd; out = (bf16_t*)(p.ws + OFF_WINO); R = 1024; C = 2304; }
    else if ((item -= 576) < 512) { const int b = item >> 8; item &= 255; in = p.w_out + (size_t)b * 1048576; out = (bf16_t*)(p.ws + OFF_WOUT) + (size_t)b * 1048576; R = 1024; C = 1024; }
    else if ((item -= 512) < 2048) { const int b = item >> 10; item &= 1023; in = p.mlp_w1 + (size_t)b * 4194304; out = (bf16_t*)(p.ws + OFF_W1) + (size_t)b * 4194304; R = 1024; C = 4096; }
    else if ((item -= 2048) < 2048) { const int b = item >> 10; item &= 1023; in = p.mlp_w2 + (size_t)b * 4194304; out = (bf16_t*)(p.ws + OFF_W2) + (size_t)b * 4194304; R = 4096; C = 1024; }
    else if ((item -= 2048) < 256) { const int b = item >> 3; item &= 7; in = p.cache_diff_v + (size_t)b * 32768; out = (bf16_t*)(p.ws + OFF_CDVT) + (size_t)b * 32768; R = 256; C = 128; }
    else if ((item -= 256) < 256) { const int b = item >> 2; item &= 3; in = p.cache_na_v + (size_t)b * 16384; out = (bf16_t*)(p.ws + OFF_CNVT) + (size_t)b * 16384; R = 256; C = 64; }
    else if ((item -= 256) < 64) { const int b = item >> 2; item &= 3; in = p.cache_swa_v + (size_t)b * 16384; out = (bf16_t*)(p.ws + OFF_CSVT) + (size_t)b * 16384; R = 256; C = 64; }
    else {
        item -= 64;
        if (item < 256) p0_kreorder(p.cache_diff_k, (bf16_t*)(p.ws + OFF_CDK), 3, item);
        else if (item < 512) p0_kreorder(p.cache_na_k, (bf16_t*)(p.ws + OFF_CNK), 3, item - 256);
        else p0_kreorder(p.cache_swa_k, (bf16_t*)(p.ws + OFF_CSK), 1, item - 512);
        return;
    }
    const int ntc = C >> 6;
    p0_transpose_tile(in, out, R, C, item / ntc, item % ntc, lds);
}

DI void rowop_phase(const Params& p, bool hasY, bool xin_input, int g_off, const float* wpost, bool hasH, const float* wpre, int sc_off, int sh_off) {
    const int lane = threadIdx.x & 63, gw = blockIdx.x * 4 + (threadIdx.x >> 6), nw = gridDim.x * 4;
    const float* mod = (const float*)(p.ws + OFF_MOD);
    for (int row = gw; row < 16384; row += nw) {
        const int v = row < 8192 ? 0 : 1 + ((row - 8192) >> 10);
        const float* xin = xin_input ? (row < 8192 ? p.x_prompt + (size_t)row * 1024 : p.x_sample + (size_t)(row - 8192) * 1024) : p.out + (size_t)row * 1024;
        char* hy = p.ws + OFF_HY + (size_t)row * 4096;
        f32x4 x[4];
#pragma unroll
        for (int i = 0; i < 4; ++i) x[i] = *(const f32x4*)(xin + lane * 4 + 256 * i);
        if (hasY) {
            f32x4 y[4];
            float ss = 0.f;
#pragma unroll
            for (int i = 0; i < 4; ++i) { y[i] = *(const f32x4*)((const float*)hy + lane * 4 + 256 * i); ss += y[i][0] * y[i][0] + y[i][1] * y[i][1] + y[i][2] * y[i][2] + y[i][3] * y[i][3]; }
            ss = wave_sum(ss);
            const float rs = rsqrtf(ss * (1.f / 1024.f) + EPSN);
#pragma unroll
            for (int i = 0; i < 4; ++i) {
                const int col = lane * 4 + 256 * i;
                const f32x4 g4 = *(const f32x4*)(mod + v * 6144 + g_off + col);
                const f32x4 wp = *(const f32x4*)(wpost + col);
                x[i] += g4 * (y[i] * rs * wp);
                *(f32x4*)(p.out + (size_t)row * 1024 + col) = x[i];
            }
        }
        if (hasH) {
            float ss = 0.f;
#pragma unroll
            for (int i = 0; i < 4; ++i) ss += x[i][0] * x[i][0] + x[i][1] * x[i][1] + x[i][2] * x[i][2] + x[i][3] * x[i][3];
            ss = wave_sum(ss);
            const float rs = rsqrtf(ss * (1.f / 1024.f) + EPSN);
#pragma unroll
            for (int i = 0; i < 4; ++i) {
                const int col = lane * 4 + 256 * i;
                const f32x4 sc = *(const f32x4*)(mod + v * 6144 + sc_off + col);
                const f32x4 sh = *(const f32x4*)(mod + v * 6144 + sh_off + col);
                const f32x4 wp = *(const f32x4*)(wpre + col);
                const f32x4 h = x[i] * rs * wp * (sc + 1.f) + sh;
                u32x2 o = {pk2(h[0], h[1]), pk2(h[2], h[3])};
                *(u32x2*)((bf16_t*)hy + col) = o;
            }
        }
    }
}

template <bool SWAP>
DI void gemm_kloop(const bf16_t* __restrict__ A, int lda, const bf16_t* __restrict__ Bt, int K, char* lds, f32x4 (&acc)[4][4]) {
    const int tid = threadIdx.x, lane = tid & 63, w = tid >> 6, wr = w >> 1, wc = w & 1, fr = lane & 15, fq = lane >> 4;
    const int sr = tid >> 3, sc = tid & 7;
    const bf16_t* ga = A + (size_t)sr * lda + sc * 8;
    const bf16_t* gb = Bt + (size_t)sr * K + sc * 8;
    u32x4 ra[4], rb[4];
#pragma unroll
    for (int i = 0; i < 4; ++i) { ra[i] = *(const u32x4*)(ga + (size_t)(32 * i) * lda); rb[i] = *(const u32x4*)(gb + (size_t)(32 * i) * K); }
    const int wofs = swz128(sr, sc);
#pragma unroll
    for (int i = 0; i < 4; ++i) { *(u32x4*)(lds + wofs + i * 4096) = ra[i]; *(u32x4*)(lds + 16384 + wofs + i * 4096) = rb[i]; }
    __syncthreads();
    const int nk = K >> 6;
    const int swf = (fr >> 1) & 7;
    const int aofs = (wr * 64 + fr) * 128, bofs = 16384 + (wc * 64 + fr) * 128;
    for (int kt = 0; kt < nk; ++kt) {
        const bool more = kt + 1 < nk;
        if (more) {
            ga += 64; gb += 64;
#pragma unroll
            for (int i = 0; i < 4; ++i) { ra[i] = *(const u32x4*)(ga + (size_t)(32 * i) * lda); rb[i] = *(const u32x4*)(gb + (size_t)(32 * i) * K); }
        }
        const char* buf = lds + (kt & 1) * 32768;
#pragma unroll
        for (int ks = 0; ks < 2; ++ks) {
            bf16x8 af[4], bfr[4];
            const int co = ((ks * 4 + fq) ^ swf) << 4;
#pragma unroll
            for (int m = 0; m < 4; ++m) af[m] = *(const bf16x8*)(buf + aofs + m * 2048 + co);
#pragma unroll
            for (int n = 0; n < 4; ++n) bfr[n] = *(const bf16x8*)(buf + bofs + n * 2048 + co);
#pragma unroll
            for (int m = 0; m < 4; ++m)
#pragma unroll
                for (int n = 0; n < 4; ++n) acc[m][n] = SWAP ? MFMA16(bfr[n], af[m], acc[m][n]) : MFMA16(af[m], bfr[n], acc[m][n]);
        }
        if (more) {
            char* nb = lds + ((kt + 1) & 1) * 32768;
#pragma unroll
            for (int i = 0; i < 4; ++i) { *(u32x4*)(nb + wofs + i * 4096) = ra[i]; *(u32x4*)(nb + 16384 + wofs + i * 4096) = rb[i]; }
        }
        __syncthreads();
    }
}

enum { EPI_PE = 0, EPI_PO = 1, EPI_Y = 2, EPI_W1 = 3 };

DI void rope_swapped(f32x4 (&acc)[4][4], int row0w, int fr, int fq) {
    float inv[4];
#pragma unroll
    for (int j = 0; j < 4; ++j) inv[j] = exp2f(-(float)(fq * 4 + j) * (13.287712379549449f / 16.f));
#pragma unroll
    for (int m = 0; m < 4; ++m) {
        const int tl = (row0w + m * 16 + fr - 8192) & 1023;
        const float prow = (float)(tl >> 6), pcol = (float)(tl & 63);
#pragma unroll
        for (int j = 0; j < 4; ++j) {
            float s, c;
            __sincosf(prow * inv[j], &s, &c);
            float a = acc[m][0][j], b = acc[m][1][j];
            acc[m][0][j] = a * c - b * s; acc[m][1][j] = b * c + a * s;
            __sincosf(pcol * inv[j], &s, &c);
            a = acc[m][2][j]; b = acc[m][3][j];
            acc[m][2][j] = a * c - b * s; acc[m][3][j] = b * c + a * s;
        }
    }
}

DI void store_bf16_rows(const f32x4 (&acc)[4][4], bf16_t* base, int ld, int row0w, int colw, int fr, int fq) {
#pragma unroll
    for (int m = 0; m < 4; ++m) {
        bf16_t* rp = base + (size_t)(row0w + m * 16 + fr) * ld + colw + fq * 4;
#pragma unroll
        for (int n = 0; n < 4; ++n) { u32x2 o = {pk2(acc[m][n][0], acc[m][n][1]), pk2(acc[m][n][2], acc[m][n][3])}; *(u32x2*)(rp + n * 16) = o; }
    }
}
DI void store_f32_head64(const f32x4 (&acc)[4][4], float* outb, int NH, int head, int row0w, int fr, int fq) {
#pragma unroll
    for (int m = 0; m < 4; ++m) {
        const int R = row0w + m * 16 + fr, b = R >> 8, t = R & 255;
        float* rp = outb + ((size_t)(b * NH + head) * 256 + t) * 64 + fq * 4;
#pragma unroll
        for (int n = 0; n < 4; ++n) *(f32x4*)(rp + n * 16) = acc[m][n];
    }
}
DI void store_vt(const f32x4 (&acc)[4][4], bf16_t* vtseq  , int T, int t0w, int fr, int fq) {
#pragma unroll
    for (int n = 0; n < 4; ++n) {
        bf16_t* rp = vtseq + (size_t)(n * 16 + fr) * T + t0w + fq * 4;
#pragma unroll
        for (int m = 0; m < 4; ++m) { u32x2 o = {pk2(acc[m][n][0], acc[m][n][1]), pk2(acc[m][n][2], acc[m][n][3])}; *(u32x2*)(rp + m * 16) = o; }
    }
}
DI void store_f32_ns(const f32x4 (&acc)[4][4], float* ob  , int ldo, int fr, int fq) {
#pragma unroll
    for (int m = 0; m < 4; ++m)
#pragma unroll
        for (int j = 0; j < 4; ++j) {
            float* rp = ob + (size_t)(m * 16 + fq * 4 + j) * ldo + fr;
#pragma unroll
            for (int n = 0; n < 4; ++n) rp[n * 16] = acc[m][n][j];
        }
}

template <int EPI>
DI void gemm_tile(const Params& p, const bf16_t* A, int lda, const bf16_t* Bt, int K, int pm, int pn, char* lds) {
    const int tid = threadIdx.x, lane = tid & 63, w = tid >> 6, wr = w >> 1, wc = w & 1, fr = lane & 15, fq = lane >> 4;
    f32x4 acc[4][4];
#pragma unroll
    for (int m = 0; m < 4; ++m)
#pragma unroll
        for (int n = 0; n < 4; ++n) acc[m][n] = (f32x4){0.f, 0.f, 0.f, 0.f};
    const bf16_t* At = A + (size_t)pm * 128 * lda;
    const bf16_t* Btt = Bt + (size_t)pn * 128 * K;
    const int row0w = pm * 128 + wr * 64, col0w = pn * 128 + wc * 64;
    const bool latent = row0w >= 8192;
    const bool vtile = (EPI == EPI_PE && pn >= 20) || (EPI == EPI_PO && ((pn >= 8 && pn < 12) || pn == 17));
    if ((EPI == EPI_PE || EPI == EPI_PO) && vtile) {
        gemm_kloop<false>(At, lda, Btt, K, lds, acc);
        int b, t0, T; size_t seqoff;
        if (latent) { b = (row0w - 8192) >> 10; t0 = (row0w - 8192) & 1023; T = 1024; } else { b = row0w >> 8; t0 = row0w & 255; T = 256; }
        if (EPI == EPI_PE) {
            const int vc = col0w - 2560;
            bf16_t* vt = (bf16_t*)(p.ws + OFF_BIG + BIG_VT_E) + (latent ? (size_t)4194304 + ((size_t)b * 512 + vc) * 1024 : ((size_t)b * 512 + vc) * 256);
            store_vt(acc, vt, T, t0, fr, fq);
            if (!latent) store_f32_ns(acc, p.out + OUT_DIFFV + ((size_t)(b * 4 + (vc >> 7)) * 256 + t0) * 128 + (vc & 127), 128, fr, fq);
        } else if (pn < 12) {
            const int vc = col0w - 1024;
            bf16_t* vt = (bf16_t*)(p.ws + OFF_BIG + BIG_VT_C) + (latent ? (size_t)4194304 + ((size_t)b * 512 + vc) * 1024 : ((size_t)b * 512 + vc) * 256);
            store_vt(acc, vt, T, t0, fr, fq);
            if (!latent) store_f32_ns(acc, p.out + OUT_NAV + ((size_t)(b * 8 + (vc >> 6)) * 256 + t0) * 64, 64, fr, fq);
        } else {
            const int vc = col0w - 2176;
            bf16_t* vt = (bf16_t*)(p.ws + OFF_BIG + BIG_VT_D) + (latent ? (size_t)1048576 + ((size_t)b * 128 + vc) * 1024 : ((size_t)b * 128 + vc) * 256);
            store_vt(acc, vt, T, t0, fr, fq);
            if (!latent) store_f32_ns(acc, p.out + OUT_SWAV + ((size_t)(b * 2 + (vc >> 6)) * 256 + t0) * 64, 64, fr, fq);
        }
        return;
    }
    gemm_kloop<true>(At, lda, Btt, K, lds, acc);
    if (EPI == EPI_PE) {
        bf16_t* proj = (bf16_t*)(p.ws + OFF_BIG);
        if (pn >= 12 && latent) rope_swapped(acc, row0w, fr, fq);
        store_bf16_rows(acc, proj, LDE, row0w, col0w, fr, fq);
        if (pn >= 16 && !latent) store_f32_head64(acc, p.out + OUT_DIFFK, 8, (col0w - 2048) >> 6, row0w, fr, fq);
    } else if (EPI == EPI_PO) {
        bf16_t* proj = (bf16_t*)(p.ws + OFF_BIG);
        if (pn >= 12 && latent) rope_swapped(acc, row0w, fr, fq);
        const int dcol = pn >= 12 ? col0w - 512 : col0w;
        store_bf16_rows(acc, proj, LDO, row0w, dcol, fr, fq);
        if (!latent) {
            if (pn >= 4 && pn < 8) store_f32_head64(acc, p.out + OUT_NAK, 8, (col0w - 512) >> 6, row0w, fr, fq);
            else if (pn == 16) store_f32_head64(acc, p.out + OUT_SWAK, 2, (col0w - 2048) >> 6, row0w, fr, fq);
        }
    } else if (EPI == EPI_Y) {
        float* Y = (float*)(p.ws + OFF_HY);
#pragma unroll
        for (int m = 0; m < 4; ++m) {
            float* rp = Y + (size_t)(row0w + m * 16 + fr) * 1024 + col0w + fq * 4;
#pragma unroll
            for (int n = 0; n < 4; ++n) *(f32x4*)(rp + n * 16) = acc[m][n];
        }
    } else {
        bf16_t* H2 = (bf16_t*)(p.ws + OFF_BIG);
#pragma unroll
        for (int m = 0; m < 4; ++m)
#pragma unroll
            for (int n = 0; n < 4; ++n)
#pragma unroll
                for (int j = 0; j < 4; ++j) { const float v = fmaxf(acc[m][n][j], 0.f); acc[m][n][j] = v * v; }
        store_bf16_rows(acc, H2, 4096, row0w, col0w, fr, fq);
    }
}

template <int EPI>
DI void gemm_phase(const Params& p, const bf16_t* A, int lda, const bf16_t* Bt, int K, int NT_N, char* lds) {
    const int xcd = blockIdx.x & 7, lb = blockIdx.x >> 3, nlb = gridDim.x >> 3;
    const int per_xcd = 16 * NT_N;
    for (int lt = lb; lt < per_xcd; lt += nlb) {
        const int sm = lt / (8 * NT_N), r = lt % (8 * NT_N), pn = r >> 3, pm = xcd * 16 + sm * 8 + (r & 7);
        gemm_tile<EPI>(p, A, lda, Bt, K, pm, pn, lds);
    }
}

struct ASeg { const bf16_t* K; const bf16_t* Vt; int ldk, ldv, ntiles; };
struct MaskP { int on, a, b, c; const float* tab; };

template <int KW, int VR, int NB, int MODE>
DI void attn_core(const ASeg& s0, const ASeg& s1, const bf16x8 (&qf)[4], int kchunk0, int vrow0, float scale_l2, float& m, float& l, f32x16 (&O)[NB], char* lds, const MaskP& mp) {
    constexpr int KC = KW / 8, NKL = 64 * KC / 256, NVL = VR * 8 / 256;
    const int tid = threadIdx.x, lane = tid & 63, p32 = lane & 31, h = lane >> 5;
    const int krow = (p32 & 19) | ((p32 & 4) << 1) | ((p32 & 8) >> 1);
    const int n0 = s0.ntiles, nt = s0.ntiles + s1.ntiles;
    u32x4 rk[NKL], rv[NVL];
#define ATT_LOAD(t_)                                                                                                         \
    {                                                                                                                        \
        const bool f_ = (t_) < n0; const int tt_ = f_ ? (t_) : (t_) - n0;                                                     \
        const bf16_t* Kp_ = (f_ ? s0.K : s1.K); const int ldk_ = f_ ? s0.ldk : s1.ldk;                                        \
        const bf16_t* Vp_ = (f_ ? s0.Vt : s1.Vt); const int ldv_ = f_ ? s0.ldv : s1.ldv;                                      \
        _Pragma("unroll") for (int i = 0; i < NKL; ++i) { const int id = tid + 256 * i, r = id / KC, c = id % KC; rk[i] = *(const u32x4*)(Kp_ + (size_t)(tt_ * 64 + r) * ldk_ + c * 8); } \
        _Pragma("unroll") for (int i = 0; i < NVL; ++i) { const int id = tid + 256 * i, r = id >> 3, c = id & 7; rv[i] = *(const u32x4*)(Vp_ + (size_t)r * ldv_ + tt_ * 64 + c * 8); }       \
    }
#define ATT_STORE(b_)                                                                                                        \
    {                                                                                                                        \
        char* kb_ = lds + (b_) * 32768; char* vb_ = kb_ + 16384;                                                              \
        _Pragma("unroll") for (int i = 0; i < NKL; ++i) { const int id = tid + 256 * i, r = id / KC, c = id % KC; *(u32x4*)(kb_ + (KW == 128 ? swz256(r, c) : swz128(r, c))) = rk[i]; } \
        _Pragma("unroll") for (int i = 0; i < NVL; ++i) { const int id = tid + 256 * i, r = id >> 3, c = id & 7; *(u32x4*)(vb_ + swz128(r, c)) = rv[i]; }                               \
    }
    ATT_LOAD(0);
    ATT_STORE(0);
    __syncthreads();
    for (int t = 0; t < nt; ++t) {
        const bool more = t + 1 < nt;
        if (more) ATT_LOAD(t + 1);
        const char* kb = lds + (t & 1) * 32768;
        const char* vb = kb + 16384;
        f32x16 S[2];
#pragma unroll
        for (int kh = 0; kh < 2; ++kh) {
#pragma unroll
            for (int i = 0; i < 16; ++i) S[kh][i] = 0.f;
            const int row = krow + 32 * kh;
#pragma unroll
            for (int s = 0; s < 4; ++s) {
                const int c = kchunk0 + 2 * s + h;
                const bf16x8 kf = *(const bf16x8*)(kb + (KW == 128 ? swz256(row, c) : swz128(row, c)));
                S[kh] = MFMA32(kf, qf[s], S[kh]);
            }
        }
        const bool msk = (MODE != 0) && mp.on && t < n0;
        float mx = -1e30f;
        if (MODE == 1 && msk) {
            int cq = mp.c + p32;
            int h8 = 8 * h;
            asm volatile("" : "+v"(cq), "+v"(h8));
            const int cs = min(max(cq - 8, 0), 48);
            const float* tab = mp.tab + (mp.b + t - mp.a + 7) * 31;
#pragma unroll
            for (int kh = 0; kh < 2; ++kh)
#pragma unroll
                for (int i = 0; i < 16; ++i) {
                    const int kc = 32 * kh + 16 * (i >> 3) + h8 + (i & 7);
                    const bool ok = (unsigned)(kc - cs) < 16u;
                    const int dc = min(max(kc - cq + 15, 0), 30);
                    const float sv = ok ? S[kh][i] * scale_l2 + tab[dc] : -1e30f;
                    S[kh][i] = sv; mx = fmaxf(mx, sv);
                }
        } else if (MODE == 2 && msk) {
            int qp = mp.a + p32 - 8 * h;
            asm volatile("" : "+v"(qp));
            const int k0 = mp.b + t * 64;
#pragma unroll
            for (int kh = 0; kh < 2; ++kh)
#pragma unroll
                for (int i = 0; i < 16; ++i) {
                    const int d = qp - (k0 + 32 * kh + 16 * (i >> 3) + (i & 7));
                    const bool ok = d <= 128 && d >= -128;
                    const float sv = ok ? S[kh][i] * scale_l2 : -1e30f;
                    S[kh][i] = sv; mx = fmaxf(mx, sv);
                }
        } else {
#pragma unroll
            for (int kh = 0; kh < 2; ++kh)
#pragma unroll
                for (int i = 0; i < 16; ++i) { const float sv = S[kh][i] * scale_l2; S[kh][i] = sv; mx = fmaxf(mx, sv); }
        }
        mx = fmaxf(mx, __shfl_xor(mx, 32));
        const float mn = fmaxf(m, mx);
        const float alpha = __builtin_amdgcn_exp2f(m - mn);
        m = mn;
        float ls = 0.f;
#pragma unroll
        for (int kh = 0; kh < 2; ++kh)
#pragma unroll
            for (int i = 0; i < 16; ++i) { const float pv = __builtin_amdgcn_exp2f(S[kh][i] - mn); S[kh][i] = pv; ls += pv; }
        l = l * alpha + ls;
#pragma unroll
        for (int blk = 0; blk < NB; ++blk)
#pragma unroll
            for (int i = 0; i < 16; ++i) O[blk][i] *= alpha;
#pragma unroll
        for (int kh = 0; kh < 2; ++kh)
#pragma unroll
            for (int s2 = 0; s2 < 2; ++s2) {
                u32x4 pp = {pk2(S[kh][8 * s2 + 0], S[kh][8 * s2 + 1]), pk2(S[kh][8 * s2 + 2], S[kh][8 * s2 + 3]), pk2(S[kh][8 * s2 + 4], S[kh][8 * s2 + 5]), pk2(S[kh][8 * s2 + 6], S[kh][8 * s2 + 7])};
                const bf16x8 pb = __builtin_bit_cast(bf16x8, pp);
                const int c = 4 * kh + 2 * s2 + h;
#pragma unroll
                for (int blk = 0; blk < NB; ++blk) {
                    const bf16x8 vf = *(const bf16x8*)(vb + swz128(vrow0 + blk * 32 + p32, c));
                    O[blk] = MFMA32(vf, pb, O[blk]);
                }
            }
        if (more) ATT_STORE((t + 1) & 1);
        __syncthreads();
    }
    l += __shfl_xor(l, 32);
#undef ATT_LOAD
#undef ATT_STORE
}

DI void load_q(bf16x8 (&qf)[4], const bf16_t* qrow, int h) {
#pragma unroll
    for (int s = 0; s < 4; ++s) qf[s] = *(const bf16x8*)(qrow + 16 * s + 8 * h);
}

DI void attn_diff_item(const Params& p, int item, char* lds) {
    const int tid = threadIdx.x, lane = tid & 63, w = tid >> 6, p32 = lane & 31, h = lane >> 5, stream = w & 1, qh = w >> 1;
    const bf16_t* proj = (const bf16_t*)(p.ws + OFF_BIG);
    const bf16_t* vte = (const bf16_t*)(p.ws + OFF_BIG + BIG_VT_E);
    bf16_t* mix = (bf16_t*)(p.ws + OFF_BIG + BIG_MIXIN);
    int b, hd, qb, rowbase; ASeg s0, s1;
    if (item < 512) {
        b = item >> 6; hd = (item >> 4) & 3; qb = item & 15; rowbase = 8192 + b * 1024;
        s0 = {proj + (size_t)rowbase * LDE + 2048 + hd * 128, vte + 4194304 + ((size_t)b * 512 + hd * 128) * 1024, LDE, 1024, 16};
        s1 = {(const bf16_t*)(p.ws + OFF_CDK) + (size_t)b * 256 * 512 + hd * 128, (const bf16_t*)(p.ws + OFF_CDVT) + (size_t)(b * 4 + hd) * 128 * 256, 512, 256, 4};
    } else {
        const int it = item - 512;
        b = it >> 4; hd = (it >> 2) & 3; qb = it & 3; rowbase = b * 256;
        s0 = {proj + (size_t)rowbase * LDE + 2048 + hd * 128, vte + ((size_t)b * 512 + hd * 128) * 256, LDE, 256, 4};
        s1 = s0; s1.ntiles = 0;
    }
    const int R = rowbase + qb * 64 + qh * 32 + p32;
    bf16x8 qf[4];
    load_q(qf, proj + (size_t)R * LDE + 1536 + hd * 128 + stream * 64, h);
    f32x16 O[4];
#pragma unroll
    for (int blk = 0; blk < 4; ++blk)
#pragma unroll
        for (int i = 0; i < 16; ++i) O[blk][i] = 0.f;
    float m = -1e30f, l = 0.f;
    MaskP mp = {0, 0, 0, 0, nullptr};
    attn_core<128, 128, 4, 0>(s0, s1, qf, stream * 8, 0, 0.125f * LOG2E, m, l, O, lds, mp);
    const float il = 1.f / l;
    const float d1 = wave_sum(p.lq1[lane] * p.lk1[lane]), d2 = wave_sum(p.lq2[lane] * p.lk2[lane]);
    const float lam_init = 0.2f;
    const float lam = __expf(d1) - __expf(d2) + lam_init;
    float* xb = (float*)(lds + qh * 16384);
    if (stream == 1) {
#pragma unroll
        for (int blk = 0; blk < 4; ++blk)
#pragma unroll
            for (int i = 0; i < 16; ++i) { const int dv = blk * 32 + 8 * (i >> 2) + 4 * h + (i & 3); xb[dv * 32 + p32] = O[blk][i] * il; }
    }
    __syncthreads();
    if (stream == 0) {
        float ss = 0.f;
#pragma unroll
        for (int blk = 0; blk < 4; ++blk)
#pragma unroll
            for (int i = 0; i < 16; ++i) { const int dv = blk * 32 + 8 * (i >> 2) + 4 * h + (i & 3); const float o = O[blk][i] * il - lam * xb[dv * 32 + p32]; O[blk][i] = o; ss += o * o; }
        ss += __shfl_xor(ss, 32);
        const float rs = rsqrtf(ss * (1.f / 128.f) + EPSN) * (1.f - lam_init);
        bf16_t* op = mix + (size_t)R * 1024 + 512 + hd * 128;
#pragma unroll
        for (int blk = 0; blk < 4; ++blk)
#pragma unroll
            for (int g = 0; g < 4; ++g) {
                const int dv = blk * 32 + 8 * g + 4 * h;
                const f32x4 sl = *(const f32x4*)(p.subln + dv);
                u32x2 o = {pk2(O[blk][4 * g] * rs * sl[0], O[blk][4 * g + 1] * rs * sl[1]), pk2(O[blk][4 * g + 2] * rs * sl[2], O[blk][4 * g + 3] * rs * sl[3])};
                *(u32x2*)(op + dv) = o;
            }
    }
    __syncthreads();
}

DI void attn_c_item(const Params& p, int item, char* lds) {
    const int tid = threadIdx.x, lane = tid & 63, w = tid >> 6, p32 = lane & 31, h = lane >> 5, stream = w & 1, qh = w >> 1;
    const bf16_t* proj = (const bf16_t*)(p.ws + OFF_BIG);
    const bf16_t* vtc = (const bf16_t*)(p.ws + OFF_BIG + BIG_VT_C);
    bf16_t* mix = (bf16_t*)(p.ws + OFF_BIG + BIG_MIXIN);
    int b, hp, qb, rowbase; ASeg s0, s1; MaskP mp = {0, 0, 0, 0, nullptr};
    float* tab = (float*)(lds + 65536);
    if (item < 512) {
        b = item >> 6; hp = (item >> 4) & 3; qb = item & 15; rowbase = 8192 + b * 1024;
        const int rstart = min(max(qb - 4, 0), 8);
        s0 = {proj + (size_t)(rowbase + rstart * 64) * LDO + 512 + hp * 128, vtc + 4194304 + ((size_t)b * 512 + hp * 128) * 1024 + rstart * 64, LDO, 1024, 8};
        s1 = {(const bf16_t*)(p.ws + OFF_CNK) + (size_t)b * 256 * 512 + hp * 128, (const bf16_t*)(p.ws + OFF_CNVT) + ((size_t)b * 512 + hp * 128) * 256, 512, 256, 4};
        for (int idx = tid; idx < 930; idx += 256) tab[idx] = p.rpb[hp * 930 + idx] * LOG2E;
        mp = {1, qb, rstart, qh * 32, tab + stream * 465};
    } else {
        const int it = item - 512;
        b = it >> 4; hp = (it >> 2) & 3; qb = it & 3; rowbase = b * 256;
        s0 = {proj + (size_t)rowbase * LDO + 512 + hp * 128, vtc + ((size_t)b * 512 + hp * 128) * 256, LDO, 256, 4};
        s1 = s0; s1.ntiles = 0;
    }
    const int R = rowbase + qb * 64 + qh * 32 + p32;
    const int head = hp * 2 + stream;
    bf16x8 qf[4];
    load_q(qf, proj + (size_t)R * LDO + head * 64, h);
    f32x16 O[2];
#pragma unroll
    for (int blk = 0; blk < 2; ++blk)
#pragma unroll
        for (int i = 0; i < 16; ++i) O[blk][i] = 0.f;
    float m = -1e30f, l = 0.f;
    attn_core<128, 128, 2, 1>(s0, s1, qf, stream * 8, stream * 64, 0.125f * LOG2E, m, l, O, lds, mp);
    const float il = 1.f / l;
    bf16_t* op = mix + (size_t)R * 1024 + head * 64;
#pragma unroll
    for (int blk = 0; blk < 2; ++blk)
#pragma unroll
        for (int g = 0; g < 4; ++g) {
            const int dv = blk * 32 + 8 * g + 4 * h;
            u32x2 o = {pk2(O[blk][4 * g] * il, O[blk][4 * g + 1] * il), pk2(O[blk][4 * g + 2] * il, O[blk][4 * g + 3] * il)};
            *(u32x2*)(op + dv) = o;
        }
}

DI void attn_d_item(const Params& p, int item, char* lds) {
    const int tid = threadIdx.x, lane = tid & 63, w = tid >> 6, p32 = lane & 31, h = lane >> 5;
    const bf16_t* proj = (const bf16_t*)(p.ws + OFF_BIG);
    const bf16_t* vtd = (const bf16_t*)(p.ws + OFF_BIG + BIG_VT_D);
    bf16_t* mix = (bf16_t*)(p.ws + OFF_BIG + BIG_MIXIN);
    int b, g, qb, rowbase; ASeg s0, s1; MaskP mp = {0, 0, 0, 0, nullptr};
    if (item < 512) {
        b = item >> 6; g = (item >> 5) & 1; qb = item & 31; rowbase = 8192 + b * 1024;
        const int q0 = qb * 32;
        const int tlo = max(q0 - 128, 0) >> 6, thi = min(q0 + 159, 1023) >> 6;
        s0 = {proj + (size_t)(rowbase + tlo * 64) * LDO + 1536 + g * 64, vtd + 1048576 + ((size_t)b * 128 + g * 64) * 1024 + tlo * 64, LDO, 1024, thi - tlo + 1};
        s1 = {(const bf16_t*)(p.ws + OFF_CSK) + (size_t)b * 256 * 128 + g * 64, (const bf16_t*)(p.ws + OFF_CSVT) + ((size_t)b * 128 + g * 64) * 256, 128, 256, 4};
        mp = {1, q0, tlo * 64, 0, nullptr};
    } else {
        const int it = item - 512;
        b = it >> 4; g = (it >> 3) & 1; qb = it & 7; rowbase = b * 256;
        s0 = {proj + (size_t)rowbase * LDO + 1536 + g * 64, vtd + ((size_t)b * 128 + g * 64) * 256, LDO, 256, 4};
        s1 = s0; s1.ntiles = 0;
    }
    const int R = rowbase + qb * 32 + p32;
    const int hq = g * 4 + w;
    bf16x8 qf[4];
    load_q(qf, proj + (size_t)R * LDO + 1024 + hq * 64, h);
    f32x16 O[2];
#pragma unroll
    for (int blk = 0; blk < 2; ++blk)
#pragma unroll
        for (int i = 0; i < 16; ++i) O[blk][i] = 0.f;
    float m = p.sink[hq] * LOG2E, l = h == 0 ? 1.f : 0.f;
    attn_core<64, 64, 2, 2>(s0, s1, qf, 0, 0, 0.125f * LOG2E, m, l, O, lds, mp);
    const float il = 1.f / l;
    bf16_t* op = mix + (size_t)R * 1024 + 512 + hq * 64;
#pragma unroll
    for (int blk = 0; blk < 2; ++blk)
#pragma unroll
        for (int gg = 0; gg < 4; ++gg) {
            const int dv = blk * 32 + 8 * gg + 4 * h;
            u32x2 o = {pk2(O[blk][4 * gg] * il, O[blk][4 * gg + 1] * il), pk2(O[blk][4 * gg + 2] * il, O[blk][4 * gg + 3] * il)};
            *(u32x2*)(op + dv) = o;
        }
}

DI void conv_item(const Params& p, int item) {
    const int tid = threadIdx.x;
    const bf16_t* proj = (const bf16_t*)(p.ws + OFF_BIG);
    bf16_t* mix = (bf16_t*)(p.ws + OFF_BIG + BIG_MIXIN);
#pragma unroll 2
    for (int i = 0; i < 8; ++i) {
        const int idx = tid + 256 * i, tl = idx >> 6, ch = (idx & 63) * 8;
        const int R = item * 32 + tl;
        int t, T;
        if (R < 8192) { t = R & 255; T = 256; } else { t = (R - 8192) & 1023; T = 1024; }
        const bf16_t* rp = proj + (size_t)R * LDE + ch;
        const u32x4 ab = *(const u32x4*)(rp);
        float accv[8];
#pragma unroll
        for (int e = 0; e < 8; ++e) accv[e] = 0.f;
#pragma unroll
        for (int j = 0; j < 3; ++j) {
            const int tt = t + j - 1;
            if (tt >= 0 && tt < T) {
                const u32x4 ac = *(const u32x4*)(rp + (ptrdiff_t)(j - 1) * LDE + 512);
                const u32x4 ax = *(const u32x4*)(rp + (ptrdiff_t)(j - 1) * LDE + 1024);
                const f32x4 w0 = *(const f32x4*)(p.conv_w + j * 512 + ch), w1 = *(const f32x4*)(p.conv_w + j * 512 + ch + 4);
#pragma unroll
                for (int e = 0; e < 4; ++e) {
                    accv[2 * e] += bflo(ac[e]) * bflo(ax[e]) * (e < 2 ? w0[2 * e] : w1[2 * e - 4]);
                    accv[2 * e + 1] += bfhi(ac[e]) * bfhi(ax[e]) * (e < 2 ? w0[2 * e + 1] : w1[2 * e - 3]);
                }
            }
        }
        u32x4 o;
#pragma unroll
        for (int e = 0; e < 4; ++e) o[e] = pk2(bflo(ab[e]) * accv[2 * e], bfhi(ab[e]) * accv[2 * e + 1]);
        *(u32x4*)(mix + (size_t)R * 1024 + ch) = o;
    }
}

constexpr int N_PHASES = 16;
DI void run_phase(const Params& p, int ph, char* lds) {
    const int nb = gridDim.x, bid = blockIdx.x;
    const bf16_t* hy = (const bf16_t*)(p.ws + OFF_HY);
    const bf16_t* big = (const bf16_t*)(p.ws + OFF_BIG);
    const bf16_t* mixin = (const bf16_t*)(p.ws + OFF_BIG + BIG_MIXIN);
    switch (ph) {
    case 0: for (int it = bid; it < P0_ITEMS; it += nb) p0_item(p, it, lds); break;
    case 1: rowop_phase(p, false, true, 0, nullptr, true, p.norm_mix_pre, 1024, 0); break;
    case 2: gemm_phase<EPI_PE>(p, hy, 2048, (const bf16_t*)(p.ws + OFF_WINE), 1024, 24, lds); break;
    case 3:
        for (int it = bid; it < 1536; it += nb) { if (it < 1024) attn_diff_item(p, it, lds); else conv_item(p, it - 1024); }
        break;
    case 4: gemm_phase<EPI_Y>(p, mixin, 1024, (const bf16_t*)(p.ws + OFF_WOUT), 1024, 8, lds); break;
    case 5: rowop_phase(p, true, true, 2048, p.norm_mix_post, true, p.norm_mlp_pre, 4096, 3072); break;
    case 6: gemm_phase<EPI_W1>(p, hy, 2048, (const bf16_t*)(p.ws + OFF_W1), 1024, 32, lds); break;
    case 7: gemm_phase<EPI_Y>(p, big, 4096, (const bf16_t*)(p.ws + OFF_W2), 4096, 8, lds); break;
    case 8: rowop_phase(p, true, false, 5120, p.norm_mlp_post, true, p.norm_mix_pre + 1024, 9 * 6144 + 1024, 9 * 6144 + 0); break;
    case 9: gemm_phase<EPI_PO>(p, hy, 2048, (const bf16_t*)(p.ws + OFF_WINO), 1024, 18, lds); break;
    case 10:
        for (int it = bid; it < 2048; it += nb) {
            const int q = it >> 9, r = it & 511;
            if (q & 1) attn_d_item(p, (q >> 1) * 512 + r, lds); else attn_c_item(p, (q >> 1) * 512 + r, lds);
        }
        break;
    case 11: gemm_phase<EPI_Y>(p, mixin, 1024, (const bf16_t*)(p.ws + OFF_WOUT) + 1048576, 1024, 8, lds); break;
    case 12: rowop_phase(p, true, false, 9 * 6144 + 2048, p.norm_mix_post + 1024, true, p.norm_mlp_pre + 1024, 9 * 6144 + 4096, 9 * 6144 + 3072); break;
    case 13: gemm_phase<EPI_W1>(p, hy, 2048, (const bf16_t*)(p.ws + OFF_W1) + 4194304, 1024, 32, lds); break;
    case 14: gemm_phase<EPI_Y>(p, big, 4096, (const bf16_t*)(p.ws + OFF_W2) + 4194304, 4096, 8, lds); break;
    case 15: rowop_phase(p, true, false, 9 * 6144 + 5120, p.norm_mlp_post + 1024, false, nullptr, 0, 0); break;
    }
}

__global__ void __launch_bounds__(256, 2) fwd_mega(Params p) {
    __shared__ __attribute__((aligned(16))) char lds[LDS_BYTES];
    cg::grid_group grid = cg::this_grid();
#define PH_(n) run_phase(p, n, lds); grid.sync();
    PH_(0) PH_(1) PH_(2) PH_(3) PH_(4) PH_(5) PH_(6) PH_(7) PH_(8) PH_(9) PH_(10) PH_(11) PH_(12) PH_(13) PH_(14)
    run_phase(p, 15, lds);
#undef PH_
}

__global__ void __launch_bounds__(256, 2) fwd_phase(Params p, int ph) {
    __shared__ __attribute__((aligned(16))) char lds[LDS_BYTES];
    run_phase(p, ph, lds);
}

extern "C" void kernel_launch(void* const* d_in, const int* in_sizes, int n_in, void* d_out, int out_size, void* d_ws, size_t ws_size, hipStream_t stream) {
    Params p{};
    const float** pp = (const float**)&p;
    for (int i = 0; i < 29; ++i) pp[i] = (const float*)d_in[i];
    p.out = (float*)d_out;
    p.ws = (char*)d_ws;
    if (ws_size < WS_NEEDED) { fprintf(stderr, "workspace too small: %zu < %zu\n", ws_size, (size_t)WS_NEEDED); return; }
    static int grid_blocks = 0;
    if (!grid_blocks) {
        int dev = 0, cus = 0, per_cu = 0;
        hipGetDevice(&dev);
        hipDeviceGetAttribute(&cus, hipDeviceAttributeMultiprocessorCount, dev);
        hipOccupancyMaxActiveBlocksPerMultiprocessor(&per_cu, fwd_mega, 256, 0);
        if (per_cu > 2) per_cu = 2;
        if (per_cu < 1) per_cu = 1;
        grid_blocks = cus * per_cu;
        grid_blocks -= grid_blocks % 8;
    }
#if ONE_LAUNCH
    void* args[] = {&p};
    hipError_t e = hipLaunchCooperativeKernel((void*)fwd_mega, dim3(grid_blocks), dim3(256), args, 0, stream);
    if (e != hipSuccess) fprintf(stderr, "cooperative launch failed: %s (grid %d)\n", hipGetErrorString(e), grid_blocks);
#else
    for (int ph = 0; ph < N_PHASES; ++ph) fwd_phase<<<grid_blocks, 256, 0, stream>>>(p, ph);
#endif
}
```

```cpp
#include <hip/hip_runtime.h>
#include <hip/hip_cooperative_groups.h>
#include <cstdio>
#include <cstdint>
namespace cg = cooperative_groups;

#ifndef DUP_MASK
#define DUP_MASK 0
#endif
#ifndef ONE_LAUNCH
#define ONE_LAUNCH 1
#endif

typedef unsigned short bf16_t;
typedef short bf16x8 __attribute__((ext_vector_type(8)));
typedef float f32x4 __attribute__((ext_vector_type(4)));
typedef float f32x2 __attribute__((ext_vector_type(2)));
typedef float f32x16 __attribute__((ext_vector_type(16)));
typedef unsigned u32x4 __attribute__((ext_vector_type(4)));
typedef unsigned u32x2 __attribute__((ext_vector_type(2)));
typedef __bf16 bfv2 __attribute__((ext_vector_type(2)));
#define DI __device__ __forceinline__
#define MFMA32(a, b, c) __builtin_amdgcn_mfma_f32_32x32x16_bf16((a), (b), (c), 0, 0, 0)
#define MFMA16(a, b, c) __builtin_amdgcn_mfma_f32_16x16x32_bf16((a), (b), (c), 0, 0, 0)

constexpr float LOG2E = 1.4426950408889634f;
constexpr float EPSN = 1e-6f;

struct Params {
    const float *x_prompt, *x_sample, *cache_diff_k, *cache_diff_v, *cache_na_k, *cache_na_v, *cache_swa_k, *cache_swa_v, *c, *c_ctx;
    const float *mod_w, *mod_b, *norm_mix_pre, *norm_mix_post, *norm_mlp_pre, *norm_mlp_post, *w_in_even, *conv_w, *lq1, *lk1, *lq2, *lk2, *subln;
    const float *w_in_odd, *rpb, *sink, *w_out, *mlp_w1, *mlp_w2;
    float* out;
    char* ws;
};

constexpr size_t OFF_MOD = 0;
constexpr size_t OFF_BAR = 458752;
constexpr size_t OFF_WINE = 524288;
constexpr size_t OFF_WINO = OFF_WINE + 6291456;
constexpr size_t OFF_WOUT = OFF_WINO + 4718592;
constexpr size_t OFF_W1 = OFF_WOUT + 4194304;
constexpr size_t OFF_W2 = OFF_W1 + 16777216;
constexpr size_t OFF_CDK = OFF_W2 + 16777216;
constexpr size_t OFF_CDVT = OFF_CDK + 2097152;
constexpr size_t OFF_CNK = OFF_CDVT + 2097152;
constexpr size_t OFF_CNVT = OFF_CNK + 2097152;
constexpr size_t OFF_CSK = OFF_CNVT + 2097152;
constexpr size_t OFF_CSVT = OFF_CSK + 524288;
constexpr size_t OFF_HY = OFF_CSVT + 524288;
constexpr size_t OFF_BIG = OFF_HY + 67108864;
constexpr size_t WS_NEEDED = OFF_BIG + 134217728;
constexpr size_t BIG_VT_E = 83886080;
constexpr size_t BIG_VT_C = 54525952;
constexpr size_t BIG_VT_D = BIG_VT_C + 16777216;
constexpr size_t BIG_MIXIN = 100663296;
constexpr int LDE = 2560, LDO = 1664;
constexpr size_t OUT_DIFFK = 16777216, OUT_DIFFV = 20971520, OUT_NAK = 25165824, OUT_NAV = 29360128, OUT_SWAK = 33554432, OUT_SWAV = 34603008;

constexpr int LDS_BYTES = 65536 + 4096;

DI unsigned pk2(float a, float b) { f32x2 v = {a, b}; bfv2 r = __builtin_convertvector(v, bfv2); return __builtin_bit_cast(unsigned, r); }
DI float bflo(unsigned u) { return __uint_as_float(u << 16); }
DI float bfhi(unsigned u) { return __uint_as_float(u & 0xffff0000u); }
DI float wave_sum(float v) {
#pragma unroll
    for (int o = 1; o < 64; o <<= 1) v += __shfl_xor(v, o);
    return v;
}
DI int swz128(int r, int c) { return r * 128 + ((c ^ ((r >> 1) & 7)) << 4); }
DI int swz256(int r, int c) { return r * 256 + ((c ^ (r & 15)) << 4); }

DI void p0_mod_item(const Params& p, int item, char* lds) {
    const int li = item / 96, cb = item % 96;
    const int tid = threadIdx.x, lane = tid & 63, w = tid >> 6;
    const float* W = p.mod_w + (size_t)li * 1024 * 6144 + cb * 64 + lane;
    float acc[9];
#pragma unroll
    for (int v = 0; v < 9; ++v) acc[v] = 0.f;
    for (int kc = 0; kc < 4; ++kc) {
        const int kb = w * 256 + kc * 64;
        float s[9];
        { const float cv = p.c_ctx[kb + lane]; s[0] = cv / (1.f + __expf(-cv)); }
#pragma unroll
        for (int v = 1; v < 9; ++v) { const float cv = p.c[(v - 1) * 1024 + kb + lane]; s[v] = cv / (1.f + __expf(-cv)); }
#pragma unroll
        for (int kk = 0; kk < 64; ++kk) {
            const float wv = W[(size_t)(kb + kk) * 6144];
#pragma unroll
            for (int v = 0; v < 9; ++v) acc[v] += __int_as_float(__builtin_amdgcn_readlane(__float_as_int(s[v]), kk)) * wv;
        }
    }
    float* red = (float*)lds;
#pragma unroll
    for (int v = 0; v < 9; ++v) red[(w * 9 + v) * 64 + lane] = acc[v];
    __syncthreads();
    float* mod = (float*)(p.ws + OFF_MOD);
    for (int idx = tid; idx < 576; idx += 256) {
        const int v = idx >> 6, col = idx & 63;
        const float sum = red[(0 * 9 + v) * 64 + col] + red[(1 * 9 + v) * 64 + col] + red[(2 * 9 + v) * 64 + col] + red[(3 * 9 + v) * 64 + col];
        mod[(li * 9 + v) * 6144 + cb * 64 + col] = sum + p.mod_b[li * 6144 + cb * 64 + col];
    }
    __syncthreads();
}

DI void p0_transpose_tile(const float* __restrict__ in, bf16_t* __restrict__ out, int R, int C, int tr, int tc, char* lds) {
    const int tid = threadIdx.x;
    const int cl = (tid & 15) * 4, rl = (tid >> 4) * 2, sw = tid & 7;
#pragma unroll
    for (int i = 0; i < 2; ++i) {
        const int r = rl + 32 * i;
        const f32x4 a = *(const f32x4*)(in + (size_t)(tr * 64 + r) * C + tc * 64 + cl);
        const f32x4 b = *(const f32x4*)(in + (size_t)(tr * 64 + r + 1) * C + tc * 64 + cl);
#pragma unroll
        for (int j = 0; j < 4; ++j) *(unsigned*)(lds + (cl + j) * 128 + (((r >> 3) ^ sw) << 4) + (r & 7) * 2) = pk2(a[j], b[j]);
    }
    __syncthreads();
#pragma unroll
    for (int i = 0; i < 2; ++i) {
        const int idx = tid + 256 * i, c = idx >> 3, q = idx & 7;
        const u32x4 v = *(const u32x4*)(lds + c * 128 + ((q ^ ((c >> 2) & 7)) << 4));
        *(u32x4*)(out + (size_t)(tc * 64 + c) * R + tr * 64 + q * 8) = v;
    }
    __syncthreads();
}

DI void p0_kreorder(const float* __restrict__ in, bf16_t* __restrict__ out, int logH, int item) {
    const int tid = threadIdx.x, H = 1 << logH;
#pragma unroll
    for (int i = 0; i < 4; ++i) {
        const int f = item * 1024 + tid + 256 * i;
        const int d4 = f & 15, key = (f >> 4) & 255, hh = (f >> 12) & (H - 1), b = f >> (12 + logH);
        const f32x4 v = *(const f32x4*)(in + (size_t)f * 4);
        u32x2 o = {pk2(v[0], v[1]), pk2(v[2], v[3])};
        *(u32x2*)(out + ((size_t)(b * 256 + key) * H + hh) * 64 + d4 * 4) = o;
    }
}

constexpr int P0_ITEMS = 192 + 768 + 576 + 512 + 2048 + 2048 + 256 + 256 + 64 + 256 + 256 + 64;
DI void p0_item(const Params& p, int item, char* lds) {
    if (item < 192) { p0_mod_item(p, item, lds); return; }
    item -= 192;
    const float* in; bf16_t* out; int R, C;
    if (item < 768) { in = p.w_in_even; out = (bf16_t*)(p.ws + OFF_WINE); R = 1024; C = 3072; }
    else if ((item -= 768) < 576) { in = p.w_in_odd; out = (bf16_t*)(p.ws + OFF_WINO); R = 1024; C = 2304; }
    else if ((item -= 576) < 512) { const int b = item >> 8; item &= 255; in = p.w_out + (size_t)b * 1048576; out = (bf16_t*)(p.ws + OFF_WOUT) + (size_t)b * 1048576; R = 1024; C = 1024; }
    else if ((item -= 512) < 2048) { const int b = item >> 10; item &= 1023; in = p.mlp_w1 + (size_t)b * 4194304; out = (bf16_t*)(p.ws + OFF_W1) + (size_t)b * 4194304; R = 1024; C = 4096; }
    else if ((item -= 2048) < 2048) { const int b = item >> 10; item &= 1023; in = p.mlp_w2 + (size_t)b * 4194304; out = (bf16_t*)(p.ws + OFF_W2) + (size_t)b * 4194304; R = 4096; C = 1024; }
    else if ((item -= 2048) < 256) { const int b = item >> 3; item &= 7; in = p.cache_diff_v + (size_t)b * 32768; out = (bf16_t*)(p.ws + OFF_CDVT) + (size_t)b * 32768; R = 256; C = 128; }
    else if ((item -= 256) < 256) { const int b = item >> 2; item &= 3; in = p.cache_na_v + (size_t)b * 16384; out = (bf16_t*)(p.ws + OFF_CNVT) + (size_t)b * 16384; R = 256; C = 64; }
    else if ((item -= 256) < 64) { const int b = item >> 2; item &= 3; in = p.cache_swa_v + (size_t)b * 16384; out = (bf16_t*)(p.ws + OFF_CSVT) + (size_t)b * 16384; R = 256; C = 64; }
    else {
        item -= 64;
        if (item < 256) p0_kreorder(p.cache_diff_k, (bf16_t*)(p.ws + OFF_CDK), 3, item);
        else if (item < 512) p0_kreorder(p.cache_na_k, (bf16_t*)(p.ws + OFF_CNK), 3, item - 256);
        else p0_kreorder(p.cache_swa_k, (bf16_t*)(p.ws + OFF_CSK), 1, item - 512);
        return;
    }
    const int ntc = C >> 6;
    p0_transpose_tile(in, out, R, C, item / ntc, item % ntc, lds);
}

DI void rowop_phase(const Params& p, bool hasY, bool xin_input, int g_off, const float* wpost, bool hasH, const float* wpre, int sc_off, int sh_off) {
    const int lane = threadIdx.x & 63, gw = blockIdx.x * 4 + (threadIdx.x >> 6), nw = gridDim.x * 4;
    const float* mod = (const float*)(p.ws + OFF_MOD);
    for (int row = gw; row < 16384; row += nw) {
        const int v = row < 8192 ? 0 : 1 + ((row - 8192) >> 10);
        const float* xin = xin_input ? (row < 8192 ? p.x_prompt + (size_t)row * 1024 : p.x_sample + (size_t)(row - 8192) * 1024) : p.out + (size_t)row * 1024;
        char* hy = p.ws + OFF_HY + (size_t)row * 4096;
        f32x4 x[4];
#pragma unroll
        for (int i = 0; i < 4; ++i) x[i] = *(const f32x4*)(xin + lane * 4 + 256 * i);
        if (hasY) {
            f32x4 y[4];
            float ss = 0.f;
#pragma unroll
            for (int i = 0; i < 4; ++i) { y[i] = *(const f32x4*)((const float*)hy + lane * 4 + 256 * i); ss += y[i][0] * y[i][0] + y[i][1] * y[i][1] + y[i][2] * y[i][2] + y[i][3] * y[i][3]; }
            ss = wave_sum(ss);
            const float rs = rsqrtf(ss * (1.f / 1024.f) + EPSN);
#pragma unroll
            for (int i = 0; i < 4; ++i) {
                const int col = lane * 4 + 256 * i;
                const f32x4 g4 = *(const f32x4*)(mod + v * 6144 + g_off + col);
                const f32x4 wp = *(const f32x4*)(wpost + col);
                x[i] += g4 * (y[i] * rs * wp);
                *(f32x4*)(p.out + (size_t)row * 1024 + col) = x[i];
            }
        }
        if (hasH) {
            float ss = 0.f;
#pragma unroll
            for (int i = 0; i < 4; ++i) ss += x[i][0] * x[i][0] + x[i][1] * x[i][1] + x[i][2] * x[i][2] + x[i][3] * x[i][3];
            ss = wave_sum(ss);
            const float rs = rsqrtf(ss * (1.f / 1024.f) + EPSN);
#pragma unroll
            for (int i = 0; i < 4; ++i) {
                const int col = lane * 4 + 256 * i;
                const f32x4 sc = *(const f32x4*)(mod + v * 6144 + sc_off + col);
                const f32x4 sh = *(const f32x4*)(mod + v * 6144 + sh_off + col);
                const f32x4 wp = *(const f32x4*)(wpre + col);
                const f32x4 h = x[i] * rs * wp * (sc + 1.f) + sh;
                u32x2 o = {pk2(h[0], h[1]), pk2(h[2], h[3])};
                *(u32x2*)((bf16_t*)hy + col) = o;
            }
        }
    }
}

template <bool SWAP>
DI void gemm_kloop(const bf16_t* __restrict__ A, int lda, const bf16_t* __restrict__ Bt, int K, char* lds, f32x4 (&acc)[4][4]) {
    const int tid = threadIdx.x, lane = tid & 63, w = tid >> 6, wr = w >> 1, wc = w & 1, fr = lane & 15, fq = lane >> 4;
    const int sr = tid >> 3, sc = tid & 7;
    const bf16_t* ga = A + (size_t)sr * lda + sc * 8;
    const bf16_t* gb = Bt + (size_t)sr * K + sc * 8;
    u32x4 ra[4], rb[4];
#pragma unroll
    for (int i = 0; i < 4; ++i) { ra[i] = *(const u32x4*)(ga + (size_t)(32 * i) * lda); rb[i] = *(const u32x4*)(gb + (size_t)(32 * i) * K); }
    const int wofs = swz128(sr, sc);
#pragma unroll
    for (int i = 0; i < 4; ++i) { *(u32x4*)(lds + wofs + i * 4096) = ra[i]; *(u32x4*)(lds + 16384 + wofs + i * 4096) = rb[i]; }
    __syncthreads();
    const int nk = K >> 6;
    const int swf = (fr >> 1) & 7;
    const int aofs = (wr * 64 + fr) * 128, bofs = 16384 + (wc * 64 + fr) * 128;
    for (int kt = 0; kt < nk; ++kt) {
        const bool more = kt + 1 < nk;
        if (more) {
            ga += 64; gb += 64;
#pragma unroll
            for (int i = 0; i < 4; ++i) { ra[i] = *(const u32x4*)(ga + (size_t)(32 * i) * lda); rb[i] = *(const u32x4*)(gb + (size_t)(32 * i) * K); }
        }
        const char* buf = lds + (kt & 1) * 32768;
#pragma unroll
        for (int ks = 0; ks < 2; ++ks) {
            bf16x8 af[4], bfr[4];
            const int co = ((ks * 4 + fq) ^ swf) << 4;
#pragma unroll
            for (int m = 0; m < 4; ++m) af[m] = *(const bf16x8*)(buf + aofs + m * 2048 + co);
#pragma unroll
            for (int n = 0; n < 4; ++n) bfr[n] = *(const bf16x8*)(buf + bofs + n * 2048 + co);
#pragma unroll
            for (int m = 0; m < 4; ++m)
#pragma unroll
                for (int n = 0; n < 4; ++n) acc[m][n] = SWAP ? MFMA16(bfr[n], af[m], acc[m][n]) : MFMA16(af[m], bfr[n], acc[m][n]);
        }
        if (more) {
            char* nb = lds + ((kt + 1) & 1) * 32768;
#pragma unroll
            for (int i = 0; i < 4; ++i) { *(u32x4*)(nb + wofs + i * 4096) = ra[i]; *(u32x4*)(nb + 16384 + wofs + i * 4096) = rb[i]; }
        }
        __syncthreads();
    }
}

enum { EPI_PE = 0, EPI_PO = 1, EPI_Y = 2, EPI_W1 = 3 };

DI void rope_swapped(f32x4 (&acc)[4][4], int row0w, int fr, int fq) {
    float inv[4];
#pragma unroll
    for (int j = 0; j < 4; ++j) inv[j] = exp2f(-(float)(fq * 4 + j) * (13.287712379549449f / 16.f));
#pragma unroll
    for (int m = 0; m < 4; ++m) {
        const int tl = (row0w + m * 16 + fr - 8192) & 1023;
        const float prow = (float)(tl >> 6), pcol = (float)(tl & 63);
#pragma unroll
        for (int j = 0; j < 4; ++j) {
            float s, c;
            __sincosf(prow * inv[j], &s, &c);
            float a = acc[m][0][j], b = acc[m][1][j];
            acc[m][0][j] = a * c - b * s; acc[m][1][j] = b * c + a * s;
            __sincosf(pcol * inv[j], &s, &c);
            a = acc[m][2][j]; b = acc[m][3][j];
            acc[m][2][j] = a * c - b * s; acc[m][3][j] = b * c + a * s;
        }
    }
}

DI void store_bf16_rows(const f32x4 (&acc)[4][4], bf16_t* base, int ld, int row0w, int colw, int fr, int fq) {
#pragma unroll
    for (int m = 0; m < 4; ++m) {
        bf16_t* rp = base + (size_t)(row0w + m * 16 + fr) * ld + colw + fq * 4;
#pragma unroll
        for (int n = 0; n < 4; ++n) { u32x2 o = {pk2(acc[m][n][0], acc[m][n][1]), pk2(acc[m][n][2], acc[m][n][3])}; *(u32x2*)(rp + n * 16) = o; }
    }
}
DI void store_f32_head64(const f32x4 (&acc)[4][4], float* outb, int NH, int head, int row0w, int fr, int fq) {
#pragma unroll
    for (int m = 0; m < 4; ++m) {
        const int R = row0w + m * 16 + fr, b = R >> 8, t = R & 255;
        float* rp = outb + ((size_t)(b * NH + head) * 256 + t) * 64 + fq * 4;
#pragma unroll
        for (int n = 0; n < 4; ++n) *(f32x4*)(rp + n * 16) = acc[m][n];
    }
}
DI void store_vt(const f32x4 (&acc)[4][4], bf16_t* vtseq  , int T, int t0w, int fr, int fq) {
#pragma unroll
    for (int n = 0; n < 4; ++n) {
        bf16_t* rp = vtseq + (size_t)(n * 16 + fr) * T + t0w + fq * 4;
#pragma unroll
        for (int m = 0; m < 4; ++m) { u32x2 o = {pk2(acc[m][n][0], acc[m][n][1]), pk2(acc[m][n][2], acc[m][n][3])}; *(u32x2*)(rp + m * 16) = o; }
    }
}
DI void store_f32_ns(const f32x4 (&acc)[4][4], float* ob  , int ldo, int fr, int fq) {
#pragma unroll
    for (int m = 0; m < 4; ++m)
#pragma unroll
        for (int j = 0; j < 4; ++j) {
            float* rp = ob + (size_t)(m * 16 + fq * 4 + j) * ldo + fr;
#pragma unroll
            for (int n = 0; n < 4; ++n) rp[n * 16] = acc[m][n][j];
        }
}

template <int EPI>
DI void gemm_tile(const Params& p, const bf16_t* A, int lda, const bf16_t* Bt, int K, int pm, int pn, char* lds) {
    const int tid = threadIdx.x, lane = tid & 63, w = tid >> 6, wr = w >> 1, wc = w & 1, fr = lane & 15, fq = lane >> 4;
    f32x4 acc[4][4];
#pragma unroll
    for (int m = 0; m < 4; ++m)
#pragma unroll
        for (int n = 0; n < 4; ++n) acc[m][n] = (f32x4){0.f, 0.f, 0.f, 0.f};
    const bf16_t* At = A + (size_t)pm * 128 * lda;
    const bf16_t* Btt = Bt + (size_t)pn * 128 * K;
    const int row0w = pm * 128 + wr * 64, col0w = pn * 128 + wc * 64;
    const bool latent = row0w >= 8192;
    const bool vtile = (EPI == EPI_PE && pn >= 20) || (EPI == EPI_PO && ((pn >= 8 && pn < 12) || pn == 17));
    if ((EPI == EPI_PE || EPI == EPI_PO) && vtile) {
        gemm_kloop<false>(At, lda, Btt, K, lds, acc);
        int b, t0, T; size_t seqoff;
        if (latent) { b = (row0w - 8192) >> 10; t0 = (row0w - 8192) & 1023; T = 1024; } else { b = row0w >> 8; t0 = row0w & 255; T = 256; }
        if (EPI == EPI_PE) {
            const int vc = col0w - 2560;
            bf16_t* vt = (bf16_t*)(p.ws + OFF_BIG + BIG_VT_E) + (latent ? (size_t)4194304 + ((size_t)b * 512 + vc) * 1024 : ((size_t)b * 512 + vc) * 256);
            store_vt(acc, vt, T, t0, fr, fq);
            if (!latent) store_f32_ns(acc, p.out + OUT_DIFFV + ((size_t)(b * 4 + (vc >> 7)) * 256 + t0) * 128 + (vc & 127), 128, fr, fq);
        } else if (pn < 12) {
            const int vc = col0w - 1024;
            bf16_t* vt = (bf16_t*)(p.ws + OFF_BIG + BIG_VT_C) + (latent ? (size_t)4194304 + ((size_t)b * 512 + vc) * 1024 : ((size_t)b * 512 + vc) * 256);
            store_vt(acc, vt, T, t0, fr, fq);
            if (!latent) store_f32_ns(acc, p.out + OUT_NAV + ((size_t)(b * 8 + (vc >> 6)) * 256 + t0) * 64, 64, fr, fq);
        } else {
            const int vc = col0w - 2176;
            bf16_t* vt = (bf16_t*)(p.ws + OFF_BIG + BIG_VT_D) + (latent ? (size_t)1048576 + ((size_t)b * 128 + vc) * 1024 : ((size_t)b * 128 + vc) * 256);
            store_vt(acc, vt, T, t0, fr, fq);
            if (!latent) store_f32_ns(acc, p.out + OUT_SWAV + ((size_t)(b * 2 + (vc >> 6)) * 256 + t0) * 64, 64, fr, fq);
        }
        return;
    }
    gemm_kloop<true>(At, lda, Btt, K, lds, acc);
    if (EPI == EPI_PE) {
        bf16_t* proj = (bf16_t*)(p.ws + OFF_BIG);
        if (pn >= 12 && latent) rope_swapped(acc, row0w, fr, fq);
        store_bf16_rows(acc, proj, LDE, row0w, col0w, fr, fq);
        if (pn >= 16 && !latent) store_f32_head64(acc, p.out + OUT_DIFFK, 8, (col0w - 2048) >> 6, row0w, fr, fq);
    } else if (EPI == EPI_PO) {
        bf16_t* proj = (bf16_t*)(p.ws + OFF_BIG);
        if (pn >= 12 && latent) rope_swapped(acc, row0w, fr, fq);
        const int dcol = pn >= 12 ? col0w - 512 : col0w;
        store_bf16_rows(acc, proj, LDO, row0w, dcol, fr, fq);
        if (!latent) {
            if (pn >= 4 && pn < 8) store_f32_head64(acc, p.out + OUT_NAK, 8, (col0w - 512) >> 6, row0w, fr, fq);
            else if (pn == 16) store_f32_head64(acc, p.out + OUT_SWAK, 2, (col0w - 2048) >> 6, row0w, fr, fq);
        }
    } else if (EPI == EPI_Y) {
        float* Y = (float*)(p.ws + OFF_HY);
#pragma unroll
        for (int m = 0; m < 4; ++m) {
            float* rp = Y + (size_t)(row0w + m * 16 + fr) * 1024 + col0w + fq * 4;
#pragma unroll
            for (int n = 0; n < 4; ++n) *(f32x4*)(rp + n * 16) = acc[m][n];
        }
    } else {
        bf16_t* H2 = (bf16_t*)(p.ws + OFF_BIG);
#pragma unroll
        for (int m = 0; m < 4; ++m)
#pragma unroll
            for (int n = 0; n < 4; ++n)
#pragma unroll
                for (int j = 0; j < 4; ++j) { const float v = fmaxf(acc[m][n][j], 0.f); acc[m][n][j] = v * v; }
        store_bf16_rows(acc, H2, 4096, row0w, col0w, fr, fq);
    }
}

template <int EPI>
DI void gemm_phase(const Params& p, const bf16_t* A, int lda, const bf16_t* Bt, int K, int NT_N, char* lds) {
    const int xcd = blockIdx.x & 7, lb = blockIdx.x >> 3, nlb = gridDim.x >> 3;
    const int per_xcd = 16 * NT_N;
    for (int lt = lb; lt < per_xcd; lt += nlb) {
        const int sm = lt / (8 * NT_N), r = lt % (8 * NT_N), pn = r >> 3, pm = xcd * 16 + sm * 8 + (r & 7);
        gemm_tile<EPI>(p, A, lda, Bt, K, pm, pn, lds);
    }
}

struct ASeg { const bf16_t* K; const bf16_t* Vt; int ldk, ldv, ntiles; };
struct MaskP { int on, a, b, c; const float* tab; };

template <int KW, int VR, int NB, int MODE>
DI void attn_core(const ASeg& s0, const ASeg& s1, const bf16x8 (&qf)[4], int kchunk0, int vrow0, float scale_l2, float& m, float& l, f32x16 (&O)[NB], char* lds, const MaskP& mp) {
    constexpr int KC = KW / 8, NKL = 64 * KC / 256, NVL = VR * 8 / 256;
    const int tid = threadIdx.x, lane = tid & 63, p32 = lane & 31, h = lane >> 5;
    const int krow = (p32 & 19) | ((p32 & 4) << 1) | ((p32 & 8) >> 1);
    const int n0 = s0.ntiles, nt = s0.ntiles + s1.ntiles;
    u32x4 rk[NKL], rv[NVL];
#define ATT_LOAD(t_)                                                                                                         \
    {                                                                                                                        \
        const bool f_ = (t_) < n0; const int tt_ = f_ ? (t_) : (t_) - n0;                                                     \
        const bf16_t* Kp_ = (f_ ? s0.K : s1.K); const int ldk_ = f_ ? s0.ldk : s1.ldk;                                        \
        const bf16_t* Vp_ = (f_ ? s0.Vt : s1.Vt); const int ldv_ = f_ ? s0.ldv : s1.ldv;                                      \
        _Pragma("unroll") for (int i = 0; i < NKL; ++i) { const int id = tid + 256 * i, r = id / KC, c = id % KC; rk[i] = *(const u32x4*)(Kp_ + (size_t)(tt_ * 64 + r) * ldk_ + c * 8); } \
        _Pragma("unroll") for (int i = 0; i < NVL; ++i) { const int id = tid + 256 * i, r = id >> 3, c = id & 7; rv[i] = *(const u32x4*)(Vp_ + (size_t)r * ldv_ + tt_ * 64 + c * 8); }       \
    }
#define ATT_STORE(b_)                                                                                                        \
    {                                                                                                                        \
        char* kb_ = lds + (b_) * 32768; char* vb_ = kb_ + 16384;                                                              \
        _Pragma("unroll") for (int i = 0; i < NKL; ++i) { const int id = tid + 256 * i, r = id / KC, c = id % KC; *(u32x4*)(kb_ + (KW == 128 ? swz256(r, c) : swz128(r, c))) = rk[i]; } \
        _Pragma("unroll") for (int i = 0; i < NVL; ++i) { const int id = tid + 256 * i, r = id >> 3, c = id & 7; *(u32x4*)(vb_ + swz128(r, c)) = rv[i]; }                               \
    }
    ATT_LOAD(0);
    ATT_STORE(0);
    __syncthreads();
    for (int t = 0; t < nt; ++t) {
        const bool more = t + 1 < nt;
        if (more) ATT_LOAD(t + 1);
        const char* kb = lds + (t & 1) * 32768;
        const char* vb = kb + 16384;
        f32x16 S[2];
#pragma unroll
        for (int kh = 0; kh < 2; ++kh) {
#pragma unroll
            for (int i = 0; i < 16; ++i) S[kh][i] = 0.f;
            const int row = krow + 32 * kh;
#pragma unroll
            for (int s = 0; s < 4; ++s) {
                const int c = kchunk0 + 2 * s + h;
                const bf16x8 kf = *(const bf16x8*)(kb + (KW == 128 ? swz256(row, c) : swz128(row, c)));
                S[kh] = MFMA32(kf, qf[s], S[kh]);
            }
        }
        const bool msk = (MODE != 0) && mp.on && t < n0;
        float mx = -1e30f;
        if (MODE == 1 && msk) {
            int cq = mp.c + p32;
            int h8 = 8 * h;
            asm volatile("" : "+v"(cq), "+v"(h8));
            const int cs = min(max(cq - 8, 0), 48);
            const float* tab = mp.tab + (mp.b + t - mp.a + 7) * 31;
#pragma unroll
            for (int kh = 0; kh < 2; ++kh)
#pragma unroll
                for (int i = 0; i < 16; ++i) {
                    const int kc = 32 * kh + 16 * (i >> 3) + h8 + (i & 7);
                    const bool ok = (unsigned)(kc - cs) < 16u;
                    const int dc = min(max(kc - cq + 15, 0), 30);
                    const float sv = ok ? S[kh][i] * scale_l2 + tab[dc] : -1e30f;
                    S[kh][i] = sv; mx = fmaxf(mx, sv);
                }
        } else if (MODE == 2 && msk) {
            int qp = mp.a + p32 - 8 * h;
            asm volatile("" : "+v"(qp));
            const int k0 = mp.b + t * 64;
#pragma unroll
            for (int kh = 0; kh < 2; ++kh)
#pragma unroll
                for (int i = 0; i < 16; ++i) {
                    const int d = qp - (k0 + 32 * kh + 16 * (i >> 3) + (i & 7));
                    const bool ok = d <= 128 && d >= -128;
                    const float sv = ok ? S[kh][i] * scale_l2 : -1e30f;
                    S[kh][i] = sv; mx = fmaxf(mx, sv);
                }
        } else {
#pragma unroll
            for (int kh = 0; kh < 2; ++kh)
#pragma unroll
                for (int i = 0; i < 16; ++i) { const float sv = S[kh][i] * scale_l2; S[kh][i] = sv; mx = fmaxf(mx, sv); }
        }
        mx = fmaxf(mx, __shfl_xor(mx, 32));
        const float mn = fmaxf(m, mx);
        const float alpha = __builtin_amdgcn_exp2f(m - mn);
        m = mn;
        float ls = 0.f;
#pragma unroll
        for (int kh = 0; kh < 2; ++kh)
#pragma unroll
            for (int i = 0; i < 16; ++i) { const float pv = __builtin_amdgcn_exp2f(S[kh][i] - mn); S[kh][i] = pv; ls += pv; }
        l = l * alpha + ls;
#pragma unroll
        for (int blk = 0; blk < NB; ++blk)
#pragma unroll
            for (int i = 0; i < 16; ++i) O[blk][i] *= alpha;
#pragma unroll
        for (int kh = 0; kh < 2; ++kh)
#pragma unroll
            for (int s2 = 0; s2 < 2; ++s2) {
                u32x4 pp = {pk2(S[kh][8 * s2 + 0], S[kh][8 * s2 + 1]), pk2(S[kh][8 * s2 + 2], S[kh][8 * s2 + 3]), pk2(S[kh][8 * s2 + 4], S[kh][8 * s2 + 5]), pk2(S[kh][8 * s2 + 6], S[kh][8 * s2 + 7])};
                const bf16x8 pb = __builtin_bit_cast(bf16x8, pp);
                const int c = 4 * kh + 2 * s2 + h;
#pragma unroll
                for (int blk = 0; blk < NB; ++blk) {
                    const bf16x8 vf = *(const bf16x8*)(vb + swz128(vrow0 + blk * 32 + p32, c));
                    O[blk] = MFMA32(vf, pb, O[blk]);
                }
            }
        if (more) ATT_STORE((t + 1) & 1);
        __syncthreads();
    }
    l += __shfl_xor(l, 32);
#undef ATT_LOAD
#undef ATT_STORE
}

DI void load_q(bf16x8 (&qf)[4], const bf16_t* qrow, int h) {
#pragma unroll
    for (int s = 0; s < 4; ++s) qf[s] = *(const bf16x8*)(qrow + 16 * s + 8 * h);
}

DI void attn_diff_item(const Params& p, int item, char* lds) {
    const int tid = threadIdx.x, lane = tid & 63, w = tid >> 6, p32 = lane & 31, h = lane >> 5, stream = w & 1, qh = w >> 1;
    const bf16_t* proj = (const bf16_t*)(p.ws + OFF_BIG);
    const bf16_t* vte = (const bf16_t*)(p.ws + OFF_BIG + BIG_VT_E);
    bf16_t* mix = (bf16_t*)(p.ws + OFF_BIG + BIG_MIXIN);
    int b, hd, qb, rowbase; ASeg s0, s1;
    if (item < 512) {
        b = item >> 6; hd = (item >> 4) & 3; qb = item & 15; rowbase = 8192 + b * 1024;
        s0 = {proj + (size_t)rowbase * LDE + 2048 + hd * 128, vte + 4194304 + ((size_t)b * 512 + hd * 128) * 1024, LDE, 1024, 16};
        s1 = {(const bf16_t*)(p.ws + OFF_CDK) + (size_t)b * 256 * 512 + hd * 128, (const bf16_t*)(p.ws + OFF_CDVT) + (size_t)(b * 4 + hd) * 128 * 256, 512, 256, 4};
    } else {
        const int it = item - 512;
        b = it >> 4; hd = (it >> 2) & 3; qb = it & 3; rowbase = b * 256;
        s0 = {proj + (size_t)rowbase * LDE + 2048 + hd * 128, vte + ((size_t)b * 512 + hd * 128) * 256, LDE, 256, 4};
        s1 = s0; s1.ntiles = 0;
    }
    const int R = rowbase + qb * 64 + qh * 32 + p32;
    bf16x8 qf[4];
    load_q(qf, proj + (size_t)R * LDE + 1536 + hd * 128 + stream * 64, h);
    f32x16 O[4];
#pragma unroll
    for (int blk = 0; blk < 4; ++blk)
#pragma unroll
        for (int i = 0; i < 16; ++i) O[blk][i] = 0.f;
    float m = -1e30f, l = 0.f;
    MaskP mp = {0, 0, 0, 0, nullptr};
    attn_core<128, 128, 4, 0>(s0, s1, qf, stream * 8, 0, 0.125f * LOG2E, m, l, O, lds, mp);
    const float il = 1.f / l;
    const float d1 = wave_sum(p.lq1[lane] * p.lk1[lane]), d2 = wave_sum(p.lq2[lane] * p.lk2[lane]);
    const float lam_init = 0.2f;
    const float lam = __expf(d1) - __expf(d2) + lam_init;
    float* xb = (float*)(lds + qh * 16384);
    if (stream == 1) {
#pragma unroll
        for (int blk = 0; blk < 4; ++blk)
#pragma unroll
            for (int i = 0; i < 16; ++i) { const int dv = blk * 32 + 8 * (i >> 2) + 4 * h + (i & 3); xb[dv * 32 + p32] = O[blk][i] * il; }
    }
    __syncthreads();
    if (stream == 0) {
        float ss = 0.f;
#pragma unroll
        for (int blk = 0; blk < 4; ++blk)
#pragma unroll
            for (int i = 0; i < 16; ++i) { const int dv = blk * 32 + 8 * (i >> 2) + 4 * h + (i & 3); const float o = O[blk][i] * il - lam * xb[dv * 32 + p32]; O[blk][i] = o; ss += o * o; }
        ss += __shfl_xor(ss, 32);
        const float rs = rsqrtf(ss * (1.f / 128.f) + EPSN) * (1.f - lam_init);
        bf16_t* op = mix + (size_t)R * 1024 + 512 + hd * 128;
#pragma unroll
        for (int blk = 0; blk < 4; ++blk)
#pragma unroll
            for (int g = 0; g < 4; ++g) {
                const int dv = blk * 32 + 8 * g + 4 * h;
                const f32x4 sl = *(const f32x4*)(p.subln + dv);
                u32x2 o = {pk2(O[blk][4 * g] * rs * sl[0], O[blk][4 * g + 1] * rs * sl[1]), pk2(O[blk][4 * g + 2] * rs * sl[2], O[blk][4 * g + 3] * rs * sl[3])};
                *(u32x2*)(op + dv) = o;
            }
    }
    __syncthreads();
}

DI void attn_c_item(const Params& p, int item, char* lds) {
    const int tid = threadIdx.x, lane = tid & 63, w = tid >> 6, p32 = lane & 31, h = lane >> 5, stream = w & 1, qh = w >> 1;
    const bf16_t* proj = (const bf16_t*)(p.ws + OFF_BIG);
    const bf16_t* vtc = (const bf16_t*)(p.ws + OFF_BIG + BIG_VT_C);
    bf16_t* mix = (bf16_t*)(p.ws + OFF_BIG + BIG_MIXIN);
    int b, hp, qb, rowbase; ASeg s0, s1; MaskP mp = {0, 0, 0, 0, nullptr};
    float* tab = (float*)(lds + 65536);
    if (item < 512) {
        b = item >> 6; hp = (item >> 4) & 3; qb = item & 15; rowbase = 8192 + b * 1024;
        const int rstart = min(max(qb - 4, 0), 8);
        s0 = {proj + (size_t)(rowbase + rstart * 64) * LDO + 512 + hp * 128, vtc + 4194304 + ((size_t)b * 512 + hp * 128) * 1024 + rstart * 64, LDO, 1024, 8};
        s1 = {(const bf16_t*)(p.ws + OFF_CNK) + (size_t)b * 256 * 512 + hp * 128, (const bf16_t*)(p.ws + OFF_CNVT) + ((size_t)b * 512 + hp * 128) * 256, 512, 256, 4};
        for (int idx = tid; idx < 930; idx += 256) tab[idx] = p.rpb[hp * 930 + idx] * LOG2E;
        mp = {1, qb, rstart, qh * 32, tab + stream * 465};
    } else {
        const int it = item - 512;
        b = it >> 4; hp = (it >> 2) & 3; qb = it & 3; rowbase = b * 256;
        s0 = {proj + (size_t)rowbase * LDO + 512 + hp * 128, vtc + ((size_t)b * 512 + hp * 128) * 256, LDO, 256, 4};
        s1 = s0; s1.ntiles = 0;
    }
    const int R = rowbase + qb * 64 + qh * 32 + p32;
    const int head = hp * 2 + stream;
    bf16x8 qf[4];
    load_q(qf, proj + (size_t)R * LDO + head * 64, h);
    f32x16 O[2];
#pragma unroll
    for (int blk = 0; blk < 2; ++blk)
#pragma unroll
        for (int i = 0; i < 16; ++i) O[blk][i] = 0.f;
    float m = -1e30f, l = 0.f;
    attn_core<128, 128, 2, 1>(s0, s1, qf, stream * 8, stream * 64, 0.125f * LOG2E, m, l, O, lds, mp);
    const float il = 1.f / l;
    bf16_t* op = mix + (size_t)R * 1024 + head * 64;
#pragma unroll
    for (int blk = 0; blk < 2; ++blk)
#pragma unroll
        for (int g = 0; g < 4; ++g) {
            const int dv = blk * 32 + 8 * g + 4 * h;
            u32x2 o = {pk2(O[blk][4 * g] * il, O[blk][4 * g + 1] * il), pk2(O[blk][4 * g + 2] * il, O[blk][4 * g + 3] * il)};
            *(u32x2*)(op + dv) = o;
        }
}

DI void attn_d_item(const Params& p, int item, char* lds) {
    const int tid = threadIdx.x, lane = tid & 63, w = tid >> 6, p32 = lane & 31, h = lane >> 5;
    const bf16_t* proj = (const bf16_t*)(p.ws + OFF_BIG);
    const bf16_t* vtd = (const bf16_t*)(p.ws + OFF_BIG + BIG_VT_D);
    bf16_t* mix = (bf16_t*)(p.ws + OFF_BIG + BIG_MIXIN);
    int b, g, qb, rowbase; ASeg s0, s1; MaskP mp = {0, 0, 0, 0, nullptr};
    if (item < 512) {
        b = item >> 6; g = (item >> 5) & 1; qb = item & 31; rowbase = 8192 + b * 1024;
        const int q0 = qb * 32;
        const int tlo = max(q0 - 128, 0) >> 6, thi = min(q0 + 159, 1023) >> 6;
        s0 = {proj + (size_t)(rowbase + tlo * 64) * LDO + 1536 + g * 64, vtd + 1048576 + ((size_t)b * 128 + g * 64) * 1024 + tlo * 64, LDO, 1024, thi - tlo + 1};
        s1 = {(const bf16_t*)(p.ws + OFF_CSK) + (size_t)b * 256 * 128 + g * 64, (const bf16_t*)(p.ws + OFF_CSVT) + ((size_t)b * 128 + g * 64) * 256, 128, 256, 4};
        mp = {1, q0, tlo * 64, 0, nullptr};
    } else {
        const int it = item - 512;
        b = it >> 4; g = (it >> 3) & 1; qb = it & 7; rowbase = b * 256;
        s0 = {proj + (size_t)rowbase * LDO + 1536 + g * 64, vtd + ((size_t)b * 128 + g * 64) * 256, LDO, 256, 4};
        s1 = s0; s1.ntiles = 0;
    }
    const int R = rowbase + qb * 32 + p32;
    const int hq = g * 4 + w;
    bf16x8 qf[4];
    load_q(qf, proj + (size_t)R * LDO + 1024 + hq * 64, h);
    f32x16 O[2];
#pragma unroll
    for (int blk = 0; blk < 2; ++blk)
#pragma unroll
        for (int i = 0; i < 16; ++i) O[blk][i] = 0.f;
    float m = p.sink[hq] * LOG2E, l = h == 0 ? 1.f : 0.f;
    attn_core<64, 64, 2, 2>(s0, s1, qf, 0, 0, 0.125f * LOG2E, m, l, O, lds, mp);
    const float il = 1.f / l;
    bf16_t* op = mix + (size_t)R * 1024 + 512 + hq * 64;
#pragma unroll
    for (int blk = 0; blk < 2; ++blk)
#pragma unroll
        for (int gg = 0; gg < 4; ++gg) {
            const int dv = blk * 32 + 8 * gg + 4 * h;
            u32x2 o = {pk2(O[blk][4 * gg] * il, O[blk][4 * gg + 1] * il), pk2(O[blk][4 * gg + 2] * il, O[blk][4 * gg + 3] * il)};
            *(u32x2*)(op + dv) = o;
        }
}

DI void conv_item(const Params& p, int item) {
    const int tid = threadIdx.x;
    const bf16_t* proj = (const bf16_t*)(p.ws + OFF_BIG);
    bf16_t* mix = (bf16_t*)(p.ws + OFF_BIG + BIG_MIXIN);
#pragma unroll 2
    for (int i = 0; i < 8; ++i) {
        const int idx = tid + 256 * i, tl = idx >> 6, ch = (idx & 63) * 8;
        const int R = item * 32 + tl;
        int t, T;
        if (R < 8192) { t = R & 255; T = 256; } else { t = (R - 8192) & 1023; T = 1024; }
        const bf16_t* rp = proj + (size_t)R * LDE + ch;
        const u32x4 ab = *(const u32x4*)(rp);
        float accv[8];
#pragma unroll
        for (int e = 0; e < 8; ++e) accv[e] = 0.f;
#pragma unroll
        for (int j = 0; j < 3; ++j) {
            const int tt = t + j - 1;
            if (tt >= 0 && tt < T) {
                const u32x4 ac = *(const u32x4*)(rp + (ptrdiff_t)(j - 1) * LDE + 512);
                const u32x4 ax = *(const u32x4*)(rp + (ptrdiff_t)(j - 1) * LDE + 1024);
                const f32x4 w0 = *(const f32x4*)(p.conv_w + j * 512 + ch), w1 = *(const f32x4*)(p.conv_w + j * 512 + ch + 4);
#pragma unroll
                for (int e = 0; e < 4; ++e) {
                    accv[2 * e] += bflo(ac[e]) * bflo(ax[e]) * (e < 2 ? w0[2 * e] : w1[2 * e - 4]);
                    accv[2 * e + 1] += bfhi(ac[e]) * bfhi(ax[e]) * (e < 2 ? w0[2 * e + 1] : w1[2 * e - 3]);
                }
            }
        }
        u32x4 o;
#pragma unroll
        for (int e = 0; e < 4; ++e) o[e] = pk2(bflo(ab[e]) * accv[2 * e], bfhi(ab[e]) * accv[2 * e + 1]);
        *(u32x4*)(mix + (size_t)R * 1024 + ch) = o;
    }
}


#define XB_TMO      128
#define XB_XCNT(j)  (256  + 64 * (j))
#define XB_XSUB(j)  (1280 + 64 * (j))
#define XB_XGEN(j)  (2304 + 64 * (j))
#define XB_TOP      3328
#define XB_TOPGEN   3392
#define XCD_BAR_WORDS 3456
#define XB_SPIN_CAP (1u << 22)
#define LAS __attribute__((address_space(3)))
DI unsigned xb_ld(unsigned* p) { return __hip_atomic_load(p, __ATOMIC_RELAXED, __HIP_MEMORY_SCOPE_AGENT); }
DI unsigned xb_add(unsigned* p, unsigned v) { return __hip_atomic_fetch_add(p, v, __ATOMIC_RELAXED, __HIP_MEMORY_SCOPE_AGENT); }
DI unsigned xb_xcc_id() { return (unsigned)__builtin_amdgcn_s_getreg((3 << 11) | 20) & 0xFu; }
#define XB_SPIN(cond, bar) do { unsigned _sp = 0; while (cond) { __builtin_amdgcn_s_sleep(1); \
    if ((++_sp & 255u) == 0u) { if (xb_ld(&(bar)[XB_TMO])) break; if (_sp > XB_SPIN_CAP) { atomicAdd(&(bar)[XB_TMO], 1u); break; } } } } while (0)
struct XcdBarrier { unsigned* bar; unsigned x; volatile LAS unsigned* st; };
DI XcdBarrier xcd_barrier_post(unsigned* bar, volatile LAS unsigned* st) {
    XcdBarrier b; b.bar = bar; b.x = xb_xcc_id(); b.st = st;
    if (threadIdx.x == 0) (void)xb_add(&bar[XB_XCNT(b.x)], 1u);
    return b;
}
DI void xcd_barrier_complete(unsigned* bar, unsigned x, unsigned& nloc, unsigned& nx) {
    const unsigned G = gridDim.x * gridDim.y * gridDim.z;
    unsigned sum, cnt, mine, sp = 0u;
    for (;;) {
        sum = 0u; cnt = 0u; mine = 0u;
#pragma unroll
        for (unsigned j = 0; j < 16; ++j) { const unsigned c = xb_ld(&bar[XB_XCNT(j)]); sum += c; cnt += (c > 0u) ? 1u : 0u; mine = (j == x) ? c : mine; }
        if (sum == G) break;
        __builtin_amdgcn_s_sleep(1);
        if ((++sp & 255u) == 0u) { if (xb_ld(&bar[XB_TMO])) break; if (sp > XB_SPIN_CAP) { atomicAdd(&bar[XB_TMO], 1u); break; } }
    }
    nloc = mine > 0u ? mine : 1u; nx = cnt > 0u ? cnt : 1u;
}
DI void xcd_barrier(const XcdBarrier& b) {
    asm volatile("s_waitcnt vmcnt(0)" ::: "memory");
    __syncthreads();
    if (threadIdx.x == 0) {
        unsigned* bar = b.bar;
        __builtin_amdgcn_s_waitcnt(0);
        unsigned nloc = b.st[0], nx = b.st[1];
        if (nloc == 0u) { xcd_barrier_complete(bar, b.x, nloc, nx); b.st[0] = nloc; b.st[1] = nx; }
        const unsigned old = xb_add(&bar[XB_XSUB(b.x)], 1u);
        const unsigned gen = old / nloc;
        if (old + 1u == (gen + 1u) * nloc) {
            __builtin_amdgcn_fence(__ATOMIC_RELEASE, "agent");
            asm volatile("s_waitcnt vmcnt(0)" ::: "memory");
            const unsigned og = xb_add(&bar[XB_TOP], 1u);
            const unsigned tg = og / nx;
            if (og + 1u == (tg + 1u) * nx) xb_add(&bar[XB_TOPGEN], 1u);
            else XB_SPIN(xb_ld(&bar[XB_TOPGEN]) == tg, bar);
            __builtin_amdgcn_fence(__ATOMIC_ACQUIRE, "agent");
            xb_add(&bar[XB_XGEN(b.x)], 1u);
            asm volatile("s_waitcnt vmcnt(0)" ::: "memory");
        } else {
            XB_SPIN(xb_ld(&bar[XB_XGEN(b.x)]) == gen, bar);
            __builtin_amdgcn_fence(__ATOMIC_ACQUIRE, "agent");
            asm volatile("s_waitcnt vmcnt(0)" ::: "memory");
        }
    }
    __syncthreads();
}

constexpr int N_PHASES = 16;
DI void run_phase(const Params& p, int ph, char* lds) {
    const int nb = gridDim.x, bid = blockIdx.x;
    const bf16_t* hy = (const bf16_t*)(p.ws + OFF_HY);
    const bf16_t* big = (const bf16_t*)(p.ws + OFF_BIG);
    const bf16_t* mixin = (const bf16_t*)(p.ws + OFF_BIG + BIG_MIXIN);
    switch (ph) {
    case 0: for (int it = bid; it < P0_ITEMS; it += nb) p0_item(p, it, lds); break;
    case 1: rowop_phase(p, false, true, 0, nullptr, true, p.norm_mix_pre, 1024, 0); break;
    case 2: gemm_phase<EPI_PE>(p, hy, 2048, (const bf16_t*)(p.ws + OFF_WINE), 1024, 24, lds); break;
    case 3:
        for (int it = bid; it < 1536; it += nb) { if (it < 1024) attn_diff_item(p, it, lds); else conv_item(p, it - 1024); }
        break;
    case 4: gemm_phase<EPI_Y>(p, mixin, 1024, (const bf16_t*)(p.ws + OFF_WOUT), 1024, 8, lds); break;
    case 5: rowop_phase(p, true, true, 2048, p.norm_mix_post, true, p.norm_mlp_pre, 4096, 3072); break;
    case 6: gemm_phase<EPI_W1>(p, hy, 2048, (const bf16_t*)(p.ws + OFF_W1), 1024, 32, lds); break;
    case 7: gemm_phase<EPI_Y>(p, big, 4096, (const bf16_t*)(p.ws + OFF_W2), 4096, 8, lds); break;
    case 8: rowop_phase(p, true, false, 5120, p.norm_mlp_post, true, p.norm_mix_pre + 1024, 9 * 6144 + 1024, 9 * 6144 + 0); break;
    case 9: gemm_phase<EPI_PO>(p, hy, 2048, (const bf16_t*)(p.ws + OFF_WINO), 1024, 18, lds); break;
    case 10:
        for (int it = bid; it < 2048; it += nb) {
            const int q = it >> 9, r = it & 511;
            if (q & 1) attn_d_item(p, (q >> 1) * 512 + r, lds); else attn_c_item(p, (q >> 1) * 512 + r, lds);
        }
        break;
    case 11: gemm_phase<EPI_Y>(p, mixin, 1024, (const bf16_t*)(p.ws + OFF_WOUT) + 1048576, 1024, 8, lds); break;
    case 12: rowop_phase(p, true, false, 9 * 6144 + 2048, p.norm_mix_post + 1024, true, p.norm_mlp_pre + 1024, 9 * 6144 + 4096, 9 * 6144 + 3072); break;
    case 13: gemm_phase<EPI_W1>(p, hy, 2048, (const bf16_t*)(p.ws + OFF_W1) + 4194304, 1024, 32, lds); break;
    case 14: gemm_phase<EPI_Y>(p, big, 4096, (const bf16_t*)(p.ws + OFF_W2) + 4194304, 4096, 8, lds); break;
    case 15: rowop_phase(p, true, false, 9 * 6144 + 5120, p.norm_mlp_post + 1024, false, nullptr, 0, 0); break;
    }
}

__global__ void __launch_bounds__(256, 2) fwd_mega(Params p) {
    __shared__ __attribute__((aligned(16))) char lds[LDS_BYTES];
    __shared__ uint4 xb_words;
    cg::grid_group grid = cg::this_grid();
    if (threadIdx.x == 0) xb_words = make_uint4(0u, 0u, 0u, 0u);
    __syncthreads();
    const XcdBarrier xb = xcd_barrier_post((unsigned*)(p.ws + OFF_BAR), (volatile LAS unsigned*)&xb_words);
#define PH_(n) run_phase(p, n, lds); xcd_barrier(xb); if ((DUP_MASK >> n) & 1) { run_phase(p, n, lds); xcd_barrier(xb); }
    run_phase(p, 0, lds);
    grid.sync();
    PH_(1) PH_(2) PH_(3) PH_(4) PH_(5) PH_(6) PH_(7) PH_(8) PH_(9) PH_(10) PH_(11) PH_(12) PH_(13) PH_(14)
    run_phase(p, 15, lds);
#undef PH_
}

__global__ void __launch_bounds__(256, 2) fwd_phase(Params p, int ph) {
    __shared__ __attribute__((aligned(16))) char lds[LDS_BYTES];
    run_phase(p, ph, lds);
}

extern "C" void kernel_launch(void* const* d_in, const int* in_sizes, int n_in, void* d_out, int out_size, void* d_ws, size_t ws_size, hipStream_t stream) {
    Params p{};
    const float** pp = (const float**)&p;
    for (int i = 0; i < 29; ++i) pp[i] = (const float*)d_in[i];
    p.out = (float*)d_out;
    p.ws = (char*)d_ws;
    if (ws_size < WS_NEEDED) { fprintf(stderr, "workspace too small: %zu < %zu\n", ws_size, (size_t)WS_NEEDED); return; }
    static int grid_blocks = 0;
    if (!grid_blocks) {
        int dev = 0, cus = 0, per_cu = 0;
        hipGetDevice(&dev);
        hipDeviceGetAttribute(&cus, hipDeviceAttributeMultiprocessorCount, dev);
        hipOccupancyMaxActiveBlocksPerMultiprocessor(&per_cu, fwd_mega, 256, 0);
        if (per_cu > 2) per_cu = 2;
        if (per_cu < 1) per_cu = 1;
        grid_blocks = cus * per_cu;
        grid_blocks -= grid_blocks % 8;
    }
#if ONE_LAUNCH
    (void)hipMemsetAsync((char*)d_ws + OFF_BAR, 0, XCD_BAR_WORDS * 4, stream);
    void* args[] = {&p};
    hipError_t e = hipLaunchCooperativeKernel((void*)fwd_mega, dim3(grid_blocks), dim3(256), args, 0, stream);
    if (e != hipSuccess) fprintf(stderr, "cooperative launch failed: %s (grid %d)\n", hipGetErrorString(e), grid_blocks);
#else
    for (int ph = 0; ph < N_PHASES; ++ph) fwd_phase<<<grid_blocks, 256, 0, stream>>>(p, ph);
#endif
}
```

```cpp
#include <hip/hip_runtime.h>
#include <hip/hip_cooperative_groups.h>
#include <cstdio>
#include <cstdint>
namespace cg = cooperative_groups;

#ifndef DUP_MASK
#define DUP_MASK 0
#endif
#ifndef ONE_LAUNCH
#define ONE_LAUNCH 1
#endif

typedef unsigned short bf16_t;
typedef short bf16x8 __attribute__((ext_vector_type(8)));
typedef float f32x4 __attribute__((ext_vector_type(4)));
typedef float f32x2 __attribute__((ext_vector_type(2)));
typedef float f32x16 __attribute__((ext_vector_type(16)));
typedef unsigned u32x4 __attribute__((ext_vector_type(4)));
typedef unsigned u32x2 __attribute__((ext_vector_type(2)));
typedef __bf16 bfv2 __attribute__((ext_vector_type(2)));
#define DI __device__ __forceinline__
DI int launder_v(int v) { asm volatile("" : "+v"(v)); return v; }
#define TIDX launder_v((int)threadIdx.x)
#define VTID (TIDX & 255)
#define VHALF (TIDX >> 8)
#define VBID ((int)(blockIdx.x * 2) + (TIDX >> 8))
#define VNB ((int)(gridDim.x * 2))
#define MFMA32(a, b, c) __builtin_amdgcn_mfma_f32_32x32x16_bf16((a), (b), (c), 0, 0, 0)
#define MFMA16(a, b, c) __builtin_amdgcn_mfma_f32_16x16x32_bf16((a), (b), (c), 0, 0, 0)

constexpr float LOG2E = 1.4426950408889634f;
constexpr float EPSN = 1e-6f;

struct Params {
    const float *x_prompt, *x_sample, *cache_diff_k, *cache_diff_v, *cache_na_k, *cache_na_v, *cache_swa_k, *cache_swa_v, *c, *c_ctx;
    const float *mod_w, *mod_b, *norm_mix_pre, *norm_mix_post, *norm_mlp_pre, *norm_mlp_post, *w_in_even, *conv_w, *lq1, *lk1, *lq2, *lk2, *subln;
    const float *w_in_odd, *rpb, *sink, *w_out, *mlp_w1, *mlp_w2;
    float* out;
    char* ws;
};

constexpr size_t OFF_MOD = 0;
constexpr size_t OFF_BAR = 458752;
constexpr size_t OFF_WINE = 524288;
constexpr size_t OFF_WINO = OFF_WINE + 6291456;
constexpr size_t OFF_WOUT = OFF_WINO + 4718592;
constexpr size_t OFF_W1 = OFF_WOUT + 4194304;
constexpr size_t OFF_W2 = OFF_W1 + 16777216;
constexpr size_t OFF_CDK = OFF_W2 + 16777216;
constexpr size_t OFF_CDVT = OFF_CDK + 2097152;
constexpr size_t OFF_CNK = OFF_CDVT + 2097152;
constexpr size_t OFF_CNVT = OFF_CNK + 2097152;
constexpr size_t OFF_CSK = OFF_CNVT + 2097152;
constexpr size_t OFF_CSVT = OFF_CSK + 524288;
constexpr size_t OFF_HY = OFF_CSVT + 524288;
constexpr size_t OFF_BIG = OFF_HY + 67108864;
constexpr size_t WS_NEEDED = OFF_BIG + 134217728;
constexpr size_t BIG_VT_E = 83886080;
constexpr size_t BIG_VT_C = 54525952;
constexpr size_t BIG_VT_D = BIG_VT_C + 16777216;
constexpr size_t BIG_MIXIN = 100663296;
constexpr int LDE = 2560, LDO = 1664;
constexpr size_t OUT_DIFFK = 16777216, OUT_DIFFV = 20971520, OUT_NAK = 25165824, OUT_NAV = 29360128, OUT_SWAK = 33554432, OUT_SWAV = 34603008;

constexpr int LDS_HALF = 65536 + 4096;
constexpr int LDS_BYTES = 2 * LDS_HALF;

DI unsigned pk2(float a, float b) { f32x2 v = {a, b}; bfv2 r = __builtin_convertvector(v, bfv2); return __builtin_bit_cast(unsigned, r); }
DI float bflo(unsigned u) { return __uint_as_float(u << 16); }
DI float bfhi(unsigned u) { return __uint_as_float(u & 0xffff0000u); }
DI float wave_sum(float v) {
#pragma unroll
    for (int o = 1; o < 64; o <<= 1) v += __shfl_xor(v, o);
    return v;
}
DI int swz128(int r, int c) { return r * 128 + ((c ^ ((r >> 1) & 7)) << 4); }
DI int swz256(int r, int c) { return r * 256 + ((c ^ (r & 15)) << 4); }

DI void p0_mod_item(const Params& p, int item, char* lds) {
    const int li = item / 96, cb = item % 96;
    const int tid = VTID, lane = tid & 63, w = tid >> 6;
    const float* W = p.mod_w + (size_t)li * 1024 * 6144 + cb * 64 + lane;
    float acc[9];
#pragma unroll
    for (int v = 0; v < 9; ++v) acc[v] = 0.f;
    for (int kc = 0; kc < 4; ++kc) {
        const int kb = w * 256 + kc * 64;
        float s[9];
        { const float cv = p.c_ctx[kb + lane]; s[0] = cv / (1.f + __expf(-cv)); }
#pragma unroll
        for (int v = 1; v < 9; ++v) { const float cv = p.c[(v - 1) * 1024 + kb + lane]; s[v] = cv / (1.f + __expf(-cv)); }
#pragma unroll
        for (int kk = 0; kk < 64; ++kk) {
            const float wv = W[(size_t)(kb + kk) * 6144];
#pragma unroll
            for (int v = 0; v < 9; ++v) acc[v] += __int_as_float(__builtin_amdgcn_readlane(__float_as_int(s[v]), kk)) * wv;
        }
    }
    float* red = (float*)lds;
#pragma unroll
    for (int v = 0; v < 9; ++v) red[(w * 9 + v) * 64 + lane] = acc[v];
    __syncthreads();
    float* mod = (float*)(p.ws + OFF_MOD);
    for (int idx = tid; idx < 576; idx += 256) {
        const int v = idx >> 6, col = idx & 63;
        const float sum = red[(0 * 9 + v) * 64 + col] + red[(1 * 9 + v) * 64 + col] + red[(2 * 9 + v) * 64 + col] + red[(3 * 9 + v) * 64 + col];
        mod[(li * 9 + v) * 6144 + cb * 64 + col] = sum + p.mod_b[li * 6144 + cb * 64 + col];
    }
    __syncthreads();
}

DI void p0_transpose_tile(const float* __restrict__ in, bf16_t* __restrict__ out, int R, int C, int tr, int tc, char* lds) {
    const int tid = VTID;
    const int cl = (tid & 15) * 4, rl = (tid >> 4) * 2, sw = tid & 7;
#pragma unroll
    for (int i = 0; i < 2; ++i) {
        const int r = rl + 32 * i;
        const f32x4 a = *(const f32x4*)(in + (size_t)(tr * 64 + r) * C + tc * 64 + cl);
        const f32x4 b = *(const f32x4*)(in + (size_t)(tr * 64 + r + 1) * C + tc * 64 + cl);
#pragma unroll
        for (int j = 0; j < 4; ++j) *(unsigned*)(lds + (cl + j) * 128 + (((r >> 3) ^ sw) << 4) + (r & 7) * 2) = pk2(a[j], b[j]);
    }
    __syncthreads();
#pragma unroll
    for (int i = 0; i < 2; ++i) {
        const int idx = tid + 256 * i, c = idx >> 3, q = idx & 7;
        const u32x4 v = *(const u32x4*)(lds + c * 128 + ((q ^ ((c >> 2) & 7)) << 4));
        *(u32x4*)(out + (size_t)(tc * 64 + c) * R + tr * 64 + q * 8) = v;
    }
    __syncthreads();
}

DI void p0_kreorder(const float* __restrict__ in, bf16_t* __restrict__ out, int logH, int item) {
    const int tid = VTID, H = 1 << logH;
#pragma unroll
    for (int i = 0; i < 4; ++i) {
        const int f = item * 1024 + tid + 256 * i;
        const int d4 = f & 15, key = (f >> 4) & 255, hh = (f >> 12) & (H - 1), b = f >> (12 + logH);
        const f32x4 v = *(const f32x4*)(in + (size_t)f * 4);
        u32x2 o = {pk2(v[0], v[1]), pk2(v[2], v[3])};
        *(u32x2*)(out + ((size_t)(b * 256 + key) * H + hh) * 64 + d4 * 4) = o;
    }
}

constexpr int P0_ITEMS = 192 + 768 + 576 + 512 + 2048 + 2048 + 256 + 256 + 64 + 256 + 256 + 64;
DI void p0_item(const Params& p, int item, char* lds) {
    if (item < 192) { p0_mod_item(p, item, lds); return; }
    item -= 192;
    const float* in; bf16_t* out; int R, C;
    if (item < 768) { in = p.w_in_even; out = (bf16_t*)(p.ws + OFF_WINE); R = 1024; C = 3072; }
    else if ((item -= 768) < 576) { in = p.w_in_odd; out = (bf16_t*)(p.ws + OFF_WINO); R = 1024; C = 2304; }
    else if ((item -= 576) < 512) { const int b = item >> 8; item &= 255; in = p.w_out + (size_t)b * 1048576; out = (bf16_t*)(p.ws + OFF_WOUT) + (size_t)b * 1048576; R = 1024; C = 1024; }
    else if ((item -= 512) < 2048) { const int b = item >> 10; item &= 1023; in = p.mlp_w1 + (size_t)b * 4194304; out = (bf16_t*)(p.ws + OFF_W1) + (size_t)b * 4194304; R = 1024; C = 4096; }
    else if ((item -= 2048) < 2048) { const int b = item >> 10; item &= 1023; in = p.mlp_w2 + (size_t)b * 4194304; out = (bf16_t*)(p.ws + OFF_W2) + (size_t)b * 4194304; R = 4096; C = 1024; }
    else if ((item -= 2048) < 256) { const int b = item >> 3; item &= 7; in = p.cache_diff_v + (size_t)b * 32768; out = (bf16_t*)(p.ws + OFF_CDVT) + (size_t)b * 32768; R = 256; C = 128; }
    else if ((item -= 256) < 256) { const int b = item >> 2; item &= 3; in = p.cache_na_v + (size_t)b * 16384; out = (bf16_t*)(p.ws + OFF_CNVT) + (size_t)b * 16384; R = 256; C = 64; }
    else if ((item -= 256) < 64) { const int b = item >> 2; item &= 3; in = p.cache_swa_v + (size_t)b * 16384; out = (bf16_t*)(p.ws + OFF_CSVT) + (size_t)b * 16384; R = 256; C = 64; }
    else {
        item -= 64;
        if (item < 256) p0_kreorder(p.cache_diff_k, (bf16_t*)(p.ws + OFF_CDK), 3, item);
        else if (item < 512) p0_kreorder(p.cache_na_k, (bf16_t*)(p.ws + OFF_CNK), 3, item - 256);
        else p0_kreorder(p.cache_swa_k, (bf16_t*)(p.ws + OFF_CSK), 1, item - 512);
        return;
    }
    const int ntc = C >> 6;
    p0_transpose_tile(in, out, R, C, item / ntc, item % ntc, lds);
}

DI void rowop_phase(const Params& p, bool hasY, bool xin_input, int g_off, const float* wpost, bool hasH, const float* wpre, int sc_off, int sh_off) {
    const int tix = TIDX, lane = tix & 63, gw = (int)(blockIdx.x * 8) + (tix >> 6), nw = VNB * 4;
    const float* mod = (const float*)(p.ws + OFF_MOD);
    for (int row = gw; row < 16384; row += nw) {
        const int v = row < 8192 ? 0 : 1 + ((row - 8192) >> 10);
        const float* xin = xin_input ? (row < 8192 ? p.x_prompt + (size_t)row * 1024 : p.x_sample + (size_t)(row - 8192) * 1024) : p.out + (size_t)row * 1024;
        char* hy = p.ws + OFF_HY + (size_t)row * 4096;
        f32x4 x[4];
#pragma unroll
        for (int i = 0; i < 4; ++i) x[i] = *(const f32x4*)(xin + lane * 4 + 256 * i);
        if (hasY) {
            f32x4 y[4];
            float ss = 0.f;
#pragma unroll
            for (int i = 0; i < 4; ++i) { y[i] = *(const f32x4*)((const float*)hy + lane * 4 + 256 * i); ss += y[i][0] * y[i][0] + y[i][1] * y[i][1] + y[i][2] * y[i][2] + y[i][3] * y[i][3]; }
            ss = wave_sum(ss);
            const float rs = rsqrtf(ss * (1.f / 1024.f) + EPSN);
#pragma unroll
            for (int i = 0; i < 4; ++i) {
                const int col = lane * 4 + 256 * i;
                const f32x4 g4 = *(const f32x4*)(mod + v * 6144 + g_off + col);
                const f32x4 wp = *(const f32x4*)(wpost + col);
                x[i] += g4 * (y[i] * rs * wp);
                *(f32x4*)(p.out + (size_t)row * 1024 + col) = x[i];
            }
        }
        if (hasH) {
            float ss = 0.f;
#pragma unroll
            for (int i = 0; i < 4; ++i) ss += x[i][0] * x[i][0] + x[i][1] * x[i][1] + x[i][2] * x[i][2] + x[i][3] * x[i][3];
            ss = wave_sum(ss);
            const float rs = rsqrtf(ss * (1.f / 1024.f) + EPSN);
#pragma unroll
            for (int i = 0; i < 4; ++i) {
                const int col = lane * 4 + 256 * i;
                const f32x4 sc = *(const f32x4*)(mod + v * 6144 + sc_off + col);
                const f32x4 sh = *(const f32x4*)(mod + v * 6144 + sh_off + col);
                const f32x4 wp = *(const f32x4*)(wpre + col);
                const f32x4 h = x[i] * rs * wp * (sc + 1.f) + sh;
                u32x2 o = {pk2(h[0], h[1]), pk2(h[2], h[3])};
                *(u32x2*)((bf16_t*)hy + col) = o;
            }
        }
    }
}

namespace g8 {
constexpr int BK = 64, HALF = 128, HTB = HALF * BK * 2;
DI int lds_byte(int r, int c) { const int st = (r >> 4) * 2 + (c >> 5), rr = r & 15, cc = c & 31, ob = rr * 64 + cc * 2; return st * 1024 + (ob ^ (((ob >> 9) & 1) << 5)); }
DI void stage_rc(int b, int& R, int& C) { const int st = b / 1024, sb = b % 1024, swz = sb ^ (((sb >> 9) & 1) << 5); R = (st >> 1) * 16 + swz / 64; C = (st & 1) * 32 + (swz % 64) / 2; }
typedef __attribute__((address_space(3))) unsigned lds_u32;
typedef __attribute__((address_space(3))) unsigned char lds_u8;
typedef __attribute__((address_space(3))) bf16x8 lds_bf16x8;

template <int VTM>
DI void kloop(const bf16_t* __restrict__ A, int lda, const bf16_t* __restrict__ Bt, int K, int brow, int bcol, char* shm, f32x4 (&acc)[2][2][4][2]) {
#define SA(b, h) (((b) * 2 + (h)) * HTB)
#define SB(b, h) ((4 + (b) * 2 + (h)) * HTB)
#define STAGE_(bufoff, gbase, voff) do { _Pragma("unroll") for (int _i = 0; _i < 2; ++_i) \
      __builtin_amdgcn_global_load_lds((const unsigned*)((gbase) + (voff)[_i]), (lds_u32*)(lds + (bufoff) + ldsw + _i * 8192), 16, 0, 0); } while (0)
#define STAGE(P, BASE, LD, br, kt) STAGE_(P, (const char*)(BASE) + ((size_t)(br) * (LD) + (size_t)(kt) * BK) * 2, voff##BASE)
#define LDA(dst, b, h) _Pragma("unroll") for (int m = 0; m < 4; ++m) _Pragma("unroll") for (int k = 0; k < 2; ++k) \
    dst[m][k] = *(const lds_bf16x8*)(lds + SA(b, h) + aoff + m * 2048 + k * 1024)
#define LDB(dst, b, h) _Pragma("unroll") for (int n = 0; n < 2; ++n) _Pragma("unroll") for (int k = 0; k < 2; ++k) \
    dst[n][k] = *(const lds_bf16x8*)(lds + SB(b, h) + boff + n * 2048 + k * 1024)
#define MMA(ai, bj, At_, Bt_) do { __builtin_amdgcn_s_setprio(1); \
    _Pragma("unroll") for (int m = 0; m < 4; ++m) _Pragma("unroll") for (int n = 0; n < 2; ++n) _Pragma("unroll") for (int k = 0; k < 2; ++k) \
      acc[ai][bj][m][n] = (VTM == 1 || (VTM == 2 && (bj) == 1)) ? MFMA16(At_[m][k], Bt_[n][k], acc[ai][bj][m][n]) : MFMA16(Bt_[n][k], At_[m][k], acc[ai][bj][m][n]); \
    __builtin_amdgcn_s_setprio(0); } while (0)
#define WAIT_V(n) asm volatile("s_waitcnt vmcnt(" #n ")" ::: "memory")
#define WAIT_L(n) asm volatile("s_waitcnt lgkmcnt(" #n ")" ::: "memory")
#define BAR __builtin_amdgcn_s_barrier()
#define SCHED __builtin_amdgcn_sched_barrier(0)
    const int tid = TIDX, wid = __builtin_amdgcn_readfirstlane(tid >> 6), lane = tid & 63, wr = wid >> 2, wc = wid & 3, fr = lane & 15, fq = lane >> 4;
    bf16x8 At[4][2], B0[2][2], B1[2][2];
    const int nt = K / BK;
    lds_u8* lds = (lds_u8*)shm;
    unsigned voffA[2], voffBt[2];
#pragma unroll
    for (int _i = 0; _i < 2; ++_i) { int _r, _c; stage_rc(tid * 16 + _i * 8192, _r, _c); voffA[_i] = (unsigned)(_r * lda + _c) * 2u; voffBt[_i] = (unsigned)(_r * K + _c) * 2u; }
    const unsigned ldsw = (unsigned)wid * 1024u;
    const int aoff = lds_byte(wr * 64 + fr, fq * 8), boff = lds_byte(wc * 32 + fr, fq * 8);
    WAIT_V(0);
    STAGE(SB(0, 0), Bt, K, bcol, 0); STAGE(SA(0, 0), A, lda, brow, 0);
    STAGE(SB(0, 1), Bt, K, bcol + HALF, 0); STAGE(SA(0, 1), A, lda, brow + HALF, 0);
    if (wr == 1) BAR;
    WAIT_V(4); BAR;
    STAGE(SB(1, 0), Bt, K, bcol, 1); STAGE(SA(1, 0), A, lda, brow, 1); STAGE(SB(1, 1), Bt, K, bcol + HALF, 1);
    WAIT_V(6); BAR;
    for (int t = 0; t < nt - 2; t += 2) {
        LDB(B0, 0, 0); SCHED; LDA(At, 0, 0); STAGE(SA(1, 1), A, lda, brow + HALF, t + 1);
        WAIT_L(8); BAR; WAIT_L(0); MMA(0, 0, At, B0); BAR; SCHED;
        LDB(B1, 0, 1); STAGE(SB(0, 0), Bt, K, bcol, t + 2);
        BAR; WAIT_L(0); MMA(0, 1, At, B1); BAR;
        LDA(At, 0, 1); STAGE(SA(0, 0), A, lda, brow, t + 2);
        BAR; WAIT_L(0); MMA(1, 0, At, B0); BAR; SCHED;
        STAGE(SB(0, 1), Bt, K, bcol + HALF, t + 2);
        WAIT_V(6); BAR; MMA(1, 1, At, B1); BAR;
        LDB(B0, 1, 0); SCHED; LDA(At, 1, 0); STAGE(SA(0, 1), A, lda, brow + HALF, t + 2);
        WAIT_L(8); BAR; WAIT_L(0); MMA(0, 0, At, B0); BAR; SCHED;
        LDB(B1, 1, 1); STAGE(SB(1, 0), Bt, K, bcol, t + 3);
        BAR; WAIT_L(0); MMA(0, 1, At, B1); BAR;
        LDA(At, 1, 1); STAGE(SA(1, 0), A, lda, brow, t + 3);
        BAR; WAIT_L(0); MMA(1, 0, At, B0); BAR; SCHED;
        STAGE(SB(1, 1), Bt, K, bcol + HALF, t + 3);
        WAIT_V(6); BAR; MMA(1, 1, At, B1); BAR;
    }
    { LDB(B0, 0, 0); LDA(At, 0, 0); STAGE(SA(1, 1), A, lda, brow + HALF, nt - 1);
      BAR; WAIT_L(0); MMA(0, 0, At, B0); BAR;
      LDB(B1, 0, 1); BAR; WAIT_L(0); MMA(0, 1, At, B1); BAR;
      LDA(At, 0, 1); WAIT_V(4); BAR; WAIT_L(0); MMA(1, 0, At, B0); MMA(1, 1, At, B1); BAR; }
    { LDB(B0, 1, 0); LDA(At, 1, 0); WAIT_V(2); BAR; WAIT_L(0); MMA(0, 0, At, B0); BAR;
      LDB(B1, 1, 1); WAIT_V(0); BAR; WAIT_L(0); MMA(0, 1, At, B1); BAR;
      LDA(At, 1, 1); BAR; WAIT_L(0); MMA(1, 0, At, B0); MMA(1, 1, At, B1); BAR; }
    if (wr == 0) BAR;
#undef SA
#undef SB
#undef STAGE
#undef STAGE_
#undef LDA
#undef LDB
#undef MMA
#undef WAIT_V
#undef WAIT_L
#undef BAR
#undef SCHED
}
}

enum { EPI_PE = 0, EPI_PO = 1, EPI_Y = 2, EPI_W1 = 3 };

DI void rope_s(f32x4 (&sub)[4][2], int R0, bool usecol, int fr, int fq) {
    float inv[4];
#pragma unroll
    for (int j = 0; j < 4; ++j) inv[j] = exp2f(-(float)(fq * 4 + j) * (13.287712379549449f / 16.f));
#pragma unroll
    for (int m = 0; m < 4; ++m) {
        const int tl = (R0 + m * 16 + fr - 8192) & 1023;
        const float pos = (float)(usecol ? (tl & 63) : (tl >> 6));
#pragma unroll
        for (int j = 0; j < 4; ++j) {
            float s, c;
            __sincosf(pos * inv[j], &s, &c);
            const float a = sub[m][0][j], b = sub[m][1][j];
            sub[m][0][j] = a * c - b * s; sub[m][1][j] = b * c + a * s;
        }
    }
}
DI void store_bf16_rows_s(const f32x4 (&sub)[4][2], bf16_t* base, int ld, int R0, int Cd0, int fr, int fq) {
#pragma unroll
    for (int m = 0; m < 4; ++m) {
        bf16_t* rp = base + (size_t)(R0 + m * 16 + fr) * ld + Cd0 + fq * 4;
#pragma unroll
        for (int n = 0; n < 2; ++n) { u32x2 o = {pk2(sub[m][n][0], sub[m][n][1]), pk2(sub[m][n][2], sub[m][n][3])}; *(u32x2*)(rp + n * 16) = o; }
    }
}
DI void store_f32_rows_s(const f32x4 (&sub)[4][2], float* ob, int ldo, int fr, int fq) {
#pragma unroll
    for (int m = 0; m < 4; ++m) {
        float* rp = ob + (size_t)(m * 16 + fr) * ldo + fq * 4;
#pragma unroll
        for (int n = 0; n < 2; ++n) *(f32x4*)(rp + n * 16) = sub[m][n];
    }
}
DI void store_vt_s(const f32x4 (&sub)[4][2], bf16_t* vt, int T, int t0, int fr, int fq) {
#pragma unroll
    for (int n = 0; n < 2; ++n) {
        bf16_t* rp = vt + (size_t)(n * 16 + fr) * T + t0 + fq * 4;
#pragma unroll
        for (int m = 0; m < 4; ++m) { u32x2 o = {pk2(sub[m][n][0], sub[m][n][1]), pk2(sub[m][n][2], sub[m][n][3])}; *(u32x2*)(rp + m * 16) = o; }
    }
}
DI void store_f32_ns_s(const f32x4 (&sub)[4][2], float* ob, int ldo, int fr, int fq) {
#pragma unroll
    for (int m = 0; m < 4; ++m)
#pragma unroll
        for (int j = 0; j < 4; ++j) {
            float* rp = ob + (size_t)(m * 16 + fq * 4 + j) * ldo + fr;
#pragma unroll
            for (int n = 0; n < 2; ++n) rp[n * 16] = sub[m][n][j];
        }
}

template <int EPI>
DI void gemm_tile(const Params& p, const bf16_t* A, int lda, const bf16_t* Bt, int K, int pm, int pn, char* shm) {
    const int tix = TIDX, wid = __builtin_amdgcn_readfirstlane(tix >> 6), lane = tix & 63, wr = wid >> 2, wc = wid & 3;
    f32x4 acc[2][2][4][2];
#pragma unroll
    for (int ai = 0; ai < 2; ++ai)
#pragma unroll
        for (int bj = 0; bj < 2; ++bj)
#pragma unroll
            for (int m = 0; m < 4; ++m)
#pragma unroll
                for (int n = 0; n < 2; ++n) acc[ai][bj][m][n] = (f32x4){0.f, 0.f, 0.f, 0.f};
    const int brow = pm * 256, bcol = pn * 256;
    int vtm = 0;
    if (EPI == EPI_PE) vtm = pn >= 10 ? 1 : 0;
    if (EPI == EPI_PO) vtm = (pn == 4 || pn == 5) ? 1 : (pn == 8 ? 2 : 0);
    if ((EPI == EPI_PE || EPI == EPI_PO) && vtm == 1) g8::kloop<1>(A, lda, Bt, K, brow, bcol, shm, acc);
    else if (EPI == EPI_PO && vtm == 2) g8::kloop<2>(A, lda, Bt, K, brow, bcol, shm, acc);
    else g8::kloop<0>(A, lda, Bt, K, brow, bcol, shm, acc);

    int fr = lane & 15, fq = lane >> 4;
    asm volatile("" : "+v"(fr), "+v"(fq));
    const bool latent = brow >= 8192;
    int b, tb, T;
    if (latent) { b = (brow - 8192) >> 10; tb = (brow - 8192) & 1023; T = 1024; } else { b = brow >> 8; tb = 0; T = 256; }
    bf16_t* big = (bf16_t*)(p.ws + OFF_BIG);
#pragma unroll
    for (int ai = 0; ai < 2; ++ai)
#pragma unroll
        for (int bj = 0; bj < 2; ++bj) {
            f32x4 (&sub)[4][2] = acc[ai][bj];
            const int R0 = brow + ai * 128 + wr * 64, t0 = tb + ai * 128 + wr * 64, C0 = bcol + bj * 128 + wc * 32;
            const bool ns = vtm == 1 || (vtm == 2 && bj == 1);
            if (EPI == EPI_PE) {
                if (ns) {
                    const int vc = C0 - 2560;
                    bf16_t* vt = (bf16_t*)(p.ws + OFF_BIG + BIG_VT_E) + (latent ? (size_t)4194304 + ((size_t)b * 512 + vc) * 1024 : ((size_t)b * 512 + vc) * 256);
                    store_vt_s(sub, vt, T, t0, fr, fq);
                    if (!latent) store_f32_ns_s(sub, p.out + OUT_DIFFV + ((size_t)(b * 4 + (vc >> 7)) * 256 + t0) * 128 + (vc & 127), 128, fr, fq);
                } else {
                    if (pn >= 6 && latent) rope_s(sub, R0, wc & 1, fr, fq);
                    store_bf16_rows_s(sub, big, LDE, R0, C0, fr, fq);
                    if (pn >= 8 && !latent) store_f32_rows_s(sub, p.out + OUT_DIFFK + ((size_t)(b * 8 + ((C0 - 2048) >> 6)) * 256 + t0) * 64 + ((C0 - 2048) & 63), 64, fr, fq);
                }
            } else if (EPI == EPI_PO) {
                if (ns) {
                    if (pn < 8) {
                        const int vc = C0 - 1024;
                        bf16_t* vt = (bf16_t*)(p.ws + OFF_BIG + BIG_VT_C) + (latent ? (size_t)4194304 + ((size_t)b * 512 + vc) * 1024 : ((size_t)b * 512 + vc) * 256);
                        store_vt_s(sub, vt, T, t0, fr, fq);
                        if (!latent) store_f32_ns_s(sub, p.out + OUT_NAV + ((size_t)(b * 8 + (vc >> 6)) * 256 + t0) * 64 + (vc & 63), 64, fr, fq);
                    } else {
                        const int vc = C0 - 2176;
                        bf16_t* vt = (bf16_t*)(p.ws + OFF_BIG + BIG_VT_D) + (latent ? (size_t)1048576 + ((size_t)b * 128 + vc) * 1024 : ((size_t)b * 128 + vc) * 256);
                        store_vt_s(sub, vt, T, t0, fr, fq);
                        if (!latent) store_f32_ns_s(sub, p.out + OUT_SWAV + ((size_t)(b * 2 + (vc >> 6)) * 256 + t0) * 64 + (vc & 63), 64, fr, fq);
                    }
                } else {
                    if (pn >= 6 && latent) rope_s(sub, R0, wc & 1, fr, fq);
                    store_bf16_rows_s(sub, big, LDO, R0, pn >= 6 ? C0 - 512 : C0, fr, fq);
                    if (!latent) {
                        if (pn == 2 || pn == 3) store_f32_rows_s(sub, p.out + OUT_NAK + ((size_t)(b * 8 + ((C0 - 512) >> 6)) * 256 + t0) * 64 + ((C0 - 512) & 63), 64, fr, fq);
                        else if (pn == 8) store_f32_rows_s(sub, p.out + OUT_SWAK + ((size_t)(b * 2 + ((C0 - 2048) >> 6)) * 256 + t0) * 64 + ((C0 - 2048) & 63), 64, fr, fq);
                    }
                }
            } else if (EPI == EPI_Y) {
                store_f32_rows_s(sub, (float*)(p.ws + OFF_HY) + (size_t)R0 * 1024 + C0, 1024, fr, fq);
            } else {
#pragma unroll
                for (int m = 0; m < 4; ++m)
#pragma unroll
                    for (int n = 0; n < 2; ++n)
#pragma unroll
                        for (int j = 0; j < 4; ++j) { const float v = fmaxf(sub[m][n][j], 0.f); sub[m][n][j] = v * v; }
                store_bf16_rows_s(sub, big, 4096, R0, C0, fr, fq);
            }
        }
}

template <int EPI>
DI void gemm_phase(const Params& p, const bf16_t* A, int lda, const bf16_t* Bt, int K, int NT_N, char* shm) {
    const int xcd = blockIdx.x & 7, lb = blockIdx.x >> 3, nlb = gridDim.x >> 3;
    const int per_xcd = 8 * NT_N;
    for (int lt = lb; lt < per_xcd; lt += nlb) gemm_tile<EPI>(p, A, lda, Bt, K, xcd * 8 + (lt & 7), lt >> 3, shm);
}

struct ASeg { const bf16_t* K; const bf16_t* Vt; int ldk, ldv, ntiles; };
struct MaskP { int on, a, b, c; const float* tab; };

template <int KW, int VR, int NB, int MODE>
DI void attn_core(const ASeg& s0, const ASeg& s1, const bf16x8 (&qf)[4], int kchunk0, int vrow0, float scale_l2, float& m, float& l, f32x16 (&O)[NB], char* lds, const MaskP& mp) {
    constexpr int KC = KW / 8, NKL = 64 * KC / 256, NVL = VR * 8 / 256;
    const int tid = VTID, lane = tid & 63, p32 = lane & 31, h = lane >> 5;
    const int krow = (p32 & 19) | ((p32 & 4) << 1) | ((p32 & 8) >> 1);
    const int n0 = s0.ntiles, nt = s0.ntiles + s1.ntiles;
    u32x4 rk[NKL], rv[NVL];
#define ATT_LOAD(t_)                                                                                                         \
    {                                                                                                                        \
        const bool f_ = (t_) < n0; const int tt_ = f_ ? (t_) : (t_) - n0;                                                     \
        const bf16_t* Kp_ = (f_ ? s0.K : s1.K); const int ldk_ = f_ ? s0.ldk : s1.ldk;                                        \
        const bf16_t* Vp_ = (f_ ? s0.Vt : s1.Vt); const int ldv_ = f_ ? s0.ldv : s1.ldv;                                      \
        _Pragma("unroll") for (int i = 0; i < NKL; ++i) { const int id = tid + 256 * i, r = id / KC, c = id % KC; rk[i] = *(const u32x4*)(Kp_ + (size_t)(tt_ * 64 + r) * ldk_ + c * 8); } \
        _Pragma("unroll") for (int i = 0; i < NVL; ++i) { const int id = tid + 256 * i, r = id >> 3, c = id & 7; rv[i] = *(const u32x4*)(Vp_ + (size_t)r * ldv_ + tt_ * 64 + c * 8); }       \
    }
#define ATT_STORE(b_)                                                                                                        \
    {                                                                                                                        \
        char* kb_ = lds + (b_) * 32768; char* vb_ = kb_ + 16384;                                                              \
        _Pragma("unroll") for (int i = 0; i < NKL; ++i) { const int id = tid + 256 * i, r = id / KC, c = id % KC; *(u32x4*)(kb_ + (KW == 128 ? swz256(r, c) : swz128(r, c))) = rk[i]; } \
        _Pragma("unroll") for (int i = 0; i < NVL; ++i) { const int id = tid + 256 * i, r = id >> 3, c = id & 7; *(u32x4*)(vb_ + swz128(r, c)) = rv[i]; }                               \
    }
    ATT_LOAD(0);
    ATT_STORE(0);
    __syncthreads();
    for (int t = 0; t < nt; ++t) {
        const bool more = t + 1 < nt;
        if (more) ATT_LOAD(t + 1);
        const char* kb = lds + (t & 1) * 32768;
        const char* vb = kb + 16384;
        f32x16 S[2];
#pragma unroll
        for (int kh = 0; kh < 2; ++kh) {
#pragma unroll
            for (int i = 0; i < 16; ++i) S[kh][i] = 0.f;
            const int row = krow + 32 * kh;
#pragma unroll
            for (int s = 0; s < 4; ++s) {
                const int c = kchunk0 + 2 * s + h;
                const bf16x8 kf = *(const bf16x8*)(kb + (KW == 128 ? swz256(row, c) : swz128(row, c)));
                S[kh] = MFMA32(kf, qf[s], S[kh]);
            }
        }
        const bool msk = (MODE != 0) && mp.on && t < n0;
        float mx = -1e30f;
        if (MODE == 1 && msk) {
            int cq = mp.c + p32;
            int h8 = 8 * h;
            asm volatile("" : "+v"(cq), "+v"(h8));
            const int cs = min(max(cq - 8, 0), 48);
            const float* tab = mp.tab + (mp.b + t - mp.a + 7) * 31;
#pragma unroll
            for (int kh = 0; kh < 2; ++kh)
#pragma unroll
                for (int i = 0; i < 16; ++i) {
                    const int kc = 32 * kh + 16 * (i >> 3) + h8 + (i & 7);
                    const bool ok = (unsigned)(kc - cs) < 16u;
                    const int dc = min(max(kc - cq + 15, 0), 30);
                    const float sv = ok ? S[kh][i] * scale_l2 + tab[dc] : -1e30f;
                    S[kh][i] = sv; mx = fmaxf(mx, sv);
                }
        } else if (MODE == 2 && msk) {
            int qp = mp.a + p32 - 8 * h;
            asm volatile("" : "+v"(qp));
            const int k0 = mp.b + t * 64;
#pragma unroll
            for (int kh = 0; kh < 2; ++kh)
#pragma unroll
                for (int i = 0; i < 16; ++i) {
                    const int d = qp - (k0 + 32 * kh + 16 * (i >> 3) + (i & 7));
                    const bool ok = d <= 128 && d >= -128;
                    const float sv = ok ? S[kh][i] * scale_l2 : -1e30f;
                    S[kh][i] = sv; mx = fmaxf(mx, sv);
                }
        } else {
#pragma unroll
            for (int kh = 0; kh < 2; ++kh)
#pragma unroll
                for (int i = 0; i < 16; ++i) { const float sv = S[kh][i] * scale_l2; S[kh][i] = sv; mx = fmaxf(mx, sv); }
        }
        mx = fmaxf(mx, __shfl_xor(mx, 32));
        const float mn = fmaxf(m, mx);
        const float alpha = __builtin_amdgcn_exp2f(m - mn);
        m = mn;
        float ls = 0.f;
#pragma unroll
        for (int kh = 0; kh < 2; ++kh)
#pragma unroll
            for (int i = 0; i < 16; ++i) { const float pv = __builtin_amdgcn_exp2f(S[kh][i] - mn); S[kh][i] = pv; ls += pv; }
        l = l * alpha + ls;
#pragma unroll
        for (int blk = 0; blk < NB; ++blk)
#pragma unroll
            for (int i = 0; i < 16; ++i) O[blk][i] *= alpha;
#pragma unroll
        for (int kh = 0; kh < 2; ++kh)
#pragma unroll
            for (int s2 = 0; s2 < 2; ++s2) {
                u32x4 pp = {pk2(S[kh][8 * s2 + 0], S[kh][8 * s2 + 1]), pk2(S[kh][8 * s2 + 2], S[kh][8 * s2 + 3]), pk2(S[kh][8 * s2 + 4], S[kh][8 * s2 + 5]), pk2(S[kh][8 * s2 + 6], S[kh][8 * s2 + 7])};
                const bf16x8 pb = __builtin_bit_cast(bf16x8, pp);
                const int c = 4 * kh + 2 * s2 + h;
#pragma unroll
                for (int blk = 0; blk < NB; ++blk) {
                    const bf16x8 vf = *(const bf16x8*)(vb + swz128(vrow0 + blk * 32 + p32, c));
                    O[blk] = MFMA32(vf, pb, O[blk]);
                }
            }
        if (more) ATT_STORE((t + 1) & 1);
        __syncthreads();
    }
    l += __shfl_xor(l, 32);
#undef ATT_LOAD
#undef ATT_STORE
}

DI void load_q(bf16x8 (&qf)[4], const bf16_t* qrow, int h) {
#pragma unroll
    for (int s = 0; s < 4; ++s) qf[s] = *(const bf16x8*)(qrow + 16 * s + 8 * h);
}

DI void attn_diff_item(const Params& p, int item, char* lds) {
    const int tid = VTID, lane = tid & 63, w = tid >> 6, p32 = lane & 31, h = lane >> 5, stream = w & 1, qh = w >> 1;
    const bf16_t* proj = (const bf16_t*)(p.ws + OFF_BIG);
    const bf16_t* vte = (const bf16_t*)(p.ws + OFF_BIG + BIG_VT_E);
    bf16_t* mix = (bf16_t*)(p.ws + OFF_BIG + BIG_MIXIN);
    int b, hd, qb, rowbase; ASeg s0, s1;
    if (item < 512) {
        b = item >> 6; hd = (item >> 4) & 3; qb = item & 15; rowbase = 8192 + b * 1024;
        s0 = {proj + (size_t)rowbase * LDE + 2048 + hd * 128, vte + 4194304 + ((size_t)b * 512 + hd * 128) * 1024, LDE, 1024, 16};
        s1 = {(const bf16_t*)(p.ws + OFF_CDK) + (size_t)b * 256 * 512 + hd * 128, (const bf16_t*)(p.ws + OFF_CDVT) + (size_t)(b * 4 + hd) * 128 * 256, 512, 256, 4};
    } else {
        const int it = item - 512;
        b = it >> 4; hd = (it >> 2) & 3; qb = it & 3; rowbase = b * 256;
        s0 = {proj + (size_t)rowbase * LDE + 2048 + hd * 128, vte + ((size_t)b * 512 + hd * 128) * 256, LDE, 256, 4};
        s1 = s0; s1.ntiles = 0;
    }
    const int R = rowbase + qb * 64 + qh * 32 + p32;
    bf16x8 qf[4];
    load_q(qf, proj + (size_t)R * LDE + 1536 + hd * 128 + stream * 64, h);
    f32x16 O[4];
#pragma unroll
    for (int blk = 0; blk < 4; ++blk)
#pragma unroll
        for (int i = 0; i < 16; ++i) O[blk][i] = 0.f;
    float m = -1e30f, l = 0.f;
    MaskP mp = {0, 0, 0, 0, nullptr};
    attn_core<128, 128, 4, 0>(s0, s1, qf, stream * 8, 0, 0.125f * LOG2E, m, l, O, lds, mp);
    const float il = 1.f / l;
    const float d1 = wave_sum(p.lq1[lane] * p.lk1[lane]), d2 = wave_sum(p.lq2[lane] * p.lk2[lane]);
    const float lam_init = 0.2f;
    const float lam = __expf(d1) - __expf(d2) + lam_init;
    float* xb = (float*)(lds + qh * 16384);
    if (stream == 1) {
#pragma unroll
        for (int blk = 0; blk < 4; ++blk)
#pragma unroll
            for (int i = 0; i < 16; ++i) { const int dv = blk * 32 + 8 * (i >> 2) + 4 * h + (i & 3); xb[dv * 32 + p32] = O[blk][i] * il; }
    }
    __syncthreads();
    if (stream == 0) {
        float ss = 0.f;
#pragma unroll
        for (int blk = 0; blk < 4; ++blk)
#pragma unroll
            for (int i = 0; i < 16; ++i) { const int dv = blk * 32 + 8 * (i >> 2) + 4 * h + (i & 3); const float o = O[blk][i] * il - lam * xb[dv * 32 + p32]; O[blk][i] = o; ss += o * o; }
        ss += __shfl_xor(ss, 32);
        const float rs = rsqrtf(ss * (1.f / 128.f) + EPSN) * (1.f - lam_init);
        bf16_t* op = mix + (size_t)R * 1024 + 512 + hd * 128;
#pragma unroll
        for (int blk = 0; blk < 4; ++blk)
#pragma unroll
            for (int g = 0; g < 4; ++g) {
                const int dv = blk * 32 + 8 * g + 4 * h;
                const f32x4 sl = *(const f32x4*)(p.subln + dv);
                u32x2 o = {pk2(O[blk][4 * g] * rs * sl[0], O[blk][4 * g + 1] * rs * sl[1]), pk2(O[blk][4 * g + 2] * rs * sl[2], O[blk][4 * g + 3] * rs * sl[3])};
                *(u32x2*)(op + dv) = o;
            }
    }
    __syncthreads();
}

DI void attn_c_item(const Params& p, int item, char* lds) {
    const int tid = VTID, lane = tid & 63, w = tid >> 6, p32 = lane & 31, h = lane >> 5, stream = w & 1, qh = w >> 1;
    const bf16_t* proj = (const bf16_t*)(p.ws + OFF_BIG);
    const bf16_t* vtc = (const bf16_t*)(p.ws + OFF_BIG + BIG_VT_C);
    bf16_t* mix = (bf16_t*)(p.ws + OFF_BIG + BIG_MIXIN);
    int b, hp, qb, rowbase; ASeg s0, s1; MaskP mp = {0, 0, 0, 0, nullptr};
    float* tab = (float*)(lds + 65536);
    if (item < 512) {
        b = item >> 6; hp = (item >> 4) & 3; qb = item & 15; rowbase = 8192 + b * 1024;
        const int rstart = min(max(qb - 4, 0), 8);
        s0 = {proj + (size_t)(rowbase + rstart * 64) * LDO + 512 + hp * 128, vtc + 4194304 + ((size_t)b * 512 + hp * 128) * 1024 + rstart * 64, LDO, 1024, 8};
        s1 = {(const bf16_t*)(p.ws + OFF_CNK) + (size_t)b * 256 * 512 + hp * 128, (const bf16_t*)(p.ws + OFF_CNVT) + ((size_t)b * 512 + hp * 128) * 256, 512, 256, 4};
        for (int idx = tid; idx < 930; idx += 256) tab[idx] = p.rpb[hp * 930 + idx] * LOG2E;
        mp = {1, qb, rstart, qh * 32, tab + stream * 465};
    } else {
        const int it = item - 512;
        b = it >> 4; hp = (it >> 2) & 3; qb = it & 3; rowbase = b * 256;
        s0 = {proj + (size_t)rowbase * LDO + 512 + hp * 128, vtc + ((size_t)b * 512 + hp * 128) * 256, LDO, 256, 4};
        s1 = s0; s1.ntiles = 0;
    }
    const int R = rowbase + qb * 64 + qh * 32 + p32;
    const int head = hp * 2 + stream;
    bf16x8 qf[4];
    load_q(qf, proj + (size_t)R * LDO + head * 64, h);
    f32x16 O[2];
#pragma unroll
    for (int blk = 0; blk < 2; ++blk)
#pragma unroll
        for (int i = 0; i < 16; ++i) O[blk][i] = 0.f;
    float m = -1e30f, l = 0.f;
    attn_core<128, 128, 2, 1>(s0, s1, qf, stream * 8, stream * 64, 0.125f * LOG2E, m, l, O, lds, mp);
    const float il = 1.f / l;
    bf16_t* op = mix + (size_t)R * 1024 + head * 64;
#pragma unroll
    for (int blk = 0; blk < 2; ++blk)
#pragma unroll
        for (int g = 0; g < 4; ++g) {
            const int dv = blk * 32 + 8 * g + 4 * h;
            u32x2 o = {pk2(O[blk][4 * g] * il, O[blk][4 * g + 1] * il), pk2(O[blk][4 * g + 2] * il, O[blk][4 * g + 3] * il)};
            *(u32x2*)(op + dv) = o;
        }
}

DI void attn_d_item(const Params& p, int item, char* lds) {
    const int tid = VTID, lane = tid & 63, w = tid >> 6, p32 = lane & 31, h = lane >> 5;
    const bf16_t* proj = (const bf16_t*)(p.ws + OFF_BIG);
    const bf16_t* vtd = (const bf16_t*)(p.ws + OFF_BIG + BIG_VT_D);
    bf16_t* mix = (bf16_t*)(p.ws + OFF_BIG + BIG_MIXIN);
    int b, g, qb, rowbase; ASeg s0, s1; MaskP mp = {0, 0, 0, 0, nullptr};
    if (item < 512) {
        b = item >> 6; g = (item >> 5) & 1; qb = item & 31; rowbase = 8192 + b * 1024;
        const int q0 = qb * 32;
        const int tlo = max(q0 - 128, 0) >> 6, thi = min(q0 + 159, 1023) >> 6;
        s0 = {proj + (size_t)(rowbase + tlo * 64) * LDO + 1536 + g * 64, vtd + 1048576 + ((size_t)b * 128 + g * 64) * 1024 + tlo * 64, LDO, 1024, thi - tlo + 1};
        s1 = {(const bf16_t*)(p.ws + OFF_CSK) + (size_t)b * 256 * 128 + g * 64, (const bf16_t*)(p.ws + OFF_CSVT) + ((size_t)b * 128 + g * 64) * 256, 128, 256, 4};
        mp = {1, q0, tlo * 64, 0, nullptr};
    } else {
        const int it = item - 512;
        b = it >> 4; g = (it >> 3) & 1; qb = it & 7; rowbase = b * 256;
        s0 = {proj + (size_t)rowbase * LDO + 1536 + g * 64, vtd + ((size_t)b * 128 + g * 64) * 256, LDO, 256, 4};
        s1 = s0; s1.ntiles = 0;
    }
    const int R = rowbase + qb * 32 + p32;
    const int hq = g * 4 + w;
    bf16x8 qf[4];
    load_q(qf, proj + (size_t)R * LDO + 1024 + hq * 64, h);
    f32x16 O[2];
#pragma unroll
    for (int blk = 0; blk < 2; ++blk)
#pragma unroll
        for (int i = 0; i < 16; ++i) O[blk][i] = 0.f;
    float m = p.sink[hq] * LOG2E, l = h == 0 ? 1.f : 0.f;
    attn_core<64, 64, 2, 2>(s0, s1, qf, 0, 0, 0.125f * LOG2E, m, l, O, lds, mp);
    const float il = 1.f / l;
    bf16_t* op = mix + (size_t)R * 1024 + 512 + hq * 64;
#pragma unroll
    for (int blk = 0; blk < 2; ++blk)
#pragma unroll
        for (int gg = 0; gg < 4; ++gg) {
            const int dv = blk * 32 + 8 * gg + 4 * h;
            u32x2 o = {pk2(O[blk][4 * gg] * il, O[blk][4 * gg + 1] * il), pk2(O[blk][4 * gg + 2] * il, O[blk][4 * gg + 3] * il)};
            *(u32x2*)(op + dv) = o;
        }
}

DI void conv_item(const Params& p, int item) {
    const int tid = VTID;
    const bf16_t* proj = (const bf16_t*)(p.ws + OFF_BIG);
    bf16_t* mix = (bf16_t*)(p.ws + OFF_BIG + BIG_MIXIN);
#pragma unroll 2
    for (int i = 0; i < 8; ++i) {
        const int idx = tid + 256 * i, tl = idx >> 6, ch = (idx & 63) * 8;
        const int R = item * 32 + tl;
        int t, T;
        if (R < 8192) { t = R & 255; T = 256; } else { t = (R - 8192) & 1023; T = 1024; }
        const bf16_t* rp = proj + (size_t)R * LDE + ch;
        const u32x4 ab = *(const u32x4*)(rp);
        float accv[8];
#pragma unroll
        for (int e = 0; e < 8; ++e) accv[e] = 0.f;
#pragma unroll
        for (int j = 0; j < 3; ++j) {
            const int tt = t + j - 1;
            if (tt >= 0 && tt < T) {
                const u32x4 ac = *(const u32x4*)(rp + (ptrdiff_t)(j - 1) * LDE + 512);
                const u32x4 ax = *(const u32x4*)(rp + (ptrdiff_t)(j - 1) * LDE + 1024);
                const f32x4 w0 = *(const f32x4*)(p.conv_w + j * 512 + ch), w1 = *(const f32x4*)(p.conv_w + j * 512 + ch + 4);
#pragma unroll
                for (int e = 0; e < 4; ++e) {
                    accv[2 * e] += bflo(ac[e]) * bflo(ax[e]) * (e < 2 ? w0[2 * e] : w1[2 * e - 4]);
                    accv[2 * e + 1] += bfhi(ac[e]) * bfhi(ax[e]) * (e < 2 ? w0[2 * e + 1] : w1[2 * e - 3]);
                }
            }
        }
        u32x4 o;
#pragma unroll
        for (int e = 0; e < 4; ++e) o[e] = pk2(bflo(ab[e]) * accv[2 * e], bfhi(ab[e]) * accv[2 * e + 1]);
        *(u32x4*)(mix + (size_t)R * 1024 + ch) = o;
    }
}


#define XB_TMO      128
#define XB_XCNT(j)  (256  + 64 * (j))
#define XB_XSUB(j)  (1280 + 64 * (j))
#define XB_XGEN(j)  (2304 + 64 * (j))
#define XB_TOP      3328
#define XB_TOPGEN   3392
#define XCD_BAR_WORDS 3456
#define XB_SPIN_CAP (1u << 22)
#define LAS __attribute__((address_space(3)))
DI unsigned xb_ld(unsigned* p) { return __hip_atomic_load(p, __ATOMIC_RELAXED, __HIP_MEMORY_SCOPE_AGENT); }
DI unsigned xb_add(unsigned* p, unsigned v) { return __hip_atomic_fetch_add(p, v, __ATOMIC_RELAXED, __HIP_MEMORY_SCOPE_AGENT); }
DI unsigned xb_xcc_id() { return (unsigned)__builtin_amdgcn_s_getreg((3 << 11) | 20) & 0xFu; }
#define XB_SPIN(cond, bar) do { unsigned _sp = 0; while (cond) { __builtin_amdgcn_s_sleep(1); \
    if ((++_sp & 255u) == 0u) { if (xb_ld(&(bar)[XB_TMO])) break; if (_sp > XB_SPIN_CAP) { atomicAdd(&(bar)[XB_TMO], 1u); break; } } } } while (0)
struct XcdBarrier { unsigned* bar; unsigned x; volatile LAS unsigned* st; };
DI XcdBarrier xcd_barrier_post(unsigned* bar, volatile LAS unsigned* st) {
    XcdBarrier b; b.bar = bar; b.x = xb_xcc_id(); b.st = st;
    if (threadIdx.x == 0) (void)xb_add(&bar[XB_XCNT(b.x)], 1u);
    return b;
}
DI void xcd_barrier_complete(unsigned* bar, unsigned x, unsigned& nloc, unsigned& nx) {
    const unsigned G = gridDim.x * gridDim.y * gridDim.z;
    unsigned sum, cnt, mine, sp = 0u;
    for (;;) {
        sum = 0u; cnt = 0u; mine = 0u;
#pragma unroll
        for (unsigned j = 0; j < 16; ++j) { const unsigned c = xb_ld(&bar[XB_XCNT(j)]); sum += c; cnt += (c > 0u) ? 1u : 0u; mine = (j == x) ? c : mine; }
        if (sum == G) break;
        __builtin_amdgcn_s_sleep(1);
        if ((++sp & 255u) == 0u) { if (xb_ld(&bar[XB_TMO])) break; if (sp > XB_SPIN_CAP) { atomicAdd(&bar[XB_TMO], 1u); break; } }
    }
    nloc = mine > 0u ? mine : 1u; nx = cnt > 0u ? cnt : 1u;
}
DI void xcd_barrier(const XcdBarrier& b) {
    asm volatile("s_waitcnt vmcnt(0)" ::: "memory");
    __syncthreads();
    if (threadIdx.x == 0) {
        unsigned* bar = b.bar;
        __builtin_amdgcn_s_waitcnt(0);
        unsigned nloc = b.st[0], nx = b.st[1];
        if (nloc == 0u) { xcd_barrier_complete(bar, b.x, nloc, nx); b.st[0] = nloc; b.st[1] = nx; }
        const unsigned old = xb_add(&bar[XB_XSUB(b.x)], 1u);
        const unsigned gen = old / nloc;
        if (old + 1u == (gen + 1u) * nloc) {
            __builtin_amdgcn_fence(__ATOMIC_RELEASE, "agent");
            asm volatile("s_waitcnt vmcnt(0)" ::: "memory");
            const unsigned og = xb_add(&bar[XB_TOP], 1u);
            const unsigned tg = og / nx;
            if (og + 1u == (tg + 1u) * nx) xb_add(&bar[XB_TOPGEN], 1u);
            else XB_SPIN(xb_ld(&bar[XB_TOPGEN]) == tg, bar);
            __builtin_amdgcn_fence(__ATOMIC_ACQUIRE, "agent");
            xb_add(&bar[XB_XGEN(b.x)], 1u);
            asm volatile("s_waitcnt vmcnt(0)" ::: "memory");
        } else {
            XB_SPIN(xb_ld(&bar[XB_XGEN(b.x)]) == gen, bar);
            __builtin_amdgcn_fence(__ATOMIC_ACQUIRE, "agent");
            asm volatile("s_waitcnt vmcnt(0)" ::: "memory");
        }
    }
    __syncthreads();
}

constexpr int N_PHASES = 16;
DI void run_phase(const Params& p, int ph, char* shm) {
    const int nb = VNB, bid = VBID;
    char* lds = shm + VHALF * LDS_HALF;
    const bf16_t* hy = (const bf16_t*)(p.ws + OFF_HY);
    const bf16_t* big = (const bf16_t*)(p.ws + OFF_BIG);
    const bf16_t* mixin = (const bf16_t*)(p.ws + OFF_BIG + BIG_MIXIN);
    switch (ph) {
    case 0: for (int it = bid; it < P0_ITEMS; it += nb) p0_item(p, it, lds); break;
    case 1: rowop_phase(p, false, true, 0, nullptr, true, p.norm_mix_pre, 1024, 0); break;
    case 2: gemm_phase<EPI_PE>(p, hy, 2048, (const bf16_t*)(p.ws + OFF_WINE), 1024, 12, shm); break;
    case 3:
        for (int it = bid; it < 1536; it += nb) { if (it < 1024) attn_diff_item(p, it, lds); else conv_item(p, it - 1024); }
        break;
    case 4: gemm_phase<EPI_Y>(p, mixin, 1024, (const bf16_t*)(p.ws + OFF_WOUT), 1024, 4, shm); break;
    case 5: rowop_phase(p, true, true, 2048, p.norm_mix_post, true, p.norm_mlp_pre, 4096, 3072); break;
    case 6: gemm_phase<EPI_W1>(p, hy, 2048, (const bf16_t*)(p.ws + OFF_W1), 1024, 16, shm); break;
    case 7: gemm_phase<EPI_Y>(p, big, 4096, (const bf16_t*)(p.ws + OFF_W2), 4096, 4, shm); break;
    case 8: rowop_phase(p, true, false, 5120, p.norm_mlp_post, true, p.norm_mix_pre + 1024, 9 * 6144 + 1024, 9 * 6144 + 0); break;
    case 9: gemm_phase<EPI_PO>(p, hy, 2048, (const bf16_t*)(p.ws + OFF_WINO), 1024, 9, shm); break;
    case 10:
        for (int it = bid; it < 2048; it += nb) {
            const int q = it >> 9, r = it & 511;
            if (q & 1) attn_d_item(p, (q >> 1) * 512 + r, lds); else attn_c_item(p, (q >> 1) * 512 + r, lds);
        }
        break;
    case 11: gemm_phase<EPI_Y>(p, mixin, 1024, (const bf16_t*)(p.ws + OFF_WOUT) + 1048576, 1024, 4, shm); break;
    case 12: rowop_phase(p, true, false, 9 * 6144 + 2048, p.norm_mix_post + 1024, true, p.norm_mlp_pre + 1024, 9 * 6144 + 4096, 9 * 6144 + 3072); break;
    case 13: gemm_phase<EPI_W1>(p, hy, 2048, (const bf16_t*)(p.ws + OFF_W1) + 4194304, 1024, 16, shm); break;
    case 14: gemm_phase<EPI_Y>(p, big, 4096, (const bf16_t*)(p.ws + OFF_W2) + 4194304, 4096, 4, shm); break;
    case 15: rowop_phase(p, true, false, 9 * 6144 + 5120, p.norm_mlp_post + 1024, false, nullptr, 0, 0); break;
    }
}

__global__ void __launch_bounds__(512, 2) fwd_mega(Params p) {
    __shared__ __attribute__((aligned(16))) char lds[LDS_BYTES];
    __shared__ uint4 xb_words;
    cg::grid_group grid = cg::this_grid();
    if (threadIdx.x == 0) xb_words = make_uint4(0u, 0u, 0u, 0u);
    __syncthreads();
    const XcdBarrier xb = xcd_barrier_post((unsigned*)(p.ws + OFF_BAR), (volatile LAS unsigned*)&xb_words);
#define PH_(n) run_phase(p, n, lds); xcd_barrier(xb); if ((DUP_MASK >> n) & 1) { run_phase(p, n, lds); xcd_barrier(xb); }
    run_phase(p, 0, lds);
    grid.sync();
    PH_(1) PH_(2) PH_(3) PH_(4) PH_(5) PH_(6) PH_(7) PH_(8) PH_(9) PH_(10) PH_(11) PH_(12) PH_(13) PH_(14)
    run_phase(p, 15, lds);
#undef PH_
}

__global__ void __launch_bounds__(512, 2) fwd_phase(Params p, int ph) {
    __shared__ __attribute__((aligned(16))) char lds[LDS_BYTES];
    run_phase(p, ph, lds);
}

extern "C" void kernel_launch(void* const* d_in, const int* in_sizes, int n_in, void* d_out, int out_size, void* d_ws, size_t ws_size, hipStream_t stream) {
    Params p{};
    const float** pp = (const float**)&p;
    for (int i = 0; i < 29; ++i) pp[i] = (const float*)d_in[i];
    p.out = (float*)d_out;
    p.ws = (char*)d_ws;
    if (ws_size < WS_NEEDED) { fprintf(stderr, "workspace too small: %zu < %zu\n", ws_size, (size_t)WS_NEEDED); return; }
    static int grid_blocks = 0;
    if (!grid_blocks) {
        int dev = 0, cus = 0, per_cu = 0;
        hipGetDevice(&dev);
        hipDeviceGetAttribute(&cus, hipDeviceAttributeMultiprocessorCount, dev);
        hipOccupancyMaxActiveBlocksPerMultiprocessor(&per_cu, fwd_mega, 512, 0);
        if (per_cu > 1) per_cu = 1;
        if (per_cu < 1) per_cu = 1;
        grid_blocks = cus * per_cu;
        grid_blocks -= grid_blocks % 8;
    }
#if ONE_LAUNCH
    (void)hipMemsetAsync((char*)d_ws + OFF_BAR, 0, XCD_BAR_WORDS * 4, stream);
    void* args[] = {&p};
    hipError_t e = hipLaunchCooperativeKernel((void*)fwd_mega, dim3(grid_blocks), dim3(512), args, 0, stream);
    if (e != hipSuccess) fprintf(stderr, "cooperative launch failed: %s (grid %d)\n", hipGetErrorString(e), grid_blocks);
#else
    for (int ph = 0; ph < N_PHASES; ++ph) fwd_phase<<<grid_blocks, 512, 0, stream>>>(p, ph);
#endif
}
```

```cpp
#include <hip/hip_runtime.h>
#include <hip/hip_cooperative_groups.h>
#include <cstdio>
#include <cstdint>
namespace cg = cooperative_groups;

#ifndef DUP_MASK
#define DUP_MASK 0
#endif
#ifndef ONE_LAUNCH
#define ONE_LAUNCH 1
#endif

typedef unsigned short bf16_t;
typedef short bf16x8 __attribute__((ext_vector_type(8)));
typedef float f32x4 __attribute__((ext_vector_type(4)));
typedef float f32x2 __attribute__((ext_vector_type(2)));
typedef float f32x16 __attribute__((ext_vector_type(16)));
typedef unsigned u32x4 __attribute__((ext_vector_type(4)));
typedef unsigned u32x2 __attribute__((ext_vector_type(2)));
typedef __bf16 bfv2 __attribute__((ext_vector_type(2)));
#define DI __device__ __forceinline__
DI int launder_v(int v) { asm volatile("" : "+v"(v)); return v; }
#define TIDX launder_v((int)threadIdx.x)
#define VTID (TIDX & 255)
#define VHALF (TIDX >> 8)
#define VBID ((int)(blockIdx.x * 2) + (TIDX >> 8))
#define VNB ((int)(gridDim.x * 2))
#define MFMA32(a, b, c) __builtin_amdgcn_mfma_f32_32x32x16_bf16((a), (b), (c), 0, 0, 0)
#define MFMA16(a, b, c) __builtin_amdgcn_mfma_f32_16x16x32_bf16((a), (b), (c), 0, 0, 0)

constexpr float LOG2E = 1.4426950408889634f;
constexpr float EPSN = 1e-6f;

struct Params {
    const float *x_prompt, *x_sample, *cache_diff_k, *cache_diff_v, *cache_na_k, *cache_na_v, *cache_swa_k, *cache_swa_v, *c, *c_ctx;
    const float *mod_w, *mod_b, *norm_mix_pre, *norm_mix_post, *norm_mlp_pre, *norm_mlp_post, *w_in_even, *conv_w, *lq1, *lk1, *lq2, *lk2, *subln;
    const float *w_in_odd, *rpb, *sink, *w_out, *mlp_w1, *mlp_w2;
    float* out;
    char* ws;
};

constexpr size_t OFF_MOD = 0;
constexpr size_t OFF_BAR = 458752;
constexpr size_t OFF_WINE = 524288;
constexpr size_t OFF_WINO = OFF_WINE + 6291456;
constexpr size_t OFF_WOUT = OFF_WINO + 4718592;
constexpr size_t OFF_W1 = OFF_WOUT + 4194304;
constexpr size_t OFF_W2 = OFF_W1 + 16777216;
constexpr size_t OFF_CDK = OFF_W2 + 16777216;
constexpr size_t OFF_CDVT = OFF_CDK + 2097152;
constexpr size_t OFF_CNK = OFF_CDVT + 2097152;
constexpr size_t OFF_CNVT = OFF_CNK + 2097152;
constexpr size_t OFF_CSK = OFF_CNVT + 2097152;
constexpr size_t OFF_CSVT = OFF_CSK + 524288;
constexpr size_t OFF_HY = OFF_CSVT + 524288;
constexpr size_t OFF_BIG = OFF_HY + 67108864;
constexpr size_t OFF_STAT = OFF_BIG + 134217728;
constexpr size_t STAT_SET = 65536 + 65536 + 8192;
constexpr size_t WS_NEEDED = OFF_STAT + 4 * STAT_SET;
constexpr size_t BIG_VT_E = 83886080;
constexpr size_t BIG_VT_C = 54525952;
constexpr size_t BIG_VT_D = BIG_VT_C + 16777216;
constexpr size_t BIG_MIXIN = 100663296;
constexpr int LDE = 2560, LDO = 1664;
constexpr size_t OUT_DIFFK = 16777216, OUT_DIFFV = 20971520, OUT_NAK = 25165824, OUT_NAV = 29360128, OUT_SWAK = 33554432, OUT_SWAV = 34603008;

constexpr int LDS_HALF = 65536 + 4096;
constexpr int LDS_BYTES = 2 * LDS_HALF;

DI unsigned pk2(float a, float b) { f32x2 v = {a, b}; bfv2 r = __builtin_convertvector(v, bfv2); return __builtin_bit_cast(unsigned, r); }
DI float bflo(unsigned u) { return __uint_as_float(u << 16); }
DI float bfhi(unsigned u) { return __uint_as_float(u & 0xffff0000u); }
DI float wave_sum(float v) {
#pragma unroll
    for (int o = 1; o < 64; o <<= 1) v += __shfl_xor(v, o);
    return v;
}
DI int swz128(int r, int c) { return r * 128 + ((c ^ ((r >> 1) & 7)) << 4); }
DI int swz256(int r, int c) { return r * 256 + ((c ^ (r & 15)) << 4); }

DI void p0_mod_item(const Params& p, int item, char* lds) {
    const int li = item / 96, cb = item % 96;
    const int tid = VTID, lane = tid & 63, w = tid >> 6;
    const float* W = p.mod_w + (size_t)li * 1024 * 6144 + cb * 64 + lane;
    float acc[9];
#pragma unroll
    for (int v = 0; v < 9; ++v) acc[v] = 0.f;
    for (int kc = 0; kc < 4; ++kc) {
        const int kb = w * 256 + kc * 64;
        float s[9];
        { const float cv = p.c_ctx[kb + lane]; s[0] = cv / (1.f + __expf(-cv)); }
#pragma unroll
        for (int v = 1; v < 9; ++v) { const float cv = p.c[(v - 1) * 1024 + kb + lane]; s[v] = cv / (1.f + __expf(-cv)); }
#pragma unroll
        for (int kk = 0; kk < 64; ++kk) {
            const float wv = W[(size_t)(kb + kk) * 6144];
#pragma unroll
            for (int v = 0; v < 9; ++v) acc[v] += __int_as_float(__builtin_amdgcn_readlane(__float_as_int(s[v]), kk)) * wv;
        }
    }
    float* red = (float*)lds;
#pragma unroll
    for (int v = 0; v < 9; ++v) red[(w * 9 + v) * 64 + lane] = acc[v];
    __syncthreads();
    float* mod = (float*)(p.ws + OFF_MOD);
    for (int idx = tid; idx < 576; idx += 256) {
        const int v = idx >> 6, col = idx & 63;
        const float sum = red[(0 * 9 + v) * 64 + col] + red[(1 * 9 + v) * 64 + col] + red[(2 * 9 + v) * 64 + col] + red[(3 * 9 + v) * 64 + col];
        mod[(li * 9 + v) * 6144 + cb * 64 + col] = sum + p.mod_b[li * 6144 + cb * 64 + col];
    }
    __syncthreads();
}

DI void p0_transpose_tile(const float* __restrict__ in, bf16_t* __restrict__ out, int R, int C, int tr, int tc, char* lds) {
    const int tid = VTID;
    const int cl = (tid & 15) * 4, rl = (tid >> 4) * 2, sw = tid & 7;
#pragma unroll
    for (int i = 0; i < 2; ++i) {
        const int r = rl + 32 * i;
        const f32x4 a = *(const f32x4*)(in + (size_t)(tr * 64 + r) * C + tc * 64 + cl);
        const f32x4 b = *(const f32x4*)(in + (size_t)(tr * 64 + r + 1) * C + tc * 64 + cl);
#pragma unroll
        for (int j = 0; j < 4; ++j) *(unsigned*)(lds + (cl + j) * 128 + (((r >> 3) ^ sw) << 4) + (r & 7) * 2) = pk2(a[j], b[j]);
    }
    __syncthreads();
#pragma unroll
    for (int i = 0; i < 2; ++i) {
        const int idx = tid + 256 * i, c = idx >> 3, q = idx & 7;
        const u32x4 v = *(const u32x4*)(lds + c * 128 + ((q ^ ((c >> 2) & 7)) << 4));
        *(u32x4*)(out + (size_t)(tc * 64 + c) * R + tr * 64 + q * 8) = v;
    }
    __syncthreads();
}

DI void p0_kreorder(const float* __restrict__ in, bf16_t* __restrict__ out, int logH, int item) {
    const int tid = VTID, H = 1 << logH;
#pragma unroll
    for (int i = 0; i < 4; ++i) {
        const int f = item * 1024 + tid + 256 * i;
        const int d4 = f & 15, key = (f >> 4) & 255, hh = (f >> 12) & (H - 1), b = f >> (12 + logH);
        const f32x4 v = *(const f32x4*)(in + (size_t)f * 4);
        u32x2 o = {pk2(v[0], v[1]), pk2(v[2], v[3])};
        *(u32x2*)(out + ((size_t)(b * 256 + key) * H + hh) * 64 + d4 * 4) = o;
    }
}

struct TJob { const float* in; bf16_t* out; int R, C, tr, tc; };
constexpr int P0_TITEMS = 768 + 576 + 512 + 2048 + 2048 + 256 + 256 + 64;
DI TJob p0_decode(const Params& p, int item) {
    TJob j;
    if (item < 768) { j.in = p.w_in_even; j.out = (bf16_t*)(p.ws + OFF_WINE); j.R = 1024; j.C = 3072; }
    else if ((item -= 768) < 576) { j.in = p.w_in_odd; j.out = (bf16_t*)(p.ws + OFF_WINO); j.R = 1024; j.C = 2304; }
    else if ((item -= 576) < 512) { const int b = item >> 8; item &= 255; j.in = p.w_out + (size_t)b * 1048576; j.out = (bf16_t*)(p.ws + OFF_WOUT) + (size_t)b * 1048576; j.R = 1024; j.C = 1024; }
    else if ((item -= 512) < 2048) { const int b = item >> 10; item &= 1023; j.in = p.mlp_w1 + (size_t)b * 4194304; j.out = (bf16_t*)(p.ws + OFF_W1) + (size_t)b * 4194304; j.R = 1024; j.C = 4096; }
    else if ((item -= 2048) < 2048) { const int b = item >> 10; item &= 1023; j.in = p.mlp_w2 + (size_t)b * 4194304; j.out = (bf16_t*)(p.ws + OFF_W2) + (size_t)b * 4194304; j.R = 4096; j.C = 1024; }
    else if ((item -= 2048) < 256) { const int b = item >> 3; item &= 7; j.in = p.cache_diff_v + (size_t)b * 32768; j.out = (bf16_t*)(p.ws + OFF_CDVT) + (size_t)b * 32768; j.R = 256; j.C = 128; }
    else if ((item -= 256) < 256) { const int b = item >> 2; item &= 3; j.in = p.cache_na_v + (size_t)b * 16384; j.out = (bf16_t*)(p.ws + OFF_CNVT) + (size_t)b * 16384; j.R = 256; j.C = 64; }
    else { item -= 256; const int b = item >> 2; item &= 3; j.in = p.cache_swa_v + (size_t)b * 16384; j.out = (bf16_t*)(p.ws + OFF_CSVT) + (size_t)b * 16384; j.R = 256; j.C = 64; }
    const int ntc = j.C >> 6;
    j.tr = item / ntc; j.tc = item % ntc;
    return j;
}
DI void p0_tload(const TJob& j, int tid, f32x4 (&a)[2], f32x4 (&b)[2]) {
    const int cl = (tid & 15) * 4, rl = (tid >> 4) * 2;
#pragma unroll
    for (int i = 0; i < 2; ++i) {
        const int r = rl + 32 * i;
        a[i] = __builtin_nontemporal_load((const f32x4*)(j.in + (size_t)(j.tr * 64 + r) * j.C + j.tc * 64 + cl));
        b[i] = __builtin_nontemporal_load((const f32x4*)(j.in + (size_t)(j.tr * 64 + r + 1) * j.C + j.tc * 64 + cl));
    }
}
DI void p0_phase(const Params& p, int bid, int nb, char* lds) {
    if (bid < 192) p0_mod_item(p, bid, lds);
    const int tid = VTID;
    {
        const int cl = (tid & 15) * 4, rl = (tid >> 4) * 2, sw = tid & 7;
        int it = bid;
        TJob cur{}; f32x4 a[2], b[2];
        if (it < P0_TITEMS) { cur = p0_decode(p, it); p0_tload(cur, tid, a, b); }
        while (it < P0_TITEMS) {
            const int nx = it + nb;
            TJob nxt{}; f32x4 an[2], bn[2];
            if (nx < P0_TITEMS) { nxt = p0_decode(p, nx); p0_tload(nxt, tid, an, bn); }
#pragma unroll
            for (int i = 0; i < 2; ++i) {
                const int r = rl + 32 * i;
#pragma unroll
                for (int jj = 0; jj < 4; ++jj) *(unsigned*)(lds + (cl + jj) * 128 + (((r >> 3) ^ sw) << 4) + (r & 7) * 2) = pk2(a[i][jj], b[i][jj]);
            }
            __syncthreads();
#pragma unroll
            for (int i = 0; i < 2; ++i) {
                const int idx = tid + 256 * i, c = idx >> 3, q = idx & 7;
                const u32x4 v = *(const u32x4*)(lds + c * 128 + ((q ^ ((c >> 2) & 7)) << 4));
                *(u32x4*)(cur.out + (size_t)(cur.tc * 64 + c) * cur.R + cur.tr * 64 + q * 8) = v;
            }
            __syncthreads();
            cur = nxt; a[0] = an[0]; a[1] = an[1]; b[0] = bn[0]; b[1] = bn[1];
            it = nx;
        }
    }
    for (int it = bid; it < 576; it += nb) {
        if (it < 256) p0_kreorder(p.cache_diff_k, (bf16_t*)(p.ws + OFF_CDK), 3, it);
        else if (it < 512) p0_kreorder(p.cache_na_k, (bf16_t*)(p.ws + OFF_CNK), 3, it - 256);
        else p0_kreorder(p.cache_swa_k, (bf16_t*)(p.ws + OFF_CSK), 1, it - 512);
    }
}

DI void rowop_phase(const Params& p, bool hasY, bool xin_input, int g_off, const float* wpost, bool hasH, const float* wpre, int sc_off, int sh_off) {
    const int tix = TIDX, lane = tix & 63, gw = (int)(blockIdx.x * 8) + (tix >> 6), nw = VNB * 4;
    const float* mod = (const float*)(p.ws + OFF_MOD);
    f32x4 wpo[4], wpr[4];
#pragma unroll
    for (int i = 0; i < 4; ++i) { if (hasY) wpo[i] = *(const f32x4*)(wpost + lane * 4 + 256 * i); if (hasH) wpr[i] = *(const f32x4*)(wpre + lane * 4 + 256 * i); }
    for (int row0 = gw; row0 < 16384; row0 += 2 * nw) {
        f32x4 x[2][4], y[2][4];
#pragma unroll
        for (int r = 0; r < 2; ++r) {
            const int row = row0 + r * nw;
            const float* xin = xin_input ? (row < 8192 ? p.x_prompt + (size_t)row * 1024 : p.x_sample + (size_t)(row - 8192) * 1024) : p.out + (size_t)row * 1024;
            const float* yin = (const float*)(p.ws + OFF_HY + (size_t)row * 4096);
#pragma unroll
            for (int i = 0; i < 4; ++i) { x[r][i] = *(const f32x4*)(xin + lane * 4 + 256 * i); if (hasY) y[r][i] = *(const f32x4*)(yin + lane * 4 + 256 * i); }
        }
#pragma unroll
        for (int r = 0; r < 2; ++r) {
            const int row = row0 + r * nw;
            const int v = row < 8192 ? 0 : 1 + ((row - 8192) >> 10);
            char* hy = p.ws + OFF_HY + (size_t)row * 4096;
            if (hasY) {
                f32x4 g4[4];
#pragma unroll
                for (int i = 0; i < 4; ++i) g4[i] = *(const f32x4*)(mod + v * 6144 + g_off + lane * 4 + 256 * i);
                float ss = 0.f;
#pragma unroll
                for (int i = 0; i < 4; ++i) ss += y[r][i][0] * y[r][i][0] + y[r][i][1] * y[r][i][1] + y[r][i][2] * y[r][i][2] + y[r][i][3] * y[r][i][3];
                ss = wave_sum(ss);
                const float rs = rsqrtf(ss * (1.f / 1024.f) + EPSN);
#pragma unroll
                for (int i = 0; i < 4; ++i) {
                    x[r][i] += g4[i] * (y[r][i] * rs * wpo[i]);
                    *(f32x4*)(p.out + (size_t)row * 1024 + lane * 4 + 256 * i) = x[r][i];
                }
            }
            if (hasH) {
                f32x4 sc[4], sh[4];
#pragma unroll
                for (int i = 0; i < 4; ++i) { sc[i] = *(const f32x4*)(mod + v * 6144 + sc_off + lane * 4 + 256 * i); sh[i] = *(const f32x4*)(mod + v * 6144 + sh_off + lane * 4 + 256 * i); }
                float ss = 0.f;
#pragma unroll
                for (int i = 0; i < 4; ++i) ss += x[r][i][0] * x[r][i][0] + x[r][i][1] * x[r][i][1] + x[r][i][2] * x[r][i][2] + x[r][i][3] * x[r][i][3];
                ss = wave_sum(ss);
                const float rs = rsqrtf(ss * (1.f / 1024.f) + EPSN);
#pragma unroll
                for (int i = 0; i < 4; ++i) {
                    const f32x4 h = x[r][i] * rs * wpr[i] * (sc[i] + 1.f) + sh[i];
                    u32x2 o = {pk2(h[0], h[1]), pk2(h[2], h[3])};
                    *(u32x2*)((bf16_t*)hy + lane * 4 + 256 * i) = o;
                }
            }
        }
    }
}

namespace g8 {
constexpr int BK = 64, HALF = 128, HTB = HALF * BK * 2;
DI int lds_byte(int r, int c) { const int st = (r >> 4) * 2 + (c >> 5), rr = r & 15, cc = c & 31, ob = rr * 64 + cc * 2; return st * 1024 + (ob ^ (((ob >> 9) & 1) << 5)); }
DI void stage_rc(int b, int& R, int& C) { const int st = b / 1024, sb = b % 1024, swz = sb ^ (((sb >> 9) & 1) << 5); R = (st >> 1) * 16 + swz / 64; C = (st & 1) * 32 + (swz % 64) / 2; }
typedef __attribute__((address_space(3))) unsigned lds_u32;
typedef __attribute__((address_space(3))) unsigned char lds_u8;
typedef __attribute__((address_space(3))) bf16x8 lds_bf16x8;

template <int VTM>
DI void kloop(const bf16_t* __restrict__ A, int lda, const bf16_t* __restrict__ Bt, int K, int brow, int bcol, char* shm, f32x4 (&acc)[2][2][4][2]) {
#define SA(b, h) (((b) * 2 + (h)) * HTB)
#define SB(b, h) ((4 + (b) * 2 + (h)) * HTB)
#define STAGE_(bufoff, gbase, voff) do { _Pragma("unroll") for (int _i = 0; _i < 2; ++_i) \
      __builtin_amdgcn_global_load_lds((const unsigned*)((gbase) + (voff)[_i]), (lds_u32*)(lds + (bufoff) + ldsw + _i * 8192), 16, 0, 0); } while (0)
#define STAGE(P, BASE, LD, br, kt) STAGE_(P, (const char*)(BASE) + ((size_t)(br) * (LD) + (size_t)(kt) * BK) * 2, voff##BASE)
#define LDA(dst, b, h) _Pragma("unroll") for (int m = 0; m < 4; ++m) _Pragma("unroll") for (int k = 0; k < 2; ++k) \
    dst[m][k] = *(const lds_bf16x8*)(lds + SA(b, h) + aoff + m * 2048 + k * 1024)
#define LDB(dst, b, h) _Pragma("unroll") for (int n = 0; n < 2; ++n) _Pragma("unroll") for (int k = 0; k < 2; ++k) \
    dst[n][k] = *(const lds_bf16x8*)(lds + SB(b, h) + boff + n * 2048 + k * 1024)
#define MMA(ai, bj, At_, Bt_) do { __builtin_amdgcn_s_setprio(1); \
    _Pragma("unroll") for (int m = 0; m < 4; ++m) _Pragma("unroll") for (int n = 0; n < 2; ++n) _Pragma("unroll") for (int k = 0; k < 2; ++k) \
      acc[ai][bj][m][n] = (VTM == 1 || (VTM == 2 && (bj) == 1)) ? MFMA16(At_[m][k], Bt_[n][k], acc[ai][bj][m][n]) : MFMA16(Bt_[n][k], At_[m][k], acc[ai][bj][m][n]); \
    __builtin_amdgcn_s_setprio(0); } while (0)
#define WAIT_V(n) asm volatile("s_waitcnt vmcnt(" #n ")" ::: "memory")
#define WAIT_L(n) asm volatile("s_waitcnt lgkmcnt(" #n ")" ::: "memory")
#define BAR __builtin_amdgcn_s_barrier()
#define SCHED __builtin_amdgcn_sched_barrier(0)
    const int tid = TIDX, wid = __builtin_amdgcn_readfirstlane(tid >> 6), lane = tid & 63, wr = wid >> 2, wc = wid & 3, fr = lane & 15, fq = lane >> 4;
    bf16x8 At[4][2], B0[2][2], B1[2][2];
    const int nt = K / BK;
    lds_u8* lds = (lds_u8*)shm;
    unsigned voffA[2], voffBt[2];
#pragma unroll
    for (int _i = 0; _i < 2; ++_i) { int _r, _c; stage_rc(tid * 16 + _i * 8192, _r, _c); voffA[_i] = (unsigned)(_r * lda + _c) * 2u; voffBt[_i] = (unsigned)(_r * K + _c) * 2u; }
    const unsigned ldsw = (unsigned)wid * 1024u;
    const int aoff = lds_byte(wr * 64 + fr, fq * 8), boff = lds_byte(wc * 32 + fr, fq * 8);
    WAIT_V(0);
    STAGE(SB(0, 0), Bt, K, bcol, 0); STAGE(SA(0, 0), A, lda, brow, 0);
    STAGE(SB(0, 1), Bt, K, bcol + HALF, 0); STAGE(SA(0, 1), A, lda, brow + HALF, 0);
    if (wr == 1) BAR;
    WAIT_V(4); BAR;
    STAGE(SB(1, 0), Bt, K, bcol, 1); STAGE(SA(1, 0), A, lda, brow, 1); STAGE(SB(1, 1), Bt, K, bcol + HALF, 1);
    WAIT_V(6); BAR;
    for (int t = 0; t < nt - 2; t += 2) {
        LDB(B0, 0, 0); SCHED; LDA(At, 0, 0); STAGE(SA(1, 1), A, lda, brow + HALF, t + 1);
        WAIT_L(8); BAR; WAIT_L(0); MMA(0, 0, At, B0); BAR; SCHED;
        LDB(B1, 0, 1); STAGE(SB(0, 0), Bt, K, bcol, t + 2);
        BAR; WAIT_L(0); MMA(0, 1, At, B1); BAR;
        LDA(At, 0, 1); STAGE(SA(0, 0), A, lda, brow, t + 2);
        BAR; WAIT_L(0); MMA(1, 0, At, B0); BAR; SCHED;
        STAGE(SB(0, 1), Bt, K, bcol + HALF, t + 2);
        WAIT_V(6); BAR; MMA(1, 1, At, B1); BAR;
        LDB(B0, 1, 0); SCHED; LDA(At, 1, 0); STAGE(SA(0, 1), A, lda, brow + HALF, t + 2);
        WAIT_L(8); BAR; WAIT_L(0); MMA(0, 0, At, B0); BAR; SCHED;
        LDB(B1, 1, 1); STAGE(SB(1, 0), Bt, K, bcol, t + 3);
        BAR; WAIT_L(0); MMA(0, 1, At, B1); BAR;
        LDA(At, 1, 1); STAGE(SA(1, 0), A, lda, brow, t + 3);
        BAR; WAIT_L(0); MMA(1, 0, At, B0); BAR; SCHED;
        STAGE(SB(1, 1), Bt, K, bcol + HALF, t + 3);
        WAIT_V(6); BAR; MMA(1, 1, At, B1); BAR;
    }
    { LDB(B0, 0, 0); LDA(At, 0, 0); STAGE(SA(1, 1), A, lda, brow + HALF, nt - 1);
      BAR; WAIT_L(0); MMA(0, 0, At, B0); BAR;
      LDB(B1, 0, 1); BAR; WAIT_L(0); MMA(0, 1, At, B1); BAR;
      LDA(At, 0, 1); WAIT_V(4); BAR; WAIT_L(0); MMA(1, 0, At, B0); MMA(1, 1, At, B1); BAR; }
    { LDB(B0, 1, 0); LDA(At, 1, 0); WAIT_V(2); BAR; WAIT_L(0); MMA(0, 0, At, B0); BAR;
      LDB(B1, 1, 1); WAIT_V(0); BAR; WAIT_L(0); MMA(0, 1, At, B1); BAR;
      LDA(At, 1, 1); BAR; WAIT_L(0); MMA(1, 0, At, B0); MMA(1, 1, At, B1); BAR; }
    if (wr == 0) BAR;
#undef SA
#undef SB
#undef STAGE
#undef STAGE_
#undef LDA
#undef LDB
#undef MMA
#undef WAIT_V
#undef WAIT_L
#undef BAR
#undef SCHED
}
}

enum { EPI_PE = 0, EPI_PO = 1, EPI_Y = 2, EPI_W1 = 3, EPI_YF = 4 };

struct FuseP { int from_input, hasH; const float* g; const float* wpost; const float* wpre; const float* sc; const float* sh; float* ssY; float* ssX; unsigned* cnt; };
DI float ld_agent(const float* q) { return __hip_atomic_load(q, __ATOMIC_RELAXED, __HIP_MEMORY_SCOPE_AGENT); }
DI void panel_wait(unsigned* c, unsigned target) {
    asm volatile("s_waitcnt vmcnt(0)" ::: "memory");
    __syncthreads();
    if (threadIdx.x == 0) {
        __hip_atomic_fetch_add(c, 1u, __ATOMIC_RELAXED, __HIP_MEMORY_SCOPE_AGENT);
        unsigned sp = 0;
        while (__hip_atomic_load(c, __ATOMIC_RELAXED, __HIP_MEMORY_SCOPE_AGENT) < target) { __builtin_amdgcn_s_sleep(1); if (++sp > (1u << 22)) break; }
    }
    __syncthreads();
}
DI float dot4(const f32x4& a) { return a[0] * a[0] + a[1] * a[1] + a[2] * a[2] + a[3] * a[3]; }

DI void rope_s(f32x4 (&sub)[4][2], int R0, bool usecol, int fr, int fq) {
    float inv[4];
#pragma unroll
    for (int j = 0; j < 4; ++j) inv[j] = exp2f(-(float)(fq * 4 + j) * (13.287712379549449f / 16.f));
#pragma unroll
    for (int m = 0; m < 4; ++m) {
        const int tl = (R0 + m * 16 + fr - 8192) & 1023;
        const float pos = (float)(usecol ? (tl & 63) : (tl >> 6));
#pragma unroll
        for (int j = 0; j < 4; ++j) {
            float s, c;
            __sincosf(pos * inv[j], &s, &c);
            const float a = sub[m][0][j], b = sub[m][1][j];
            sub[m][0][j] = a * c - b * s; sub[m][1][j] = b * c + a * s;
        }
    }
}
DI void store_bf16_rows_s(const f32x4 (&sub)[4][2], bf16_t* base, int ld, int R0, int Cd0, int fr, int fq) {
#pragma unroll
    for (int m = 0; m < 4; ++m) {
        bf16_t* rp = base + (size_t)(R0 + m * 16 + fr) * ld + Cd0 + fq * 4;
#pragma unroll
        for (int n = 0; n < 2; ++n) { u32x2 o = {pk2(sub[m][n][0], sub[m][n][1]), pk2(sub[m][n][2], sub[m][n][3])}; *(u32x2*)(rp + n * 16) = o; }
    }
}
DI void store_f32_rows_s(const f32x4 (&sub)[4][2], float* ob, int ldo, int fr, int fq) {
#pragma unroll
    for (int m = 0; m < 4; ++m) {
        float* rp = ob + (size_t)(m * 16 + fr) * ldo + fq * 4;
#pragma unroll
        for (int n = 0; n < 2; ++n) *(f32x4*)(rp + n * 16) = sub[m][n];
    }
}
DI void store_vt_s(const f32x4 (&sub)[4][2], bf16_t* vt, int T, int t0, int fr, int fq) {
#pragma unroll
    for (int n = 0; n < 2; ++n) {
        bf16_t* rp = vt + (size_t)(n * 16 + fr) * T + t0 + fq * 4;
#pragma unroll
        for (int m = 0; m < 4; ++m) { u32x2 o = {pk2(sub[m][n][0], sub[m][n][1]), pk2(sub[m][n][2], sub[m][n][3])}; *(u32x2*)(rp + m * 16) = o; }
    }
}
DI void store_f32_ns_s(const f32x4 (&sub)[4][2], float* ob, int ldo, int fr, int fq) {
#pragma unroll
    for (int m = 0; m < 4; ++m)
#pragma unroll
        for (int j = 0; j < 4; ++j) {
            float* rp = ob + (size_t)(m * 16 + fq * 4 + j) * ldo + fr;
#pragma unroll
            for (int n = 0; n < 2; ++n) rp[n * 16] = sub[m][n][j];
        }
}

template <int EPI>
DI void gemm_tile(const Params& p, const bf16_t* A, int lda, const bf16_t* Bt, int K, int pm, int pn, char* shm, const FuseP& fz) {
    const int tix = TIDX, wid = __builtin_amdgcn_readfirstlane(tix >> 6), lane = tix & 63, wr = wid >> 2, wc = wid & 3;
    f32x4 acc[2][2][4][2];
#pragma unroll
    for (int ai = 0; ai < 2; ++ai)
#pragma unroll
        for (int bj = 0; bj < 2; ++bj)
#pragma unroll
            for (int m = 0; m < 4; ++m)
#pragma unroll
                for (int n = 0; n < 2; ++n) acc[ai][bj][m][n] = (f32x4){0.f, 0.f, 0.f, 0.f};
    const int brow = pm * 256, bcol = pn * 256;
    int vtm = 0;
    if (EPI == EPI_PE) vtm = pn >= 10 ? 1 : 0;
    if (EPI == EPI_PO) vtm = (pn == 4 || pn == 5) ? 1 : (pn == 8 ? 2 : 0);
    if ((EPI == EPI_PE || EPI == EPI_PO) && vtm == 1) g8::kloop<1>(A, lda, Bt, K, brow, bcol, shm, acc);
    else if (EPI == EPI_PO && vtm == 2) g8::kloop<2>(A, lda, Bt, K, brow, bcol, shm, acc);
    else g8::kloop<0>(A, lda, Bt, K, brow, bcol, shm, acc);

    int fr = lane & 15, fq = lane >> 4;
    asm volatile("" : "+v"(fr), "+v"(fq));
    const bool latent = brow >= 8192;
    int b, tb, T;
    if (latent) { b = (brow - 8192) >> 10; tb = (brow - 8192) & 1023; T = 1024; } else { b = brow >> 8; tb = 0; T = 256; }
    bf16_t* big = (bf16_t*)(p.ws + OFF_BIG);
    if (EPI == EPI_YF) {
        const int v = latent ? 1 + b : 0;
        const int rbase = brow + wr * 64 + fr;
        const int cbase = bcol + wc * 32 + fq * 4;
        float rs[2][4];
#pragma unroll
        for (int ai = 0; ai < 2; ++ai)
#pragma unroll
            for (int m = 0; m < 4; ++m) {
                float sq = dot4(acc[ai][0][m][0]) + dot4(acc[ai][0][m][1]) + dot4(acc[ai][1][m][0]) + dot4(acc[ai][1][m][1]);
                sq += __shfl_xor(sq, 16); sq += __shfl_xor(sq, 32);
                if (fq == 0) { const float old = __hip_atomic_fetch_add(fz.ssY + rbase + ai * 128 + m * 16, sq, __ATOMIC_RELAXED, __HIP_MEMORY_SCOPE_AGENT); asm volatile("" :: "v"(old)); }
            }
        panel_wait(fz.cnt + pm * 32, 4u);
#pragma unroll
        for (int ai = 0; ai < 2; ++ai)
#pragma unroll
            for (int m = 0; m < 4; ++m) rs[ai][m] = rsqrtf(ld_agent(fz.ssY + rbase + ai * 128 + m * 16) * (1.f / 1024.f) + EPSN);
        const float* xin = fz.from_input ? (latent ? p.x_sample - (size_t)8192 * 1024 : p.x_prompt) : p.out;
        float s2[2][4];
#pragma unroll
        for (int ai = 0; ai < 2; ++ai)
#pragma unroll
            for (int m = 0; m < 4; ++m) s2[ai][m] = 0.f;
#pragma unroll
        for (int bj = 0; bj < 2; ++bj)
#pragma unroll
            for (int n = 0; n < 2; ++n) {
                const int col = cbase + bj * 128 + n * 16;
                const f32x4 g4 = *(const f32x4*)(fz.g + v * 6144 + col), wp4 = *(const f32x4*)(fz.wpost + col);
#pragma unroll
                for (int ai = 0; ai < 2; ++ai)
#pragma unroll
                    for (int m = 0; m < 4; ++m) {
                        const size_t off = (size_t)(rbase + ai * 128 + m * 16) * 1024 + col;
                        const f32x4 x4 = *(const f32x4*)(xin + off);
                        const f32x4 a = x4 + g4 * (acc[ai][bj][m][n] * rs[ai][m] * wp4);
                        acc[ai][bj][m][n] = a;
                        *(f32x4*)(p.out + off) = a;
                        s2[ai][m] += dot4(a);
                    }
            }
        if (fz.hasH) {
#pragma unroll
            for (int ai = 0; ai < 2; ++ai)
#pragma unroll
                for (int m = 0; m < 4; ++m) {
                    float sq = s2[ai][m];
                    sq += __shfl_xor(sq, 16); sq += __shfl_xor(sq, 32);
                    if (fq == 0) { const float old = __hip_atomic_fetch_add(fz.ssX + rbase + ai * 128 + m * 16, sq, __ATOMIC_RELAXED, __HIP_MEMORY_SCOPE_AGENT); asm volatile("" :: "v"(old)); }
                }
            panel_wait(fz.cnt + pm * 32 + 16, 4u);
#pragma unroll
            for (int ai = 0; ai < 2; ++ai)
#pragma unroll
                for (int m = 0; m < 4; ++m) rs[ai][m] = rsqrtf(ld_agent(fz.ssX + rbase + ai * 128 + m * 16) * (1.f / 1024.f) + EPSN);
            bf16_t* hb = (bf16_t*)(p.ws + OFF_HY);
#pragma unroll
            for (int bj = 0; bj < 2; ++bj)
#pragma unroll
                for (int n = 0; n < 2; ++n) {
                    const int col = cbase + bj * 128 + n * 16;
                    const f32x4 wq4 = *(const f32x4*)(fz.wpre + col), sc4 = *(const f32x4*)(fz.sc + v * 6144 + col) + 1.f, sh4 = *(const f32x4*)(fz.sh + v * 6144 + col);
#pragma unroll
                    for (int ai = 0; ai < 2; ++ai)
#pragma unroll
                        for (int m = 0; m < 4; ++m) {
                            const f32x4 h = acc[ai][bj][m][n] * rs[ai][m] * wq4 * sc4 + sh4;
                            u32x2 o = {pk2(h[0], h[1]), pk2(h[2], h[3])};
                            *(u32x2*)(hb + (size_t)(rbase + ai * 128 + m * 16) * 2048 + col) = o;
                        }
                }
        }
        return;
    }
#pragma unroll
    for (int ai = 0; ai < 2; ++ai)
#pragma unroll
        for (int bj = 0; bj < 2; ++bj) {
            f32x4 (&sub)[4][2] = acc[ai][bj];
            const int R0 = brow + ai * 128 + wr * 64, t0 = tb + ai * 128 + wr * 64, C0 = bcol + bj * 128 + wc * 32;
            const bool ns = vtm == 1 || (vtm == 2 && bj == 1);
            if (EPI == EPI_PE) {
                if (ns) {
                    const int vc = C0 - 2560;
                    bf16_t* vt = (bf16_t*)(p.ws + OFF_BIG + BIG_VT_E) + (latent ? (size_t)4194304 + ((size_t)b * 512 + vc) * 1024 : ((size_t)b * 512 + vc) * 256);
                    store_vt_s(sub, vt, T, t0, fr, fq);
                    if (!latent) store_f32_ns_s(sub, p.out + OUT_DIFFV + ((size_t)(b * 4 + (vc >> 7)) * 256 + t0) * 128 + (vc & 127), 128, fr, fq);
                } else {
                    if (pn >= 6 && latent) rope_s(sub, R0, wc & 1, fr, fq);
                    store_bf16_rows_s(sub, big, LDE, R0, C0, fr, fq);
                    if (pn >= 8 && !latent) store_f32_rows_s(sub, p.out + OUT_DIFFK + ((size_t)(b * 8 + ((C0 - 2048) >> 6)) * 256 + t0) * 64 + ((C0 - 2048) & 63), 64, fr, fq);
                }
            } else if (EPI == EPI_PO) {
                if (ns) {
                    if (pn < 8) {
                        const int vc = C0 - 1024;
                        bf16_t* vt = (bf16_t*)(p.ws + OFF_BIG + BIG_VT_C) + (latent ? (size_t)4194304 + ((size_t)b * 512 + vc) * 1024 : ((size_t)b * 512 + vc) * 256);
                        store_vt_s(sub, vt, T, t0, fr, fq);
                        if (!latent) store_f32_ns_s(sub, p.out + OUT_NAV + ((size_t)(b * 8 + (vc >> 6)) * 256 + t0) * 64 + (vc & 63), 64, fr, fq);
                    } else {
                        const int vc = C0 - 2176;
                        bf16_t* vt = (bf16_t*)(p.ws + OFF_BIG + BIG_VT_D) + (latent ? (size_t)1048576 + ((size_t)b * 128 + vc) * 1024 : ((size_t)b * 128 + vc) * 256);
                        store_vt_s(sub, vt, T, t0, fr, fq);
                        if (!latent) store_f32_ns_s(sub, p.out + OUT_SWAV + ((size_t)(b * 2 + (vc >> 6)) * 256 + t0) * 64 + (vc & 63), 64, fr, fq);
                    }
                } else {
                    if (pn >= 6 && latent) rope_s(sub, R0, wc & 1, fr, fq);
                    store_bf16_rows_s(sub, big, LDO, R0, pn >= 6 ? C0 - 512 : C0, fr, fq);
                    if (!latent) {
                        if (pn == 2 || pn == 3) store_f32_rows_s(sub, p.out + OUT_NAK + ((size_t)(b * 8 + ((C0 - 512) >> 6)) * 256 + t0) * 64 + ((C0 - 512) & 63), 64, fr, fq);
                        else if (pn == 8) store_f32_rows_s(sub, p.out + OUT_SWAK + ((size_t)(b * 2 + ((C0 - 2048) >> 6)) * 256 + t0) * 64 + ((C0 - 2048) & 63), 64, fr, fq);
                    }
                }
            } else if (EPI == EPI_Y) {
                store_f32_rows_s(sub, (float*)(p.ws + OFF_HY) + (size_t)R0 * 1024 + C0, 1024, fr, fq);
            } else {
#pragma unroll
                for (int m = 0; m < 4; ++m)
#pragma unroll
                    for (int n = 0; n < 2; ++n)
#pragma unroll
                        for (int j = 0; j < 4; ++j) { const float v = fmaxf(sub[m][n][j], 0.f); sub[m][n][j] = v * v; }
                store_bf16_rows_s(sub, big, 4096, R0, C0, fr, fq);
            }
        }
}

template <int EPI>
DI void gemm_phase(const Params& p, const bf16_t* A, int lda, const bf16_t* Bt, int K, int NT_N, char* shm, const FuseP& fz = FuseP{}) {
    const int xcd = blockIdx.x & 7, lb = blockIdx.x >> 3, nlb = gridDim.x >> 3;
    const int per_xcd = 8 * NT_N;
    for (int lt = lb; lt < per_xcd; lt += nlb) gemm_tile<EPI>(p, A, lda, Bt, K, xcd * 8 + (lt & 7), lt >> 3, shm, fz);
}

struct ASeg { const bf16_t* K; const bf16_t* Vt; int ldk, ldv, ntiles; };
struct MaskP { int on, a, b, c; const float* tab; };

template <int KW, int VR, int NB, int MODE>
DI void attn_core(const ASeg& s0, const ASeg& s1, const bf16x8 (&qf)[4], int kchunk0, int vrow0, float scale_l2, float& m, float& l, f32x16 (&O)[NB], char* lds, const MaskP& mp) {
    constexpr int KC = KW / 8, NKL = 64 * KC / 256, NVL = VR * 8 / 256;
    const int tid = VTID, lane = tid & 63, p32 = lane & 31, h = lane >> 5;
    const int krow = (p32 & 19) | ((p32 & 4) << 1) | ((p32 & 8) >> 1);
    const int n0 = s0.ntiles, nt = s0.ntiles + s1.ntiles;
    u32x4 rk[NKL], rv[NVL];
#define ATT_LOAD(t_)                                                                                                         \
    {                                                                                                                        \
        const bool f_ = (t_) < n0; const int tt_ = f_ ? (t_) : (t_) - n0;                                                     \
        const bf16_t* Kp_ = (f_ ? s0.K : s1.K); const int ldk_ = f_ ? s0.ldk : s1.ldk;                                        \
        const bf16_t* Vp_ = (f_ ? s0.Vt : s1.Vt); const int ldv_ = f_ ? s0.ldv : s1.ldv;                                      \
        _Pragma("unroll") for (int i = 0; i < NKL; ++i) { const int id = tid + 256 * i, r = id / KC, c = id % KC; rk[i] = *(const u32x4*)(Kp_ + (size_t)(tt_ * 64 + r) * ldk_ + c * 8); } \
        _Pragma("unroll") for (int i = 0; i < NVL; ++i) { const int id = tid + 256 * i, r = id >> 3, c = id & 7; rv[i] = *(const u32x4*)(Vp_ + (size_t)r * ldv_ + tt_ * 64 + c * 8); }       \
    }
#define ATT_STORE(b_)                                                                                                        \
    {                                                                                                                        \
        char* kb_ = lds + (b_) * 32768; char* vb_ = kb_ + 16384;                                                              \
        _Pragma("unroll") for (int i = 0; i < NKL; ++i) { const int id = tid + 256 * i, r = id / KC, c = id % KC; *(u32x4*)(kb_ + (KW == 128 ? swz256(r, c) : swz128(r, c))) = rk[i]; } \
        _Pragma("unroll") for (int i = 0; i < NVL; ++i) { const int id = tid + 256 * i, r = id >> 3, c = id & 7; *(u32x4*)(vb_ + swz128(r, c)) = rv[i]; }                               \
    }
    ATT_LOAD(0);
    ATT_STORE(0);
    __syncthreads();
    for (int t = 0; t < nt; ++t) {
        const bool more = t + 1 < nt;
        if (more) ATT_LOAD(t + 1);
        const char* kb = lds + (t & 1) * 32768;
        const char* vb = kb + 16384;
        f32x16 S[2];
#pragma unroll
        for (int kh = 0; kh < 2; ++kh) {
#pragma unroll
            for (int i = 0; i < 16; ++i) S[kh][i] = 0.f;
            const int row = krow + 32 * kh;
#pragma unroll
            for (int s = 0; s < 4; ++s) {
                const int c = kchunk0 + 2 * s + h;
                const bf16x8 kf = *(const bf16x8*)(kb + (KW == 128 ? swz256(row, c) : swz128(row, c)));
                S[kh] = MFMA32(kf, qf[s], S[kh]);
            }
        }
        const bool msk = (MODE != 0) && mp.on && t < n0;
        float mx = -1e30f;
        if (MODE == 1 && msk) {
            int cq = mp.c + p32;
            int h8 = 8 * h;
            asm volatile("" : "+v"(cq), "+v"(h8));
            const int cs = min(max(cq - 8, 0), 48);
            const float* tab = mp.tab + (mp.b + t - mp.a + 7) * 31;
#pragma unroll
            for (int kh = 0; kh < 2; ++kh)
#pragma unroll
                for (int i = 0; i < 16; ++i) {
                    const int kc = 32 * kh + 16 * (i >> 3) + h8 + (i & 7);
                    const bool ok = (unsigned)(kc - cs) < 16u;
                    const int dc = min(max(kc - cq + 15, 0), 30);
                    const float sv = ok ? S[kh][i] * scale_l2 + tab[dc] : -1e30f;
                    S[kh][i] = sv; mx = fmaxf(mx, sv);
                }
        } else if (MODE == 2 && msk) {
            int qp = mp.a + p32 - 8 * h;
            asm volatile("" : "+v"(qp));
            const int k0 = mp.b + t * 64;
#pragma unroll
            for (int kh = 0; kh < 2; ++kh)
#pragma unroll
                for (int i = 0; i < 16; ++i) {
                    const int d = qp - (k0 + 32 * kh + 16 * (i >> 3) + (i & 7));
                    const bool ok = d <= 128 && d >= -128;
                    const float sv = ok ? S[kh][i] * scale_l2 : -1e30f;
                    S[kh][i] = sv; mx = fmaxf(mx, sv);
                }
        } else {
#pragma unroll
            for (int kh = 0; kh < 2; ++kh)
#pragma unroll
                for (int i = 0; i < 16; ++i) { const float sv = S[kh][i] * scale_l2; S[kh][i] = sv; mx = fmaxf(mx, sv); }
        }
        mx = fmaxf(mx, __shfl_xor(mx, 32));
        const float mn = fmaxf(m, mx);
        const float alpha = __builtin_amdgcn_exp2f(m - mn);
        m = mn;
        float ls = 0.f;
#pragma unroll
        for (int kh = 0; kh < 2; ++kh)
#pragma unroll
            for (int i = 0; i < 16; ++i) { const float pv = __builtin_amdgcn_exp2f(S[kh][i] - mn); S[kh][i] = pv; ls += pv; }
        l = l * alpha + ls;
#pragma unroll
        for (int blk = 0; blk < NB; ++blk)
#pragma unroll
            for (int i = 0; i < 16; ++i) O[blk][i] *= alpha;
#pragma unroll
        for (int kh = 0; kh < 2; ++kh)
#pragma unroll
            for (int s2 = 0; s2 < 2; ++s2) {
                u32x4 pp = {pk2(S[kh][8 * s2 + 0], S[kh][8 * s2 + 1]), pk2(S[kh][8 * s2 + 2], S[kh][8 * s2 + 3]), pk2(S[kh][8 * s2 + 4], S[kh][8 * s2 + 5]), pk2(S[kh][8 * s2 + 6], S[kh][8 * s2 + 7])};
                const bf16x8 pb = __builtin_bit_cast(bf16x8, pp);
                const int c = 4 * kh + 2 * s2 + h;
#pragma unroll
                for (int blk = 0; blk < NB; ++blk) {
                    const bf16x8 vf = *(const bf16x8*)(vb + swz128(vrow0 + blk * 32 + p32, c));
                    O[blk] = MFMA32(vf, pb, O[blk]);
                }
            }
        if (more) ATT_STORE((t + 1) & 1);
        __syncthreads();
    }
    l += __shfl_xor(l, 32);
#undef ATT_LOAD
#undef ATT_STORE
}

DI void load_q(bf16x8 (&qf)[4], const bf16_t* qrow, int h) {
#pragma unroll
    for (int s = 0; s < 4; ++s) qf[s] = *(const bf16x8*)(qrow + 16 * s + 8 * h);
}

DI void attn_diff_item(const Params& p, int item, char* lds) {
    const int tid = VTID, lane = tid & 63, w = tid >> 6, p32 = lane & 31, h = lane >> 5, stream = w & 1, qh = w >> 1;
    const bf16_t* proj = (const bf16_t*)(p.ws + OFF_BIG);
    const bf16_t* vte = (const bf16_t*)(p.ws + OFF_BIG + BIG_VT_E);
    bf16_t* mix = (bf16_t*)(p.ws + OFF_BIG + BIG_MIXIN);
    int b, hd, qb, rowbase; ASeg s0, s1;
    if (item < 512) {
        b = item >> 6; hd = (item >> 4) & 3; qb = item & 15; rowbase = 8192 + b * 1024;
        s0 = {proj + (size_t)rowbase * LDE + 2048 + hd * 128, vte + 4194304 + ((size_t)b * 512 + hd * 128) * 1024, LDE, 1024, 16};
        s1 = {(const bf16_t*)(p.ws + OFF_CDK) + (size_t)b * 256 * 512 + hd * 128, (const bf16_t*)(p.ws + OFF_CDVT) + (size_t)(b * 4 + hd) * 128 * 256, 512, 256, 4};
    } else {
        const int it = item - 512;
        b = it >> 4; hd = (it >> 2) & 3; qb = it & 3; rowbase = b * 256;
        s0 = {proj + (size_t)rowbase * LDE + 2048 + hd * 128, vte + ((size_t)b * 512 + hd * 128) * 256, LDE, 256, 4};
        s1 = s0; s1.ntiles = 0;
    }
    const int R = rowbase + qb * 64 + qh * 32 + p32;
    bf16x8 qf[4];
    load_q(qf, proj + (size_t)R * LDE + 1536 + hd * 128 + stream * 64, h);
    f32x16 O[4];
#pragma unroll
    for (int blk = 0; blk < 4; ++blk)
#pragma unroll
        for (int i = 0; i < 16; ++i) O[blk][i] = 0.f;
    float m = -1e30f, l = 0.f;
    MaskP mp = {0, 0, 0, 0, nullptr};
    attn_core<128, 128, 4, 0>(s0, s1, qf, stream * 8, 0, 0.125f * LOG2E, m, l, O, lds, mp);
    const float il = 1.f / l;
    const float d1 = wave_sum(p.lq1[lane] * p.lk1[lane]), d2 = wave_sum(p.lq2[lane] * p.lk2[lane]);
    const float lam_init = 0.2f;
    const float lam = __expf(d1) - __expf(d2) + lam_init;
    float* xb = (float*)(lds + qh * 16384);
    if (stream == 1) {
#pragma unroll
        for (int blk = 0; blk < 4; ++blk)
#pragma unroll
            for (int i = 0; i < 16; ++i) { const int dv = blk * 32 + 8 * (i >> 2) + 4 * h + (i & 3); xb[dv * 32 + p32] = O[blk][i] * il; }
    }
    __syncthreads();
    if (stream == 0) {
        float ss = 0.f;
#pragma unroll
        for (int blk = 0; blk < 4; ++blk)
#pragma unroll
            for (int i = 0; i < 16; ++i) { const int dv = blk * 32 + 8 * (i >> 2) + 4 * h + (i & 3); const float o = O[blk][i] * il - lam * xb[dv * 32 + p32]; O[blk][i] = o; ss += o * o; }
        ss += __shfl_xor(ss, 32);
        const float rs = rsqrtf(ss * (1.f / 128.f) + EPSN) * (1.f - lam_init);
        bf16_t* op = mix + (size_t)R * 1024 + 512 + hd * 128;
#pragma unroll
        for (int blk = 0; blk < 4; ++blk)
#pragma unroll
            for (int g = 0; g < 4; ++g) {
                const int dv = blk * 32 + 8 * g + 4 * h;
                const f32x4 sl = *(const f32x4*)(p.subln + dv);
                u32x2 o = {pk2(O[blk][4 * g] * rs * sl[0], O[blk][4 * g + 1] * rs * sl[1]), pk2(O[blk][4 * g + 2] * rs * sl[2], O[blk][4 * g + 3] * rs * sl[3])};
                *(u32x2*)(op + dv) = o;
            }
    }
    __syncthreads();
}

DI void attn_c_item(const Params& p, int item, char* lds) {
    const int tid = VTID, lane = tid & 63, w = tid >> 6, p32 = lane & 31, h = lane >> 5, stream = w & 1, qh = w >> 1;
    const bf16_t* proj = (const bf16_t*)(p.ws + OFF_BIG);
    const bf16_t* vtc = (const bf16_t*)(p.ws + OFF_BIG + BIG_VT_C);
    bf16_t* mix = (bf16_t*)(p.ws + OFF_BIG + BIG_MIXIN);
    int b, hp, qb, rowbase; ASeg s0, s1; MaskP mp = {0, 0, 0, 0, nullptr};
    float* tab = (float*)(lds + 65536);
    if (item < 512) {
        b = item >> 6; hp = (item >> 4) & 3; qb = item & 15; rowbase = 8192 + b * 1024;
        const int rstart = min(max(qb - 4, 0), 8);
        s0 = {proj + (size_t)(rowbase + rstart * 64) * LDO + 512 + hp * 128, vtc + 4194304 + ((size_t)b * 512 + hp * 128) * 1024 + rstart * 64, LDO, 1024, 8};
        s1 = {(const bf16_t*)(p.ws + OFF_CNK) + (size_t)b * 256 * 512 + hp * 128, (const bf16_t*)(p.ws + OFF_CNVT) + ((size_t)b * 512 + hp * 128) * 256, 512, 256, 4};
        for (int idx = tid; idx < 930; idx += 256) tab[idx] = p.rpb[hp * 930 + idx] * LOG2E;
        mp = {1, qb, rstart, qh * 32, tab + stream * 465};
    } else {
        const int it = item - 512;
        b = it >> 4; hp = (it >> 2) & 3; qb = it & 3; rowbase = b * 256;
        s0 = {proj + (size_t)rowbase * LDO + 512 + hp * 128, vtc + ((size_t)b * 512 + hp * 128) * 256, LDO, 256, 4};
        s1 = s0; s1.ntiles = 0;
    }
    const int R = rowbase + qb * 64 + qh * 32 + p32;
    const int head = hp * 2 + stream;
    bf16x8 qf[4];
    load_q(qf, proj + (size_t)R * LDO + head * 64, h);
    f32x16 O[2];
#pragma unroll
    for (int blk = 0; blk < 2; ++blk)
#pragma unroll
        for (int i = 0; i < 16; ++i) O[blk][i] = 0.f;
    float m = -1e30f, l = 0.f;
    attn_core<128, 128, 2, 1>(s0, s1, qf, stream * 8, stream * 64, 0.125f * LOG2E, m, l, O, lds, mp);
    const float il = 1.f / l;
    bf16_t* op = mix + (size_t)R * 1024 + head * 64;
#pragma unroll
    for (int blk = 0; blk < 2; ++blk)
#pragma unroll
        for (int g = 0; g < 4; ++g) {
            const int dv = blk * 32 + 8 * g + 4 * h;
            u32x2 o = {pk2(O[blk][4 * g] * il, O[blk][4 * g + 1] * il), pk2(O[blk][4 * g + 2] * il, O[blk][4 * g + 3] * il)};
            *(u32x2*)(op + dv) = o;
        }
}

DI void attn_d_item(const Params& p, int item, char* lds) {
    const int tid = VTID, lane = tid & 63, w = tid >> 6, p32 = lane & 31, h = lane >> 5;
    const bf16_t* proj = (const bf16_t*)(p.ws + OFF_BIG);
    const bf16_t* vtd = (const bf16_t*)(p.ws + OFF_BIG + BIG_VT_D);
    bf16_t* mix = (bf16_t*)(p.ws + OFF_BIG + BIG_MIXIN);
    int b, g, qb, rowbase; ASeg s0, s1; MaskP mp = {0, 0, 0, 0, nullptr};
    if (item < 512) {
        b = item >> 6; g = (item >> 5) & 1; qb = item & 31; rowbase = 8192 + b * 1024;
        const int q0 = qb * 32;
        const int tlo = max(q0 - 128, 0) >> 6, thi = min(q0 + 159, 1023) >> 6;
        s0 = {proj + (size_t)(rowbase + tlo * 64) * LDO + 1536 + g * 64, vtd + 1048576 + ((size_t)b * 128 + g * 64) * 1024 + tlo * 64, LDO, 1024, thi - tlo + 1};
        s1 = {(const bf16_t*)(p.ws + OFF_CSK) + (size_t)b * 256 * 128 + g * 64, (const bf16_t*)(p.ws + OFF_CSVT) + ((size_t)b * 128 + g * 64) * 256, 128, 256, 4};
        mp = {1, q0, tlo * 64, 0, nullptr};
    } else {
        const int it = item - 512;
        b = it >> 4; g = (it >> 3) & 1; qb = it & 7; rowbase = b * 256;
        s0 = {proj + (size_t)rowbase * LDO + 1536 + g * 64, vtd + ((size_t)b * 128 + g * 64) * 256, LDO, 256, 4};
        s1 = s0; s1.ntiles = 0;
    }
    const int R = rowbase + qb * 32 + p32;
    const int hq = g * 4 + w;
    bf16x8 qf[4];
    load_q(qf, proj + (size_t)R * LDO + 1024 + hq * 64, h);
    f32x16 O[2];
#pragma unroll
    for (int blk = 0; blk < 2; ++blk)
#pragma unroll
        for (int i = 0; i < 16; ++i) O[blk][i] = 0.f;
    float m = p.sink[hq] * LOG2E, l = h == 0 ? 1.f : 0.f;
    attn_core<64, 64, 2, 2>(s0, s1, qf, 0, 0, 0.125f * LOG2E, m, l, O, lds, mp);
    const float il = 1.f / l;
    bf16_t* op = mix + (size_t)R * 1024 + 512 + hq * 64;
#pragma unroll
    for (int blk = 0; blk < 2; ++blk)
#pragma unroll
        for (int gg = 0; gg < 4; ++gg) {
            const int dv = blk * 32 + 8 * gg + 4 * h;
            u32x2 o = {pk2(O[blk][4 * gg] * il, O[blk][4 * gg + 1] * il), pk2(O[blk][4 * gg + 2] * il, O[blk][4 * gg + 3] * il)};
            *(u32x2*)(op + dv) = o;
        }
}

DI void conv_item(const Params& p, int item) {
    const int tid = VTID;
    const bf16_t* proj = (const bf16_t*)(p.ws + OFF_BIG);
    bf16_t* mix = (bf16_t*)(p.ws + OFF_BIG + BIG_MIXIN);
#pragma unroll 2
    for (int i = 0; i < 8; ++i) {
        const int idx = tid + 256 * i, tl = idx >> 6, ch = (idx & 63) * 8;
        const int R = item * 32 + tl;
        int t, T;
        if (R < 8192) { t = R & 255; T = 256; } else { t = (R - 8192) & 1023; T = 1024; }
        const bf16_t* rp = proj + (size_t)R * LDE + ch;
        const u32x4 ab = *(const u32x4*)(rp);
        float accv[8];
#pragma unroll
        for (int e = 0; e < 8; ++e) accv[e] = 0.f;
#pragma unroll
        for (int j = 0; j < 3; ++j) {
            const int tt = t + j - 1;
            if (tt >= 0 && tt < T) {
                const u32x4 ac = *(const u32x4*)(rp + (ptrdiff_t)(j - 1) * LDE + 512);
                const u32x4 ax = *(const u32x4*)(rp + (ptrdiff_t)(j - 1) * LDE + 1024);
                const f32x4 w0 = *(const f32x4*)(p.conv_w + j * 512 + ch), w1 = *(const f32x4*)(p.conv_w + j * 512 + ch + 4);
#pragma unroll
                for (int e = 0; e < 4; ++e) {
                    accv[2 * e] += bflo(ac[e]) * bflo(ax[e]) * (e < 2 ? w0[2 * e] : w1[2 * e - 4]);
                    accv[2 * e + 1] += bfhi(ac[e]) * bfhi(ax[e]) * (e < 2 ? w0[2 * e + 1] : w1[2 * e - 3]);
                }
            }
        }
        u32x4 o;
#pragma unroll
        for (int e = 0; e < 4; ++e) o[e] = pk2(bflo(ab[e]) * accv[2 * e], bfhi(ab[e]) * accv[2 * e + 1]);
        *(u32x4*)(mix + (size_t)R * 1024 + ch) = o;
    }
}


#define XB_TMO      128
#define XB_XCNT(j)  (256  + 64 * (j))
#define XB_XSUB(j)  (1280 + 64 * (j))
#define XB_XGEN(j)  (2304 + 64 * (j))
#define XB_TOP      3328
#define XB_TOPGEN   3392
#define XCD_BAR_WORDS 3456
#define XB_SPIN_CAP (1u << 22)
#define LAS __attribute__((address_space(3)))
DI unsigned xb_ld(unsigned* p) { return __hip_atomic_load(p, __ATOMIC_RELAXED, __HIP_MEMORY_SCOPE_AGENT); }
DI unsigned xb_add(unsigned* p, unsigned v) { return __hip_atomic_fetch_add(p, v, __ATOMIC_RELAXED, __HIP_MEMORY_SCOPE_AGENT); }
DI unsigned xb_xcc_id() { return (unsigned)__builtin_amdgcn_s_getreg((3 << 11) | 20) & 0xFu; }
#define XB_SPIN(cond, bar) do { unsigned _sp = 0; while (cond) { __builtin_amdgcn_s_sleep(1); \
    if ((++_sp & 255u) == 0u) { if (xb_ld(&(bar)[XB_TMO])) break; if (_sp > XB_SPIN_CAP) { atomicAdd(&(bar)[XB_TMO], 1u); break; } } } } while (0)
struct XcdBarrier { unsigned* bar; unsigned x; volatile LAS unsigned* st; };
DI XcdBarrier xcd_barrier_post(unsigned* bar, volatile LAS unsigned* st) {
    XcdBarrier b; b.bar = bar; b.x = xb_xcc_id(); b.st = st;
    if (threadIdx.x == 0) (void)xb_add(&bar[XB_XCNT(b.x)], 1u);
    return b;
}
DI void xcd_barrier_complete(unsigned* bar, unsigned x, unsigned& nloc, unsigned& nx) {
    const unsigned G = gridDim.x * gridDim.y * gridDim.z;
    unsigned sum, cnt, mine, sp = 0u;
    for (;;) {
        sum = 0u; cnt = 0u; mine = 0u;
#pragma unroll
        for (unsigned j = 0; j < 16; ++j) { const unsigned c = xb_ld(&bar[XB_XCNT(j)]); sum += c; cnt += (c > 0u) ? 1u : 0u; mine = (j == x) ? c : mine; }
        if (sum == G) break;
        __builtin_amdgcn_s_sleep(1);
        if ((++sp & 255u) == 0u) { if (xb_ld(&bar[XB_TMO])) break; if (sp > XB_SPIN_CAP) { atomicAdd(&bar[XB_TMO], 1u); break; } }
    }
    nloc = mine > 0u ? mine : 1u; nx = cnt > 0u ? cnt : 1u;
}
DI void xcd_barrier(const XcdBarrier& b) {
    asm volatile("s_waitcnt vmcnt(0)" ::: "memory");
    __syncthreads();
    if (threadIdx.x == 0) {
        unsigned* bar = b.bar;
        __builtin_amdgcn_s_waitcnt(0);
        unsigned nloc = b.st[0], nx = b.st[1];
        if (nloc == 0u) { xcd_barrier_complete(bar, b.x, nloc, nx); b.st[0] = nloc; b.st[1] = nx; }
        const unsigned old = xb_add(&bar[XB_XSUB(b.x)], 1u);
        const unsigned gen = old / nloc;
        if (old + 1u == (gen + 1u) * nloc) {
            __builtin_amdgcn_fence(__ATOMIC_RELEASE, "agent");
            asm volatile("s_waitcnt vmcnt(0)" ::: "memory");
            const unsigned og = xb_add(&bar[XB_TOP], 1u);
            const unsigned tg = og / nx;
            if (og + 1u == (tg + 1u) * nx) xb_add(&bar[XB_TOPGEN], 1u);
            else XB_SPIN(xb_ld(&bar[XB_TOPGEN]) == tg, bar);
            __builtin_amdgcn_fence(__ATOMIC_ACQUIRE, "agent");
            xb_add(&bar[XB_XGEN(b.x)], 1u);
            asm volatile("s_waitcnt vmcnt(0)" ::: "memory");
        } else {
            XB_SPIN(xb_ld(&bar[XB_XGEN(b.x)]) == gen, bar);
            __builtin_amdgcn_fence(__ATOMIC_ACQUIRE, "agent");
            asm volatile("s_waitcnt vmcnt(0)" ::: "memory");
        }
    }
    __syncthreads();
}

constexpr int N_PHASES = 12;
DI void run_phase(const Params& p, int ph, char* shm) {
    const int nb = VNB, bid = VBID;
    char* lds = shm + VHALF * LDS_HALF;
    const bf16_t* hy = (const bf16_t*)(p.ws + OFF_HY);
    const bf16_t* big = (const bf16_t*)(p.ws + OFF_BIG);
    const bf16_t* mixin = (const bf16_t*)(p.ws + OFF_BIG + BIG_MIXIN);
    const float* mod = (const float*)(p.ws + OFF_MOD);
    char* st = p.ws + OFF_STAT;
#define FZ(set, from_in, hasH, goff, wpost, wpre, scoff, shoff) FuseP{from_in, hasH, mod + (goff), wpost, wpre, mod + (scoff), mod + (shoff), (float*)(st + (set) * STAT_SET), (float*)(st + (set) * STAT_SET + 65536), (unsigned*)(st + (set) * STAT_SET + 131072)}
    switch (ph) {
    case 0: p0_phase(p, bid, nb, lds); break;
    case 1: rowop_phase(p, false, true, 0, nullptr, true, p.norm_mix_pre, 1024, 0); break;
    case 2: gemm_phase<EPI_PE>(p, hy, 2048, (const bf16_t*)(p.ws + OFF_WINE), 1024, 12, shm); break;
    case 3:
        for (int it = bid; it < 1536; it += nb) { if (it < 1024) attn_diff_item(p, it, lds); else conv_item(p, it - 1024); }
        break;
    case 4: gemm_phase<EPI_YF>(p, mixin, 1024, (const bf16_t*)(p.ws + OFF_WOUT), 1024, 4, shm, FZ(0, 1, 1, 2048, p.norm_mix_post, p.norm_mlp_pre, 4096, 3072)); break;
    case 5: gemm_phase<EPI_W1>(p, hy, 2048, (const bf16_t*)(p.ws + OFF_W1), 1024, 16, shm); break;
    case 6: gemm_phase<EPI_YF>(p, big, 4096, (const bf16_t*)(p.ws + OFF_W2), 4096, 4, shm, FZ(1, 0, 1, 5120, p.norm_mlp_post, p.norm_mix_pre + 1024, 9 * 6144 + 1024, 9 * 6144 + 0)); break;
    case 7: gemm_phase<EPI_PO>(p, hy, 2048, (const bf16_t*)(p.ws + OFF_WINO), 1024, 9, shm); break;
    case 8:
        for (int it = bid; it < 2048; it += nb) {
            const int q = it >> 9, r = it & 511;
            if (q & 1) attn_d_item(p, (q >> 1) * 512 + r, lds); else attn_c_item(p, (q >> 1) * 512 + r, lds);
        }
        break;
    case 9: gemm_phase<EPI_YF>(p, mixin, 1024, (const bf16_t*)(p.ws + OFF_WOUT) + 1048576, 1024, 4, shm, FZ(2, 0, 1, 9 * 6144 + 2048, p.norm_mix_post + 1024, p.norm_mlp_pre + 1024, 9 * 6144 + 4096, 9 * 6144 + 3072)); break;
    case 10: gemm_phase<EPI_W1>(p, hy, 2048, (const bf16_t*)(p.ws + OFF_W1) + 4194304, 1024, 16, shm); break;
    case 11: gemm_phase<EPI_YF>(p, big, 4096, (const bf16_t*)(p.ws + OFF_W2) + 4194304, 4096, 4, shm, FZ(3, 0, 0, 9 * 6144 + 5120, p.norm_mlp_post + 1024, p.norm_mlp_post, 0, 0)); break;
    }
#undef FZ
}

__global__ void __launch_bounds__(512, 2) fwd_mega(Params p) {
    __shared__ __attribute__((aligned(16))) char lds[LDS_BYTES];
    __shared__ uint4 xb_words;
    cg::grid_group grid = cg::this_grid();
    if (threadIdx.x == 0) xb_words = make_uint4(0u, 0u, 0u, 0u);
    __syncthreads();
    const XcdBarrier xb = xcd_barrier_post((unsigned*)(p.ws + OFF_BAR), (volatile LAS unsigned*)&xb_words);
#define PH_(n) run_phase(p, n, lds); xcd_barrier(xb); if ((DUP_MASK >> n) & 1) { run_phase(p, n, lds); xcd_barrier(xb); }
    PH_(0)
    if (p.ws == nullptr) grid.sync();
    PH_(1) PH_(2) PH_(3) PH_(4) PH_(5) PH_(6) PH_(7) PH_(8) PH_(9) PH_(10)
    run_phase(p, 11, lds);
#undef PH_
}

__global__ void __launch_bounds__(512, 2) fwd_phase(Params p, int ph) {
    __shared__ __attribute__((aligned(16))) char lds[LDS_BYTES];
    run_phase(p, ph, lds);
}

extern "C" void kernel_launch(void* const* d_in, const int* in_sizes, int n_in, void* d_out, int out_size, void* d_ws, size_t ws_size, hipStream_t stream) {
    Params p{};
    const float** pp = (const float**)&p;
    for (int i = 0; i < 29; ++i) pp[i] = (const float*)d_in[i];
    p.out = (float*)d_out;
    p.ws = (char*)d_ws;
    if (ws_size < WS_NEEDED) { fprintf(stderr, "workspace too small: %zu < %zu\n", ws_size, (size_t)WS_NEEDED); return; }
    static int grid_blocks = 0;
    if (!grid_blocks) {
        int dev = 0, cus = 0, per_cu = 0;
        hipGetDevice(&dev);
        hipDeviceGetAttribute(&cus, hipDeviceAttributeMultiprocessorCount, dev);
        hipOccupancyMaxActiveBlocksPerMultiprocessor(&per_cu, fwd_mega, 512, 0);
        if (per_cu > 1) per_cu = 1;
        if (per_cu < 1) per_cu = 1;
        grid_blocks = cus * per_cu;
        grid_blocks -= grid_blocks % 8;
    }
#if ONE_LAUNCH
    (void)hipMemsetAsync((char*)d_ws + OFF_BAR, 0, XCD_BAR_WORDS * 4, stream);
    (void)hipMemsetAsync((char*)d_ws + OFF_STAT, 0, 4 * STAT_SET, stream);
    if (grid_blocks != 256) { fprintf(stderr, "fused epilogues need exactly 256 workgroups (got %d)\n", grid_blocks); return; }
    void* args[] = {&p};
    hipError_t e = hipLaunchCooperativeKernel((void*)fwd_mega, dim3(grid_blocks), dim3(512), args, 0, stream);
    if (e != hipSuccess) fprintf(stderr, "cooperative launch failed: %s (grid %d)\n", hipGetErrorString(e), grid_blocks);
#else
    for (int ph = 0; ph < N_PHASES; ++ph) fwd_phase<<<grid_blocks, 512, 0, stream>>>(p, ph);
#endif
}
```

```cpp
#include <hip/hip_runtime.h>
#include <hip/hip_cooperative_groups.h>
#include <cstdio>
#include <cstdint>
namespace cg = cooperative_groups;

#ifndef DUP_MASK
#define DUP_MASK 0
#endif
#ifndef ONE_LAUNCH
#define ONE_LAUNCH 1
#endif

typedef unsigned short bf16_t;
typedef short bf16x8 __attribute__((ext_vector_type(8)));
typedef float f32x4 __attribute__((ext_vector_type(4)));
typedef float f32x2 __attribute__((ext_vector_type(2)));
typedef float f32x16 __attribute__((ext_vector_type(16)));
typedef unsigned u32x4 __attribute__((ext_vector_type(4)));
typedef unsigned u32x2 __attribute__((ext_vector_type(2)));
typedef __bf16 bfv2 __attribute__((ext_vector_type(2)));
#define DI __device__ __forceinline__
DI int launder_v(int v) { asm volatile("" : "+v"(v)); return v; }
#define TIDX launder_v((int)threadIdx.x)
#define VTID (TIDX & 255)
#define VHALF (TIDX >> 8)
#define VBID ((int)(blockIdx.x * 2) + (TIDX >> 8))
#define VNB ((int)(gridDim.x * 2))
#define MFMA32(a, b, c) __builtin_amdgcn_mfma_f32_32x32x16_bf16((a), (b), (c), 0, 0, 0)
#define MFMA16(a, b, c) __builtin_amdgcn_mfma_f32_16x16x32_bf16((a), (b), (c), 0, 0, 0)

constexpr float LOG2E = 1.4426950408889634f;
constexpr float EPSN = 1e-6f;

struct Params {
    const float *x_prompt, *x_sample, *cache_diff_k, *cache_diff_v, *cache_na_k, *cache_na_v, *cache_swa_k, *cache_swa_v, *c, *c_ctx;
    const float *mod_w, *mod_b, *norm_mix_pre, *norm_mix_post, *norm_mlp_pre, *norm_mlp_post, *w_in_even, *conv_w, *lq1, *lk1, *lq2, *lk2, *subln;
    const float *w_in_odd, *rpb, *sink, *w_out, *mlp_w1, *mlp_w2;
    float* out;
    char* ws;
};

constexpr size_t OFF_MOD = 0;
constexpr size_t OFF_BAR = 458752;
constexpr size_t OFF_WINE = 524288;
constexpr size_t OFF_WINO = OFF_WINE + 6291456;
constexpr size_t OFF_WOUT = OFF_WINO + 4718592;
constexpr size_t OFF_W1 = OFF_WOUT + 4194304;
constexpr size_t OFF_W2 = OFF_W1 + 16777216;
constexpr size_t OFF_CDK = OFF_W2 + 16777216;
constexpr size_t OFF_CDVT = OFF_CDK + 2097152;
constexpr size_t OFF_CNK = OFF_CDVT + 2097152;
constexpr size_t OFF_CNVT = OFF_CNK + 2097152;
constexpr size_t OFF_CSK = OFF_CNVT + 2097152;
constexpr size_t OFF_CSVT = OFF_CSK + 524288;
constexpr size_t OFF_HY = OFF_CSVT + 524288;
constexpr size_t OFF_BIG = OFF_HY + 67108864;
constexpr size_t OFF_STAT = OFF_BIG + 134217728;
constexpr size_t STAT_SET = 65536 + 65536 + 8192;
constexpr size_t WS_NEEDED = OFF_STAT + 4 * STAT_SET;
constexpr size_t BIG_VT_E = 83886080;
constexpr size_t BIG_VT_C = 54525952;
constexpr size_t BIG_VT_D = BIG_VT_C + 16777216;
constexpr size_t BIG_MIXIN = 100663296;
constexpr int LDE = 2560, LDO = 1664;
constexpr size_t OUT_DIFFK = 16777216, OUT_DIFFV = 20971520, OUT_NAK = 25165824, OUT_NAV = 29360128, OUT_SWAK = 33554432, OUT_SWAV = 34603008;

constexpr int LDS_HALF = 65536 + 4096;
constexpr int LDS_BYTES = 2 * LDS_HALF;

DI unsigned pk2(float a, float b) { f32x2 v = {a, b}; bfv2 r = __builtin_convertvector(v, bfv2); return __builtin_bit_cast(unsigned, r); }
DI float bflo(unsigned u) { return __uint_as_float(u << 16); }
DI float bfhi(unsigned u) { return __uint_as_float(u & 0xffff0000u); }
DI float wave_sum(float v) {
#pragma unroll
    for (int o = 1; o < 64; o <<= 1) v += __shfl_xor(v, o);
    return v;
}
DI int swz128(int r, int c) { return r * 128 + ((c ^ ((r >> 1) & 7)) << 4); }
DI int swz256(int r, int c) { return r * 256 + ((c ^ (r & 15)) << 4); }

DI void p0_mod_item(const Params& p, int item, char* lds) {
    const int li = item / 96, cb = item % 96;
    const int tid = VTID, lane = tid & 63, w = tid >> 6;
    const float* W = p.mod_w + (size_t)li * 1024 * 6144 + cb * 64 + lane;
    float acc[9];
#pragma unroll
    for (int v = 0; v < 9; ++v) acc[v] = 0.f;
    for (int kc = 0; kc < 4; ++kc) {
        const int kb = w * 256 + kc * 64;
        float s[9];
        { const float cv = p.c_ctx[kb + lane]; s[0] = cv / (1.f + __expf(-cv)); }
#pragma unroll
        for (int v = 1; v < 9; ++v) { const float cv = p.c[(v - 1) * 1024 + kb + lane]; s[v] = cv / (1.f + __expf(-cv)); }
#pragma unroll
        for (int kk = 0; kk < 64; ++kk) {
            const float wv = W[(size_t)(kb + kk) * 6144];
#pragma unroll
            for (int v = 0; v < 9; ++v) acc[v] += __int_as_float(__builtin_amdgcn_readlane(__float_as_int(s[v]), kk)) * wv;
        }
    }
    float* red = (float*)lds;
#pragma unroll
    for (int v = 0; v < 9; ++v) red[(w * 9 + v) * 64 + lane] = acc[v];
    __syncthreads();
    float* mod = (float*)(p.ws + OFF_MOD);
    for (int idx = tid; idx < 576; idx += 256) {
        const int v = idx >> 6, col = idx & 63;
        const float sum = red[(0 * 9 + v) * 64 + col] + red[(1 * 9 + v) * 64 + col] + red[(2 * 9 + v) * 64 + col] + red[(3 * 9 + v) * 64 + col];
        mod[(li * 9 + v) * 6144 + cb * 64 + col] = sum + p.mod_b[li * 6144 + cb * 64 + col];
    }
    __syncthreads();
}

DI void p0_transpose_tile(const float* __restrict__ in, bf16_t* __restrict__ out, int R, int C, int tr, int tc, char* lds) {
    const int tid = VTID;
    const int cl = (tid & 15) * 4, rl = (tid >> 4) * 2, sw = tid & 7;
#pragma unroll
    for (int i = 0; i < 2; ++i) {
        const int r = rl + 32 * i;
        const f32x4 a = *(const f32x4*)(in + (size_t)(tr * 64 + r) * C + tc * 64 + cl);
        const f32x4 b = *(const f32x4*)(in + (size_t)(tr * 64 + r + 1) * C + tc * 64 + cl);
#pragma unroll
        for (int j = 0; j < 4; ++j) *(unsigned*)(lds + (cl + j) * 128 + (((r >> 3) ^ sw) << 4) + (r & 7) * 2) = pk2(a[j], b[j]);
    }
    __syncthreads();
#pragma unroll
    for (int i = 0; i < 2; ++i) {
        const int idx = tid + 256 * i, c = idx >> 3, q = idx & 7;
        const u32x4 v = *(const u32x4*)(lds + c * 128 + ((q ^ ((c >> 2) & 7)) << 4));
        *(u32x4*)(out + (size_t)(tc * 64 + c) * R + tr * 64 + q * 8) = v;
    }
    __syncthreads();
}

DI void p0_kreorder(const float* __restrict__ in, bf16_t* __restrict__ out, int logH, int item) {
    const int tid = VTID, H = 1 << logH;
#pragma unroll
    for (int i = 0; i < 4; ++i) {
        const int f = item * 1024 + tid + 256 * i;
        const int d4 = f & 15, key = (f >> 4) & 255, hh = (f >> 12) & (H - 1), b = f >> (12 + logH);
        const f32x4 v = *(const f32x4*)(in + (size_t)f * 4);
        u32x2 o = {pk2(v[0], v[1]), pk2(v[2], v[3])};
        *(u32x2*)(out + ((size_t)(b * 256 + key) * H + hh) * 64 + d4 * 4) = o;
    }
}

struct TJob { const float* in; bf16_t* out; int R, C, tr, tc; };
constexpr int P0_TITEMS = 768 + 576 + 512 + 2048 + 2048 + 256 + 256 + 64;
DI TJob p0_decode(const Params& p, int item) {
    TJob j;
    if (item < 768) { j.in = p.w_in_even; j.out = (bf16_t*)(p.ws + OFF_WINE); j.R = 1024; j.C = 3072; }
    else if ((item -= 768) < 576) { j.in = p.w_in_odd; j.out = (bf16_t*)(p.ws + OFF_WINO); j.R = 1024; j.C = 2304; }
    else if ((item -= 576) < 512) { const int b = item >> 8; item &= 255; j.in = p.w_out + (size_t)b * 1048576; j.out = (bf16_t*)(p.ws + OFF_WOUT) + (size_t)b * 1048576; j.R = 1024; j.C = 1024; }
    else if ((item -= 512) < 2048) { const int b = item >> 10; item &= 1023; j.in = p.mlp_w1 + (size_t)b * 4194304; j.out = (bf16_t*)(p.ws + OFF_W1) + (size_t)b * 4194304; j.R = 1024; j.C = 4096; }
    else if ((item -= 2048) < 2048) { const int b = item >> 10; item &= 1023; j.in = p.mlp_w2 + (size_t)b * 4194304; j.out = (bf16_t*)(p.ws + OFF_W2) + (size_t)b * 4194304; j.R = 4096; j.C = 1024; }
    else if ((item -= 2048) < 256) { const int b = item >> 3; item &= 7; j.in = p.cache_diff_v + (size_t)b * 32768; j.out = (bf16_t*)(p.ws + OFF_CDVT) + (size_t)b * 32768; j.R = 256; j.C = 128; }
    else if ((item -= 256) < 256) { const int b = item >> 2; item &= 3; j.in = p.cache_na_v + (size_t)b * 16384; j.out = (bf16_t*)(p.ws + OFF_CNVT) + (size_t)b * 16384; j.R = 256; j.C = 64; }
    else { item -= 256; const int b = item >> 2; item &= 3; j.in = p.cache_swa_v + (size_t)b * 16384; j.out = (bf16_t*)(p.ws + OFF_CSVT) + (size_t)b * 16384; j.R = 256; j.C = 64; }
    const int ntc = j.C >> 6;
    j.tr = item / ntc; j.tc = item % ntc;
    return j;
}
DI void p0_tload(const TJob& j, int tid, f32x4 (&a)[2], f32x4 (&b)[2]) {
    const int cl = (tid & 15) * 4, rl = (tid >> 4) * 2;
#pragma unroll
    for (int i = 0; i < 2; ++i) {
        const int r = rl + 32 * i;
        a[i] = __builtin_nontemporal_load((const f32x4*)(j.in + (size_t)(j.tr * 64 + r) * j.C + j.tc * 64 + cl));
        b[i] = __builtin_nontemporal_load((const f32x4*)(j.in + (size_t)(j.tr * 64 + r + 1) * j.C + j.tc * 64 + cl));
    }
}
DI void p0_phase(const Params& p, int bid, int nb, char* lds) {
    if (bid < 192) p0_mod_item(p, bid, lds);
    const int tid = VTID;
    {
        const int cl = (tid & 15) * 4, rl = (tid >> 4) * 2, sw = tid & 7;
        int it = bid;
        TJob cur{}; f32x4 a[2], b[2];
        if (it < P0_TITEMS) { cur = p0_decode(p, it); p0_tload(cur, tid, a, b); }
        while (it < P0_TITEMS) {
            const int nx = it + nb;
            TJob nxt{}; f32x4 an[2], bn[2];
            if (nx < P0_TITEMS) { nxt = p0_decode(p, nx); p0_tload(nxt, tid, an, bn); }
#pragma unroll
            for (int i = 0; i < 2; ++i) {
                const int r = rl + 32 * i;
#pragma unroll
                for (int jj = 0; jj < 4; ++jj) *(unsigned*)(lds + (cl + jj) * 128 + (((r >> 3) ^ sw) << 4) + (r & 7) * 2) = pk2(a[i][jj], b[i][jj]);
            }
            __syncthreads();
#pragma unroll
            for (int i = 0; i < 2; ++i) {
                const int idx = tid + 256 * i, c = idx >> 3, q = idx & 7;
                const u32x4 v = *(const u32x4*)(lds + c * 128 + ((q ^ ((c >> 2) & 7)) << 4));
                *(u32x4*)(cur.out + (size_t)(cur.tc * 64 + c) * cur.R + cur.tr * 64 + q * 8) = v;
            }
            __syncthreads();
            cur = nxt; a[0] = an[0]; a[1] = an[1]; b[0] = bn[0]; b[1] = bn[1];
            it = nx;
        }
    }
    for (int it = bid; it < 576; it += nb) {
        if (it < 256) p0_kreorder(p.cache_diff_k, (bf16_t*)(p.ws + OFF_CDK), 3, it);
        else if (it < 512) p0_kreorder(p.cache_na_k, (bf16_t*)(p.ws + OFF_CNK), 3, it - 256);
        else p0_kreorder(p.cache_swa_k, (bf16_t*)(p.ws + OFF_CSK), 1, it - 512);
    }
}

DI void rowop_phase(const Params& p, bool hasY, bool xin_input, int g_off, const float* wpost, bool hasH, const float* wpre, int sc_off, int sh_off) {
    const int tix = TIDX, lane = tix & 63, gw = (int)(blockIdx.x * 8) + (tix >> 6), nw = VNB * 4;
    const float* mod = (const float*)(p.ws + OFF_MOD);
    f32x4 wpo[4], wpr[4];
#pragma unroll
    for (int i = 0; i < 4; ++i) { if (hasY) wpo[i] = *(const f32x4*)(wpost + lane * 4 + 256 * i); if (hasH) wpr[i] = *(const f32x4*)(wpre + lane * 4 + 256 * i); }
    for (int row0 = gw; row0 < 16384; row0 += 2 * nw) {
        f32x4 x[2][4], y[2][4];
#pragma unroll
        for (int r = 0; r < 2; ++r) {
            const int row = row0 + r * nw;
            const float* xin = xin_input ? (row < 8192 ? p.x_prompt + (size_t)row * 1024 : p.x_sample + (size_t)(row - 8192) * 1024) : p.out + (size_t)row * 1024;
            const float* yin = (const float*)(p.ws + OFF_HY + (size_t)row * 4096);
#pragma unroll
            for (int i = 0; i < 4; ++i) { x[r][i] = *(const f32x4*)(xin + lane * 4 + 256 * i); if (hasY) y[r][i] = *(const f32x4*)(yin + lane * 4 + 256 * i); }
        }
#pragma unroll
        for (int r = 0; r < 2; ++r) {
            const int row = row0 + r * nw;
            const int v = row < 8192 ? 0 : 1 + ((row - 8192) >> 10);
            char* hy = p.ws + OFF_HY + (size_t)row * 4096;
            if (hasY) {
                f32x4 g4[4];
#pragma unroll
                for (int i = 0; i < 4; ++i) g4[i] = *(const f32x4*)(mod + v * 6144 + g_off + lane * 4 + 256 * i);
                float ss = 0.f;
#pragma unroll
                for (int i = 0; i < 4; ++i) ss += y[r][i][0] * y[r][i][0] + y[r][i][1] * y[r][i][1] + y[r][i][2] * y[r][i][2] + y[r][i][3] * y[r][i][3];
                ss = wave_sum(ss);
                const float rs = rsqrtf(ss * (1.f / 1024.f) + EPSN);
#pragma unroll
                for (int i = 0; i < 4; ++i) {
                    x[r][i] += g4[i] * (y[r][i] * rs * wpo[i]);
                    *(f32x4*)(p.out + (size_t)row * 1024 + lane * 4 + 256 * i) = x[r][i];
                }
            }
            if (hasH) {
                f32x4 sc[4], sh[4];
#pragma unroll
                for (int i = 0; i < 4; ++i) { sc[i] = *(const f32x4*)(mod + v * 6144 + sc_off + lane * 4 + 256 * i); sh[i] = *(const f32x4*)(mod + v * 6144 + sh_off + lane * 4 + 256 * i); }
                float ss = 0.f;
#pragma unroll
                for (int i = 0; i < 4; ++i) ss += x[r][i][0] * x[r][i][0] + x[r][i][1] * x[r][i][1] + x[r][i][2] * x[r][i][2] + x[r][i][3] * x[r][i][3];
                ss = wave_sum(ss);
                const float rs = rsqrtf(ss * (1.f / 1024.f) + EPSN);
#pragma unroll
                for (int i = 0; i < 4; ++i) {
                    const f32x4 h = x[r][i] * rs * wpr[i] * (sc[i] + 1.f) + sh[i];
                    u32x2 o = {pk2(h[0], h[1]), pk2(h[2], h[3])};
                    *(u32x2*)((bf16_t*)hy + lane * 4 + 256 * i) = o;
                }
            }
        }
    }
}

namespace g8 {
constexpr int BK = 64, HALF = 128, HTB = HALF * BK * 2;
DI int lds_byte(int r, int c) { const int st = (r >> 4) * 2 + (c >> 5), rr = r & 15, cc = c & 31, ob = rr * 64 + cc * 2; return st * 1024 + (ob ^ (((ob >> 9) & 1) << 5)); }
DI void stage_rc(int b, int& R, int& C) { const int st = b / 1024, sb = b % 1024, swz = sb ^ (((sb >> 9) & 1) << 5); R = (st >> 1) * 16 + swz / 64; C = (st & 1) * 32 + (swz % 64) / 2; }
typedef __attribute__((address_space(3))) unsigned lds_u32;
typedef __attribute__((address_space(3))) unsigned char lds_u8;
typedef __attribute__((address_space(3))) bf16x8 lds_bf16x8;

}

enum { EPI_PE = 0, EPI_PO = 1, EPI_Y = 2, EPI_W1 = 3, EPI_YF = 4 };

struct FuseP { int from_input, hasH; float* xout; const float* g; const float* wpost; const float* wpre; const float* sc; const float* sh; float* ssY; float* ssX; unsigned* cnt; };
DI float ld_agent(const float* q) { return __hip_atomic_load(q, __ATOMIC_RELAXED, __HIP_MEMORY_SCOPE_AGENT); }
DI void panel_wait(unsigned* c, unsigned target) {
    asm volatile("s_waitcnt vmcnt(0)" ::: "memory");
    __syncthreads();
    if (threadIdx.x == 0) {
        __hip_atomic_fetch_add(c, 1u, __ATOMIC_RELAXED, __HIP_MEMORY_SCOPE_AGENT);
        unsigned sp = 0;
        while (__hip_atomic_load(c, __ATOMIC_RELAXED, __HIP_MEMORY_SCOPE_AGENT) < target) { __builtin_amdgcn_s_sleep(1); if (++sp > (1u << 22)) break; }
    }
    __syncthreads();
}
DI float dot4(const f32x4& a) { return a[0] * a[0] + a[1] * a[1] + a[2] * a[2] + a[3] * a[3]; }

DI void rope_s(f32x4 (&sub)[4][2], int R0, bool usecol, int fr, int fq) {
    asm volatile("" : "+s"(R0));
    float inv[4];
#pragma unroll
    for (int j = 0; j < 4; ++j) inv[j] = exp2f(-(float)(fq * 4 + j) * (13.287712379549449f / 16.f));
#pragma unroll
    for (int m = 0; m < 4; ++m) {
        __builtin_amdgcn_sched_barrier(0);
        const int tl = (R0 + m * 16 + fr - 8192) & 1023;
        const float pos = (float)(usecol ? (tl & 63) : (tl >> 6));
#pragma unroll
        for (int j = 0; j < 4; ++j) {
            float s, c;
            __sincosf(pos * inv[j], &s, &c);
            const float a = sub[m][0][j], b = sub[m][1][j];
            sub[m][0][j] = a * c - b * s; sub[m][1][j] = b * c + a * s;
        }
    }
}
DI void store_bf16_rows_s(const f32x4 (&sub)[4][2], bf16_t* base, int ld, int R0, int Cd0, int fr, int fq) {
#pragma unroll
    for (int m = 0; m < 4; ++m) {
        bf16_t* rp = base + (size_t)(R0 + m * 16 + fr) * ld + Cd0 + fq * 4;
#pragma unroll
        for (int n = 0; n < 2; ++n) { u32x2 o = {pk2(sub[m][n][0], sub[m][n][1]), pk2(sub[m][n][2], sub[m][n][3])}; *(u32x2*)(rp + n * 16) = o; }
    }
}
DI void store_f32_rows_s(const f32x4 (&sub)[4][2], float* ob, int ldo, int fr, int fq) {
#pragma unroll
    for (int m = 0; m < 4; ++m) {
        float* rp = ob + (size_t)(m * 16 + fr) * ldo + fq * 4;
#pragma unroll
        for (int n = 0; n < 2; ++n) *(f32x4*)(rp + n * 16) = sub[m][n];
    }
}
DI void store_vt_s(const f32x4 (&sub)[4][2], bf16_t* vt, int T, int t0, int fr, int fq) {
#pragma unroll
    for (int n = 0; n < 2; ++n) {
        bf16_t* rp = vt + (size_t)(n * 16 + fr) * T + t0 + fq * 4;
#pragma unroll
        for (int m = 0; m < 4; ++m) { u32x2 o = {pk2(sub[m][n][0], sub[m][n][1]), pk2(sub[m][n][2], sub[m][n][3])}; *(u32x2*)(rp + m * 16) = o; }
    }
}
DI void store_f32_ns_s(const f32x4 (&sub)[4][2], float* ob, int ldo, int fr, int fq) {
#pragma unroll
    for (int m = 0; m < 4; ++m)
#pragma unroll
        for (int j = 0; j < 4; ++j) {
            float* rp = ob + (size_t)(m * 16 + fq * 4 + j) * ldo + fr;
#pragma unroll
            for (int n = 0; n < 2; ++n) rp[n * 16] = sub[m][n][j];
        }
}

template <int EPI>
DI void tile_epilogue(const Params& p, f32x4 (&acc)[2][2][4][2], int pm, int pn, int vtm, const FuseP& fz) {
    const int tix = TIDX, wid = __builtin_amdgcn_readfirstlane(tix >> 6), lane = tix & 63, wr = wid >> 2, wc = wid & 3;
    const int brow = pm * 256, bcol = pn * 256;
    int fr = lane & 15, fq = lane >> 4;
    asm volatile("" : "+v"(fr), "+v"(fq));
    const bool latent = brow >= 8192;
    int b, tb, T;
    if (latent) { b = (brow - 8192) >> 10; tb = (brow - 8192) & 1023; T = 1024; } else { b = brow >> 8; tb = 0; T = 256; }
    bf16_t* big = (bf16_t*)(p.ws + OFF_BIG);
    if (EPI == EPI_YF) {
        const int v = latent ? 1 + b : 0;
        const int rbase = brow + wr * 64 + fr;
        const int cbase = bcol + wc * 32 + fq * 4;
        float rs[2][4];
#pragma unroll
        for (int ai = 0; ai < 2; ++ai)
#pragma unroll
            for (int m = 0; m < 4; ++m) {
                float sq = dot4(acc[ai][0][m][0]) + dot4(acc[ai][0][m][1]) + dot4(acc[ai][1][m][0]) + dot4(acc[ai][1][m][1]);
                sq += __shfl_xor(sq, 16); sq += __shfl_xor(sq, 32);
                if (fq == 0) { const float old = __hip_atomic_fetch_add(fz.ssY + rbase + ai * 128 + m * 16, sq, __ATOMIC_RELAXED, __HIP_MEMORY_SCOPE_AGENT); asm volatile("" :: "v"(old)); }
            }
        panel_wait(fz.cnt + pm * 32, 4u);
#pragma unroll
        for (int ai = 0; ai < 2; ++ai)
#pragma unroll
            for (int m = 0; m < 4; ++m) rs[ai][m] = rsqrtf(ld_agent(fz.ssY + rbase + ai * 128 + m * 16) * (1.f / 1024.f) + EPSN);
        const float* xin = fz.from_input ? (latent ? p.x_sample - (size_t)8192 * 1024 : p.x_prompt) : p.out;
        float s2[2][4];
#pragma unroll
        for (int ai = 0; ai < 2; ++ai)
#pragma unroll
            for (int m = 0; m < 4; ++m) s2[ai][m] = 0.f;
#pragma unroll
        for (int bj = 0; bj < 2; ++bj)
#pragma unroll
            for (int n = 0; n < 2; ++n) {
                const int col = cbase + bj * 128 + n * 16;
                const f32x4 g4 = *(const f32x4*)(fz.g + v * 6144 + col), wp4 = *(const f32x4*)(fz.wpost + col);
#pragma unroll
                for (int ai = 0; ai < 2; ++ai)
#pragma unroll
                    for (int m = 0; m < 4; ++m) {
                        const size_t off = (size_t)(rbase + ai * 128 + m * 16) * 1024 + col;
                        const f32x4 x4 = *(const f32x4*)(xin + off);
                        const f32x4 a = x4 + g4 * (acc[ai][bj][m][n] * rs[ai][m] * wp4);
                        acc[ai][bj][m][n] = a;
                        *(f32x4*)(fz.xout + off) = a;
                        s2[ai][m] += dot4(a);
                    }
            }
        if (fz.hasH) {
#pragma unroll
            for (int ai = 0; ai < 2; ++ai)
#pragma unroll
                for (int m = 0; m < 4; ++m) {
                    float sq = s2[ai][m];
                    sq += __shfl_xor(sq, 16); sq += __shfl_xor(sq, 32);
                    if (fq == 0) { const float old = __hip_atomic_fetch_add(fz.ssX + rbase + ai * 128 + m * 16, sq, __ATOMIC_RELAXED, __HIP_MEMORY_SCOPE_AGENT); asm volatile("" :: "v"(old)); }
                }
            panel_wait(fz.cnt + pm * 32 + 16, 4u);
#pragma unroll
            for (int ai = 0; ai < 2; ++ai)
#pragma unroll
                for (int m = 0; m < 4; ++m) rs[ai][m] = rsqrtf(ld_agent(fz.ssX + rbase + ai * 128 + m * 16) * (1.f / 1024.f) + EPSN);
            bf16_t* hb = (bf16_t*)(p.ws + OFF_HY);
#pragma unroll
            for (int bj = 0; bj < 2; ++bj)
#pragma unroll
                for (int n = 0; n < 2; ++n) {
                    const int col = cbase + bj * 128 + n * 16;
                    const f32x4 wq4 = *(const f32x4*)(fz.wpre + col), sc4 = *(const f32x4*)(fz.sc + v * 6144 + col) + 1.f, sh4 = *(const f32x4*)(fz.sh + v * 6144 + col);
#pragma unroll
                    for (int ai = 0; ai < 2; ++ai)
#pragma unroll
                        for (int m = 0; m < 4; ++m) {
                            const f32x4 h = acc[ai][bj][m][n] * rs[ai][m] * wq4 * sc4 + sh4;
                            u32x2 o = {pk2(h[0], h[1]), pk2(h[2], h[3])};
                            *(u32x2*)(hb + (size_t)(rbase + ai * 128 + m * 16) * 2048 + col) = o;
                        }
                }
        }
        return;
    }
#pragma unroll
    for (int ai = 0; ai < 2; ++ai)
#pragma unroll
        for (int bj = 0; bj < 2; ++bj) {
            __builtin_amdgcn_sched_barrier(0);
            f32x4 (&sub)[4][2] = acc[ai][bj];
            const int R0 = brow + ai * 128 + wr * 64, t0 = tb + ai * 128 + wr * 64, C0 = bcol + bj * 128 + wc * 32;
            const bool ns = vtm == 1 || (vtm == 2 && bj == 1);
            if (EPI == EPI_PE) {
                if (ns) {
                    const int vc = C0 - 2560;
                    bf16_t* vt = (bf16_t*)(p.ws + OFF_BIG + BIG_VT_E) + (latent ? (size_t)4194304 + ((size_t)b * 512 + vc) * 1024 : ((size_t)b * 512 + vc) * 256);
                    store_vt_s(sub, vt, T, t0, fr, fq);
                    if (!latent) store_f32_ns_s(sub, p.out + OUT_DIFFV + ((size_t)(b * 4 + (vc >> 7)) * 256 + t0) * 128 + (vc & 127), 128, fr, fq);
                } else {
                    if (pn >= 6 && latent) rope_s(sub, R0, wc & 1, fr, fq);
                    store_bf16_rows_s(sub, big, LDE, R0, C0, fr, fq);
                    if (pn >= 8 && !latent) store_f32_rows_s(sub, p.out + OUT_DIFFK + ((size_t)(b * 8 + ((C0 - 2048) >> 6)) * 256 + t0) * 64 + ((C0 - 2048) & 63), 64, fr, fq);
                }
            } else if (EPI == EPI_PO) {
                if (ns) {
                    if (pn < 8) {
                        const int vc = C0 - 1024;
                        bf16_t* vt = (bf16_t*)(p.ws + OFF_BIG + BIG_VT_C) + (latent ? (size_t)4194304 + ((size_t)b * 512 + vc) * 1024 : ((size_t)b * 512 + vc) * 256);
                        store_vt_s(sub, vt, T, t0, fr, fq);
                        if (!latent) store_f32_ns_s(sub, p.out + OUT_NAV + ((size_t)(b * 8 + (vc >> 6)) * 256 + t0) * 64 + (vc & 63), 64, fr, fq);
                    } else {
                        const int vc = C0 - 2176;
                        bf16_t* vt = (bf16_t*)(p.ws + OFF_BIG + BIG_VT_D) + (latent ? (size_t)1048576 + ((size_t)b * 128 + vc) * 1024 : ((size_t)b * 128 + vc) * 256);
                        store_vt_s(sub, vt, T, t0, fr, fq);
                        if (!latent) store_f32_ns_s(sub, p.out + OUT_SWAV + ((size_t)(b * 2 + (vc >> 6)) * 256 + t0) * 64 + (vc & 63), 64, fr, fq);
                    }
                } else {
                    if (pn >= 6 && latent) rope_s(sub, R0, wc & 1, fr, fq);
                    store_bf16_rows_s(sub, big, LDO, R0, pn >= 6 ? C0 - 512 : C0, fr, fq);
                    if (!latent) {
                        if (pn == 2 || pn == 3) store_f32_rows_s(sub, p.out + OUT_NAK + ((size_t)(b * 8 + ((C0 - 512) >> 6)) * 256 + t0) * 64 + ((C0 - 512) & 63), 64, fr, fq);
                        else if (pn == 8) store_f32_rows_s(sub, p.out + OUT_SWAK + ((size_t)(b * 2 + ((C0 - 2048) >> 6)) * 256 + t0) * 64 + ((C0 - 2048) & 63), 64, fr, fq);
                    }
                }
            } else if (EPI == EPI_Y) {
                store_f32_rows_s(sub, (float*)(p.ws + OFF_HY) + (size_t)R0 * 1024 + C0, 1024, fr, fq);
            } else {
#pragma unroll
                for (int m = 0; m < 4; ++m)
#pragma unroll
                    for (int n = 0; n < 2; ++n)
#pragma unroll
                        for (int j = 0; j < 4; ++j) { const float v = fmaxf(sub[m][n][j], 0.f); sub[m][n][j] = v * v; }
                store_bf16_rows_s(sub, big, 4096, R0, C0, fr, fq);
            }
        }
}

template <int EPI>
DI void gemm_phase(const Params& p, const bf16_t* A, int lda, const bf16_t* Bt, int K, int NT_N, char* shm, const FuseP& fz = FuseP{}) {
    using namespace g8;
    const int xcd = blockIdx.x & 7, lb = blockIdx.x >> 3, nlb = gridDim.x >> 3, per_xcd = 8 * NT_N;
    if (lb >= per_xcd) return;
    const int tid = TIDX, wid = __builtin_amdgcn_readfirstlane(tid >> 6), lane = tid & 63, wr = wid >> 2, wc = wid & 3, fr = lane & 15, fq = lane >> 4;
    const int nt = K / BK;
    lds_u8* lds = (lds_u8*)shm;
    unsigned voffA[2], voffB[2];
#pragma unroll
    for (int _i = 0; _i < 2; ++_i) { int _r, _c; stage_rc(tid * 16 + _i * 8192, _r, _c); voffA[_i] = (unsigned)(_r * lda + _c) * 2u; voffB[_i] = (unsigned)(_r * K + _c) * 2u; }
    const size_t kstep = (size_t)BK * 2, hstepA = (size_t)HALF * lda * 2, hstepB = (size_t)HALF * K * 2;
    const unsigned ldsw = (unsigned)wid * 1024u;
    const int aoff = lds_byte(wr * 64 + fr, fq * 8), boff = lds_byte(wc * 32 + fr, fq * 8);
#define SA(b, h) (((b) * 2 + (h)) * HTB)
#define SB(b, h) ((4 + (b) * 2 + (h)) * HTB)
#define STAGE(bufoff, gbase, voff) do { _Pragma("unroll") for (int _i = 0; _i < 2; ++_i) \
      __builtin_amdgcn_global_load_lds((const unsigned*)((gbase) + (voff)[_i]), (lds_u32*)(lds + (bufoff) + ldsw + _i * 8192), 16, 0, 0); } while (0)
#define LDA(dst, b, h) _Pragma("unroll") for (int m = 0; m < 4; ++m) _Pragma("unroll") for (int k = 0; k < 2; ++k) \
    dst[m][k] = *(const lds_bf16x8*)(lds + SA(b, h) + aoff + m * 2048 + k * 1024)
#define LDB(dst, b, h) _Pragma("unroll") for (int n = 0; n < 2; ++n) _Pragma("unroll") for (int k = 0; k < 2; ++k) \
    dst[n][k] = *(const lds_bf16x8*)(lds + SB(b, h) + boff + n * 2048 + k * 1024)
#define MMA(VT, ai, bj, At_, Bt_) do { __builtin_amdgcn_s_setprio(1); \
    _Pragma("unroll") for (int m = 0; m < 4; ++m) _Pragma("unroll") for (int n = 0; n < 2; ++n) _Pragma("unroll") for (int k = 0; k < 2; ++k) \
      acc[ai][bj][m][n] = ((VT) == 1 || ((VT) == 2 && (bj) == 1)) ? MFMA16(At_[m][k], Bt_[n][k], acc[ai][bj][m][n]) : MFMA16(Bt_[n][k], At_[m][k], acc[ai][bj][m][n]); \
    __builtin_amdgcn_s_setprio(0); } while (0)
#define WAIT_V(n) asm volatile("s_waitcnt vmcnt(" #n ")" ::: "memory")
#define WAIT_L(n) asm volatile("s_waitcnt lgkmcnt(" #n ")" ::: "memory")
#define BAR __builtin_amdgcn_s_barrier()
#define SCHED __builtin_amdgcn_sched_barrier(0)
#define TLOOP(VT) for (int t = 0; t < nt; t += 2) { \
        const bool last = (t == nt - 2); \
        const char* a1 = cA + (size_t)(t + 1) * kstep; \
        const char* a2 = last ? nA : cA + (size_t)(t + 2) * kstep; const char* b2 = last ? nB : cB + (size_t)(t + 2) * kstep; \
        const char* a3 = a2 + kstep; const char* b3 = b2 + kstep; \
        LDB(B0, 0, 0); LDB(B1, 0, 1); SCHED; LDA(At, 0, 0); STAGE(SA(1, 1), a1 + hstepA, voffA); \
        WAIT_V(8); WAIT_L(0); BAR; MMA(VT, 0, 0, At, B0); MMA(VT, 0, 1, At, B1); BAR; SCHED; \
        LDA(At, 0, 1); STAGE(SB(0, 0), b2, voffB); STAGE(SB(0, 1), b2 + hstepB, voffB); STAGE(SA(0, 0), a2, voffA); \
        WAIT_V(8); WAIT_L(0); BAR; MMA(VT, 1, 0, At, B0); MMA(VT, 1, 1, At, B1); BAR; SCHED; \
        LDB(B0, 1, 0); LDB(B1, 1, 1); SCHED; LDA(At, 1, 0); STAGE(SA(0, 1), a2 + hstepA, voffA); \
        WAIT_V(8); WAIT_L(0); BAR; MMA(VT, 0, 0, At, B0); MMA(VT, 0, 1, At, B1); BAR; SCHED; \
        LDA(At, 1, 1); STAGE(SB(1, 0), b3, voffB); STAGE(SB(1, 1), b3 + hstepB, voffB); STAGE(SA(1, 0), a3, voffA); \
        WAIT_V(8); WAIT_L(0); BAR; MMA(VT, 1, 0, At, B0); MMA(VT, 1, 1, At, B1); BAR; SCHED; \
    }
    int lt = lb, pm = xcd * 8 + (lt & 7), pn = lt >> 3;
    f32x4 acc[2][2][4][2];
#pragma unroll
    for (int a = 0; a < 2; ++a)
#pragma unroll
        for (int b = 0; b < 2; ++b)
#pragma unroll
            for (int m = 0; m < 4; ++m)
#pragma unroll
                for (int n = 0; n < 2; ++n) acc[a][b][m][n] = (f32x4){0.f, 0.f, 0.f, 0.f};
    bf16x8 At[4][2], B0[2][2], B1[2][2];
    const char* cA = (const char*)A + (size_t)pm * 2 * hstepA;
    const char* cB = (const char*)Bt + (size_t)pn * 2 * hstepB;
    WAIT_V(0);
    STAGE(SB(0, 0), cB, voffB); STAGE(SB(0, 1), cB + hstepB, voffB); STAGE(SA(0, 0), cA, voffA); STAGE(SA(0, 1), cA + hstepA, voffA);
    if (wr == 1) BAR;
    WAIT_V(2); BAR;
    STAGE(SB(1, 0), cB + kstep, voffB); STAGE(SA(1, 0), cA + kstep, voffA); STAGE(SB(1, 1), cB + hstepB + kstep, voffB);
    WAIT_V(6); BAR;
    for (;;) {
        const int ltn = lt + nlb;
        const bool has_next = ltn < per_xcd;
        const int pmn = xcd * 8 + (ltn & 7), pnn = ltn >> 3;
        const char* nA = has_next ? (const char*)A + (size_t)pmn * 2 * hstepA : cA;
        const char* nB = has_next ? (const char*)Bt + (size_t)pnn * 2 * hstepB : cB;
        int vtm = 0;
        if (EPI == EPI_PE) vtm = pn >= 10 ? 1 : 0;
        if (EPI == EPI_PO) vtm = (pn == 4 || pn == 5) ? 1 : (pn == 8 ? 2 : 0);
        if ((EPI == EPI_PE || EPI == EPI_PO) && vtm == 1) { TLOOP(1) }
        else if (EPI == EPI_PO && vtm == 2) { TLOOP(2) }
        else { TLOOP(0) }
        if (EPI != EPI_YF) tile_epilogue<EPI>(p, acc, pm, pn, vtm, fz);
        if (!has_next) break;
#pragma unroll
        for (int a = 0; a < 2; ++a)
#pragma unroll
            for (int b = 0; b < 2; ++b)
#pragma unroll
                for (int m = 0; m < 4; ++m)
#pragma unroll
                    for (int n = 0; n < 2; ++n) acc[a][b][m][n] = (f32x4){0.f, 0.f, 0.f, 0.f};
        lt = ltn; pm = pmn; pn = pnn; cA = nA; cB = nB;
    }
    WAIT_V(0);
    if (wr == 0) BAR;
    BAR;
    if (EPI == EPI_YF) tile_epilogue<EPI>(p, acc, pm, pn, 0, fz);
#undef SA
#undef SB
#undef STAGE
#undef LDA
#undef LDB
#undef MMA
#undef WAIT_V
#undef WAIT_L
#undef BAR
#undef SCHED
#undef TLOOP
}

struct ASeg { const bf16_t* K; const bf16_t* Vt; int ldk, ldv, ntiles; };
struct MaskP { int on, a, b, c; const float* tab; };

template <int KW, int VR, int NB, int MODE>
DI void attn_core(const ASeg& s0, const ASeg& s1, const bf16x8 (&qf)[4], int kchunk0, int vrow0, float scale_l2, float& m, float& l, f32x16 (&O)[NB], char* lds, const MaskP& mp) {
    constexpr int KC = KW / 8, NKL = 64 * KC / 256, NVL = VR * 8 / 256;
    const int tid = VTID, lane = tid & 63, p32 = lane & 31, h = lane >> 5;
    const int krow = (p32 & 19) | ((p32 & 4) << 1) | ((p32 & 8) >> 1);
    const int n0 = s0.ntiles, nt = s0.ntiles + s1.ntiles;
    u32x4 rk[NKL], rv[NVL];
#define ATT_LOAD(t_)                                                                                                         \
    {                                                                                                                        \
        const bool f_ = (t_) < n0; const int tt_ = f_ ? (t_) : (t_) - n0;                                                     \
        const bf16_t* Kp_ = (f_ ? s0.K : s1.K); const int ldk_ = f_ ? s0.ldk : s1.ldk;                                        \
        const bf16_t* Vp_ = (f_ ? s0.Vt : s1.Vt); const int ldv_ = f_ ? s0.ldv : s1.ldv;                                      \
        _Pragma("unroll") for (int i = 0; i < NKL; ++i) { const int id = tid + 256 * i, r = id / KC, c = id % KC; rk[i] = *(const u32x4*)(Kp_ + (size_t)(tt_ * 64 + r) * ldk_ + c * 8); } \
        _Pragma("unroll") for (int i = 0; i < NVL; ++i) { const int id = tid + 256 * i, r = id >> 3, c = id & 7; rv[i] = *(const u32x4*)(Vp_ + (size_t)r * ldv_ + tt_ * 64 + c * 8); }       \
    }
#define ATT_STORE(b_)                                                                                                        \
    {                                                                                                                        \
        char* kb_ = lds + (b_) * 32768; char* vb_ = kb_ + 16384;                                                              \
        _Pragma("unroll") for (int i = 0; i < NKL; ++i) { const int id = tid + 256 * i, r = id / KC, c = id % KC; *(u32x4*)(kb_ + (KW == 128 ? swz256(r, c) : swz128(r, c))) = rk[i]; } \
        _Pragma("unroll") for (int i = 0; i < NVL; ++i) { const int id = tid + 256 * i, r = id >> 3, c = id & 7; *(u32x4*)(vb_ + swz128(r, c)) = rv[i]; }                               \
    }
    ATT_LOAD(0);
    ATT_STORE(0);
    __syncthreads();
    for (int t = 0; t < nt; ++t) {
        const bool more = t + 1 < nt;
        if (more) ATT_LOAD(t + 1);
        const char* kb = lds + (t & 1) * 32768;
        const char* vb = kb + 16384;
        f32x16 S[2];
#pragma unroll
        for (int kh = 0; kh < 2; ++kh) {
#pragma unroll
            for (int i = 0; i < 16; ++i) S[kh][i] = 0.f;
            const int row = krow + 32 * kh;
#pragma unroll
            for (int s = 0; s < 4; ++s) {
                const int c = kchunk0 + 2 * s + h;
                const bf16x8 kf = *(const bf16x8*)(kb + (KW == 128 ? swz256(row, c) : swz128(row, c)));
                S[kh] = MFMA32(kf, qf[s], S[kh]);
            }
        }
        const bool msk = (MODE != 0) && mp.on && t < n0;
        float mx = -1e30f;
        if (MODE == 1 && msk) {
            int cq = mp.c + p32;
            int h8 = 8 * h;
            asm volatile("" : "+v"(cq), "+v"(h8));
            const int cs = min(max(cq - 8, 0), 48);
            const float* tab = mp.tab + (mp.b + t - mp.a + 7) * 31;
#pragma unroll
            for (int kh = 0; kh < 2; ++kh)
#pragma unroll
                for (int i = 0; i < 16; ++i) {
                    const int kc = 32 * kh + 16 * (i >> 3) + h8 + (i & 7);
                    const bool ok = (unsigned)(kc - cs) < 16u;
                    const int dc = min(max(kc - cq + 15, 0), 30);
                    const float sv = ok ? S[kh][i] * scale_l2 + tab[dc] : -1e30f;
                    S[kh][i] = sv; mx = fmaxf(mx, sv);
                }
        } else if (MODE == 2 && msk) {
            int qp = mp.a + p32 - 8 * h;
            asm volatile("" : "+v"(qp));
            const int k0 = mp.b + t * 64;
#pragma unroll
            for (int kh = 0; kh < 2; ++kh)
#pragma unroll
                for (int i = 0; i < 16; ++i) {
                    const int d = qp - (k0 + 32 * kh + 16 * (i >> 3) + (i & 7));
                    const bool ok = d <= 128 && d >= -128;
                    const float sv = ok ? S[kh][i] * scale_l2 : -1e30f;
                    S[kh][i] = sv; mx = fmaxf(mx, sv);
                }
        } else {
#pragma unroll
            for (int kh = 0; kh < 2; ++kh)
#pragma unroll
                for (int i = 0; i < 16; ++i) { const float sv = S[kh][i] * scale_l2; S[kh][i] = sv; mx = fmaxf(mx, sv); }
        }
        mx = fmaxf(mx, __shfl_xor(mx, 32));
        const float mn = fmaxf(m, mx);
        const float alpha = __builtin_amdgcn_exp2f(m - mn);
        m = mn;
        float ls = 0.f;
#pragma unroll
        for (int kh = 0; kh < 2; ++kh)
#pragma unroll
            for (int i = 0; i < 16; ++i) { const float pv = __builtin_amdgcn_exp2f(S[kh][i] - mn); S[kh][i] = pv; ls += pv; }
        l = l * alpha + ls;
#pragma unroll
        for (int blk = 0; blk < NB; ++blk)
#pragma unroll
            for (int i = 0; i < 16; ++i) O[blk][i] *= alpha;
#pragma unroll
        for (int kh = 0; kh < 2; ++kh)
#pragma unroll
            for (int s2 = 0; s2 < 2; ++s2) {
                u32x4 pp = {pk2(S[kh][8 * s2 + 0], S[kh][8 * s2 + 1]), pk2(S[kh][8 * s2 + 2], S[kh][8 * s2 + 3]), pk2(S[kh][8 * s2 + 4], S[kh][8 * s2 + 5]), pk2(S[kh][8 * s2 + 6], S[kh][8 * s2 + 7])};
                const bf16x8 pb = __builtin_bit_cast(bf16x8, pp);
                const int c = 4 * kh + 2 * s2 + h;
#pragma unroll
                for (int blk = 0; blk < NB; ++blk) {
                    const bf16x8 vf = *(const bf16x8*)(vb + swz128(vrow0 + blk * 32 + p32, c));
                    O[blk] = MFMA32(vf, pb, O[blk]);
                }
            }
        if (more) ATT_STORE((t + 1) & 1);
        __syncthreads();
    }
    l += __shfl_xor(l, 32);
#undef ATT_LOAD
#undef ATT_STORE
}

DI void load_q(bf16x8 (&qf)[4], const bf16_t* qrow, int h) {
#pragma unroll
    for (int s = 0; s < 4; ++s) qf[s] = *(const bf16x8*)(qrow + 16 * s + 8 * h);
}

DI void attn_diff_item(const Params& p, int item, char* lds) {
    const int tid = VTID, lane = tid & 63, w = tid >> 6, p32 = lane & 31, h = lane >> 5, stream = w & 1, qh = w >> 1;
    const bf16_t* proj = (const bf16_t*)(p.ws + OFF_BIG);
    const bf16_t* vte = (const bf16_t*)(p.ws + OFF_BIG + BIG_VT_E);
    bf16_t* mix = (bf16_t*)(p.ws + OFF_BIG + BIG_MIXIN);
    int b, hd, qb, rowbase; ASeg s0, s1;
    if (item < 512) {
        b = item >> 6; hd = (item >> 4) & 3; qb = item & 15; rowbase = 8192 + b * 1024;
        s0 = {proj + (size_t)rowbase * LDE + 2048 + hd * 128, vte + 4194304 + ((size_t)b * 512 + hd * 128) * 1024, LDE, 1024, 16};
        s1 = {(const bf16_t*)(p.ws + OFF_CDK) + (size_t)b * 256 * 512 + hd * 128, (const bf16_t*)(p.ws + OFF_CDVT) + (size_t)(b * 4 + hd) * 128 * 256, 512, 256, 4};
    } else {
        const int it = item - 512;
        b = it >> 4; hd = (it >> 2) & 3; qb = it & 3; rowbase = b * 256;
        s0 = {proj + (size_t)rowbase * LDE + 2048 + hd * 128, vte + ((size_t)b * 512 + hd * 128) * 256, LDE, 256, 4};
        s1 = s0; s1.ntiles = 0;
    }
    const int R = rowbase + qb * 64 + qh * 32 + p32;
    bf16x8 qf[4];
    load_q(qf, proj + (size_t)R * LDE + 1536 + hd * 128 + stream * 64, h);
    f32x16 O[4];
#pragma unroll
    for (int blk = 0; blk < 4; ++blk)
#pragma unroll
        for (int i = 0; i < 16; ++i) O[blk][i] = 0.f;
    float m = -1e30f, l = 0.f;
    MaskP mp = {0, 0, 0, 0, nullptr};
    attn_core<128, 128, 4, 0>(s0, s1, qf, stream * 8, 0, 0.125f * LOG2E, m, l, O, lds, mp);
    const float il = 1.f / l;
    const float d1 = wave_sum(p.lq1[lane] * p.lk1[lane]), d2 = wave_sum(p.lq2[lane] * p.lk2[lane]);
    const float lam_init = 0.2f;
    const float lam = __expf(d1) - __expf(d2) + lam_init;
    float* xb = (float*)(lds + qh * 16384);
    if (stream == 1) {
#pragma unroll
        for (int blk = 0; blk < 4; ++blk)
#pragma unroll
            for (int i = 0; i < 16; ++i) { const int dv = blk * 32 + 8 * (i >> 2) + 4 * h + (i & 3); xb[dv * 32 + p32] = O[blk][i] * il; }
    }
    __syncthreads();
    if (stream == 0) {
        float ss = 0.f;
#pragma unroll
        for (int blk = 0; blk < 4; ++blk)
#pragma unroll
            for (int i = 0; i < 16; ++i) { const int dv = blk * 32 + 8 * (i >> 2) + 4 * h + (i & 3); const float o = O[blk][i] * il - lam * xb[dv * 32 + p32]; O[blk][i] = o; ss += o * o; }
        ss += __shfl_xor(ss, 32);
        const float rs = rsqrtf(ss * (1.f / 128.f) + EPSN) * (1.f - lam_init);
        bf16_t* op = mix + (size_t)R * 1024 + 512 + hd * 128;
#pragma unroll
        for (int blk = 0; blk < 4; ++blk)
#pragma unroll
            for (int g = 0; g < 4; ++g) {
                const int dv = blk * 32 + 8 * g + 4 * h;
                const f32x4 sl = *(const f32x4*)(p.subln + dv);
                u32x2 o = {pk2(O[blk][4 * g] * rs * sl[0], O[blk][4 * g + 1] * rs * sl[1]), pk2(O[blk][4 * g + 2] * rs * sl[2], O[blk][4 * g + 3] * rs * sl[3])};
                *(u32x2*)(op + dv) = o;
            }
    }
    __syncthreads();
}

DI void attn_c_item(const Params& p, int item, char* lds) {
    const int tid = VTID, lane = tid & 63, w = tid >> 6, p32 = lane & 31, h = lane >> 5, stream = w & 1, qh = w >> 1;
    const bf16_t* proj = (const bf16_t*)(p.ws + OFF_BIG);
    const bf16_t* vtc = (const bf16_t*)(p.ws + OFF_BIG + BIG_VT_C);
    bf16_t* mix = (bf16_t*)(p.ws + OFF_BIG + BIG_MIXIN);
    int b, hp, qb, rowbase; ASeg s0, s1; MaskP mp = {0, 0, 0, 0, nullptr};
    float* tab = (float*)(lds + 65536);
    if (item < 512) {
        b = item >> 6; hp = (item >> 4) & 3; qb = item & 15; rowbase = 8192 + b * 1024;
        const int rstart = min(max(qb - 4, 0), 8);
        s0 = {proj + (size_t)(rowbase + rstart * 64) * LDO + 512 + hp * 128, vtc + 4194304 + ((size_t)b * 512 + hp * 128) * 1024 + rstart * 64, LDO, 1024, 8};
        s1 = {(const bf16_t*)(p.ws + OFF_CNK) + (size_t)b * 256 * 512 + hp * 128, (const bf16_t*)(p.ws + OFF_CNVT) + ((size_t)b * 512 + hp * 128) * 256, 512, 256, 4};
        for (int idx = tid; idx < 930; idx += 256) tab[idx] = p.rpb[hp * 930 + idx] * LOG2E;
        mp = {1, qb, rstart, qh * 32, tab + stream * 465};
    } else {
        const int it = item - 512;
        b = it >> 4; hp = (it >> 2) & 3; qb = it & 3; rowbase = b * 256;
        s0 = {proj + (size_t)rowbase * LDO + 512 + hp * 128, vtc + ((size_t)b * 512 + hp * 128) * 256, LDO, 256, 4};
        s1 = s0; s1.ntiles = 0;
    }
    const int R = rowbase + qb * 64 + qh * 32 + p32;
    const int head = hp * 2 + stream;
    bf16x8 qf[4];
    load_q(qf, proj + (size_t)R * LDO + head * 64, h);
    f32x16 O[2];
#pragma unroll
    for (int blk = 0; blk < 2; ++blk)
#pragma unroll
        for (int i = 0; i < 16; ++i) O[blk][i] = 0.f;
    float m = -1e30f, l = 0.f;
    attn_core<128, 128, 2, 1>(s0, s1, qf, stream * 8, stream * 64, 0.125f * LOG2E, m, l, O, lds, mp);
    const float il = 1.f / l;
    bf16_t* op = mix + (size_t)R * 1024 + head * 64;
#pragma unroll
    for (int blk = 0; blk < 2; ++blk)
#pragma unroll
        for (int g = 0; g < 4; ++g) {
            const int dv = blk * 32 + 8 * g + 4 * h;
            u32x2 o = {pk2(O[blk][4 * g] * il, O[blk][4 * g + 1] * il), pk2(O[blk][4 * g + 2] * il, O[blk][4 * g + 3] * il)};
            *(u32x2*)(op + dv) = o;
        }
}

DI void attn_d_item(const Params& p, int item, char* lds) {
    const int tid = VTID, lane = tid & 63, w = tid >> 6, p32 = lane & 31, h = lane >> 5;
    const bf16_t* proj = (const bf16_t*)(p.ws + OFF_BIG);
    const bf16_t* vtd = (const bf16_t*)(p.ws + OFF_BIG + BIG_VT_D);
    bf16_t* mix = (bf16_t*)(p.ws + OFF_BIG + BIG_MIXIN);
    int b, g, qb, rowbase; ASeg s0, s1; MaskP mp = {0, 0, 0, 0, nullptr};
    if (item < 512) {
        b = item >> 6; g = (item >> 5) & 1; qb = item & 31; rowbase = 8192 + b * 1024;
        const int q0 = qb * 32;
        const int tlo = max(q0 - 128, 0) >> 6, thi = min(q0 + 159, 1023) >> 6;
        s0 = {proj + (size_t)(rowbase + tlo * 64) * LDO + 1536 + g * 64, vtd + 1048576 + ((size_t)b * 128 + g * 64) * 1024 + tlo * 64, LDO, 1024, thi - tlo + 1};
        s1 = {(const bf16_t*)(p.ws + OFF_CSK) + (size_t)b * 256 * 128 + g * 64, (const bf16_t*)(p.ws + OFF_CSVT) + ((size_t)b * 128 + g * 64) * 256, 128, 256, 4};
        mp = {1, q0, tlo * 64, 0, nullptr};
    } else {
        const int it = item - 512;
        b = it >> 4; g = (it >> 3) & 1; qb = it & 7; rowbase = b * 256;
        s0 = {proj + (size_t)rowbase * LDO + 1536 + g * 64, vtd + ((size_t)b * 128 + g * 64) * 256, LDO, 256, 4};
        s1 = s0; s1.ntiles = 0;
    }
    const int R = rowbase + qb * 32 + p32;
    const int hq = g * 4 + w;
    bf16x8 qf[4];
    load_q(qf, proj + (size_t)R * LDO + 1024 + hq * 64, h);
    f32x16 O[2];
#pragma unroll
    for (int blk = 0; blk < 2; ++blk)
#pragma unroll
        for (int i = 0; i < 16; ++i) O[blk][i] = 0.f;
    float m = p.sink[hq] * LOG2E, l = h == 0 ? 1.f : 0.f;
    attn_core<64, 64, 2, 2>(s0, s1, qf, 0, 0, 0.125f * LOG2E, m, l, O, lds, mp);
    const float il = 1.f / l;
    bf16_t* op = mix + (size_t)R * 1024 + 512 + hq * 64;
#pragma unroll
    for (int blk = 0; blk < 2; ++blk)
#pragma unroll
        for (int gg = 0; gg < 4; ++gg) {
            const int dv = blk * 32 + 8 * gg + 4 * h;
            u32x2 o = {pk2(O[blk][4 * gg] * il, O[blk][4 * gg + 1] * il), pk2(O[blk][4 * gg + 2] * il, O[blk][4 * gg + 3] * il)};
            *(u32x2*)(op + dv) = o;
        }
}

DI void conv_item(const Params& p, int item) {
    const int tid = VTID;
    const bf16_t* proj = (const bf16_t*)(p.ws + OFF_BIG);
    bf16_t* mix = (bf16_t*)(p.ws + OFF_BIG + BIG_MIXIN);
#pragma unroll 2
    for (int i = 0; i < 8; ++i) {
        const int idx = tid + 256 * i, tl = idx >> 6, ch = (idx & 63) * 8;
        const int R = item * 32 + tl;
        int t, T;
        if (R < 8192) { t = R & 255; T = 256; } else { t = (R - 8192) & 1023; T = 1024; }
        const bf16_t* rp = proj + (size_t)R * LDE + ch;
        const u32x4 ab = *(const u32x4*)(rp);
        float accv[8];
#pragma unroll
        for (int e = 0; e < 8; ++e) accv[e] = 0.f;
#pragma unroll
        for (int j = 0; j < 3; ++j) {
            const int tt = t + j - 1;
            if (tt >= 0 && tt < T) {
                const u32x4 ac = *(const u32x4*)(rp + (ptrdiff_t)(j - 1) * LDE + 512);
                const u32x4 ax = *(const u32x4*)(rp + (ptrdiff_t)(j - 1) * LDE + 1024);
                const f32x4 w0 = *(const f32x4*)(p.conv_w + j * 512 + ch), w1 = *(const f32x4*)(p.conv_w + j * 512 + ch + 4);
#pragma unroll
                for (int e = 0; e < 4; ++e) {
                    accv[2 * e] += bflo(ac[e]) * bflo(ax[e]) * (e < 2 ? w0[2 * e] : w1[2 * e - 4]);
                    accv[2 * e + 1] += bfhi(ac[e]) * bfhi(ax[e]) * (e < 2 ? w0[2 * e + 1] : w1[2 * e - 3]);
                }
            }
        }
        u32x4 o;
#pragma unroll
        for (int e = 0; e < 4; ++e) o[e] = pk2(bflo(ab[e]) * accv[2 * e], bfhi(ab[e]) * accv[2 * e + 1]);
        *(u32x4*)(mix + (size_t)R * 1024 + ch) = o;
    }
}


#define XB_TMO      128
#define XB_XCNT(j)  (256  + 64 * (j))
#define XB_XSUB(j)  (1280 + 64 * (j))
#define XB_XGEN(j)  (2304 + 64 * (j))
#define XB_TOP      3328
#define XB_TOPGEN   3392
#define XCD_BAR_WORDS 3456
#define XB_SPIN_CAP (1u << 22)
#define LAS __attribute__((address_space(3)))
DI unsigned xb_ld(unsigned* p) { return __hip_atomic_load(p, __ATOMIC_RELAXED, __HIP_MEMORY_SCOPE_AGENT); }
DI unsigned xb_add(unsigned* p, unsigned v) { return __hip_atomic_fetch_add(p, v, __ATOMIC_RELAXED, __HIP_MEMORY_SCOPE_AGENT); }
DI unsigned xb_xcc_id() { return (unsigned)__builtin_amdgcn_s_getreg((3 << 11) | 20) & 0xFu; }
#define XB_SPIN(cond, bar) do { unsigned _sp = 0; while (cond) { __builtin_amdgcn_s_sleep(1); \
    if ((++_sp & 255u) == 0u) { if (xb_ld(&(bar)[XB_TMO])) break; if (_sp > XB_SPIN_CAP) { atomicAdd(&(bar)[XB_TMO], 1u); break; } } } } while (0)
struct XcdBarrier { unsigned* bar; unsigned x; volatile LAS unsigned* st; };
DI XcdBarrier xcd_barrier_post(unsigned* bar, volatile LAS unsigned* st) {
    XcdBarrier b; b.bar = bar; b.x = xb_xcc_id(); b.st = st;
    if (threadIdx.x == 0) (void)xb_add(&bar[XB_XCNT(b.x)], 1u);
    return b;
}
DI void xcd_barrier_complete(unsigned* bar, unsigned x, unsigned& nloc, unsigned& nx) {
    const unsigned G = gridDim.x * gridDim.y * gridDim.z;
    unsigned sum, cnt, mine, sp = 0u;
    for (;;) {
        sum = 0u; cnt = 0u; mine = 0u;
#pragma unroll
        for (unsigned j = 0; j < 16; ++j) { const unsigned c = xb_ld(&bar[XB_XCNT(j)]); sum += c; cnt += (c > 0u) ? 1u : 0u; mine = (j == x) ? c : mine; }
        if (sum == G) break;
        __builtin_amdgcn_s_sleep(1);
        if ((++sp & 255u) == 0u) { if (xb_ld(&bar[XB_TMO])) break; if (sp > XB_SPIN_CAP) { atomicAdd(&bar[XB_TMO], 1u); break; } }
    }
    nloc = mine > 0u ? mine : 1u; nx = cnt > 0u ? cnt : 1u;
}
DI void xcd_barrier(const XcdBarrier& b) {
    asm volatile("s_waitcnt vmcnt(0)" ::: "memory");
    __syncthreads();
    if (threadIdx.x == 0) {
        unsigned* bar = b.bar;
        __builtin_amdgcn_s_waitcnt(0);
        unsigned nloc = b.st[0], nx = b.st[1];
        if (nloc == 0u) { xcd_barrier_complete(bar, b.x, nloc, nx); b.st[0] = nloc; b.st[1] = nx; }
        const unsigned old = xb_add(&bar[XB_XSUB(b.x)], 1u);
        const unsigned gen = old / nloc;
        if (old + 1u == (gen + 1u) * nloc) {
            __builtin_amdgcn_fence(__ATOMIC_RELEASE, "agent");
            asm volatile("s_waitcnt vmcnt(0)" ::: "memory");
            const unsigned og = xb_add(&bar[XB_TOP], 1u);
            const unsigned tg = og / nx;
            if (og + 1u == (tg + 1u) * nx) xb_add(&bar[XB_TOPGEN], 1u);
            else XB_SPIN(xb_ld(&bar[XB_TOPGEN]) == tg, bar);
            __builtin_amdgcn_fence(__ATOMIC_ACQUIRE, "agent");
            xb_add(&bar[XB_XGEN(b.x)], 1u);
            asm volatile("s_waitcnt vmcnt(0)" ::: "memory");
        } else {
            XB_SPIN(xb_ld(&bar[XB_XGEN(b.x)]) == gen, bar);
            __builtin_amdgcn_fence(__ATOMIC_ACQUIRE, "agent");
            asm volatile("s_waitcnt vmcnt(0)" ::: "memory");
        }
    }
    __syncthreads();
}

constexpr int N_PHASES = 12;
DI void run_phase(const Params& p, int ph, char* shm) {
    const int nb = VNB, bid = VBID;
    char* lds = shm + VHALF * LDS_HALF;
    const bf16_t* hy = (const bf16_t*)(p.ws + OFF_HY);
    const bf16_t* big = (const bf16_t*)(p.ws + OFF_BIG);
    const bf16_t* mixin = (const bf16_t*)(p.ws + OFF_BIG + BIG_MIXIN);
    const float* mod = (const float*)(p.ws + OFF_MOD);
    char* st = p.ws + OFF_STAT;
#define FZ(set, from_in, hasH, goff, wpost, wpre, scoff, shoff) FuseP{from_in, hasH, p.out, mod + (goff), wpost, wpre, mod + (scoff), mod + (shoff), (float*)(st + (set) * STAT_SET), (float*)(st + (set) * STAT_SET + 65536), (unsigned*)(st + (set) * STAT_SET + 131072)}
    switch (ph) {
    case 0: p0_phase(p, bid, nb, lds); break;
    case 1: rowop_phase(p, false, true, 0, nullptr, true, p.norm_mix_pre, 1024, 0); break;
    case 2: gemm_phase<EPI_PE>(p, hy, 2048, (const bf16_t*)(p.ws + OFF_WINE), 1024, 12, shm); break;
    case 3:
        for (int it = bid; it < 1536; it += nb) { if (it < 1024) attn_diff_item(p, it, lds); else conv_item(p, it - 1024); }
        break;
    case 4: gemm_phase<EPI_YF>(p, mixin, 1024, (const bf16_t*)(p.ws + OFF_WOUT), 1024, 4, shm, FZ(0, 1, 1, 2048, p.norm_mix_post, p.norm_mlp_pre, 4096, 3072)); break;
    case 5: gemm_phase<EPI_W1>(p, hy, 2048, (const bf16_t*)(p.ws + OFF_W1), 1024, 16, shm); break;
    case 6: gemm_phase<EPI_YF>(p, big, 4096, (const bf16_t*)(p.ws + OFF_W2), 4096, 4, shm, FZ(1, 0, 1, 5120, p.norm_mlp_post, p.norm_mix_pre + 1024, 9 * 6144 + 1024, 9 * 6144 + 0)); break;
    case 7: gemm_phase<EPI_PO>(p, hy, 2048, (const bf16_t*)(p.ws + OFF_WINO), 1024, 9, shm); break;
    case 8:
        for (int it = bid; it < 2048; it += nb) {
            const int q = it >> 9, r = it & 511;
            if (q & 1) attn_d_item(p, (q >> 1) * 512 + r, lds); else attn_c_item(p, (q >> 1) * 512 + r, lds);
        }
        break;
    case 9: gemm_phase<EPI_YF>(p, mixin, 1024, (const bf16_t*)(p.ws + OFF_WOUT) + 1048576, 1024, 4, shm, FZ(2, 0, 1, 9 * 6144 + 2048, p.norm_mix_post + 1024, p.norm_mlp_pre + 1024, 9 * 6144 + 4096, 9 * 6144 + 3072)); break;
    case 10: gemm_phase<EPI_W1>(p, hy, 2048, (const bf16_t*)(p.ws + OFF_W1) + 4194304, 1024, 16, shm); break;
    case 11: gemm_phase<EPI_YF>(p, big, 4096, (const bf16_t*)(p.ws + OFF_W2) + 4194304, 4096, 4, shm, FZ(3, 0, 0, 9 * 6144 + 5120, p.norm_mlp_post + 1024, p.norm_mlp_post, 0, 0)); break;
    }
#undef FZ
}

__global__ void __launch_bounds__(512, 2) fwd_mega(Params p) {
    __shared__ __attribute__((aligned(16))) char lds[LDS_BYTES];
    __shared__ uint4 xb_words;
    cg::grid_group grid = cg::this_grid();
    if (threadIdx.x == 0) xb_words = make_uint4(0u, 0u, 0u, 0u);
    __syncthreads();
    const XcdBarrier xb = xcd_barrier_post((unsigned*)(p.ws + OFF_BAR), (volatile LAS unsigned*)&xb_words);
#define PH_(n) run_phase(p, n, lds); xcd_barrier(xb); if ((DUP_MASK >> n) & 1) { run_phase(p, n, lds); xcd_barrier(xb); }
    PH_(0)
    if (p.ws == nullptr) grid.sync();
    PH_(1) PH_(2) PH_(3) PH_(4) PH_(5) PH_(6) PH_(7) PH_(8) PH_(9) PH_(10)
    run_phase(p, 11, lds);
#undef PH_
}

__global__ void __launch_bounds__(512, 2) fwd_phase(Params p, int ph) {
    __shared__ __attribute__((aligned(16))) char lds[LDS_BYTES];
    run_phase(p, ph, lds);
}

extern "C" void kernel_launch(void* const* d_in, const int* in_sizes, int n_in, void* d_out, int out_size, void* d_ws, size_t ws_size, hipStream_t stream) {
    Params p{};
    const float** pp = (const float**)&p;
    for (int i = 0; i < 29; ++i) pp[i] = (const float*)d_in[i];
    p.out = (float*)d_out;
    p.ws = (char*)d_ws;
    if (ws_size < WS_NEEDED) { fprintf(stderr, "workspace too small: %zu < %zu\n", ws_size, (size_t)WS_NEEDED); return; }
    static int grid_blocks = 0;
    if (!grid_blocks) {
        int dev = 0, cus = 0, per_cu = 0;
        hipGetDevice(&dev);
        hipDeviceGetAttribute(&cus, hipDeviceAttributeMultiprocessorCount, dev);
        hipOccupancyMaxActiveBlocksPerMultiprocessor(&per_cu, fwd_mega, 512, 0);
        if (per_cu > 1) per_cu = 1;
        if (per_cu < 1) per_cu = 1;
        grid_blocks = cus * per_cu;
        grid_blocks -= grid_blocks % 8;
    }
#if ONE_LAUNCH
    (void)hipMemsetAsync((char*)d_ws + OFF_BAR, 0, XCD_BAR_WORDS * 4, stream);
    (void)hipMemsetAsync((char*)d_ws + OFF_STAT, 0, 4 * STAT_SET, stream);
    if (grid_blocks != 256) { fprintf(stderr, "fused epilogues need exactly 256 workgroups (got %d)\n", grid_blocks); return; }
    void* args[] = {&p};
    hipError_t e = hipLaunchCooperativeKernel((void*)fwd_mega, dim3(grid_blocks), dim3(512), args, 0, stream);
    if (e != hipSuccess) fprintf(stderr, "cooperative launch failed: %s (grid %d)\n", hipGetErrorString(e), grid_blocks);
#else
    for (int ph = 0; ph < N_PHASES; ++ph) fwd_phase<<<grid_blocks, 512, 0, stream>>>(p, ph);
#endif
}
```

```cpp
#include <hip/hip_runtime.h>
#include <hip/hip_cooperative_groups.h>
#include <cstdio>
#include <cstdint>
namespace cg = cooperative_groups;

#ifndef DUP_MASK
#define DUP_MASK 0
#endif
#ifndef ONE_LAUNCH
#define ONE_LAUNCH 1
#endif

typedef unsigned short bf16_t;
typedef short bf16x8 __attribute__((ext_vector_type(8)));
typedef float f32x4 __attribute__((ext_vector_type(4)));
typedef float f32x2 __attribute__((ext_vector_type(2)));
typedef float f32x16 __attribute__((ext_vector_type(16)));
typedef unsigned u32x4 __attribute__((ext_vector_type(4)));
typedef unsigned u32x2 __attribute__((ext_vector_type(2)));
typedef __bf16 bfv2 __attribute__((ext_vector_type(2)));
#define DI __device__ __forceinline__
DI int launder_v(int v) { asm volatile("" : "+v"(v)); return v; }
#define TIDX launder_v((int)threadIdx.x)
#define VTID (TIDX & 255)
#define VHALF (TIDX >> 8)
#define VBID ((int)(blockIdx.x * 2) + (TIDX >> 8))
#define VNB ((int)(gridDim.x * 2))
#define MFMA32(a, b, c) __builtin_amdgcn_mfma_f32_32x32x16_bf16((a), (b), (c), 0, 0, 0)
#define MFMA16(a, b, c) __builtin_amdgcn_mfma_f32_16x16x32_bf16((a), (b), (c), 0, 0, 0)

constexpr float LOG2E = 1.4426950408889634f;
constexpr float EPSN = 1e-6f;

struct Params {
    const float *x_prompt, *x_sample, *cache_diff_k, *cache_diff_v, *cache_na_k, *cache_na_v, *cache_swa_k, *cache_swa_v, *c, *c_ctx;
    const float *mod_w, *mod_b, *norm_mix_pre, *norm_mix_post, *norm_mlp_pre, *norm_mlp_post, *w_in_even, *conv_w, *lq1, *lk1, *lq2, *lk2, *subln;
    const float *w_in_odd, *rpb, *sink, *w_out, *mlp_w1, *mlp_w2;
    float* out;
    char* ws;
};

constexpr size_t OFF_MOD = 0;
constexpr size_t OFF_BAR = 458752;
constexpr size_t OFF_WINE = 524288;
constexpr size_t OFF_WINO = OFF_WINE + 6291456;
constexpr size_t OFF_WOUT = OFF_WINO + 4718592;
constexpr size_t OFF_W1 = OFF_WOUT + 4194304;
constexpr size_t OFF_W2 = OFF_W1 + 16777216;
constexpr size_t OFF_CDK = OFF_W2 + 16777216;
constexpr size_t OFF_CDVT = OFF_CDK + 2097152;
constexpr size_t OFF_CNK = OFF_CDVT + 2097152;
constexpr size_t OFF_CNVT = OFF_CNK + 2097152;
constexpr size_t OFF_CSK = OFF_CNVT + 2097152;
constexpr size_t OFF_CSVT = OFF_CSK + 524288;
constexpr size_t OFF_HY = OFF_CSVT + 524288;
constexpr size_t OFF_BIG = OFF_HY + 67108864;
constexpr size_t OFF_STAT = OFF_BIG + 134217728;
constexpr size_t STAT_SET = 65536 + 65536 + 8192;
constexpr size_t WS_NEEDED = OFF_STAT + 4 * STAT_SET;
constexpr size_t BIG_VT_E = 83886080;
constexpr size_t BIG_VT_C = 54525952;
constexpr size_t BIG_VT_D = BIG_VT_C + 16777216;
constexpr size_t BIG_MIXIN = 100663296;
constexpr int LDE = 2560, LDO = 1664;
constexpr size_t OUT_DIFFK = 16777216, OUT_DIFFV = 20971520, OUT_NAK = 25165824, OUT_NAV = 29360128, OUT_SWAK = 33554432, OUT_SWAV = 34603008;

constexpr int LDS_HALF = 65536 + 4096;
constexpr int LDS_BYTES = 2 * LDS_HALF;

DI unsigned pk2(float a, float b) { f32x2 v = {a, b}; bfv2 r = __builtin_convertvector(v, bfv2); return __builtin_bit_cast(unsigned, r); }
DI float bflo(unsigned u) { return __uint_as_float(u << 16); }
DI float bfhi(unsigned u) { return __uint_as_float(u & 0xffff0000u); }
DI float wave_sum(float v) {
#pragma unroll
    for (int o = 1; o < 64; o <<= 1) v += __shfl_xor(v, o);
    return v;
}
DI int swz128(int r, int c) { return r * 128 + ((c ^ ((r >> 1) & 7)) << 4); }
DI int swz256(int r, int c) { return r * 256 + ((c ^ (r & 15)) << 4); }

DI void p0_mod_item(const Params& p, int item, char* lds) {
    const int li = item / 96, cb = item % 96;
    const int tid = VTID, lane = tid & 63, w = tid >> 6;
    const float* W = p.mod_w + (size_t)li * 1024 * 6144 + cb * 64 + lane;
    float acc[9];
#pragma unroll
    for (int v = 0; v < 9; ++v) acc[v] = 0.f;
    for (int kc = 0; kc < 4; ++kc) {
        const int kb = w * 256 + kc * 64;
        float s[9];
        { const float cv = p.c_ctx[kb + lane]; s[0] = cv / (1.f + __expf(-cv)); }
#pragma unroll
        for (int v = 1; v < 9; ++v) { const float cv = p.c[(v - 1) * 1024 + kb + lane]; s[v] = cv / (1.f + __expf(-cv)); }
#pragma unroll
        for (int kk = 0; kk < 64; ++kk) {
            const float wv = W[(size_t)(kb + kk) * 6144];
#pragma unroll
            for (int v = 0; v < 9; ++v) acc[v] += __int_as_float(__builtin_amdgcn_readlane(__float_as_int(s[v]), kk)) * wv;
        }
    }
    float* red = (float*)lds;
#pragma unroll
    for (int v = 0; v < 9; ++v) red[(w * 9 + v) * 64 + lane] = acc[v];
    __syncthreads();
    float* mod = (float*)(p.ws + OFF_MOD);
    for (int idx = tid; idx < 576; idx += 256) {
        const int v = idx >> 6, col = idx & 63;
        const float sum = red[(0 * 9 + v) * 64 + col] + red[(1 * 9 + v) * 64 + col] + red[(2 * 9 + v) * 64 + col] + red[(3 * 9 + v) * 64 + col];
        mod[(li * 9 + v) * 6144 + cb * 64 + col] = sum + p.mod_b[li * 6144 + cb * 64 + col];
    }
    __syncthreads();
}

DI void p0_transpose_tile(const float* __restrict__ in, bf16_t* __restrict__ out, int R, int C, int tr, int tc, char* lds) {
    const int tid = VTID;
    const int cl = (tid & 15) * 4, rl = (tid >> 4) * 2, sw = tid & 7;
#pragma unroll
    for (int i = 0; i < 2; ++i) {
        const int r = rl + 32 * i;
        const f32x4 a = *(const f32x4*)(in + (size_t)(tr * 64 + r) * C + tc * 64 + cl);
        const f32x4 b = *(const f32x4*)(in + (size_t)(tr * 64 + r + 1) * C + tc * 64 + cl);
#pragma unroll
        for (int j = 0; j < 4; ++j) *(unsigned*)(lds + (cl + j) * 128 + (((r >> 3) ^ sw) << 4) + (r & 7) * 2) = pk2(a[j], b[j]);
    }
    __syncthreads();
#pragma unroll
    for (int i = 0; i < 2; ++i) {
        const int idx = tid + 256 * i, c = idx >> 3, q = idx & 7;
        const u32x4 v = *(const u32x4*)(lds + c * 128 + ((q ^ ((c >> 2) & 7)) << 4));
        *(u32x4*)(out + (size_t)(tc * 64 + c) * R + tr * 64 + q * 8) = v;
    }
    __syncthreads();
}

DI void p0_kreorder(const float* __restrict__ in, bf16_t* __restrict__ out, int logH, int item) {
    const int tid = VTID, H = 1 << logH;
#pragma unroll
    for (int i = 0; i < 4; ++i) {
        const int f = item * 1024 + tid + 256 * i;
        const int d4 = f & 15, key = (f >> 4) & 255, hh = (f >> 12) & (H - 1), b = f >> (12 + logH);
        const f32x4 v = *(const f32x4*)(in + (size_t)f * 4);
        u32x2 o = {pk2(v[0], v[1]), pk2(v[2], v[3])};
        *(u32x2*)(out + ((size_t)(b * 256 + key) * H + hh) * 64 + d4 * 4) = o;
    }
}

struct TJob { const float* in; bf16_t* out; int R, C, tr, tc; };
constexpr int P0_TITEMS = 768 + 576 + 512 + 2048 + 2048 + 256 + 256 + 64;
DI TJob p0_decode(const Params& p, int item) {
    TJob j;
    if (item < 768) { j.in = p.w_in_even; j.out = (bf16_t*)(p.ws + OFF_WINE); j.R = 1024; j.C = 3072; }
    else if ((item -= 768) < 576) { j.in = p.w_in_odd; j.out = (bf16_t*)(p.ws + OFF_WINO); j.R = 1024; j.C = 2304; }
    else if ((item -= 576) < 512) { const int b = item >> 8; item &= 255; j.in = p.w_out + (size_t)b * 1048576; j.out = (bf16_t*)(p.ws + OFF_WOUT) + (size_t)b * 1048576; j.R = 1024; j.C = 1024; }
    else if ((item -= 512) < 2048) { const int b = item >> 10; item &= 1023; j.in = p.mlp_w1 + (size_t)b * 4194304; j.out = (bf16_t*)(p.ws + OFF_W1) + (size_t)b * 4194304; j.R = 1024; j.C = 4096; }
    else if ((item -= 2048) < 2048) { const int b = item >> 10; item &= 1023; j.in = p.mlp_w2 + (size_t)b * 4194304; j.out = (bf16_t*)(p.ws + OFF_W2) + (size_t)b * 4194304; j.R = 4096; j.C = 1024; }
    else if ((item -= 2048) < 256) { const int b = item >> 3; item &= 7; j.in = p.cache_diff_v + (size_t)b * 32768; j.out = (bf16_t*)(p.ws + OFF_CDVT) + (size_t)b * 32768; j.R = 256; j.C = 128; }
    else if ((item -= 256) < 256) { const int b = item >> 2; item &= 3; j.in = p.cache_na_v + (size_t)b * 16384; j.out = (bf16_t*)(p.ws + OFF_CNVT) + (size_t)b * 16384; j.R = 256; j.C = 64; }
    else { item -= 256; const int b = item >> 2; item &= 3; j.in = p.cache_swa_v + (size_t)b * 16384; j.out = (bf16_t*)(p.ws + OFF_CSVT) + (size_t)b * 16384; j.R = 256; j.C = 64; }
    const int ntc = j.C >> 6;
    j.tr = item / ntc; j.tc = item % ntc;
    return j;
}
DI void p0_tload(const TJob& j, int tid, f32x4 (&a)[2], f32x4 (&b)[2]) {
    const int cl = (tid & 15) * 4, rl = (tid >> 4) * 2;
#pragma unroll
    for (int i = 0; i < 2; ++i) {
        const int r = rl + 32 * i;
        a[i] = __builtin_nontemporal_load((const f32x4*)(j.in + (size_t)(j.tr * 64 + r) * j.C + j.tc * 64 + cl));
        b[i] = __builtin_nontemporal_load((const f32x4*)(j.in + (size_t)(j.tr * 64 + r + 1) * j.C + j.tc * 64 + cl));
    }
}
DI void p0_phase(const Params& p, int bid, int nb, char* lds) {
    if (bid < 192) p0_mod_item(p, bid, lds);
    const int tid = VTID;
    {
        const int cl = (tid & 15) * 4, rl = (tid >> 4) * 2, sw = tid & 7;
        int it = bid;
        TJob cur{}; f32x4 a[2], b[2];
        if (it < P0_TITEMS) { cur = p0_decode(p, it); p0_tload(cur, tid, a, b); }
        while (it < P0_TITEMS) {
            const int nx = it + nb;
            TJob nxt{}; f32x4 an[2], bn[2];
            if (nx < P0_TITEMS) { nxt = p0_decode(p, nx); p0_tload(nxt, tid, an, bn); }
#pragma unroll
            for (int i = 0; i < 2; ++i) {
                const int r = rl + 32 * i;
#pragma unroll
                for (int jj = 0; jj < 4; ++jj) *(unsigned*)(lds + (cl + jj) * 128 + (((r >> 3) ^ sw) << 4) + (r & 7) * 2) = pk2(a[i][jj], b[i][jj]);
            }
            __syncthreads();
#pragma unroll
            for (int i = 0; i < 2; ++i) {
                const int idx = tid + 256 * i, c = idx >> 3, q = idx & 7;
                const u32x4 v = *(const u32x4*)(lds + c * 128 + ((q ^ ((c >> 2) & 7)) << 4));
                *(u32x4*)(cur.out + (size_t)(cur.tc * 64 + c) * cur.R + cur.tr * 64 + q * 8) = v;
            }
            __syncthreads();
            cur = nxt; a[0] = an[0]; a[1] = an[1]; b[0] = bn[0]; b[1] = bn[1];
            it = nx;
        }
    }
    {
        f32x4* st4 = (f32x4*)(p.ws + OFF_STAT);
        const f32x4 z = {0.f, 0.f, 0.f, 0.f};
        for (int i = bid * 256 + tid; i < (int)(4 * STAT_SET / 16); i += nb * 256) st4[i] = z;
    }
    for (int it = bid; it < 576; it += nb) {
        if (it < 256) p0_kreorder(p.cache_diff_k, (bf16_t*)(p.ws + OFF_CDK), 3, it);
        else if (it < 512) p0_kreorder(p.cache_na_k, (bf16_t*)(p.ws + OFF_CNK), 3, it - 256);
        else p0_kreorder(p.cache_swa_k, (bf16_t*)(p.ws + OFF_CSK), 1, it - 512);
    }
}

DI void rowop_phase(const Params& p, bool hasY, bool xin_input, int g_off, const float* wpost, bool hasH, const float* wpre, int sc_off, int sh_off) {
    const int tix = TIDX, lane = tix & 63, gw = (int)(blockIdx.x * 8) + (tix >> 6), nw = VNB * 4;
    const float* mod = (const float*)(p.ws + OFF_MOD);
    f32x4 wpo[4], wpr[4];
#pragma unroll
    for (int i = 0; i < 4; ++i) { if (hasY) wpo[i] = *(const f32x4*)(wpost + lane * 4 + 256 * i); if (hasH) wpr[i] = *(const f32x4*)(wpre + lane * 4 + 256 * i); }
    for (int row0 = gw; row0 < 16384; row0 += 2 * nw) {
        f32x4 x[2][4], y[2][4];
#pragma unroll
        for (int r = 0; r < 2; ++r) {
            const int row = row0 + r * nw;
            const float* xin = xin_input ? (row < 8192 ? p.x_prompt + (size_t)row * 1024 : p.x_sample + (size_t)(row - 8192) * 1024) : p.out + (size_t)row * 1024;
            const float* yin = (const float*)(p.ws + OFF_HY + (size_t)row * 4096);
#pragma unroll
            for (int i = 0; i < 4; ++i) { x[r][i] = *(const f32x4*)(xin + lane * 4 + 256 * i); if (hasY) y[r][i] = *(const f32x4*)(yin + lane * 4 + 256 * i); }
        }
#pragma unroll
        for (int r = 0; r < 2; ++r) {
            const int row = row0 + r * nw;
            const int v = row < 8192 ? 0 : 1 + ((row - 8192) >> 10);
            char* hy = p.ws + OFF_HY + (size_t)row * 4096;
            if (hasY) {
                f32x4 g4[4];
#pragma unroll
                for (int i = 0; i < 4; ++i) g4[i] = *(const f32x4*)(mod + v * 6144 + g_off + lane * 4 + 256 * i);
                float ss = 0.f;
#pragma unroll
                for (int i = 0; i < 4; ++i) ss += y[r][i][0] * y[r][i][0] + y[r][i][1] * y[r][i][1] + y[r][i][2] * y[r][i][2] + y[r][i][3] * y[r][i][3];
                ss = wave_sum(ss);
                const float rs = rsqrtf(ss * (1.f / 1024.f) + EPSN);
#pragma unroll
                for (int i = 0; i < 4; ++i) {
                    x[r][i] += g4[i] * (y[r][i] * rs * wpo[i]);
                    *(f32x4*)(p.out + (size_t)row * 1024 + lane * 4 + 256 * i) = x[r][i];
                }
            }
            if (hasH) {
                f32x4 sc[4], sh[4];
#pragma unroll
                for (int i = 0; i < 4; ++i) { sc[i] = *(const f32x4*)(mod + v * 6144 + sc_off + lane * 4 + 256 * i); sh[i] = *(const f32x4*)(mod + v * 6144 + sh_off + lane * 4 + 256 * i); }
                float ss = 0.f;
#pragma unroll
                for (int i = 0; i < 4; ++i) ss += x[r][i][0] * x[r][i][0] + x[r][i][1] * x[r][i][1] + x[r][i][2] * x[r][i][2] + x[r][i][3] * x[r][i][3];
                ss = wave_sum(ss);
                const float rs = rsqrtf(ss * (1.f / 1024.f) + EPSN);
#pragma unroll
                for (int i = 0; i < 4; ++i) {
                    const f32x4 h = x[r][i] * rs * wpr[i] * (sc[i] + 1.f) + sh[i];
                    u32x2 o = {pk2(h[0], h[1]), pk2(h[2], h[3])};
                    *(u32x2*)((bf16_t*)hy + lane * 4 + 256 * i) = o;
                }
            }
        }
    }
}

namespace g8 {
constexpr int BK = 64, HALF = 128, HTB = HALF * BK * 2;
DI int lds_byte(int r, int c) { const int st = (r >> 4) * 2 + (c >> 5), rr = r & 15, cc = c & 31, ob = rr * 64 + cc * 2; return st * 1024 + (ob ^ (((ob >> 9) & 1) << 5)); }
DI void stage_rc(int b, int& R, int& C) { const int st = b / 1024, sb = b % 1024, swz = sb ^ (((sb >> 9) & 1) << 5); R = (st >> 1) * 16 + swz / 64; C = (st & 1) * 32 + (swz % 64) / 2; }
typedef __attribute__((address_space(3))) unsigned lds_u32;
typedef __attribute__((address_space(3))) unsigned char lds_u8;
typedef __attribute__((address_space(3))) bf16x8 lds_bf16x8;

}

enum { EPI_PE = 0, EPI_PO = 1, EPI_Y = 2, EPI_W1 = 3, EPI_YF = 4 };

struct FuseP { int from_input, hasH; float* xout; const float* g; const float* wpost; const float* wpre; const float* sc; const float* sh; float* ssY; float* ssX; unsigned* cnt; };
DI float ld_agent(const float* q) { return __hip_atomic_load(q, __ATOMIC_RELAXED, __HIP_MEMORY_SCOPE_AGENT); }
DI void panel_wait(unsigned* c, unsigned target) {
    asm volatile("s_waitcnt vmcnt(0)" ::: "memory");
    __syncthreads();
    if (threadIdx.x == 0) {
        __hip_atomic_fetch_add(c, 1u, __ATOMIC_RELAXED, __HIP_MEMORY_SCOPE_AGENT);
        unsigned sp = 0;
        while (__hip_atomic_load(c, __ATOMIC_RELAXED, __HIP_MEMORY_SCOPE_AGENT) < target) { __builtin_amdgcn_s_sleep(1); if (++sp > (1u << 22)) break; }
    }
    __syncthreads();
}
DI float dot4(const f32x4& a) { return a[0] * a[0] + a[1] * a[1] + a[2] * a[2] + a[3] * a[3]; }

DI void rope_s(f32x4 (&sub)[4][2], int R0, bool usecol, int fr, int fq) {
    asm volatile("" : "+s"(R0));
    float inv[4];
#pragma unroll
    for (int j = 0; j < 4; ++j) inv[j] = exp2f(-(float)(fq * 4 + j) * (13.287712379549449f / 16.f));
#pragma unroll
    for (int m = 0; m < 4; ++m) {
        __builtin_amdgcn_sched_barrier(0);
        const int tl = (R0 + m * 16 + fr - 8192) & 1023;
        const float pos = (float)(usecol ? (tl & 63) : (tl >> 6));
#pragma unroll
        for (int j = 0; j < 4; ++j) {
            float s, c;
            __sincosf(pos * inv[j], &s, &c);
            const float a = sub[m][0][j], b = sub[m][1][j];
            sub[m][0][j] = a * c - b * s; sub[m][1][j] = b * c + a * s;
        }
    }
}
DI void store_bf16_rows_s(const f32x4 (&sub)[4][2], bf16_t* base, int ld, int R0, int Cd0, int fr, int fq) {
#pragma unroll
    for (int m = 0; m < 4; ++m) {
        bf16_t* rp = base + (size_t)(R0 + m * 16 + fr) * ld + Cd0 + fq * 4;
#pragma unroll
        for (int n = 0; n < 2; ++n) { u32x2 o = {pk2(sub[m][n][0], sub[m][n][1]), pk2(sub[m][n][2], sub[m][n][3])}; *(u32x2*)(rp + n * 16) = o; }
    }
}
DI void store_f32_rows_s(const f32x4 (&sub)[4][2], float* ob, int ldo, int fr, int fq) {
#pragma unroll
    for (int m = 0; m < 4; ++m) {
        float* rp = ob + (size_t)(m * 16 + fr) * ldo + fq * 4;
#pragma unroll
        for (int n = 0; n < 2; ++n) *(f32x4*)(rp + n * 16) = sub[m][n];
    }
}
DI void store_vt_s(const f32x4 (&sub)[4][2], bf16_t* vt, int T, int t0, int fr, int fq) {
#pragma unroll
    for (int n = 0; n < 2; ++n) {
        bf16_t* rp = vt + (size_t)(n * 16 + fr) * T + t0 + fq * 4;
#pragma unroll
        for (int m = 0; m < 4; ++m) { u32x2 o = {pk2(sub[m][n][0], sub[m][n][1]), pk2(sub[m][n][2], sub[m][n][3])}; *(u32x2*)(rp + m * 16) = o; }
    }
}
DI void store_f32_ns_s(const f32x4 (&sub)[4][2], float* ob, int ldo, int fr, int fq) {
#pragma unroll
    for (int m = 0; m < 4; ++m)
#pragma unroll
        for (int j = 0; j < 4; ++j) {
            float* rp = ob + (size_t)(m * 16 + fq * 4 + j) * ldo + fr;
#pragma unroll
            for (int n = 0; n < 2; ++n) rp[n * 16] = sub[m][n][j];
        }
}

template <int EPI>
DI void tile_epilogue(const Params& p, f32x4 (&acc)[2][2][4][2], int pm, int pn, int vtm, const FuseP& fz) {
    const int tix = TIDX, wid = __builtin_amdgcn_readfirstlane(tix >> 6), lane = tix & 63, wr = wid >> 2, wc = wid & 3;
    const int brow = pm * 256, bcol = pn * 256;
    int fr = lane & 15, fq = lane >> 4;
    asm volatile("" : "+v"(fr), "+v"(fq));
    const bool latent = brow >= 8192;
    int b, tb, T;
    if (latent) { b = (brow - 8192) >> 10; tb = (brow - 8192) & 1023; T = 1024; } else { b = brow >> 8; tb = 0; T = 256; }
    bf16_t* big = (bf16_t*)(p.ws + OFF_BIG);
    if (EPI == EPI_YF) {
        const int v = latent ? 1 + b : 0;
        const int rbase = brow + wr * 64 + fr;
        const int cbase = bcol + wc * 32 + fq * 4;
        float rs[2][4];
#pragma unroll
        for (int ai = 0; ai < 2; ++ai)
#pragma unroll
            for (int m = 0; m < 4; ++m) {
                float sq = dot4(acc[ai][0][m][0]) + dot4(acc[ai][0][m][1]) + dot4(acc[ai][1][m][0]) + dot4(acc[ai][1][m][1]);
                sq += __shfl_xor(sq, 16); sq += __shfl_xor(sq, 32);
                if (fq == 0) { const float old = __hip_atomic_fetch_add(fz.ssY + rbase + ai * 128 + m * 16, sq, __ATOMIC_RELAXED, __HIP_MEMORY_SCOPE_AGENT); asm volatile("" :: "v"(old)); }
            }
        panel_wait(fz.cnt + pm * 32, 4u);
#pragma unroll
        for (int ai = 0; ai < 2; ++ai)
#pragma unroll
            for (int m = 0; m < 4; ++m) rs[ai][m] = rsqrtf(ld_agent(fz.ssY + rbase + ai * 128 + m * 16) * (1.f / 1024.f) + EPSN);
        const float* xin = latent ? p.x_sample - (size_t)8192 * 1024 : p.x_prompt;
        bf16_t* xb = (bf16_t*)(p.ws + OFF_HY) + 1024;
        float s2[2][4];
#pragma unroll
        for (int ai = 0; ai < 2; ++ai)
#pragma unroll
            for (int m = 0; m < 4; ++m) s2[ai][m] = 0.f;
#pragma unroll
        for (int bj = 0; bj < 2; ++bj)
#pragma unroll
            for (int n = 0; n < 2; ++n) {
                const int col = cbase + bj * 128 + n * 16;
                const f32x4 g4 = *(const f32x4*)(fz.g + v * 6144 + col), wp4 = *(const f32x4*)(fz.wpost + col);
#pragma unroll
                for (int ai = 0; ai < 2; ++ai)
#pragma unroll
                    for (int m = 0; m < 4; ++m) {
                        const size_t off = (size_t)(rbase + ai * 128 + m * 16) * 1024 + col;
                        f32x4 x4;
                        if (fz.from_input) x4 = *(const f32x4*)(xin + off);
                        else { const u32x2 xr = *(const u32x2*)(xb + 2 * off - col); x4 = (f32x4){bflo(xr[0]), bfhi(xr[0]), bflo(xr[1]), bfhi(xr[1])}; }
                        const f32x4 a = x4 + g4 * (acc[ai][bj][m][n] * rs[ai][m] * wp4);
                        acc[ai][bj][m][n] = a;
                        if (fz.hasH) { u32x2 xo = {pk2(a[0], a[1]), pk2(a[2], a[3])}; *(u32x2*)(xb + 2 * off - col) = xo; }
                        else *(f32x4*)(fz.xout + off) = a;
                        s2[ai][m] += dot4(a);
                    }
            }
        if (fz.hasH) {
#pragma unroll
            for (int ai = 0; ai < 2; ++ai)
#pragma unroll
                for (int m = 0; m < 4; ++m) {
                    float sq = s2[ai][m];
                    sq += __shfl_xor(sq, 16); sq += __shfl_xor(sq, 32);
                    if (fq == 0) { const float old = __hip_atomic_fetch_add(fz.ssX + rbase + ai * 128 + m * 16, sq, __ATOMIC_RELAXED, __HIP_MEMORY_SCOPE_AGENT); asm volatile("" :: "v"(old)); }
                }
            panel_wait(fz.cnt + pm * 32 + 16, 4u);
#pragma unroll
            for (int ai = 0; ai < 2; ++ai)
#pragma unroll
                for (int m = 0; m < 4; ++m) rs[ai][m] = rsqrtf(ld_agent(fz.ssX + rbase + ai * 128 + m * 16) * (1.f / 1024.f) + EPSN);
            bf16_t* hb = (bf16_t*)(p.ws + OFF_HY);
#pragma unroll
            for (int bj = 0; bj < 2; ++bj)
#pragma unroll
                for (int n = 0; n < 2; ++n) {
                    const int col = cbase + bj * 128 + n * 16;
                    const f32x4 wq4 = *(const f32x4*)(fz.wpre + col), sc4 = *(const f32x4*)(fz.sc + v * 6144 + col) + 1.f, sh4 = *(const f32x4*)(fz.sh + v * 6144 + col);
#pragma unroll
                    for (int ai = 0; ai < 2; ++ai)
#pragma unroll
                        for (int m = 0; m < 4; ++m) {
                            const f32x4 h = acc[ai][bj][m][n] * rs[ai][m] * wq4 * sc4 + sh4;
                            u32x2 o = {pk2(h[0], h[1]), pk2(h[2], h[3])};
                            *(u32x2*)(hb + (size_t)(rbase + ai * 128 + m * 16) * 2048 + col) = o;
                        }
                }
        }
        return;
    }
#pragma unroll
    for (int ai = 0; ai < 2; ++ai)
#pragma unroll
        for (int bj = 0; bj < 2; ++bj) {
            __builtin_amdgcn_sched_barrier(0);
            f32x4 (&sub)[4][2] = acc[ai][bj];
            const int R0 = brow + ai * 128 + wr * 64, t0 = tb + ai * 128 + wr * 64, C0 = bcol + bj * 128 + wc * 32;
            const bool ns = vtm == 1 || (vtm == 2 && bj == 1);
            if (EPI == EPI_PE) {
                if (ns) {
                    const int vc = C0 - 2560;
                    bf16_t* vt = (bf16_t*)(p.ws + OFF_BIG + BIG_VT_E) + (latent ? (size_t)4194304 + ((size_t)b * 512 + vc) * 1024 : ((size_t)b * 512 + vc) * 256);
                    store_vt_s(sub, vt, T, t0, fr, fq);
                    if (!latent) store_f32_ns_s(sub, p.out + OUT_DIFFV + ((size_t)(b * 4 + (vc >> 7)) * 256 + t0) * 128 + (vc & 127), 128, fr, fq);
                } else {
                    if (pn >= 6 && latent) rope_s(sub, R0, wc & 1, fr, fq);
                    store_bf16_rows_s(sub, big, LDE, R0, C0, fr, fq);
                    if (pn >= 8 && !latent) store_f32_rows_s(sub, p.out + OUT_DIFFK + ((size_t)(b * 8 + ((C0 - 2048) >> 6)) * 256 + t0) * 64 + ((C0 - 2048) & 63), 64, fr, fq);
                }
            } else if (EPI == EPI_PO) {
                if (ns) {
                    if (pn < 8) {
                        const int vc = C0 - 1024;
                        bf16_t* vt = (bf16_t*)(p.ws + OFF_BIG + BIG_VT_C) + (latent ? (size_t)4194304 + ((size_t)b * 512 + vc) * 1024 : ((size_t)b * 512 + vc) * 256);
                        store_vt_s(sub, vt, T, t0, fr, fq);
                        if (!latent) store_f32_ns_s(sub, p.out + OUT_NAV + ((size_t)(b * 8 + (vc >> 6)) * 256 + t0) * 64 + (vc & 63), 64, fr, fq);
                    } else {
                        const int vc = C0 - 2176;
                        bf16_t* vt = (bf16_t*)(p.ws + OFF_BIG + BIG_VT_D) + (latent ? (size_t)1048576 + ((size_t)b * 128 + vc) * 1024 : ((size_t)b * 128 + vc) * 256);
                        store_vt_s(sub, vt, T, t0, fr, fq);
                        if (!latent) store_f32_ns_s(sub, p.out + OUT_SWAV + ((size_t)(b * 2 + (vc >> 6)) * 256 + t0) * 64 + (vc & 63), 64, fr, fq);
                    }
                } else {
                    if (pn >= 6 && latent) rope_s(sub, R0, wc & 1, fr, fq);
                    store_bf16_rows_s(sub, big, LDO, R0, pn >= 6 ? C0 - 512 : C0, fr, fq);
                    if (!latent) {
                        if (pn == 2 || pn == 3) store_f32_rows_s(sub, p.out + OUT_NAK + ((size_t)(b * 8 + ((C0 - 512) >> 6)) * 256 + t0) * 64 + ((C0 - 512) & 63), 64, fr, fq);
                        else if (pn == 8) store_f32_rows_s(sub, p.out + OUT_SWAK + ((size_t)(b * 2 + ((C0 - 2048) >> 6)) * 256 + t0) * 64 + ((C0 - 2048) & 63), 64, fr, fq);
                    }
                }
            } else if (EPI == EPI_Y) {
                store_f32_rows_s(sub, (float*)(p.ws + OFF_HY) + (size_t)R0 * 1024 + C0, 1024, fr, fq);
            } else {
#pragma unroll
                for (int m = 0; m < 4; ++m)
#pragma unroll
                    for (int n = 0; n < 2; ++n)
#pragma unroll
                        for (int j = 0; j < 4; ++j) { const float v = fmaxf(sub[m][n][j], 0.f); sub[m][n][j] = v * v; }
                store_bf16_rows_s(sub, big, 4096, R0, C0, fr, fq);
            }
        }
}

template <int EPI>
DI void gemm_phase(const Params& p, const bf16_t* A, int lda, const bf16_t* Bt, int K, int NT_N, char* shm, const FuseP& fz = FuseP{}) {
    using namespace g8;
    const int xcd = blockIdx.x & 7, lb = blockIdx.x >> 3, nlb = gridDim.x >> 3, per_xcd = 8 * NT_N;
    if (lb >= per_xcd) return;
    const int tid = TIDX, wid = __builtin_amdgcn_readfirstlane(tid >> 6), lane = tid & 63, wr = wid >> 2, wc = wid & 3, fr = lane & 15, fq = lane >> 4;
    const int nt = K / BK;
    lds_u8* lds = (lds_u8*)shm;
    unsigned voffA[2], voffB[2];
#pragma unroll
    for (int _i = 0; _i < 2; ++_i) { int _r, _c; stage_rc(tid * 16 + _i * 8192, _r, _c); voffA[_i] = (unsigned)(_r * lda + _c) * 2u; voffB[_i] = (unsigned)(_r * K + _c) * 2u; }
    const size_t kstep = (size_t)BK * 2, hstepA = (size_t)HALF * lda * 2, hstepB = (size_t)HALF * K * 2;
    const unsigned ldsw = (unsigned)wid * 1024u;
    const int aoff = lds_byte(wr * 64 + fr, fq * 8), boff = lds_byte(wc * 32 + fr, fq * 8);
#define SA(b, h) (((b) * 2 + (h)) * HTB)
#define SB(b, h) ((4 + (b) * 2 + (h)) * HTB)
#define STAGE(bufoff, gbase, voff) do { _Pragma("unroll") for (int _i = 0; _i < 2; ++_i) \
      __builtin_amdgcn_global_load_lds((const unsigned*)((gbase) + (voff)[_i]), (lds_u32*)(lds + (bufoff) + ldsw + _i * 8192), 16, 0, 0); } while (0)
#define LDA(dst, b, h) _Pragma("unroll") for (int m = 0; m < 4; ++m) _Pragma("unroll") for (int k = 0; k < 2; ++k) \
    dst[m][k] = *(const lds_bf16x8*)(lds + SA(b, h) + aoff + m * 2048 + k * 1024)
#define LDB(dst, b, h) _Pragma("unroll") for (int n = 0; n < 2; ++n) _Pragma("unroll") for (int k = 0; k < 2; ++k) \
    dst[n][k] = *(const lds_bf16x8*)(lds + SB(b, h) + boff + n * 2048 + k * 1024)
#define MMA(VT, ai, bj, At_, Bt_) do { __builtin_amdgcn_s_setprio(1); \
    _Pragma("unroll") for (int m = 0; m < 4; ++m) _Pragma("unroll") for (int n = 0; n < 2; ++n) _Pragma("unroll") for (int k = 0; k < 2; ++k) \
      acc[ai][bj][m][n] = ((VT) == 1 || ((VT) == 2 && (bj) == 1)) ? MFMA16(At_[m][k], Bt_[n][k], acc[ai][bj][m][n]) : MFMA16(Bt_[n][k], At_[m][k], acc[ai][bj][m][n]); \
    __builtin_amdgcn_s_setprio(0); } while (0)
#define WAIT_V(n) asm volatile("s_waitcnt vmcnt(" #n ")" ::: "memory")
#define WAIT_L(n) asm volatile("s_waitcnt lgkmcnt(" #n ")" ::: "memory")
#define BAR __builtin_amdgcn_s_barrier()
#define SCHED __builtin_amdgcn_sched_barrier(0)
#define TLOOP(VT) for (int t = 0; t < nt; t += 2) { \
        const bool last = (t == nt - 2); \
        const char* a1 = cA + (size_t)(t + 1) * kstep; \
        const char* a2 = last ? nA : cA + (size_t)(t + 2) * kstep; const char* b2 = last ? nB : cB + (size_t)(t + 2) * kstep; \
        const char* a3 = a2 + kstep; const char* b3 = b2 + kstep; \
        LDB(B0, 0, 0); LDB(B1, 0, 1); SCHED; LDA(At, 0, 0); STAGE(SA(1, 1), a1 + hstepA, voffA); \
        WAIT_V(8); WAIT_L(0); BAR; MMA(VT, 0, 0, At, B0); MMA(VT, 0, 1, At, B1); BAR; SCHED; \
        LDA(At, 0, 1); STAGE(SB(0, 0), b2, voffB); STAGE(SB(0, 1), b2 + hstepB, voffB); STAGE(SA(0, 0), a2, voffA); \
        WAIT_V(8); WAIT_L(0); BAR; MMA(VT, 1, 0, At, B0); MMA(VT, 1, 1, At, B1); BAR; SCHED; \
        LDB(B0, 1, 0); LDB(B1, 1, 1); SCHED; LDA(At, 1, 0); STAGE(SA(0, 1), a2 + hstepA, voffA); \
        WAIT_V(8); WAIT_L(0); BAR; MMA(VT, 0, 0, At, B0); MMA(VT, 0, 1, At, B1); BAR; SCHED; \
        LDA(At, 1, 1); STAGE(SB(1, 0), b3, voffB); STAGE(SB(1, 1), b3 + hstepB, voffB); STAGE(SA(1, 0), a3, voffA); \
        WAIT_V(8); WAIT_L(0); BAR; MMA(VT, 1, 0, At, B0); MMA(VT, 1, 1, At, B1); BAR; SCHED; \
    }
    int lt = lb, pm = xcd * 8 + (lt & 7), pn = lt >> 3;
    f32x4 acc[2][2][4][2];
#pragma unroll
    for (int a = 0; a < 2; ++a)
#pragma unroll
        for (int b = 0; b < 2; ++b)
#pragma unroll
            for (int m = 0; m < 4; ++m)
#pragma unroll
                for (int n = 0; n < 2; ++n) acc[a][b][m][n] = (f32x4){0.f, 0.f, 0.f, 0.f};
    bf16x8 At[4][2], B0[2][2], B1[2][2];
    const char* cA = (const char*)A + (size_t)pm * 2 * hstepA;
    const char* cB = (const char*)Bt + (size_t)pn * 2 * hstepB;
    WAIT_V(0);
    STAGE(SB(0, 0), cB, voffB); STAGE(SB(0, 1), cB + hstepB, voffB); STAGE(SA(0, 0), cA, voffA); STAGE(SA(0, 1), cA + hstepA, voffA);
    if (wr == 1) BAR;
    WAIT_V(2); BAR;
    STAGE(SB(1, 0), cB + kstep, voffB); STAGE(SA(1, 0), cA + kstep, voffA); STAGE(SB(1, 1), cB + hstepB + kstep, voffB);
    WAIT_V(6); BAR;
    for (;;) {
        const int ltn = lt + nlb;
        const bool has_next = ltn < per_xcd;
        const int pmn = xcd * 8 + (ltn & 7), pnn = ltn >> 3;
        const char* nA = has_next ? (const char*)A + (size_t)pmn * 2 * hstepA : cA;
        const char* nB = has_next ? (const char*)Bt + (size_t)pnn * 2 * hstepB : cB;
        int vtm = 0;
        if (EPI == EPI_PE) vtm = pn >= 10 ? 1 : 0;
        if (EPI == EPI_PO) vtm = (pn == 4 || pn == 5) ? 1 : (pn == 8 ? 2 : 0);
        if ((EPI == EPI_PE || EPI == EPI_PO) && vtm == 1) { TLOOP(1) }
        else if (EPI == EPI_PO && vtm == 2) { TLOOP(2) }
        else { TLOOP(0) }
        if (wr == 0) BAR;
        if (EPI != EPI_YF) tile_epilogue<EPI>(p, acc, pm, pn, vtm, fz);
        if (!has_next) break;
#pragma unroll
        for (int a = 0; a < 2; ++a)
#pragma unroll
            for (int b = 0; b < 2; ++b)
#pragma unroll
                for (int m = 0; m < 4; ++m)
#pragma unroll
                    for (int n = 0; n < 2; ++n) acc[a][b][m][n] = (f32x4){0.f, 0.f, 0.f, 0.f};
        lt = ltn; pm = pmn; pn = pnn; cA = nA; cB = nB;
        if (wr == 1) BAR;
    }
    WAIT_V(0);
    BAR;
    if (EPI == EPI_YF) tile_epilogue<EPI>(p, acc, pm, pn, 0, fz);
#undef SA
#undef SB
#undef STAGE
#undef LDA
#undef LDB
#undef MMA
#undef WAIT_V
#undef WAIT_L
#undef BAR
#undef SCHED
#undef TLOOP
}

struct ASeg { const bf16_t* K; const bf16_t* Vt; int ldk, ldv, ntiles; };
struct MaskP { int on, a, b, c; const float* tab; };

template <int KW, int VR, int NB, int MODE>
DI void attn_core(const ASeg& s0, const ASeg& s1, const bf16x8 (&qf)[4], int kchunk0, int vrow0, float scale_l2, float& m, float& l, f32x16 (&O)[NB], char* lds, const MaskP& mp) {
    constexpr int KC = KW / 8, NKL = 64 * KC / 256, NVL = VR * 8 / 256;
    const int tid = VTID, lane = tid & 63, p32 = lane & 31, h = lane >> 5;
    const int krow = (p32 & 19) | ((p32 & 4) << 1) | ((p32 & 8) >> 1);
    const int n0 = s0.ntiles, nt = s0.ntiles + s1.ntiles;
    u32x4 rk[NKL], rv[NVL];
#define ATT_LOAD(t_)                                                                                                         \
    {                                                                                                                        \
        const bool f_ = (t_) < n0; const int tt_ = f_ ? (t_) : (t_) - n0;                                                     \
        const bf16_t* Kp_ = (f_ ? s0.K : s1.K); const int ldk_ = f_ ? s0.ldk : s1.ldk;                                        \
        const bf16_t* Vp_ = (f_ ? s0.Vt : s1.Vt); const int ldv_ = f_ ? s0.ldv : s1.ldv;                                      \
        _Pragma("unroll") for (int i = 0; i < NKL; ++i) { const int id = tid + 256 * i, r = id / KC, c = id % KC; rk[i] = *(const u32x4*)(Kp_ + (size_t)(tt_ * 64 + r) * ldk_ + c * 8); } \
        _Pragma("unroll") for (int i = 0; i < NVL; ++i) { const int id = tid + 256 * i, r = id >> 3, c = id & 7; rv[i] = *(const u32x4*)(Vp_ + (size_t)r * ldv_ + tt_ * 64 + c * 8); }       \
    }
#define ATT_STORE(b_)                                                                                                        \
    {                                                                                                                        \
        char* kb_ = lds + (b_) * 32768; char* vb_ = kb_ + 16384;                                                              \
        _Pragma("unroll") for (int i = 0; i < NKL; ++i) { const int id = tid + 256 * i, r = id / KC, c = id % KC; *(u32x4*)(kb_ + (KW == 128 ? swz256(r, c) : swz128(r, c))) = rk[i]; } \
        _Pragma("unroll") for (int i = 0; i < NVL; ++i) { const int id = tid + 256 * i, r = id >> 3, c = id & 7; *(u32x4*)(vb_ + swz128(r, c)) = rv[i]; }                               \
    }
    ATT_LOAD(0);
    ATT_STORE(0);
    __syncthreads();
    for (int t = 0; t < nt; ++t) {
        const bool more = t + 1 < nt;
        if (more) ATT_LOAD(t + 1);
        const char* kb = lds + (t & 1) * 32768;
        const char* vb = kb + 16384;
        f32x16 S[2];
#pragma unroll
        for (int kh = 0; kh < 2; ++kh) {
#pragma unroll
            for (int i = 0; i < 16; ++i) S[kh][i] = 0.f;
            const int row = krow + 32 * kh;
#pragma unroll
            for (int s = 0; s < 4; ++s) {
                const int c = kchunk0 + 2 * s + h;
                const bf16x8 kf = *(const bf16x8*)(kb + (KW == 128 ? swz256(row, c) : swz128(row, c)));
                S[kh] = MFMA32(kf, qf[s], S[kh]);
            }
        }
        const bool msk = (MODE != 0) && mp.on && t < n0;
        float mx = -1e30f;
        if (MODE == 1 && msk) {
            int cq = mp.c + p32;
            int h8 = 8 * h;
            asm volatile("" : "+v"(cq), "+v"(h8));
            const int cs = min(max(cq - 8, 0), 48);
            const float* tab = mp.tab + (mp.b + t - mp.a + 7) * 31;
#pragma unroll
            for (int kh = 0; kh < 2; ++kh)
#pragma unroll
                for (int i = 0; i < 16; ++i) {
                    const int kc = 32 * kh + 16 * (i >> 3) + h8 + (i & 7);
                    const bool ok = (unsigned)(kc - cs) < 16u;
                    const int dc = min(max(kc - cq + 15, 0), 30);
                    const float sv = ok ? S[kh][i] * scale_l2 + tab[dc] : -1e30f;
                    S[kh][i] = sv; mx = fmaxf(mx, sv);
                }
        } else if (MODE == 2 && msk) {
            int qp = mp.a + p32 - 8 * h;
            asm volatile("" : "+v"(qp));
            const int k0 = mp.b + t * 64;
#pragma unroll
            for (int kh = 0; kh < 2; ++kh)
#pragma unroll
                for (int i = 0; i < 16; ++i) {
                    const int d = qp - (k0 + 32 * kh + 16 * (i >> 3) + (i & 7));
                    const bool ok = d <= 128 && d >= -128;
                    const float sv = ok ? S[kh][i] * scale_l2 : -1e30f;
                    S[kh][i] = sv; mx = fmaxf(mx, sv);
                }
        } else {
#pragma unroll
            for (int kh = 0; kh < 2; ++kh)
#pragma unroll
                for (int i = 0; i < 16; ++i) { const float sv = S[kh][i] * scale_l2; S[kh][i] = sv; mx = fmaxf(mx, sv); }
        }
        mx = fmaxf(mx, __shfl_xor(mx, 32));
        const float mn = fmaxf(m, mx);
        const float alpha = __builtin_amdgcn_exp2f(m - mn);
        m = mn;
        float ls = 0.f;
#pragma unroll
        for (int kh = 0; kh < 2; ++kh)
#pragma unroll
            for (int i = 0; i < 16; ++i) { const float pv = __builtin_amdgcn_exp2f(S[kh][i] - mn); S[kh][i] = pv; ls += pv; }
        l = l * alpha + ls;
#pragma unroll
        for (int blk = 0; blk < NB; ++blk)
#pragma unroll
            for (int i = 0; i < 16; ++i) O[blk][i] *= alpha;
#pragma unroll
        for (int kh = 0; kh < 2; ++kh)
#pragma unroll
            for (int s2 = 0; s2 < 2; ++s2) {
                u32x4 pp = {pk2(S[kh][8 * s2 + 0], S[kh][8 * s2 + 1]), pk2(S[kh][8 * s2 + 2], S[kh][8 * s2 + 3]), pk2(S[kh][8 * s2 + 4], S[kh][8 * s2 + 5]), pk2(S[kh][8 * s2 + 6], S[kh][8 * s2 + 7])};
                const bf16x8 pb = __builtin_bit_cast(bf16x8, pp);
                const int c = 4 * kh + 2 * s2 + h;
#pragma unroll
                for (int blk = 0; blk < NB; ++blk) {
                    const bf16x8 vf = *(const bf16x8*)(vb + swz128(vrow0 + blk * 32 + p32, c));
                    O[blk] = MFMA32(vf, pb, O[blk]);
                }
            }
        if (more) ATT_STORE((t + 1) & 1);
        __syncthreads();
    }
    l += __shfl_xor(l, 32);
#undef ATT_LOAD
#undef ATT_STORE
}

DI void load_q(bf16x8 (&qf)[4], const bf16_t* qrow, int h) {
#pragma unroll
    for (int s = 0; s < 4; ++s) qf[s] = *(const bf16x8*)(qrow + 16 * s + 8 * h);
}

DI void attn_diff_item(const Params& p, int item, char* lds) {
    const int tid = VTID, lane = tid & 63, w = tid >> 6, p32 = lane & 31, h = lane >> 5, stream = w & 1, qh = w >> 1;
    const bf16_t* proj = (const bf16_t*)(p.ws + OFF_BIG);
    const bf16_t* vte = (const bf16_t*)(p.ws + OFF_BIG + BIG_VT_E);
    bf16_t* mix = (bf16_t*)(p.ws + OFF_BIG + BIG_MIXIN);
    int b, hd, qb, rowbase; ASeg s0, s1;
    if (item < 512) {
        b = item >> 6; hd = (item >> 4) & 3; qb = item & 15; rowbase = 8192 + b * 1024;
        s0 = {proj + (size_t)rowbase * LDE + 2048 + hd * 128, vte + 4194304 + ((size_t)b * 512 + hd * 128) * 1024, LDE, 1024, 16};
        s1 = {(const bf16_t*)(p.ws + OFF_CDK) + (size_t)b * 256 * 512 + hd * 128, (const bf16_t*)(p.ws + OFF_CDVT) + (size_t)(b * 4 + hd) * 128 * 256, 512, 256, 4};
    } else {
        const int it = item - 512;
        b = it >> 4; hd = (it >> 2) & 3; qb = it & 3; rowbase = b * 256;
        s0 = {proj + (size_t)rowbase * LDE + 2048 + hd * 128, vte + ((size_t)b * 512 + hd * 128) * 256, LDE, 256, 4};
        s1 = s0; s1.ntiles = 0;
    }
    const int R = rowbase + qb * 64 + qh * 32 + p32;
    bf16x8 qf[4];
    load_q(qf, proj + (size_t)R * LDE + 1536 + hd * 128 + stream * 64, h);
    f32x16 O[4];
#pragma unroll
    for (int blk = 0; blk < 4; ++blk)
#pragma unroll
        for (int i = 0; i < 16; ++i) O[blk][i] = 0.f;
    float m = -1e30f, l = 0.f;
    MaskP mp = {0, 0, 0, 0, nullptr};
    attn_core<128, 128, 4, 0>(s0, s1, qf, stream * 8, 0, 0.125f * LOG2E, m, l, O, lds, mp);
    const float il = 1.f / l;
    const float d1 = wave_sum(p.lq1[lane] * p.lk1[lane]), d2 = wave_sum(p.lq2[lane] * p.lk2[lane]);
    const float lam_init = 0.2f;
    const float lam = __expf(d1) - __expf(d2) + lam_init;
    float* xb = (float*)(lds + qh * 16384);
    if (stream == 1) {
#pragma unroll
        for (int blk = 0; blk < 4; ++blk)
#pragma unroll
            for (int i = 0; i < 16; ++i) { const int dv = blk * 32 + 8 * (i >> 2) + 4 * h + (i & 3); xb[dv * 32 + p32] = O[blk][i] * il; }
    }
    __syncthreads();
    if (stream == 0) {
        float ss = 0.f;
#pragma unroll
        for (int blk = 0; blk < 4; ++blk)
#pragma unroll
            for (int i = 0; i < 16; ++i) { const int dv = blk * 32 + 8 * (i >> 2) + 4 * h + (i & 3); const float o = O[blk][i] * il - lam * xb[dv * 32 + p32]; O[blk][i] = o; ss += o * o; }
        ss += __shfl_xor(ss, 32);
        const float rs = rsqrtf(ss * (1.f / 128.f) + EPSN) * (1.f - lam_init);
        bf16_t* op = mix + (size_t)R * 1024 + 512 + hd * 128;
#pragma unroll
        for (int blk = 0; blk < 4; ++blk)
#pragma unroll
            for (int g = 0; g < 4; ++g) {
                const int dv = blk * 32 + 8 * g + 4 * h;
                const f32x4 sl = *(const f32x4*)(p.subln + dv);
                u32x2 o = {pk2(O[blk][4 * g] * rs * sl[0], O[blk][4 * g + 1] * rs * sl[1]), pk2(O[blk][4 * g + 2] * rs * sl[2], O[blk][4 * g + 3] * rs * sl[3])};
                *(u32x2*)(op + dv) = o;
            }
    }
    __syncthreads();
}

DI void attn_c_item(const Params& p, int item, char* lds) {
    const int tid = VTID, lane = tid & 63, w = tid >> 6, p32 = lane & 31, h = lane >> 5, stream = w & 1, qh = w >> 1;
    const bf16_t* proj = (const bf16_t*)(p.ws + OFF_BIG);
    const bf16_t* vtc = (const bf16_t*)(p.ws + OFF_BIG + BIG_VT_C);
    bf16_t* mix = (bf16_t*)(p.ws + OFF_BIG + BIG_MIXIN);
    int b, hp, qb, rowbase; ASeg s0, s1; MaskP mp = {0, 0, 0, 0, nullptr};
    float* tab = (float*)(lds + 65536);
    if (item < 512) {
        b = item >> 6; hp = (item >> 4) & 3; qb = item & 15; rowbase = 8192 + b * 1024;
        const int rstart = min(max(qb - 4, 0), 8);
        s0 = {proj + (size_t)(rowbase + rstart * 64) * LDO + 512 + hp * 128, vtc + 4194304 + ((size_t)b * 512 + hp * 128) * 1024 + rstart * 64, LDO, 1024, 8};
        s1 = {(const bf16_t*)(p.ws + OFF_CNK) + (size_t)b * 256 * 512 + hp * 128, (const bf16_t*)(p.ws + OFF_CNVT) + ((size_t)b * 512 + hp * 128) * 256, 512, 256, 4};
        for (int idx = tid; idx < 930; idx += 256) tab[idx] = p.rpb[hp * 930 + idx] * LOG2E;
        mp = {1, qb, rstart, qh * 32, tab + stream * 465};
    } else {
        const int it = item - 512;
        b = it >> 4; hp = (it >> 2) & 3; qb = it & 3; rowbase = b * 256;
        s0 = {proj + (size_t)rowbase * LDO + 512 + hp * 128, vtc + ((size_t)b * 512 + hp * 128) * 256, LDO, 256, 4};
        s1 = s0; s1.ntiles = 0;
    }
    const int R = rowbase + qb * 64 + qh * 32 + p32;
    const int head = hp * 2 + stream;
    bf16x8 qf[4];
    load_q(qf, proj + (size_t)R * LDO + head * 64, h);
    f32x16 O[2];
#pragma unroll
    for (int blk = 0; blk < 2; ++blk)
#pragma unroll
        for (int i = 0; i < 16; ++i) O[blk][i] = 0.f;
    float m = -1e30f, l = 0.f;
    attn_core<128, 128, 2, 1>(s0, s1, qf, stream * 8, stream * 64, 0.125f * LOG2E, m, l, O, lds, mp);
    const float il = 1.f / l;
    bf16_t* op = mix + (size_t)R * 1024 + head * 64;
#pragma unroll
    for (int blk = 0; blk < 2; ++blk)
#pragma unroll
        for (int g = 0; g < 4; ++g) {
            const int dv = blk * 32 + 8 * g + 4 * h;
            u32x2 o = {pk2(O[blk][4 * g] * il, O[blk][4 * g + 1] * il), pk2(O[blk][4 * g + 2] * il, O[blk][4 * g + 3] * il)};
            *(u32x2*)(op + dv) = o;
        }
}

DI void attn_d_item(const Params& p, int item, char* lds) {
    const int tid = VTID, lane = tid & 63, w = tid >> 6, p32 = lane & 31, h = lane >> 5;
    const bf16_t* proj = (const bf16_t*)(p.ws + OFF_BIG);
    const bf16_t* vtd = (const bf16_t*)(p.ws + OFF_BIG + BIG_VT_D);
    bf16_t* mix = (bf16_t*)(p.ws + OFF_BIG + BIG_MIXIN);
    int b, g, qb, rowbase; ASeg s0, s1; MaskP mp = {0, 0, 0, 0, nullptr};
    if (item < 512) {
        b = item >> 6; g = (item >> 5) & 1; qb = item & 31; rowbase = 8192 + b * 1024;
        const int q0 = qb * 32;
        const int tlo = max(q0 - 128, 0) >> 6, thi = min(q0 + 159, 1023) >> 6;
        s0 = {proj + (size_t)(rowbase + tlo * 64) * LDO + 1536 + g * 64, vtd + 1048576 + ((size_t)b * 128 + g * 64) * 1024 + tlo * 64, LDO, 1024, thi - tlo + 1};
        s1 = {(const bf16_t*)(p.ws + OFF_CSK) + (size_t)b * 256 * 128 + g * 64, (const bf16_t*)(p.ws + OFF_CSVT) + ((size_t)b * 128 + g * 64) * 256, 128, 256, 4};
        mp = {1, q0, tlo * 64, 0, nullptr};
    } else {
        const int it = item - 512;
        b = it >> 4; g = (it >> 3) & 1; qb = it & 7; rowbase = b * 256;
        s0 = {proj + (size_t)rowbase * LDO + 1536 + g * 64, vtd + ((size_t)b * 128 + g * 64) * 256, LDO, 256, 4};
        s1 = s0; s1.ntiles = 0;
    }
    const int R = rowbase + qb * 32 + p32;
    const int hq = g * 4 + w;
    bf16x8 qf[4];
    load_q(qf, proj + (size_t)R * LDO + 1024 + hq * 64, h);
    f32x16 O[2];
#pragma unroll
    for (int blk = 0; blk < 2; ++blk)
#pragma unroll
        for (int i = 0; i < 16; ++i) O[blk][i] = 0.f;
    float m = p.sink[hq] * LOG2E, l = h == 0 ? 1.f : 0.f;
    attn_core<64, 64, 2, 2>(s0, s1, qf, 0, 0, 0.125f * LOG2E, m, l, O, lds, mp);
    const float il = 1.f / l;
    bf16_t* op = mix + (size_t)R * 1024 + 512 + hq * 64;
#pragma unroll
    for (int blk = 0; blk < 2; ++blk)
#pragma unroll
        for (int gg = 0; gg < 4; ++gg) {
            const int dv = blk * 32 + 8 * gg + 4 * h;
            u32x2 o = {pk2(O[blk][4 * gg] * il, O[blk][4 * gg + 1] * il), pk2(O[blk][4 * gg + 2] * il, O[blk][4 * gg + 3] * il)};
            *(u32x2*)(op + dv) = o;
        }
}

DI void conv_item(const Params& p, int item) {
    const int tid = VTID;
    const bf16_t* proj = (const bf16_t*)(p.ws + OFF_BIG);
    bf16_t* mix = (bf16_t*)(p.ws + OFF_BIG + BIG_MIXIN);
#pragma unroll 2
    for (int i = 0; i < 8; ++i) {
        const int idx = tid + 256 * i, tl = idx >> 6, ch = (idx & 63) * 8;
        const int R = item * 32 + tl;
        int t, T;
        if (R < 8192) { t = R & 255; T = 256; } else { t = (R - 8192) & 1023; T = 1024; }
        const bf16_t* rp = proj + (size_t)R * LDE + ch;
        const u32x4 ab = *(const u32x4*)(rp);
        float accv[8];
#pragma unroll
        for (int e = 0; e < 8; ++e) accv[e] = 0.f;
#pragma unroll
        for (int j = 0; j < 3; ++j) {
            const int tt = t + j - 1;
            if (tt >= 0 && tt < T) {
                const u32x4 ac = *(const u32x4*)(rp + (ptrdiff_t)(j - 1) * LDE + 512);
                const u32x4 ax = *(const u32x4*)(rp + (ptrdiff_t)(j - 1) * LDE + 1024);
                const f32x4 w0 = *(const f32x4*)(p.conv_w + j * 512 + ch), w1 = *(const f32x4*)(p.conv_w + j * 512 + ch + 4);
#pragma unroll
                for (int e = 0; e < 4; ++e) {
                    accv[2 * e] += bflo(ac[e]) * bflo(ax[e]) * (e < 2 ? w0[2 * e] : w1[2 * e - 4]);
                    accv[2 * e + 1] += bfhi(ac[e]) * bfhi(ax[e]) * (e < 2 ? w0[2 * e + 1] : w1[2 * e - 3]);
                }
            }
        }
        u32x4 o;
#pragma unroll
        for (int e = 0; e < 4; ++e) o[e] = pk2(bflo(ab[e]) * accv[2 * e], bfhi(ab[e]) * accv[2 * e + 1]);
        *(u32x4*)(mix + (size_t)R * 1024 + ch) = o;
    }
}


#define XB_TMO      128
#define XB_XCNT(j)  (256  + 64 * (j))
#define XB_XSUB(j)  (1280 + 64 * (j))
#define XB_XGEN(j)  (2304 + 64 * (j))
#define XB_TOP      3328
#define XB_TOPGEN   3392
#define XCD_BAR_WORDS 3456
#define XB_SPIN_CAP (1u << 22)
#define LAS __attribute__((address_space(3)))
DI unsigned xb_ld(unsigned* p) { return __hip_atomic_load(p, __ATOMIC_RELAXED, __HIP_MEMORY_SCOPE_AGENT); }
DI unsigned xb_add(unsigned* p, unsigned v) { return __hip_atomic_fetch_add(p, v, __ATOMIC_RELAXED, __HIP_MEMORY_SCOPE_AGENT); }
DI unsigned xb_xcc_id() { return (unsigned)__builtin_amdgcn_s_getreg((3 << 11) | 20) & 0xFu; }
#define XB_SPIN(cond, bar) do { unsigned _sp = 0; while (cond) { __builtin_amdgcn_s_sleep(1); \
    if ((++_sp & 255u) == 0u) { if (xb_ld(&(bar)[XB_TMO])) break; if (_sp > XB_SPIN_CAP) { atomicAdd(&(bar)[XB_TMO], 1u); break; } } } } while (0)
struct XcdBarrier { unsigned* bar; unsigned x; volatile LAS unsigned* st; };
DI XcdBarrier xcd_barrier_post(unsigned* bar, volatile LAS unsigned* st) {
    XcdBarrier b; b.bar = bar; b.x = xb_xcc_id(); b.st = st;
    if (threadIdx.x == 0) (void)xb_add(&bar[XB_XCNT(b.x)], 1u);
    return b;
}
DI void xcd_barrier_complete(unsigned* bar, unsigned x, unsigned& nloc, unsigned& nx) {
    const unsigned G = gridDim.x * gridDim.y * gridDim.z;
    unsigned sum, cnt, mine, sp = 0u;
    for (;;) {
        sum = 0u; cnt = 0u; mine = 0u;
#pragma unroll
        for (unsigned j = 0; j < 16; ++j) { const unsigned c = xb_ld(&bar[XB_XCNT(j)]); sum += c; cnt += (c > 0u) ? 1u : 0u; mine = (j == x) ? c : mine; }
        if (sum == G) break;
        __builtin_amdgcn_s_sleep(1);
        if ((++sp & 255u) == 0u) { if (xb_ld(&bar[XB_TMO])) break; if (sp > XB_SPIN_CAP) { atomicAdd(&bar[XB_TMO], 1u); break; } }
    }
    nloc = mine > 0u ? mine : 1u; nx = cnt > 0u ? cnt : 1u;
}
DI void xcd_barrier(const XcdBarrier& b) {
    asm volatile("s_waitcnt vmcnt(0)" ::: "memory");
    __syncthreads();
    if (threadIdx.x == 0) {
        unsigned* bar = b.bar;
        __builtin_amdgcn_s_waitcnt(0);
        unsigned nloc = b.st[0], nx = b.st[1];
        if (nloc == 0u) { xcd_barrier_complete(bar, b.x, nloc, nx); b.st[0] = nloc; b.st[1] = nx; }
        const unsigned old = xb_add(&bar[XB_XSUB(b.x)], 1u);
        const unsigned gen = old / nloc;
        if (old + 1u == (gen + 1u) * nloc) {
            __builtin_amdgcn_fence(__ATOMIC_RELEASE, "agent");
            asm volatile("s_waitcnt vmcnt(0)" ::: "memory");
            const unsigned og = xb_add(&bar[XB_TOP], 1u);
            const unsigned tg = og / nx;
            if (og + 1u == (tg + 1u) * nx) xb_add(&bar[XB_TOPGEN], 1u);
            else XB_SPIN(xb_ld(&bar[XB_TOPGEN]) == tg, bar);
            __builtin_amdgcn_fence(__ATOMIC_ACQUIRE, "agent");
            xb_add(&bar[XB_XGEN(b.x)], 1u);
            asm volatile("s_waitcnt vmcnt(0)" ::: "memory");
        } else {
            XB_SPIN(xb_ld(&bar[XB_XGEN(b.x)]) == gen, bar);
            __builtin_amdgcn_fence(__ATOMIC_ACQUIRE, "agent");
            asm volatile("s_waitcnt vmcnt(0)" ::: "memory");
        }
    }
    __syncthreads();
}

constexpr int N_PHASES = 12;
DI void run_phase(const Params& p, int ph, char* shm) {
    const int nb = VNB, bid = VBID;
    char* lds = shm + VHALF * LDS_HALF;
    const bf16_t* hy = (const bf16_t*)(p.ws + OFF_HY);
    const bf16_t* big = (const bf16_t*)(p.ws + OFF_BIG);
    const bf16_t* mixin = (const bf16_t*)(p.ws + OFF_BIG + BIG_MIXIN);
    const float* mod = (const float*)(p.ws + OFF_MOD);
    char* st = p.ws + OFF_STAT;
#define FZ(set, from_in, hasH, goff, wpost, wpre, scoff, shoff) FuseP{from_in, hasH, p.out, mod + (goff), wpost, wpre, mod + (scoff), mod + (shoff), (float*)(st + (set) * STAT_SET), (float*)(st + (set) * STAT_SET + 65536), (unsigned*)(st + (set) * STAT_SET + 131072)}
    switch (ph) {
    case 0: p0_phase(p, bid, nb, lds); break;
    case 1: rowop_phase(p, false, true, 0, nullptr, true, p.norm_mix_pre, 1024, 0); break;
    case 2: gemm_phase<EPI_PE>(p, hy, 2048, (const bf16_t*)(p.ws + OFF_WINE), 1024, 12, shm); break;
    case 3:
        for (int it = bid; it < 1536; it += nb) { if (it < 1024) attn_diff_item(p, it, lds); else conv_item(p, it - 1024); }
        break;
    case 4: gemm_phase<EPI_YF>(p, mixin, 1024, (const bf16_t*)(p.ws + OFF_WOUT), 1024, 4, shm, FZ(0, 1, 1, 2048, p.norm_mix_post, p.norm_mlp_pre, 4096, 3072)); break;
    case 5: gemm_phase<EPI_W1>(p, hy, 2048, (const bf16_t*)(p.ws + OFF_W1), 1024, 16, shm); break;
    case 6: gemm_phase<EPI_YF>(p, big, 4096, (const bf16_t*)(p.ws + OFF_W2), 4096, 4, shm, FZ(1, 0, 1, 5120, p.norm_mlp_post, p.norm_mix_pre + 1024, 9 * 6144 + 1024, 9 * 6144 + 0)); break;
    case 7: gemm_phase<EPI_PO>(p, hy, 2048, (const bf16_t*)(p.ws + OFF_WINO), 1024, 9, shm); break;
    case 8:
        for (int it = bid; it < 2048; it += nb) {
            const int q = it >> 9, r = it & 511;
            if (q & 1) attn_d_item(p, (q >> 1) * 512 + r, lds); else attn_c_item(p, (q >> 1) * 512 + r, lds);
        }
        break;
    case 9: gemm_phase<EPI_YF>(p, mixin, 1024, (const bf16_t*)(p.ws + OFF_WOUT) + 1048576, 1024, 4, shm, FZ(2, 0, 1, 9 * 6144 + 2048, p.norm_mix_post + 1024, p.norm_mlp_pre + 1024, 9 * 6144 + 4096, 9 * 6144 + 3072)); break;
    case 10: gemm_phase<EPI_W1>(p, hy, 2048, (const bf16_t*)(p.ws + OFF_W1) + 4194304, 1024, 16, shm); break;
    case 11: gemm_phase<EPI_YF>(p, big, 4096, (const bf16_t*)(p.ws + OFF_W2) + 4194304, 4096, 4, shm, FZ(3, 0, 0, 9 * 6144 + 5120, p.norm_mlp_post + 1024, p.norm_mlp_post, 0, 0)); break;
    }
#undef FZ
}

__global__ void __launch_bounds__(512, 2) fwd_mega(Params p) {
    __shared__ __attribute__((aligned(16))) char lds[LDS_BYTES];
    __shared__ uint4 xb_words;
    cg::grid_group grid = cg::this_grid();
    if (threadIdx.x == 0) xb_words = make_uint4(0u, 0u, 0u, 0u);
    __syncthreads();
    const XcdBarrier xb = xcd_barrier_post((unsigned*)(p.ws + OFF_BAR), (volatile LAS unsigned*)&xb_words);
#define PH_(n) run_phase(p, n, lds); xcd_barrier(xb); if ((DUP_MASK >> n) & 1) { run_phase(p, n, lds); xcd_barrier(xb); }
    PH_(0)
    if (p.ws == nullptr) grid.sync();
    PH_(1) PH_(2) PH_(3) PH_(4) PH_(5) PH_(6) PH_(7) PH_(8) PH_(9) PH_(10)
    run_phase(p, 11, lds);
#undef PH_
}

__global__ void __launch_bounds__(512, 2) fwd_phase(Params p, int ph) {
    __shared__ __attribute__((aligned(16))) char lds[LDS_BYTES];
    run_phase(p, ph, lds);
}

extern "C" void kernel_launch(void* const* d_in, const int* in_sizes, int n_in, void* d_out, int out_size, void* d_ws, size_t ws_size, hipStream_t stream) {
    Params p{};
    const float** pp = (const float**)&p;
    for (int i = 0; i < 29; ++i) pp[i] = (const float*)d_in[i];
    p.out = (float*)d_out;
    p.ws = (char*)d_ws;
    if (ws_size < WS_NEEDED) { fprintf(stderr, "workspace too small: %zu < %zu\n", ws_size, (size_t)WS_NEEDED); return; }
    static int grid_blocks = 0;
    if (!grid_blocks) {
        int dev = 0, cus = 0, per_cu = 0;
        hipGetDevice(&dev);
        hipDeviceGetAttribute(&cus, hipDeviceAttributeMultiprocessorCount, dev);
        hipOccupancyMaxActiveBlocksPerMultiprocessor(&per_cu, fwd_mega, 512, 0);
        if (per_cu > 1) per_cu = 1;
        if (per_cu < 1) per_cu = 1;
        grid_blocks = cus * per_cu;
        grid_blocks -= grid_blocks % 8;
    }
#if ONE_LAUNCH
    (void)hipMemsetAsync((char*)d_ws + OFF_BAR, 0, XCD_BAR_WORDS * 4, stream);
    if (grid_blocks != 256) { fprintf(stderr, "fused epilogues need exactly 256 workgroups (got %d)\n", grid_blocks); return; }
    void* args[] = {&p};
    hipError_t e = hipLaunchCooperativeKernel((void*)fwd_mega, dim3(grid_blocks), dim3(512), args, 0, stream);
    if (e != hipSuccess) fprintf(stderr, "cooperative launch failed: %s (grid %d)\n", hipGetErrorString(e), grid_blocks);
#else
    for (int ph = 0; ph < N_PHASES; ++ph) fwd_phase<<<grid_blocks, 512, 0, stream>>>(p, ph);
#endif
}
```

```cpp
#include <hip/hip_runtime.h>
#include <hip/hip_cooperative_groups.h>
#include <cstdio>
#include <cstdint>
namespace cg = cooperative_groups;

#ifndef DUP_MASK
#define DUP_MASK 0
#endif
#ifndef ONE_LAUNCH
#define ONE_LAUNCH 1
#endif

typedef unsigned short bf16_t;
typedef short bf16x8 __attribute__((ext_vector_type(8)));
typedef float f32x4 __attribute__((ext_vector_type(4)));
typedef float f32x2 __attribute__((ext_vector_type(2)));
typedef float f32x16 __attribute__((ext_vector_type(16)));
typedef unsigned u32x4 __attribute__((ext_vector_type(4)));
typedef unsigned u32x2 __attribute__((ext_vector_type(2)));
typedef __bf16 bfv2 __attribute__((ext_vector_type(2)));
#define DI __device__ __forceinline__
DI int launder_v(int v) { asm volatile("" : "+v"(v)); return v; }
#define TIDX launder_v((int)threadIdx.x)
#define VTID (TIDX & 255)
#define VHALF (TIDX >> 8)
#define VBID ((int)(blockIdx.x * 2) + (TIDX >> 8))
#define VNB ((int)(gridDim.x * 2))
#define MFMA32(a, b, c) __builtin_amdgcn_mfma_f32_32x32x16_bf16((a), (b), (c), 0, 0, 0)
#define MFMA16(a, b, c) __builtin_amdgcn_mfma_f32_16x16x32_bf16((a), (b), (c), 0, 0, 0)

constexpr float LOG2E = 1.4426950408889634f;
constexpr float EPSN = 1e-6f;

struct Params {
    const float *x_prompt, *x_sample, *cache_diff_k, *cache_diff_v, *cache_na_k, *cache_na_v, *cache_swa_k, *cache_swa_v, *c, *c_ctx;
    const float *mod_w, *mod_b, *norm_mix_pre, *norm_mix_post, *norm_mlp_pre, *norm_mlp_post, *w_in_even, *conv_w, *lq1, *lk1, *lq2, *lk2, *subln;
    const float *w_in_odd, *rpb, *sink, *w_out, *mlp_w1, *mlp_w2;
    float* out;
    char* ws;
};

constexpr size_t OFF_MOD = 0;
constexpr size_t OFF_BAR = 458752;
constexpr size_t OFF_WINE = 524288;
constexpr size_t OFF_WINO = OFF_WINE + 6291456;
constexpr size_t OFF_WOUT = OFF_WINO + 4718592;
constexpr size_t OFF_W1 = OFF_WOUT + 4194304;
constexpr size_t OFF_W2 = OFF_W1 + 16777216;
constexpr size_t OFF_CDK = OFF_W2 + 16777216;
constexpr size_t OFF_CDVT = OFF_CDK + 2097152;
constexpr size_t OFF_CNK = OFF_CDVT + 2097152;
constexpr size_t OFF_CNVT = OFF_CNK + 2097152;
constexpr size_t OFF_CSK = OFF_CNVT + 2097152;
constexpr size_t OFF_CSVT = OFF_CSK + 524288;
constexpr size_t OFF_HY = OFF_CSVT + 524288;
constexpr size_t OFF_BIG = OFF_HY + 67108864;
constexpr size_t OFF_STAT = OFF_BIG + 134217728;
constexpr size_t STAT_SET = 65536 + 65536 + 8192;
constexpr size_t WS_NEEDED = OFF_STAT + 4 * STAT_SET;
constexpr size_t BIG_VT_E = 83886080;
constexpr size_t BIG_VT_C = 54525952;
constexpr size_t BIG_VT_D = BIG_VT_C + 16777216;
constexpr size_t BIG_MIXIN = 100663296;
constexpr int LDE = 2560, LDO = 1664;
constexpr size_t OUT_DIFFK = 16777216, OUT_DIFFV = 20971520, OUT_NAK = 25165824, OUT_NAV = 29360128, OUT_SWAK = 33554432, OUT_SWAV = 34603008;

constexpr int LDS_HALF = 65536 + 4096;
constexpr int LDS_BYTES = 2 * LDS_HALF;

DI unsigned pk2(float a, float b) { f32x2 v = {a, b}; bfv2 r = __builtin_convertvector(v, bfv2); return __builtin_bit_cast(unsigned, r); }
DI float bflo(unsigned u) { return __uint_as_float(u << 16); }
DI float bfhi(unsigned u) { return __uint_as_float(u & 0xffff0000u); }
DI float wave_sum(float v) {
#pragma unroll
    for (int o = 1; o < 64; o <<= 1) v += __shfl_xor(v, o);
    return v;
}
DI int swz128(int r, int c) { return r * 128 + ((c ^ ((r >> 1) & 7)) << 4); }
DI int swz256(int r, int c) { return r * 256 + ((c ^ (r & 15)) << 4); }

DI void p0_mod_item(const Params& p, int item, char* lds) {
    const int li = item / 96, cb = item % 96;
    const int tid = VTID, lane = tid & 63, w = tid >> 6;
    const float* W = p.mod_w + (size_t)li * 1024 * 6144 + cb * 64 + lane;
    float acc[9];
#pragma unroll
    for (int v = 0; v < 9; ++v) acc[v] = 0.f;
    for (int kc = 0; kc < 4; ++kc) {
        const int kb = w * 256 + kc * 64;
        float s[9];
        { const float cv = p.c_ctx[kb + lane]; s[0] = cv / (1.f + __expf(-cv)); }
#pragma unroll
        for (int v = 1; v < 9; ++v) { const float cv = p.c[(v - 1) * 1024 + kb + lane]; s[v] = cv / (1.f + __expf(-cv)); }
#pragma unroll
        for (int kk = 0; kk < 64; ++kk) {
            const float wv = W[(size_t)(kb + kk) * 6144];
#pragma unroll
            for (int v = 0; v < 9; ++v) acc[v] += __int_as_float(__builtin_amdgcn_readlane(__float_as_int(s[v]), kk)) * wv;
        }
    }
    float* red = (float*)lds;
#pragma unroll
    for (int v = 0; v < 9; ++v) red[(w * 9 + v) * 64 + lane] = acc[v];
    __syncthreads();
    float* mod = (float*)(p.ws + OFF_MOD);
    for (int idx = tid; idx < 576; idx += 256) {
        const int v = idx >> 6, col = idx & 63;
        const float sum = red[(0 * 9 + v) * 64 + col] + red[(1 * 9 + v) * 64 + col] + red[(2 * 9 + v) * 64 + col] + red[(3 * 9 + v) * 64 + col];
        mod[(li * 9 + v) * 6144 + cb * 64 + col] = sum + p.mod_b[li * 6144 + cb * 64 + col];
    }
    __syncthreads();
}

DI void p0_transpose_tile(const float* __restrict__ in, bf16_t* __restrict__ out, int R, int C, int tr, int tc, char* lds) {
    const int tid = VTID;
    const int cl = (tid & 15) * 4, rl = (tid >> 4) * 2, sw = tid & 7;
#pragma unroll
    for (int i = 0; i < 2; ++i) {
        const int r = rl + 32 * i;
        const f32x4 a = *(const f32x4*)(in + (size_t)(tr * 64 + r) * C + tc * 64 + cl);
        const f32x4 b = *(const f32x4*)(in + (size_t)(tr * 64 + r + 1) * C + tc * 64 + cl);
#pragma unroll
        for (int j = 0; j < 4; ++j) *(unsigned*)(lds + (cl + j) * 128 + (((r >> 3) ^ sw) << 4) + (r & 7) * 2) = pk2(a[j], b[j]);
    }
    __syncthreads();
#pragma unroll
    for (int i = 0; i < 2; ++i) {
        const int idx = tid + 256 * i, c = idx >> 3, q = idx & 7;
        const u32x4 v = *(const u32x4*)(lds + c * 128 + ((q ^ ((c >> 2) & 7)) << 4));
        *(u32x4*)(out + (size_t)(tc * 64 + c) * R + tr * 64 + q * 8) = v;
    }
    __syncthreads();
}

DI void p0_kreorder(const float* __restrict__ in, bf16_t* __restrict__ out, int logH, int item) {
    const int tid = VTID, H = 1 << logH;
#pragma unroll
    for (int i = 0; i < 4; ++i) {
        const int f = item * 1024 + tid + 256 * i;
        const int d4 = f & 15, key = (f >> 4) & 255, hh = (f >> 12) & (H - 1), b = f >> (12 + logH);
        const f32x4 v = *(const f32x4*)(in + (size_t)f * 4);
        u32x2 o = {pk2(v[0], v[1]), pk2(v[2], v[3])};
        *(u32x2*)(out + ((size_t)(b * 256 + key) * H + hh) * 64 + d4 * 4) = o;
    }
}

struct TJob { const float* in; bf16_t* out; int R, C, tr, tc; };
constexpr int P0_TITEMS = 768 + 576 + 512 + 2048 + 2048 + 256 + 256 + 64;
DI TJob p0_decode(const Params& p, int item) {
    TJob j;
    if (item < 768) { j.in = p.w_in_even; j.out = (bf16_t*)(p.ws + OFF_WINE); j.R = 1024; j.C = 3072; }
    else if ((item -= 768) < 576) { j.in = p.w_in_odd; j.out = (bf16_t*)(p.ws + OFF_WINO); j.R = 1024; j.C = 2304; }
    else if ((item -= 576) < 512) { const int b = item >> 8; item &= 255; j.in = p.w_out + (size_t)b * 1048576; j.out = (bf16_t*)(p.ws + OFF_WOUT) + (size_t)b * 1048576; j.R = 1024; j.C = 1024; }
    else if ((item -= 512) < 2048) { const int b = item >> 10; item &= 1023; j.in = p.mlp_w1 + (size_t)b * 4194304; j.out = (bf16_t*)(p.ws + OFF_W1) + (size_t)b * 4194304; j.R = 1024; j.C = 4096; }
    else if ((item -= 2048) < 2048) { const int b = item >> 10; item &= 1023; j.in = p.mlp_w2 + (size_t)b * 4194304; j.out = (bf16_t*)(p.ws + OFF_W2) + (size_t)b * 4194304; j.R = 4096; j.C = 1024; }
    else if ((item -= 2048) < 256) { const int b = item >> 3; item &= 7; j.in = p.cache_diff_v + (size_t)b * 32768; j.out = (bf16_t*)(p.ws + OFF_CDVT) + (size_t)b * 32768; j.R = 256; j.C = 128; }
    else if ((item -= 256) < 256) { const int b = item >> 2; item &= 3; j.in = p.cache_na_v + (size_t)b * 16384; j.out = (bf16_t*)(p.ws + OFF_CNVT) + (size_t)b * 16384; j.R = 256; j.C = 64; }
    else { item -= 256; const int b = item >> 2; item &= 3; j.in = p.cache_swa_v + (size_t)b * 16384; j.out = (bf16_t*)(p.ws + OFF_CSVT) + (size_t)b * 16384; j.R = 256; j.C = 64; }
    const int ntc = j.C >> 6;
    j.tr = item / ntc; j.tc = item % ntc;
    return j;
}
DI void p0_tload(const TJob& j, int tid, f32x4 (&a)[2], f32x4 (&b)[2]) {
    const int cl = (tid & 15) * 4, rl = (tid >> 4) * 2;
#pragma unroll
    for (int i = 0; i < 2; ++i) {
        const int r = rl + 32 * i;
        a[i] = __builtin_nontemporal_load((const f32x4*)(j.in + (size_t)(j.tr * 64 + r) * j.C + j.tc * 64 + cl));
        b[i] = __builtin_nontemporal_load((const f32x4*)(j.in + (size_t)(j.tr * 64 + r + 1) * j.C + j.tc * 64 + cl));
    }
}
DI void p0_phase(const Params& p, int bid, int nb, char* lds) {
    if (bid < 192) p0_mod_item(p, bid, lds);
    const int tid = VTID;
    {
        const int cl = (tid & 15) * 4, rl = (tid >> 4) * 2, sw = tid & 7;
        int it = bid;
        TJob cur{}; f32x4 a[2], b[2];
        if (it < P0_TITEMS) { cur = p0_decode(p, it); p0_tload(cur, tid, a, b); }
        while (it < P0_TITEMS) {
            const int nx = it + nb;
            TJob nxt{}; f32x4 an[2], bn[2];
            if (nx < P0_TITEMS) { nxt = p0_decode(p, nx); p0_tload(nxt, tid, an, bn); }
#pragma unroll
            for (int i = 0; i < 2; ++i) {
                const int r = rl + 32 * i;
#pragma unroll
                for (int jj = 0; jj < 4; ++jj) *(unsigned*)(lds + (cl + jj) * 128 + (((r >> 3) ^ sw) << 4) + (r & 7) * 2) = pk2(a[i][jj], b[i][jj]);
            }
            __syncthreads();
#pragma unroll
            for (int i = 0; i < 2; ++i) {
                const int idx = tid + 256 * i, c = idx >> 3, q = idx & 7;
                const u32x4 v = *(const u32x4*)(lds + c * 128 + ((q ^ ((c >> 2) & 7)) << 4));
                *(u32x4*)(cur.out + (size_t)(cur.tc * 64 + c) * cur.R + cur.tr * 64 + q * 8) = v;
            }
            __syncthreads();
            cur = nxt; a[0] = an[0]; a[1] = an[1]; b[0] = bn[0]; b[1] = bn[1];
            it = nx;
        }
    }
    {
        f32x4* st4 = (f32x4*)(p.ws + OFF_STAT);
        const f32x4 z = {0.f, 0.f, 0.f, 0.f};
        for (int i = bid * 256 + tid; i < (int)(4 * STAT_SET / 16); i += nb * 256) st4[i] = z;
    }
    for (int it = bid; it < 576; it += nb) {
        if (it < 256) p0_kreorder(p.cache_diff_k, (bf16_t*)(p.ws + OFF_CDK), 3, it);
        else if (it < 512) p0_kreorder(p.cache_na_k, (bf16_t*)(p.ws + OFF_CNK), 3, it - 256);
        else p0_kreorder(p.cache_swa_k, (bf16_t*)(p.ws + OFF_CSK), 1, it - 512);
    }
}

DI void rowop_phase(const Params& p, bool hasY, bool xin_input, int g_off, const float* wpost, bool hasH, const float* wpre, int sc_off, int sh_off) {
    const int tix = TIDX, lane = tix & 63, gw = (int)(blockIdx.x * 8) + (tix >> 6), nw = VNB * 4;
    const float* mod = (const float*)(p.ws + OFF_MOD);
    f32x4 wpo[4], wpr[4];
#pragma unroll
    for (int i = 0; i < 4; ++i) { if (hasY) wpo[i] = *(const f32x4*)(wpost + lane * 4 + 256 * i); if (hasH) wpr[i] = *(const f32x4*)(wpre + lane * 4 + 256 * i); }
    for (int row0 = gw; row0 < 16384; row0 += 2 * nw) {
        f32x4 x[2][4], y[2][4];
#pragma unroll
        for (int r = 0; r < 2; ++r) {
            const int row = row0 + r * nw;
            const float* xin = xin_input ? (row < 8192 ? p.x_prompt + (size_t)row * 1024 : p.x_sample + (size_t)(row - 8192) * 1024) : p.out + (size_t)row * 1024;
            const float* yin = (const float*)(p.ws + OFF_HY + (size_t)row * 4096);
#pragma unroll
            for (int i = 0; i < 4; ++i) { x[r][i] = *(const f32x4*)(xin + lane * 4 + 256 * i); if (hasY) y[r][i] = *(const f32x4*)(yin + lane * 4 + 256 * i); }
        }
#pragma unroll
        for (int r = 0; r < 2; ++r) {
            const int row = row0 + r * nw;
            const int v = row < 8192 ? 0 : 1 + ((row - 8192) >> 10);
            char* hy = p.ws + OFF_HY + (size_t)row * 4096;
            if (hasY) {
                f32x4 g4[4];
#pragma unroll
                for (int i = 0; i < 4; ++i) g4[i] = *(const f32x4*)(mod + v * 6144 + g_off + lane * 4 + 256 * i);
                float ss = 0.f;
#pragma unroll
                for (int i = 0; i < 4; ++i) ss += y[r][i][0] * y[r][i][0] + y[r][i][1] * y[r][i][1] + y[r][i][2] * y[r][i][2] + y[r][i][3] * y[r][i][3];
                ss = wave_sum(ss);
                const float rs = rsqrtf(ss * (1.f / 1024.f) + EPSN);
#pragma unroll
                for (int i = 0; i < 4; ++i) {
                    x[r][i] += g4[i] * (y[r][i] * rs * wpo[i]);
                    *(f32x4*)(p.out + (size_t)row * 1024 + lane * 4 + 256 * i) = x[r][i];
                }
            }
            if (hasH) {
                f32x4 sc[4], sh[4];
#pragma unroll
                for (int i = 0; i < 4; ++i) { sc[i] = *(const f32x4*)(mod + v * 6144 + sc_off + lane * 4 + 256 * i); sh[i] = *(const f32x4*)(mod + v * 6144 + sh_off + lane * 4 + 256 * i); }
                float ss = 0.f;
#pragma unroll
                for (int i = 0; i < 4; ++i) ss += x[r][i][0] * x[r][i][0] + x[r][i][1] * x[r][i][1] + x[r][i][2] * x[r][i][2] + x[r][i][3] * x[r][i][3];
                ss = wave_sum(ss);
                const float rs = rsqrtf(ss * (1.f / 1024.f) + EPSN);
#pragma unroll
                for (int i = 0; i < 4; ++i) {
                    const f32x4 h = x[r][i] * rs * wpr[i] * (sc[i] + 1.f) + sh[i];
                    u32x2 o = {pk2(h[0], h[1]), pk2(h[2], h[3])};
                    *(u32x2*)((bf16_t*)hy + lane * 4 + 256 * i) = o;
                }
            }
        }
    }
}

namespace g8 {
constexpr int BK = 64, HALF = 128, HTB = HALF * BK * 2;
DI int lds_byte(int r, int c) { const int st = (r >> 4) * 2 + (c >> 5), rr = r & 15, cc = c & 31, ob = rr * 64 + cc * 2; return st * 1024 + (ob ^ (((ob >> 9) & 1) << 5)); }
DI void stage_rc(int b, int& R, int& C) { const int st = b / 1024, sb = b % 1024, swz = sb ^ (((sb >> 9) & 1) << 5); R = (st >> 1) * 16 + swz / 64; C = (st & 1) * 32 + (swz % 64) / 2; }
typedef __attribute__((address_space(3))) unsigned lds_u32;
typedef __attribute__((address_space(3))) unsigned char lds_u8;
typedef __attribute__((address_space(3))) bf16x8 lds_bf16x8;

}

enum { EPI_PE = 0, EPI_PO = 1, EPI_Y = 2, EPI_W1 = 3, EPI_YF = 4 };

struct FuseP { int from_input, hasH; float* xout; const float* g; const float* wpost; const float* wpre; const float* sc; const float* sh; float* ssY; float* ssX; unsigned* cnt; };
DI float ld_agent(const float* q) { return __hip_atomic_load(q, __ATOMIC_RELAXED, __HIP_MEMORY_SCOPE_AGENT); }
DI void panel_wait(unsigned* c, unsigned target) {
    asm volatile("s_waitcnt vmcnt(0)" ::: "memory");
    __syncthreads();
    if (threadIdx.x == 0) {
        __hip_atomic_fetch_add(c, 1u, __ATOMIC_RELAXED, __HIP_MEMORY_SCOPE_AGENT);
        unsigned sp = 0;
        while (__hip_atomic_load(c, __ATOMIC_RELAXED, __HIP_MEMORY_SCOPE_AGENT) < target) { __builtin_amdgcn_s_sleep(1); if (++sp > (1u << 22)) break; }
    }
    __syncthreads();
}
DI float dot4(const f32x4& a) { return a[0] * a[0] + a[1] * a[1] + a[2] * a[2] + a[3] * a[3]; }

DI void rope_s(f32x4 (&sub)[4][2], int R0, bool usecol, int fr, int fq) {
    asm volatile("" : "+s"(R0));
    const float sgn = fq < 2 ? -1.f : 1.f;
#pragma unroll
    for (int m = 0; m < 4; ++m) {
        __builtin_amdgcn_sched_barrier(0);
        const int tl = (R0 + m * 16 + fr - 8192) & 1023;
        const float pos = (float)(usecol ? (tl & 63) : (tl >> 6));
#pragma unroll
        for (int n = 0; n < 2; ++n)
#pragma unroll
            for (int j = 0; j < 4; ++j) {
                const float inv = exp2f(-(float)(8 * (fq & 1) + 4 * n + j) * (13.287712379549449f / 16.f));
                float sn, cs;
                __sincosf(pos * inv, &sn, &cs);
                const float v = sub[m][n][j], pv = __shfl_xor(v, 32);
                sub[m][n][j] = v * cs + sgn * pv * sn;
            }
    }
}
DI void store_bf16_rows_s(const f32x4 (&sub)[4][2], bf16_t* base, int ld, int R0, int Cd0, int fr, int fq) {
#pragma unroll
    for (int m = 0; m < 4; ++m) {
        u32x4 o = {pk2(sub[m][0][0], sub[m][0][1]), pk2(sub[m][0][2], sub[m][0][3]), pk2(sub[m][1][0], sub[m][1][1]), pk2(sub[m][1][2], sub[m][1][3])};
        *(u32x4*)(base + (size_t)(R0 + m * 16 + fr) * ld + Cd0 + fq * 8) = o;
    }
}
DI void store_f32_rows_s(const f32x4 (&sub)[4][2], float* ob, int ldo, int fr, int fq) {
#pragma unroll
    for (int m = 0; m < 4; ++m) {
        float* rp = ob + (size_t)(m * 16 + fr) * ldo + fq * 8;
#pragma unroll
        for (int n = 0; n < 2; ++n) *(f32x4*)(rp + n * 4) = sub[m][n];
    }
}
DI void store_vt_s(const f32x4 (&sub)[4][2], bf16_t* vt, int T, int t0, int fr, int fq) {
#pragma unroll
    for (int n = 0; n < 2; ++n) {
        bf16_t* rp = vt + (size_t)(8 * (fr >> 2) + 4 * n + (fr & 3)) * T + t0 + fq * 4;
#pragma unroll
        for (int m = 0; m < 4; ++m) { u32x2 o = {pk2(sub[m][n][0], sub[m][n][1]), pk2(sub[m][n][2], sub[m][n][3])}; *(u32x2*)(rp + m * 16) = o; }
    }
}
DI void store_f32_ns_s(const f32x4 (&sub)[4][2], float* ob, int ldo, int fr, int fq) {
#pragma unroll
    for (int m = 0; m < 4; ++m)
#pragma unroll
        for (int j = 0; j < 4; ++j) {
            float* rp = ob + (size_t)(m * 16 + fq * 4 + j) * ldo + 8 * (fr >> 2) + (fr & 3);
#pragma unroll
            for (int n = 0; n < 2; ++n) rp[n * 4] = sub[m][n][j];
        }
}

template <int EPI>
DI void tile_epilogue(const Params& p, f32x4 (&acc)[2][2][4][2], int pm, int pn, int vtm, const FuseP& fz) {
    const int tix = TIDX, wid = __builtin_amdgcn_readfirstlane(tix >> 6), lane = tix & 63, wr = wid >> 2, wc = wid & 3;
    const int brow = pm * 256, bcol = pn * 256;
    int fr = lane & 15, fq = lane >> 4;
    asm volatile("" : "+v"(fr), "+v"(fq));
    const bool latent = brow >= 8192;
    int b, tb, T;
    if (latent) { b = (brow - 8192) >> 10; tb = (brow - 8192) & 1023; T = 1024; } else { b = brow >> 8; tb = 0; T = 256; }
    bf16_t* big = (bf16_t*)(p.ws + OFF_BIG);
    if (EPI == EPI_YF) {
        const int v = latent ? 1 + b : 0;
        const int rbase = brow + wr * 64 + fr;
        const int cbase = bcol + wc * 32 + fq * 8;
        float rs[2][4];
#pragma unroll
        for (int ai = 0; ai < 2; ++ai)
#pragma unroll
            for (int m = 0; m < 4; ++m) {
                float sq = dot4(acc[ai][0][m][0]) + dot4(acc[ai][0][m][1]) + dot4(acc[ai][1][m][0]) + dot4(acc[ai][1][m][1]);
                sq += __shfl_xor(sq, 16); sq += __shfl_xor(sq, 32);
                if (fq == 0) { const float old = __hip_atomic_fetch_add(fz.ssY + rbase + ai * 128 + m * 16, sq, __ATOMIC_RELAXED, __HIP_MEMORY_SCOPE_AGENT); asm volatile("" :: "v"(old)); }
            }
        panel_wait(fz.cnt + pm * 32, 4u);
#pragma unroll
        for (int ai = 0; ai < 2; ++ai)
#pragma unroll
            for (int m = 0; m < 4; ++m) rs[ai][m] = rsqrtf(ld_agent(fz.ssY + rbase + ai * 128 + m * 16) * (1.f / 1024.f) + EPSN);
        const float* xin = latent ? p.x_sample - (size_t)8192 * 1024 : p.x_prompt;
        bf16_t* xb = (bf16_t*)(p.ws + OFF_HY) + 1024;
        float s2[2][4];
#pragma unroll
        for (int ai = 0; ai < 2; ++ai)
#pragma unroll
            for (int m = 0; m < 4; ++m) s2[ai][m] = 0.f;
#pragma unroll
        for (int bj = 0; bj < 2; ++bj) {
            const int col = cbase + bj * 128;
            f32x4 g4[2], wp4[2];
#pragma unroll
            for (int n = 0; n < 2; ++n) { g4[n] = *(const f32x4*)(fz.g + v * 6144 + col + 4 * n); wp4[n] = *(const f32x4*)(fz.wpost + col + 4 * n); }
#pragma unroll
            for (int ai = 0; ai < 2; ++ai)
#pragma unroll
                for (int m = 0; m < 4; ++m) {
                    const size_t off = (size_t)(rbase + ai * 128 + m * 16) * 1024 + col;
                    f32x4 x4[2];
                    if (fz.from_input) { x4[0] = *(const f32x4*)(xin + off); x4[1] = *(const f32x4*)(xin + off + 4); }
                    else {
                        const u32x4 xr = *(const u32x4*)(xb + 2 * off - col);
                        x4[0] = (f32x4){bflo(xr[0]), bfhi(xr[0]), bflo(xr[1]), bfhi(xr[1])}; x4[1] = (f32x4){bflo(xr[2]), bfhi(xr[2]), bflo(xr[3]), bfhi(xr[3])};
                    }
                    f32x4 a[2];
#pragma unroll
                    for (int n = 0; n < 2; ++n) { a[n] = x4[n] + g4[n] * (acc[ai][bj][m][n] * rs[ai][m] * wp4[n]); acc[ai][bj][m][n] = a[n]; s2[ai][m] += dot4(a[n]); }
                    if (fz.hasH) { u32x4 xo = {pk2(a[0][0], a[0][1]), pk2(a[0][2], a[0][3]), pk2(a[1][0], a[1][1]), pk2(a[1][2], a[1][3])}; *(u32x4*)(xb + 2 * off - col) = xo; }
                    else { *(f32x4*)(fz.xout + off) = a[0]; *(f32x4*)(fz.xout + off + 4) = a[1]; }
                }
        }
        if (fz.hasH) {
#pragma unroll
            for (int ai = 0; ai < 2; ++ai)
#pragma unroll
                for (int m = 0; m < 4; ++m) {
                    float sq = s2[ai][m];
                    sq += __shfl_xor(sq, 16); sq += __shfl_xor(sq, 32);
                    if (fq == 0) { const float old = __hip_atomic_fetch_add(fz.ssX + rbase + ai * 128 + m * 16, sq, __ATOMIC_RELAXED, __HIP_MEMORY_SCOPE_AGENT); asm volatile("" :: "v"(old)); }
                }
            panel_wait(fz.cnt + pm * 32 + 16, 4u);
#pragma unroll
            for (int ai = 0; ai < 2; ++ai)
#pragma unroll
                for (int m = 0; m < 4; ++m) rs[ai][m] = rsqrtf(ld_agent(fz.ssX + rbase + ai * 128 + m * 16) * (1.f / 1024.f) + EPSN);
            bf16_t* hb = (bf16_t*)(p.ws + OFF_HY);
#pragma unroll
            for (int bj = 0; bj < 2; ++bj) {
                const int col = cbase + bj * 128;
                f32x4 wq4[2], sc4[2], sh4[2];
#pragma unroll
                for (int n = 0; n < 2; ++n) { wq4[n] = *(const f32x4*)(fz.wpre + col + 4 * n); sc4[n] = *(const f32x4*)(fz.sc + v * 6144 + col + 4 * n) + 1.f; sh4[n] = *(const f32x4*)(fz.sh + v * 6144 + col + 4 * n); }
#pragma unroll
                for (int ai = 0; ai < 2; ++ai)
#pragma unroll
                    for (int m = 0; m < 4; ++m) {
                        const f32x4 h0 = acc[ai][bj][m][0] * rs[ai][m] * wq4[0] * sc4[0] + sh4[0], h1 = acc[ai][bj][m][1] * rs[ai][m] * wq4[1] * sc4[1] + sh4[1];
                        u32x4 o = {pk2(h0[0], h0[1]), pk2(h0[2], h0[3]), pk2(h1[0], h1[1]), pk2(h1[2], h1[3])};
                        *(u32x4*)(hb + (size_t)(rbase + ai * 128 + m * 16) * 2048 + col) = o;
                    }
            }
        }
        return;
    }
#pragma unroll
    for (int ai = 0; ai < 2; ++ai)
#pragma unroll
        for (int bj = 0; bj < 2; ++bj) {
            __builtin_amdgcn_sched_barrier(0);
            f32x4 (&sub)[4][2] = acc[ai][bj];
            const int R0 = brow + ai * 128 + wr * 64, t0 = tb + ai * 128 + wr * 64, C0 = bcol + bj * 128 + wc * 32;
            const bool ns = vtm == 1 || (vtm == 2 && bj == 1);
            if (EPI == EPI_PE) {
                if (ns) {
                    const int vc = C0 - 2560;
                    bf16_t* vt = (bf16_t*)(p.ws + OFF_BIG + BIG_VT_E) + (latent ? (size_t)4194304 + ((size_t)b * 512 + vc) * 1024 : ((size_t)b * 512 + vc) * 256);
                    store_vt_s(sub, vt, T, t0, fr, fq);
                    if (!latent) store_f32_ns_s(sub, p.out + OUT_DIFFV + ((size_t)(b * 4 + (vc >> 7)) * 256 + t0) * 128 + (vc & 127), 128, fr, fq);
                } else {
                    if (pn >= 6 && latent) rope_s(sub, R0, wc & 1, fr, fq);
                    store_bf16_rows_s(sub, big, LDE, R0, C0, fr, fq);
                    if (pn >= 8 && !latent) store_f32_rows_s(sub, p.out + OUT_DIFFK + ((size_t)(b * 8 + ((C0 - 2048) >> 6)) * 256 + t0) * 64 + ((C0 - 2048) & 63), 64, fr, fq);
                }
            } else if (EPI == EPI_PO) {
                if (ns) {
                    if (pn < 8) {
                        const int vc = C0 - 1024;
                        bf16_t* vt = (bf16_t*)(p.ws + OFF_BIG + BIG_VT_C) + (latent ? (size_t)4194304 + ((size_t)b * 512 + vc) * 1024 : ((size_t)b * 512 + vc) * 256);
                        store_vt_s(sub, vt, T, t0, fr, fq);
                        if (!latent) store_f32_ns_s(sub, p.out + OUT_NAV + ((size_t)(b * 8 + (vc >> 6)) * 256 + t0) * 64 + (vc & 63), 64, fr, fq);
                    } else {
                        const int vc = C0 - 2176;
                        bf16_t* vt = (bf16_t*)(p.ws + OFF_BIG + BIG_VT_D) + (latent ? (size_t)1048576 + ((size_t)b * 128 + vc) * 1024 : ((size_t)b * 128 + vc) * 256);
                        store_vt_s(sub, vt, T, t0, fr, fq);
                        if (!latent) store_f32_ns_s(sub, p.out + OUT_SWAV + ((size_t)(b * 2 + (vc >> 6)) * 256 + t0) * 64 + (vc & 63), 64, fr, fq);
                    }
                } else {
                    if (pn >= 6 && latent) rope_s(sub, R0, wc & 1, fr, fq);
                    store_bf16_rows_s(sub, big, LDO, R0, pn >= 6 ? C0 - 512 : C0, fr, fq);
                    if (!latent) {
                        if (pn == 2 || pn == 3) store_f32_rows_s(sub, p.out + OUT_NAK + ((size_t)(b * 8 + ((C0 - 512) >> 6)) * 256 + t0) * 64 + ((C0 - 512) & 63), 64, fr, fq);
                        else if (pn == 8) store_f32_rows_s(sub, p.out + OUT_SWAK + ((size_t)(b * 2 + ((C0 - 2048) >> 6)) * 256 + t0) * 64 + ((C0 - 2048) & 63), 64, fr, fq);
                    }
                }
            } else if (EPI == EPI_Y) {
                store_f32_rows_s(sub, (float*)(p.ws + OFF_HY) + (size_t)R0 * 1024 + C0, 1024, fr, fq);
            } else {
#pragma unroll
                for (int m = 0; m < 4; ++m)
#pragma unroll
                    for (int n = 0; n < 2; ++n)
#pragma unroll
                        for (int j = 0; j < 4; ++j) { const float v = fmaxf(sub[m][n][j], 0.f); sub[m][n][j] = v * v; }
                store_bf16_rows_s(sub, big, 4096, R0, C0, fr, fq);
            }
        }
}

template <int EPI>
DI void gemm_phase(const Params& p, const bf16_t* A, int lda, const bf16_t* Bt, int K, int NT_N, char* shm, const FuseP& fz = FuseP{}) {
    using namespace g8;
    const int xcd = blockIdx.x & 7, lb = blockIdx.x >> 3, nlb = gridDim.x >> 3, per_xcd = 8 * NT_N;
    if (lb >= per_xcd) return;
    const int tid = TIDX, wid = __builtin_amdgcn_readfirstlane(tid >> 6), lane = tid & 63, wr = wid >> 2, wc = wid & 3, fr = lane & 15, fq = lane >> 4;
    const int nt = K / BK;
    lds_u8* lds = (lds_u8*)shm;
    unsigned voffA[2], voffB[2];
#pragma unroll
    for (int _i = 0; _i < 2; ++_i) { int _r, _c; stage_rc(tid * 16 + _i * 8192, _r, _c); const int _i16 = _r & 15, _rb = (_r & ~31) + 8 * (_i16 >> 2) + 4 * ((_r >> 4) & 1) + (_i16 & 3);
        voffA[_i] = (unsigned)(_r * lda + _c) * 2u; voffB[_i] = (unsigned)(_rb * K + _c) * 2u; }
    const size_t kstep = (size_t)BK * 2, hstepA = (size_t)HALF * lda * 2, hstepB = (size_t)HALF * K * 2;
    const unsigned ldsw = (unsigned)wid * 1024u;
    const int aoff = lds_byte(wr * 64 + fr, fq * 8), boff = lds_byte(wc * 32 + fr, fq * 8);
#define SA(b, h) (((b) * 2 + (h)) * HTB)
#define SB(b, h) ((4 + (b) * 2 + (h)) * HTB)
#define STAGE(bufoff, gbase, voff) do { _Pragma("unroll") for (int _i = 0; _i < 2; ++_i) \
      __builtin_amdgcn_global_load_lds((const unsigned*)((gbase) + (voff)[_i]), (lds_u32*)(lds + (bufoff) + ldsw + _i * 8192), 16, 0, 0); } while (0)
#define LDA(dst, b, h) _Pragma("unroll") for (int m = 0; m < 4; ++m) _Pragma("unroll") for (int k = 0; k < 2; ++k) \
    dst[m][k] = *(const lds_bf16x8*)(lds + SA(b, h) + aoff + m * 2048 + k * 1024)
#define LDB(dst, b, h) _Pragma("unroll") for (int n = 0; n < 2; ++n) _Pragma("unroll") for (int k = 0; k < 2; ++k) \
    dst[n][k] = *(const lds_bf16x8*)(lds + SB(b, h) + boff + n * 2048 + k * 1024)
#define MMA(VT, ai, bj, At_, Bt_) do { __builtin_amdgcn_s_setprio(1); \
    _Pragma("unroll") for (int m = 0; m < 4; ++m) _Pragma("unroll") for (int n = 0; n < 2; ++n) _Pragma("unroll") for (int k = 0; k < 2; ++k) \
      acc[ai][bj][m][n] = ((VT) == 1 || ((VT) == 2 && (bj) == 1)) ? MFMA16(At_[m][k], Bt_[n][k], acc[ai][bj][m][n]) : MFMA16(Bt_[n][k], At_[m][k], acc[ai][bj][m][n]); \
    __builtin_amdgcn_s_setprio(0); } while (0)
#define WAIT_V(n) asm volatile("s_waitcnt vmcnt(" #n ")" ::: "memory")
#define WAIT_L(n) asm volatile("s_waitcnt lgkmcnt(" #n ")" ::: "memory")
#define BAR __builtin_amdgcn_s_barrier()
#define SCHED __builtin_amdgcn_sched_barrier(0)
#define TLOOP(VT) for (int t = 0; t < nt; t += 2) { \
        const bool last = (t == nt - 2); \
        const char* a1 = cA + (size_t)(t + 1) * kstep; \
        const char* a2 = last ? nA : cA + (size_t)(t + 2) * kstep; const char* b2 = last ? nB : cB + (size_t)(t + 2) * kstep; \
        const char* a3 = a2 + kstep; const char* b3 = b2 + kstep; \
        LDB(B0, 0, 0); LDB(B1, 0, 1); SCHED; LDA(At, 0, 0); STAGE(SA(1, 1), a1 + hstepA, voffA); \
        WAIT_V(8); WAIT_L(0); BAR; MMA(VT, 0, 0, At, B0); MMA(VT, 0, 1, At, B1); BAR; SCHED; \
        LDA(At, 0, 1); STAGE(SB(0, 0), b2, voffB); STAGE(SB(0, 1), b2 + hstepB, voffB); STAGE(SA(0, 0), a2, voffA); \
        WAIT_V(8); WAIT_L(0); BAR; MMA(VT, 1, 0, At, B0); MMA(VT, 1, 1, At, B1); BAR; SCHED; \
        LDB(B0, 1, 0); LDB(B1, 1, 1); SCHED; LDA(At, 1, 0); STAGE(SA(0, 1), a2 + hstepA, voffA); \
        WAIT_V(8); WAIT_L(0); BAR; MMA(VT, 0, 0, At, B0); MMA(VT, 0, 1, At, B1); BAR; SCHED; \
        LDA(At, 1, 1); STAGE(SB(1, 0), b3, voffB); STAGE(SB(1, 1), b3 + hstepB, voffB); STAGE(SA(1, 0), a3, voffA); \
        WAIT_V(8); WAIT_L(0); BAR; MMA(VT, 1, 0, At, B0); MMA(VT, 1, 1, At, B1); BAR; SCHED; \
    }
    int lt = lb, pm = xcd * 8 + (lt & 7), pn = lt >> 3;
    f32x4 acc[2][2][4][2];
#pragma unroll
    for (int a = 0; a < 2; ++a)
#pragma unroll
        for (int b = 0; b < 2; ++b)
#pragma unroll
            for (int m = 0; m < 4; ++m)
#pragma unroll
                for (int n = 0; n < 2; ++n) acc[a][b][m][n] = (f32x4){0.f, 0.f, 0.f, 0.f};
    bf16x8 At[4][2], B0[2][2], B1[2][2];
    const char* cA = (const char*)A + (size_t)pm * 2 * hstepA;
    const char* cB = (const char*)Bt + (size_t)pn * 2 * hstepB;
    WAIT_V(0);
    STAGE(SB(0, 0), cB, voffB); STAGE(SB(0, 1), cB + hstepB, voffB); STAGE(SA(0, 0), cA, voffA); STAGE(SA(0, 1), cA + hstepA, voffA);
    if (wr == 1) BAR;
    WAIT_V(2); BAR;
    STAGE(SB(1, 0), cB + kstep, voffB); STAGE(SA(1, 0), cA + kstep, voffA); STAGE(SB(1, 1), cB + hstepB + kstep, voffB);
    WAIT_V(6); BAR;
    for (;;) {
        const int ltn = lt + nlb;
        const bool has_next = ltn < per_xcd;
        const int pmn = xcd * 8 + (ltn & 7), pnn = ltn >> 3;
        const char* nA = has_next ? (const char*)A + (size_t)pmn * 2 * hstepA : cA;
        const char* nB = has_next ? (const char*)Bt + (size_t)pnn * 2 * hstepB : cB;
        int vtm = 0;
        if (EPI == EPI_PE) vtm = pn >= 10 ? 1 : 0;
        if (EPI == EPI_PO) vtm = (pn == 4 || pn == 5) ? 1 : (pn == 8 ? 2 : 0);
        if ((EPI == EPI_PE || EPI == EPI_PO) && vtm == 1) { TLOOP(1) }
        else if (EPI == EPI_PO && vtm == 2) { TLOOP(2) }
        else { TLOOP(0) }
        if (wr == 0) BAR;
        if (EPI != EPI_YF) tile_epilogue<EPI>(p, acc, pm, pn, vtm, fz);
        if (!has_next) break;
#pragma unroll
        for (int a = 0; a < 2; ++a)
#pragma unroll
            for (int b = 0; b < 2; ++b)
#pragma unroll
                for (int m = 0; m < 4; ++m)
#pragma unroll
                    for (int n = 0; n < 2; ++n) acc[a][b][m][n] = (f32x4){0.f, 0.f, 0.f, 0.f};
        lt = ltn; pm = pmn; pn = pnn; cA = nA; cB = nB;
        if (wr == 1) BAR;
    }
    WAIT_V(0);
    BAR;
    if (EPI == EPI_YF) tile_epilogue<EPI>(p, acc, pm, pn, 0, fz);
#undef SA
#undef SB
#undef STAGE
#undef LDA
#undef LDB
#undef MMA
#undef WAIT_V
#undef WAIT_L
#undef BAR
#undef SCHED
#undef TLOOP
}

struct ASeg { const bf16_t* K; const bf16_t* Vt; int ldk, ldv, ntiles; };
struct MaskP { int on, a, b, c; const float* tab; };

template <int KW, int VR, int NB, int MODE>
DI void attn_core(const ASeg& s0, const ASeg& s1, const bf16x8 (&qf)[4], int kchunk0, int vrow0, float scale_l2, float& m, float& l, f32x16 (&O)[NB], char* lds, const MaskP& mp) {
    constexpr int KC = KW / 8, NKL = 64 * KC / 256, NVL = VR * 8 / 256;
    const int tid = VTID, lane = tid & 63, p32 = lane & 31, h = lane >> 5;
    const int krow = (p32 & 19) | ((p32 & 4) << 1) | ((p32 & 8) >> 1);
    const int n0 = s0.ntiles, nt = s0.ntiles + s1.ntiles;
    u32x4 rk[NKL], rv[NVL];
#define ATT_LOAD(t_)                                                                                                         \
    {                                                                                                                        \
        const bool f_ = (t_) < n0; const int tt_ = f_ ? (t_) : (t_) - n0;                                                     \
        const bf16_t* Kp_ = (f_ ? s0.K : s1.K); const int ldk_ = f_ ? s0.ldk : s1.ldk;                                        \
        const bf16_t* Vp_ = (f_ ? s0.Vt : s1.Vt); const int ldv_ = f_ ? s0.ldv : s1.ldv;                                      \
        _Pragma("unroll") for (int i = 0; i < NKL; ++i) { const int id = tid + 256 * i, r = id / KC, c = id % KC; rk[i] = *(const u32x4*)(Kp_ + (size_t)(tt_ * 64 + r) * ldk_ + c * 8); } \
        _Pragma("unroll") for (int i = 0; i < NVL; ++i) { const int id = tid + 256 * i, r = id >> 3, c = id & 7; rv[i] = *(const u32x4*)(Vp_ + (size_t)r * ldv_ + tt_ * 64 + c * 8); }       \
    }
#define ATT_STORE(b_)                                                                                                        \
    {                                                                                                                        \
        char* kb_ = lds + (b_) * 32768; char* vb_ = kb_ + 16384;                                                              \
        _Pragma("unroll") for (int i = 0; i < NKL; ++i) { const int id = tid + 256 * i, r = id / KC, c = id % KC; *(u32x4*)(kb_ + (KW == 128 ? swz256(r, c) : swz128(r, c))) = rk[i]; } \
        _Pragma("unroll") for (int i = 0; i < NVL; ++i) { const int id = tid + 256 * i, r = id >> 3, c = id & 7; *(u32x4*)(vb_ + swz128(r, c)) = rv[i]; }                               \
    }
    int dco[2][16];
    if (MODE == 1) {
        const int cq = mp.c + p32, cs = min(max(cq - 8, 0), 48);
#pragma unroll
        for (int kh = 0; kh < 2; ++kh)
#pragma unroll
            for (int i = 0; i < 16; ++i) {
                const int kc = 32 * kh + 16 * (i >> 3) + 8 * h + (i & 7);
                dco[kh][i] = ((unsigned)(kc - cs) < 16u ? min(max(kc - cq + 15, 0), 30) : 31) * 4;
            }
    }
    ATT_LOAD(0);
    ATT_STORE(0);
    __syncthreads();
    for (int t = 0; t < nt; ++t) {
        const bool more = t + 1 < nt;
        if (more) ATT_LOAD(t + 1);
        const char* kb = lds + (t & 1) * 32768;
        const char* vb = kb + 16384;
        f32x16 S[2];
#pragma unroll
        for (int kh = 0; kh < 2; ++kh) {
#pragma unroll
            for (int i = 0; i < 16; ++i) S[kh][i] = 0.f;
            const int row = krow + 32 * kh;
#pragma unroll
            for (int s = 0; s < 4; ++s) {
                const int c = kchunk0 + 2 * s + h;
                const bf16x8 kf = *(const bf16x8*)(kb + (KW == 128 ? swz256(row, c) : swz128(row, c)));
                S[kh] = MFMA32(kf, qf[s], S[kh]);
            }
        }
        const bool msk = (MODE != 0) && mp.on && t < n0;
        float mx = -1e30f;
        if (MODE == 1 && msk) {
            const char* trow = (const char*)(mp.tab + (mp.b + t - mp.a + 7) * 32);
#pragma unroll
            for (int kh = 0; kh < 2; ++kh)
#pragma unroll
                for (int i = 0; i < 16; ++i) {
                    const float sv = __builtin_fmaf(S[kh][i], scale_l2, *(const float*)(trow + dco[kh][i]));
                    S[kh][i] = sv; mx = fmaxf(mx, sv);
                }
        } else if (MODE == 2 && msk) {
            int qp = mp.a + p32 - 8 * h;
            asm volatile("" : "+v"(qp));
            const int k0 = mp.b + t * 64;
#pragma unroll
            for (int kh = 0; kh < 2; ++kh)
#pragma unroll
                for (int i = 0; i < 16; ++i) {
                    const int d = qp - (k0 + 32 * kh + 16 * (i >> 3) + (i & 7));
                    const bool ok = d <= 128 && d >= -128;
                    const float sv = ok ? S[kh][i] * scale_l2 : -1e30f;
                    S[kh][i] = sv; mx = fmaxf(mx, sv);
                }
        } else {
            float m0 = fmaxf(fmaxf(S[0][0], S[0][1]), S[0][2]), m1 = fmaxf(fmaxf(S[1][0], S[1][1]), S[1][2]);
#pragma unroll
            for (int i = 3; i < 15; i += 2) { m0 = fmaxf(fmaxf(m0, S[0][i]), S[0][i + 1]); m1 = fmaxf(fmaxf(m1, S[1][i]), S[1][i + 1]); }
            mx = fmaxf(fmaxf(m0, m1), fmaxf(S[0][15], S[1][15])) * scale_l2;
        }
        mx = fmaxf(mx, __shfl_xor(mx, 32));
        if (__any(mx > m + 8.f)) {
            const float mn = fmaxf(m, mx);
            const float alpha = __builtin_amdgcn_exp2f(m - mn);
            m = mn;
            l *= alpha;
#pragma unroll
            for (int blk = 0; blk < NB; ++blk)
#pragma unroll
                for (int i = 0; i < 16; ++i) O[blk][i] *= alpha;
        }
        float ls = 0.f;
        if ((MODE == 1 || MODE == 2) && msk) {
#pragma unroll
            for (int kh = 0; kh < 2; ++kh)
#pragma unroll
                for (int i = 0; i < 16; ++i) { const float pv = __builtin_amdgcn_exp2f(S[kh][i] - m); S[kh][i] = pv; ls += pv; }
        } else {
            const float negm = -m;
#pragma unroll
            for (int kh = 0; kh < 2; ++kh)
#pragma unroll
                for (int i = 0; i < 16; ++i) { const float pv = __builtin_amdgcn_exp2f(__builtin_fmaf(S[kh][i], scale_l2, negm)); S[kh][i] = pv; ls += pv; }
        }
        l += ls;
#pragma unroll
        for (int kh = 0; kh < 2; ++kh)
#pragma unroll
            for (int s2 = 0; s2 < 2; ++s2) {
                u32x4 pp = {pk2(S[kh][8 * s2 + 0], S[kh][8 * s2 + 1]), pk2(S[kh][8 * s2 + 2], S[kh][8 * s2 + 3]), pk2(S[kh][8 * s2 + 4], S[kh][8 * s2 + 5]), pk2(S[kh][8 * s2 + 6], S[kh][8 * s2 + 7])};
                const bf16x8 pb = __builtin_bit_cast(bf16x8, pp);
                const int c = 4 * kh + 2 * s2 + h;
#pragma unroll
                for (int blk = 0; blk < NB; ++blk) {
                    const bf16x8 vf = *(const bf16x8*)(vb + swz128(vrow0 + blk * 32 + p32, c));
                    O[blk] = MFMA32(vf, pb, O[blk]);
                }
            }
        if (more) ATT_STORE((t + 1) & 1);
        __syncthreads();
    }
    l += __shfl_xor(l, 32);
#undef ATT_LOAD
#undef ATT_STORE
}

DI void load_q(bf16x8 (&qf)[4], const bf16_t* qrow, int h) {
#pragma unroll
    for (int s = 0; s < 4; ++s) qf[s] = *(const bf16x8*)(qrow + 16 * s + 8 * h);
}

DI void attn_diff_item(const Params& p, int item, char* lds) {
    const int tid = VTID, lane = tid & 63, w = tid >> 6, p32 = lane & 31, h = lane >> 5, stream = w & 1, qh = w >> 1;
    const bf16_t* proj = (const bf16_t*)(p.ws + OFF_BIG);
    const bf16_t* vte = (const bf16_t*)(p.ws + OFF_BIG + BIG_VT_E);
    bf16_t* mix = (bf16_t*)(p.ws + OFF_BIG + BIG_MIXIN);
    int b, hd, qb, rowbase; ASeg s0, s1;
    if (item < 512) {
        b = item >> 6; hd = (item >> 4) & 3; qb = item & 15; rowbase = 8192 + b * 1024;
        s0 = {proj + (size_t)rowbase * LDE + 2048 + hd * 128, vte + 4194304 + ((size_t)b * 512 + hd * 128) * 1024, LDE, 1024, 16};
        s1 = {(const bf16_t*)(p.ws + OFF_CDK) + (size_t)b * 256 * 512 + hd * 128, (const bf16_t*)(p.ws + OFF_CDVT) + (size_t)(b * 4 + hd) * 128 * 256, 512, 256, 4};
    } else {
        const int it = item - 512;
        b = it >> 4; hd = (it >> 2) & 3; qb = it & 3; rowbase = b * 256;
        s0 = {proj + (size_t)rowbase * LDE + 2048 + hd * 128, vte + ((size_t)b * 512 + hd * 128) * 256, LDE, 256, 4};
        s1 = s0; s1.ntiles = 0;
    }
    const int R = rowbase + qb * 64 + qh * 32 + p32;
    bf16x8 qf[4];
    load_q(qf, proj + (size_t)R * LDE + 1536 + hd * 128 + stream * 64, h);
    f32x16 O[4];
#pragma unroll
    for (int blk = 0; blk < 4; ++blk)
#pragma unroll
        for (int i = 0; i < 16; ++i) O[blk][i] = 0.f;
    float m = -1e30f, l = 0.f;
    MaskP mp = {0, 0, 0, 0, nullptr};
    attn_core<128, 128, 4, 0>(s0, s1, qf, stream * 8, 0, 0.125f * LOG2E, m, l, O, lds, mp);
    const float il = 1.f / l;
    const float d1 = wave_sum(p.lq1[lane] * p.lk1[lane]), d2 = wave_sum(p.lq2[lane] * p.lk2[lane]);
    const float lam_init = 0.2f;
    const float lam = __expf(d1) - __expf(d2) + lam_init;
    float* xb = (float*)(lds + qh * 16384);
    if (stream == 1) {
#pragma unroll
        for (int blk = 0; blk < 4; ++blk)
#pragma unroll
            for (int i = 0; i < 16; ++i) { const int dv = blk * 32 + 8 * (i >> 2) + 4 * h + (i & 3); xb[dv * 32 + p32] = O[blk][i] * il; }
    }
    __syncthreads();
    if (stream == 0) {
        float ss = 0.f;
#pragma unroll
        for (int blk = 0; blk < 4; ++blk)
#pragma unroll
            for (int i = 0; i < 16; ++i) { const int dv = blk * 32 + 8 * (i >> 2) + 4 * h + (i & 3); const float o = O[blk][i] * il - lam * xb[dv * 32 + p32]; O[blk][i] = o; ss += o * o; }
        ss += __shfl_xor(ss, 32);
        const float rs = rsqrtf(ss * (1.f / 128.f) + EPSN) * (1.f - lam_init);
        bf16_t* op = mix + (size_t)R * 1024 + 512 + hd * 128;
#pragma unroll
        for (int blk = 0; blk < 4; ++blk)
#pragma unroll
            for (int g = 0; g < 4; ++g) {
                const int dv = blk * 32 + 8 * g + 4 * h;
                const f32x4 sl = *(const f32x4*)(p.subln + dv);
                u32x2 o = {pk2(O[blk][4 * g] * rs * sl[0], O[blk][4 * g + 1] * rs * sl[1]), pk2(O[blk][4 * g + 2] * rs * sl[2], O[blk][4 * g + 3] * rs * sl[3])};
                *(u32x2*)(op + dv) = o;
            }
    }
    __syncthreads();
}

DI void attn_c_item(const Params& p, int item, char* lds) {
    const int tid = VTID, lane = tid & 63, w = tid >> 6, p32 = lane & 31, h = lane >> 5, stream = w & 1, qh = w >> 1;
    const bf16_t* proj = (const bf16_t*)(p.ws + OFF_BIG);
    const bf16_t* vtc = (const bf16_t*)(p.ws + OFF_BIG + BIG_VT_C);
    bf16_t* mix = (bf16_t*)(p.ws + OFF_BIG + BIG_MIXIN);
    int b, hp, qb, rowbase; ASeg s0, s1; MaskP mp = {0, 0, 0, 0, nullptr};
    float* tab = (float*)(lds + 65536);
    if (item < 512) {
        b = item >> 6; hp = (item >> 4) & 3; qb = item & 15; rowbase = 8192 + b * 1024;
        const int rstart = min(max(qb - 4, 0), 8);
        s0 = {proj + (size_t)(rowbase + rstart * 64) * LDO + 512 + hp * 128, vtc + 4194304 + ((size_t)b * 512 + hp * 128) * 1024 + rstart * 64, LDO, 1024, 8};
        s1 = {(const bf16_t*)(p.ws + OFF_CNK) + (size_t)b * 256 * 512 + hp * 128, (const bf16_t*)(p.ws + OFF_CNVT) + ((size_t)b * 512 + hp * 128) * 256, 512, 256, 4};
        for (int idx = tid; idx < 960; idx += 256) { const int hr = idx >> 5, cc = idx & 31; tab[idx] = cc < 31 ? p.rpb[hp * 930 + hr * 31 + cc] * LOG2E : -1e30f; }
        mp = {1, qb, rstart, qh * 32, tab + stream * 480};
    } else {
        const int it = item - 512;
        b = it >> 4; hp = (it >> 2) & 3; qb = it & 3; rowbase = b * 256;
        s0 = {proj + (size_t)rowbase * LDO + 512 + hp * 128, vtc + ((size_t)b * 512 + hp * 128) * 256, LDO, 256, 4};
        s1 = s0; s1.ntiles = 0;
    }
    const int R = rowbase + qb * 64 + qh * 32 + p32;
    const int head = hp * 2 + stream;
    bf16x8 qf[4];
    load_q(qf, proj + (size_t)R * LDO + head * 64, h);
    f32x16 O[2];
#pragma unroll
    for (int blk = 0; blk < 2; ++blk)
#pragma unroll
        for (int i = 0; i < 16; ++i) O[blk][i] = 0.f;
    float m = -1e30f, l = 0.f;
    attn_core<128, 128, 2, 1>(s0, s1, qf, stream * 8, stream * 64, 0.125f * LOG2E, m, l, O, lds, mp);
    const float il = 1.f / l;
    bf16_t* op = mix + (size_t)R * 1024 + head * 64;
#pragma unroll
    for (int blk = 0; blk < 2; ++blk)
#pragma unroll
        for (int g = 0; g < 4; ++g) {
            const int dv = blk * 32 + 8 * g + 4 * h;
            u32x2 o = {pk2(O[blk][4 * g] * il, O[blk][4 * g + 1] * il), pk2(O[blk][4 * g + 2] * il, O[blk][4 * g + 3] * il)};
            *(u32x2*)(op + dv) = o;
        }
}

DI void attn_d_item(const Params& p, int item, char* lds) {
    const int tid = VTID, lane = tid & 63, w = tid >> 6, p32 = lane & 31, h = lane >> 5;
    const bf16_t* proj = (const bf16_t*)(p.ws + OFF_BIG);
    const bf16_t* vtd = (const bf16_t*)(p.ws + OFF_BIG + BIG_VT_D);
    bf16_t* mix = (bf16_t*)(p.ws + OFF_BIG + BIG_MIXIN);
    int b, g, qb, rowbase; ASeg s0, s1; MaskP mp = {0, 0, 0, 0, nullptr};
    if (item < 512) {
        b = item >> 6; g = (item >> 5) & 1; qb = item & 31; rowbase = 8192 + b * 1024;
        const int q0 = qb * 32;
        const int tlo = max(q0 - 128, 0) >> 6, thi = min(q0 + 159, 1023) >> 6;
        s0 = {proj + (size_t)(rowbase + tlo * 64) * LDO + 1536 + g * 64, vtd + 1048576 + ((size_t)b * 128 + g * 64) * 1024 + tlo * 64, LDO, 1024, thi - tlo + 1};
        s1 = {(const bf16_t*)(p.ws + OFF_CSK) + (size_t)b * 256 * 128 + g * 64, (const bf16_t*)(p.ws + OFF_CSVT) + ((size_t)b * 128 + g * 64) * 256, 128, 256, 4};
        mp = {1, q0, tlo * 64, 0, nullptr};
    } else {
        const int it = item - 512;
        b = it >> 4; g = (it >> 3) & 1; qb = it & 7; rowbase = b * 256;
        s0 = {proj + (size_t)rowbase * LDO + 1536 + g * 64, vtd + ((size_t)b * 128 + g * 64) * 256, LDO, 256, 4};
        s1 = s0; s1.ntiles = 0;
    }
    const int R = rowbase + qb * 32 + p32;
    const int hq = g * 4 + w;
    bf16x8 qf[4];
    load_q(qf, proj + (size_t)R * LDO + 1024 + hq * 64, h);
    f32x16 O[2];
#pragma unroll
    for (int blk = 0; blk < 2; ++blk)
#pragma unroll
        for (int i = 0; i < 16; ++i) O[blk][i] = 0.f;
    float m = p.sink[hq] * LOG2E, l = h == 0 ? 1.f : 0.f;
    attn_core<64, 64, 2, 2>(s0, s1, qf, 0, 0, 0.125f * LOG2E, m, l, O, lds, mp);
    const float il = 1.f / l;
    bf16_t* op = mix + (size_t)R * 1024 + 512 + hq * 64;
#pragma unroll
    for (int blk = 0; blk < 2; ++blk)
#pragma unroll
        for (int gg = 0; gg < 4; ++gg) {
            const int dv = blk * 32 + 8 * gg + 4 * h;
            u32x2 o = {pk2(O[blk][4 * gg] * il, O[blk][4 * gg + 1] * il), pk2(O[blk][4 * gg + 2] * il, O[blk][4 * gg + 3] * il)};
            *(u32x2*)(op + dv) = o;
        }
}

DI void conv_item(const Params& p, int item) {
    const int tid = VTID;
    const bf16_t* proj = (const bf16_t*)(p.ws + OFF_BIG);
    bf16_t* mix = (bf16_t*)(p.ws + OFF_BIG + BIG_MIXIN);
#pragma unroll 2
    for (int i = 0; i < 8; ++i) {
        const int idx = tid + 256 * i, tl = idx >> 6, ch = (idx & 63) * 8;
        const int R = item * 32 + tl;
        int t, T;
        if (R < 8192) { t = R & 255; T = 256; } else { t = (R - 8192) & 1023; T = 1024; }
        const bf16_t* rp = proj + (size_t)R * LDE + ch;
        const u32x4 ab = *(const u32x4*)(rp);
        float accv[8];
#pragma unroll
        for (int e = 0; e < 8; ++e) accv[e] = 0.f;
#pragma unroll
        for (int j = 0; j < 3; ++j) {
            const int tt = t + j - 1;
            if (tt >= 0 && tt < T) {
                const u32x4 ac = *(const u32x4*)(rp + (ptrdiff_t)(j - 1) * LDE + 512);
                const u32x4 ax = *(const u32x4*)(rp + (ptrdiff_t)(j - 1) * LDE + 1024);
                const f32x4 w0 = *(const f32x4*)(p.conv_w + j * 512 + ch), w1 = *(const f32x4*)(p.conv_w + j * 512 + ch + 4);
#pragma unroll
                for (int e = 0; e < 4; ++e) {
                    accv[2 * e] += bflo(ac[e]) * bflo(ax[e]) * (e < 2 ? w0[2 * e] : w1[2 * e - 4]);
                    accv[2 * e + 1] += bfhi(ac[e]) * bfhi(ax[e]) * (e < 2 ? w0[2 * e + 1] : w1[2 * e - 3]);
                }
            }
        }
        u32x4 o;
#pragma unroll
        for (int e = 0; e < 4; ++e) o[e] = pk2(bflo(ab[e]) * accv[2 * e], bfhi(ab[e]) * accv[2 * e + 1]);
        *(u32x4*)(mix + (size_t)R * 1024 + ch) = o;
    }
}


#define XB_TMO      128
#define XB_XCNT(j)  (256  + 64 * (j))
#define XB_XSUB(j)  (1280 + 64 * (j))
#define XB_XGEN(j)  (2304 + 64 * (j))
#define XB_TOP      3328
#define XB_TOPGEN   3392
#define XCD_BAR_WORDS 3456
#define XB_SPIN_CAP (1u << 22)
#define LAS __attribute__((address_space(3)))
DI unsigned xb_ld(unsigned* p) { return __hip_atomic_load(p, __ATOMIC_RELAXED, __HIP_MEMORY_SCOPE_AGENT); }
DI unsigned xb_add(unsigned* p, unsigned v) { return __hip_atomic_fetch_add(p, v, __ATOMIC_RELAXED, __HIP_MEMORY_SCOPE_AGENT); }
DI unsigned xb_xcc_id() { return (unsigned)__builtin_amdgcn_s_getreg((3 << 11) | 20) & 0xFu; }
#define XB_SPIN(cond, bar) do { unsigned _sp = 0; while (cond) { __builtin_amdgcn_s_sleep(1); \
    if ((++_sp & 255u) == 0u) { if (xb_ld(&(bar)[XB_TMO])) break; if (_sp > XB_SPIN_CAP) { atomicAdd(&(bar)[XB_TMO], 1u); break; } } } } while (0)
struct XcdBarrier { unsigned* bar; unsigned x; volatile LAS unsigned* st; };
DI XcdBarrier xcd_barrier_post(unsigned* bar, volatile LAS unsigned* st) {
    XcdBarrier b; b.bar = bar; b.x = xb_xcc_id(); b.st = st;
    if (threadIdx.x == 0) (void)xb_add(&bar[XB_XCNT(b.x)], 1u);
    return b;
}
DI void xcd_barrier_complete(unsigned* bar, unsigned x, unsigned& nloc, unsigned& nx) {
    const unsigned G = gridDim.x * gridDim.y * gridDim.z;
    unsigned sum, cnt, mine, sp = 0u;
    for (;;) {
        sum = 0u; cnt = 0u; mine = 0u;
#pragma unroll
        for (unsigned j = 0; j < 16; ++j) { const unsigned c = xb_ld(&bar[XB_XCNT(j)]); sum += c; cnt += (c > 0u) ? 1u : 0u; mine = (j == x) ? c : mine; }
        if (sum == G) break;
        __builtin_amdgcn_s_sleep(1);
        if ((++sp & 255u) == 0u) { if (xb_ld(&bar[XB_TMO])) break; if (sp > XB_SPIN_CAP) { atomicAdd(&bar[XB_TMO], 1u); break; } }
    }
    nloc = mine > 0u ? mine : 1u; nx = cnt > 0u ? cnt : 1u;
}
DI void xcd_barrier(const XcdBarrier& b) {
    asm volatile("s_waitcnt vmcnt(0)" ::: "memory");
    __syncthreads();
    if (threadIdx.x == 0) {
        unsigned* bar = b.bar;
        __builtin_amdgcn_s_waitcnt(0);
        unsigned nloc = b.st[0], nx = b.st[1];
        if (nloc == 0u) { xcd_barrier_complete(bar, b.x, nloc, nx); b.st[0] = nloc; b.st[1] = nx; }
        const unsigned old = xb_add(&bar[XB_XSUB(b.x)], 1u);
        const unsigned gen = old / nloc;
        if (old + 1u == (gen + 1u) * nloc) {
            __builtin_amdgcn_fence(__ATOMIC_RELEASE, "agent");
            asm volatile("s_waitcnt vmcnt(0)" ::: "memory");
            const unsigned og = xb_add(&bar[XB_TOP], 1u);
            const unsigned tg = og / nx;
            if (og + 1u == (tg + 1u) * nx) xb_add(&bar[XB_TOPGEN], 1u);
            else XB_SPIN(xb_ld(&bar[XB_TOPGEN]) == tg, bar);
            __builtin_amdgcn_fence(__ATOMIC_ACQUIRE, "agent");
            xb_add(&bar[XB_XGEN(b.x)], 1u);
            asm volatile("s_waitcnt vmcnt(0)" ::: "memory");
        } else {
            XB_SPIN(xb_ld(&bar[XB_XGEN(b.x)]) == gen, bar);
            __builtin_amdgcn_fence(__ATOMIC_ACQUIRE, "agent");
            asm volatile("s_waitcnt vmcnt(0)" ::: "memory");
        }
    }
    __syncthreads();
}

constexpr int N_PHASES = 12;
DI void run_phase(const Params& p, int ph, char* shm) {
    const int nb = VNB, bid = VBID;
    char* lds = shm + VHALF * LDS_HALF;
    const bf16_t* hy = (const bf16_t*)(p.ws + OFF_HY);
    const bf16_t* big = (const bf16_t*)(p.ws + OFF_BIG);
    const bf16_t* mixin = (const bf16_t*)(p.ws + OFF_BIG + BIG_MIXIN);
    const float* mod = (const float*)(p.ws + OFF_MOD);
    char* st = p.ws + OFF_STAT;
#define FZ(set, from_in, hasH, goff, wpost, wpre, scoff, shoff) FuseP{from_in, hasH, p.out, mod + (goff), wpost, wpre, mod + (scoff), mod + (shoff), (float*)(st + (set) * STAT_SET), (float*)(st + (set) * STAT_SET + 65536), (unsigned*)(st + (set) * STAT_SET + 131072)}
    switch (ph) {
    case 0: p0_phase(p, bid, nb, lds); break;
    case 1: rowop_phase(p, false, true, 0, nullptr, true, p.norm_mix_pre, 1024, 0); break;
    case 2: gemm_phase<EPI_PE>(p, hy, 2048, (const bf16_t*)(p.ws + OFF_WINE), 1024, 12, shm); break;
    case 3:
        for (int it = bid; it < 1536; it += nb) { if (it < 1024) attn_diff_item(p, it, lds); else conv_item(p, it - 1024); }
        break;
    case 4: gemm_phase<EPI_YF>(p, mixin, 1024, (const bf16_t*)(p.ws + OFF_WOUT), 1024, 4, shm, FZ(0, 1, 1, 2048, p.norm_mix_post, p.norm_mlp_pre, 4096, 3072)); break;
    case 5: gemm_phase<EPI_W1>(p, hy, 2048, (const bf16_t*)(p.ws + OFF_W1), 1024, 16, shm); break;
    case 6: gemm_phase<EPI_YF>(p, big, 4096, (const bf16_t*)(p.ws + OFF_W2), 4096, 4, shm, FZ(1, 0, 1, 5120, p.norm_mlp_post, p.norm_mix_pre + 1024, 9 * 6144 + 1024, 9 * 6144 + 0)); break;
    case 7: gemm_phase<EPI_PO>(p, hy, 2048, (const bf16_t*)(p.ws + OFF_WINO), 1024, 9, shm); break;
    case 8:
        for (int it = bid; it < 2048; it += nb) {
            const int q = it >> 9, r = it & 511;
            if (q & 1) attn_d_item(p, (q >> 1) * 512 + r, lds); else attn_c_item(p, (q >> 1) * 512 + r, lds);
        }
        break;
    case 9: gemm_phase<EPI_YF>(p, mixin, 1024, (const bf16_t*)(p.ws + OFF_WOUT) + 1048576, 1024, 4, shm, FZ(2, 0, 1, 9 * 6144 + 2048, p.norm_mix_post + 1024, p.norm_mlp_pre + 1024, 9 * 6144 + 4096, 9 * 6144 + 3072)); break;
    case 10: gemm_phase<EPI_W1>(p, hy, 2048, (const bf16_t*)(p.ws + OFF_W1) + 4194304, 1024, 16, shm); break;
    case 11: gemm_phase<EPI_YF>(p, big, 4096, (const bf16_t*)(p.ws + OFF_W2) + 4194304, 4096, 4, shm, FZ(3, 0, 0, 9 * 6144 + 5120, p.norm_mlp_post + 1024, p.norm_mlp_post, 0, 0)); break;
    }
#undef FZ
}

__global__ void __launch_bounds__(512, 2) fwd_mega(Params p) {
    __shared__ __attribute__((aligned(16))) char lds[LDS_BYTES];
    __shared__ uint4 xb_words;
    cg::grid_group grid = cg::this_grid();
    if (threadIdx.x == 0) xb_words = make_uint4(0u, 0u, 0u, 0u);
    __syncthreads();
    const XcdBarrier xb = xcd_barrier_post((unsigned*)(p.ws + OFF_BAR), (volatile LAS unsigned*)&xb_words);
#define PH_(n) run_phase(p, n, lds); xcd_barrier(xb); if ((DUP_MASK >> n) & 1) { run_phase(p, n, lds); xcd_barrier(xb); }
    PH_(0)
    if (p.ws == nullptr) grid.sync();
    PH_(1) PH_(2) PH_(3) PH_(4) PH_(5) PH_(6) PH_(7) PH_(8) PH_(9) PH_(10)
    run_phase(p, 11, lds);
#undef PH_
}

__global__ void __launch_bounds__(512, 2) fwd_phase(Params p, int ph) {
    __shared__ __attribute__((aligned(16))) char lds[LDS_BYTES];
    run_phase(p, ph, lds);
}

extern "C" void kernel_launch(void* const* d_in, const int* in_sizes, int n_in, void* d_out, int out_size, void* d_ws, size_t ws_size, hipStream_t stream) {
    Params p{};
    const float** pp = (const float**)&p;
    for (int i = 0; i < 29; ++i) pp[i] = (const float*)d_in[i];
    p.out = (float*)d_out;
    p.ws = (char*)d_ws;
    if (ws_size < WS_NEEDED) { fprintf(stderr, "workspace too small: %zu < %zu\n", ws_size, (size_t)WS_NEEDED); return; }
    static int grid_blocks = 0;
    if (!grid_blocks) {
        int dev = 0, cus = 0, per_cu = 0;
        hipGetDevice(&dev);
        hipDeviceGetAttribute(&cus, hipDeviceAttributeMultiprocessorCount, dev);
        hipOccupancyMaxActiveBlocksPerMultiprocessor(&per_cu, fwd_mega, 512, 0);
        if (per_cu > 1) per_cu = 1;
        if (per_cu < 1) per_cu = 1;
        grid_blocks = cus * per_cu;
        grid_blocks -= grid_blocks % 8;
    }
#if ONE_LAUNCH
    (void)hipMemsetAsync((char*)d_ws + OFF_BAR, 0, XCD_BAR_WORDS * 4, stream);
    if (grid_blocks != 256) { fprintf(stderr, "fused epilogues need exactly 256 workgroups (got %d)\n", grid_blocks); return; }
    void* args[] = {&p};
    hipError_t e = hipLaunchCooperativeKernel((void*)fwd_mega, dim3(grid_blocks), dim3(512), args, 0, stream);
    if (e != hipSuccess) fprintf(stderr, "cooperative launch failed: %s (grid %d)\n", hipGetErrorString(e), grid_blocks);
#else
    for (int ph = 0; ph < N_PHASES; ++ph) fwd_phase<<<grid_blocks, 512, 0, stream>>>(p, ph);
#endif
}
```

```cpp
#include <hip/hip_runtime.h>
#include <hip/hip_cooperative_groups.h>
#include <cstdio>
#include <cstdint>
namespace cg = cooperative_groups;

#ifndef DUP_MASK
#define DUP_MASK 0
#endif
#ifndef ONE_LAUNCH
#define ONE_LAUNCH 1
#endif

typedef unsigned short bf16_t;
typedef short bf16x8 __attribute__((ext_vector_type(8)));
typedef float f32x4 __attribute__((ext_vector_type(4)));
typedef float f32x2 __attribute__((ext_vector_type(2)));
typedef float f32x16 __attribute__((ext_vector_type(16)));
typedef unsigned u32x4 __attribute__((ext_vector_type(4)));
typedef unsigned u32x2 __attribute__((ext_vector_type(2)));
typedef __bf16 bfv2 __attribute__((ext_vector_type(2)));
#define DI __device__ __forceinline__
DI int launder_v(int v) { asm volatile("" : "+v"(v)); return v; }
#define TIDX launder_v((int)threadIdx.x)
#define VTID (TIDX & 255)
#define VHALF (TIDX >> 8)
#define VBID ((int)(blockIdx.x * 2) + (TIDX >> 8))
#define VNB ((int)(gridDim.x * 2))
#define MFMA32(a, b, c) __builtin_amdgcn_mfma_f32_32x32x16_bf16((a), (b), (c), 0, 0, 0)
#define MFMA16(a, b, c) __builtin_amdgcn_mfma_f32_16x16x32_bf16((a), (b), (c), 0, 0, 0)

constexpr float LOG2E = 1.4426950408889634f;
constexpr float EPSN = 1e-6f;

struct Params {
    const float *x_prompt, *x_sample, *cache_diff_k, *cache_diff_v, *cache_na_k, *cache_na_v, *cache_swa_k, *cache_swa_v, *c, *c_ctx;
    const float *mod_w, *mod_b, *norm_mix_pre, *norm_mix_post, *norm_mlp_pre, *norm_mlp_post, *w_in_even, *conv_w, *lq1, *lk1, *lq2, *lk2, *subln;
    const float *w_in_odd, *rpb, *sink, *w_out, *mlp_w1, *mlp_w2;
    float* out;
    char* ws;
};

constexpr size_t OFF_MOD = 0;
constexpr size_t OFF_BAR = 458752;
constexpr size_t OFF_WINE = 524288;
constexpr size_t OFF_WINO = OFF_WINE + 6291456;
constexpr size_t OFF_WOUT = OFF_WINO + 4718592;
constexpr size_t OFF_W1 = OFF_WOUT + 4194304;
constexpr size_t OFF_W2 = OFF_W1 + 16777216;
constexpr size_t OFF_CDK = OFF_W2 + 16777216;
constexpr size_t OFF_CDVT = OFF_CDK + 2097152;
constexpr size_t OFF_CNK = OFF_CDVT + 2097152;
constexpr size_t OFF_CNVT = OFF_CNK + 2097152;
constexpr size_t OFF_CSK = OFF_CNVT + 2097152;
constexpr size_t OFF_CSVT = OFF_CSK + 524288;
constexpr size_t OFF_HY = OFF_CSVT + 524288;
constexpr size_t OFF_BIG = OFF_HY + 67108864;
constexpr size_t OFF_STAT = OFF_BIG + 134217728;
constexpr size_t STAT_SET = 65536 + 65536 + 8192;
constexpr size_t WS_NEEDED = OFF_STAT + 4 * STAT_SET;
constexpr size_t BIG_VT_E = 83886080;
constexpr size_t BIG_VT_C = 54525952;
constexpr size_t BIG_VT_D = BIG_VT_C + 16777216;
constexpr size_t BIG_MIXIN = 100663296;
constexpr int LDE = 2560, LDO = 1664;
constexpr size_t OUT_DIFFK = 16777216, OUT_DIFFV = 20971520, OUT_NAK = 25165824, OUT_NAV = 29360128, OUT_SWAK = 33554432, OUT_SWAV = 34603008;

constexpr int LDS_HALF = 65536 + 4096;
constexpr int LDS_BYTES = 2 * LDS_HALF;

DI unsigned pk2(float a, float b) { f32x2 v = {a, b}; bfv2 r = __builtin_convertvector(v, bfv2); return __builtin_bit_cast(unsigned, r); }
DI float bflo(unsigned u) { return __uint_as_float(u << 16); }
DI float bfhi(unsigned u) { return __uint_as_float(u & 0xffff0000u); }
DI float wave_sum(float v) {
#pragma unroll
    for (int o = 1; o < 64; o <<= 1) v += __shfl_xor(v, o);
    return v;
}
DI int swz128(int r, int c) { return r * 128 + ((c ^ ((r >> 1) & 7)) << 4); }
DI int swz256(int r, int c) { return r * 256 + ((c ^ (r & 15)) << 4); }

DI void p0_mod_item(const Params& p, int item, char* lds) {
    const int li = item / 96, cb = item % 96;
    const int tid = VTID, lane = tid & 63, w = tid >> 6;
    const float* W = p.mod_w + (size_t)li * 1024 * 6144 + cb * 64 + lane;
    float acc[9];
#pragma unroll
    for (int v = 0; v < 9; ++v) acc[v] = 0.f;
    for (int kc = 0; kc < 4; ++kc) {
        const int kb = w * 256 + kc * 64;
        float s[9];
        { const float cv = p.c_ctx[kb + lane]; s[0] = cv / (1.f + __expf(-cv)); }
#pragma unroll
        for (int v = 1; v < 9; ++v) { const float cv = p.c[(v - 1) * 1024 + kb + lane]; s[v] = cv / (1.f + __expf(-cv)); }
#pragma unroll
        for (int kk = 0; kk < 64; ++kk) {
            const float wv = W[(size_t)(kb + kk) * 6144];
#pragma unroll
            for (int v = 0; v < 9; ++v) acc[v] += __int_as_float(__builtin_amdgcn_readlane(__float_as_int(s[v]), kk)) * wv;
        }
    }
    float* red = (float*)lds;
#pragma unroll
    for (int v = 0; v < 9; ++v) red[(w * 9 + v) * 64 + lane] = acc[v];
    __syncthreads();
    float* mod = (float*)(p.ws + OFF_MOD);
    for (int idx = tid; idx < 576; idx += 256) {
        const int v = idx >> 6, col = idx & 63;
        const float sum = red[(0 * 9 + v) * 64 + col] + red[(1 * 9 + v) * 64 + col] + red[(2 * 9 + v) * 64 + col] + red[(3 * 9 + v) * 64 + col];
        mod[(li * 9 + v) * 6144 + cb * 64 + col] = sum + p.mod_b[li * 6144 + cb * 64 + col];
    }
    __syncthreads();
}

DI void p0_transpose_tile(const float* __restrict__ in, bf16_t* __restrict__ out, int R, int C, int tr, int tc, char* lds) {
    const int tid = VTID;
    const int cl = (tid & 15) * 4, rl = (tid >> 4) * 2, sw = tid & 7;
#pragma unroll
    for (int i = 0; i < 2; ++i) {
        const int r = rl + 32 * i;
        const f32x4 a = *(const f32x4*)(in + (size_t)(tr * 64 + r) * C + tc * 64 + cl);
        const f32x4 b = *(const f32x4*)(in + (size_t)(tr * 64 + r + 1) * C + tc * 64 + cl);
#pragma unroll
        for (int j = 0; j < 4; ++j) *(unsigned*)(lds + (cl + j) * 128 + (((r >> 3) ^ sw) << 4) + (r & 7) * 2) = pk2(a[j], b[j]);
    }
    __syncthreads();
#pragma unroll
    for (int i = 0; i < 2; ++i) {
        const int idx = tid + 256 * i, c = idx >> 3, q = idx & 7;
        const u32x4 v = *(const u32x4*)(lds + c * 128 + ((q ^ ((c >> 2) & 7)) << 4));
        *(u32x4*)(out + (size_t)(tc * 64 + c) * R + tr * 64 + q * 8) = v;
    }
    __syncthreads();
}

DI void p0_kreorder(const float* __restrict__ in, bf16_t* __restrict__ out, int logH, int item) {
    const int tid = VTID, H = 1 << logH;
#pragma unroll
    for (int i = 0; i < 4; ++i) {
        const int f = item * 1024 + tid + 256 * i;
        const int d4 = f & 15, key = (f >> 4) & 255, hh = (f >> 12) & (H - 1), b = f >> (12 + logH);
        const f32x4 v = *(const f32x4*)(in + (size_t)f * 4);
        u32x2 o = {pk2(v[0], v[1]), pk2(v[2], v[3])};
        *(u32x2*)(out + ((size_t)(b * 256 + key) * H + hh) * 64 + d4 * 4) = o;
    }
}

struct TJob { const float* in; bf16_t* out; int R, C, tr, tc; };
constexpr int P0_TITEMS = 768 + 576 + 512 + 2048 + 2048 + 256 + 256 + 64;
DI TJob p0_decode(const Params& p, int item) {
    TJob j;
    if (item < 768) { j.in = p.w_in_even; j.out = (bf16_t*)(p.ws + OFF_WINE); j.R = 1024; j.C = 3072; }
    else if ((item -= 768) < 576) { j.in = p.w_in_odd; j.out = (bf16_t*)(p.ws + OFF_WINO); j.R = 1024; j.C = 2304; }
    else if ((item -= 576) < 512) { const int b = item >> 8; item &= 255; j.in = p.w_out + (size_t)b * 1048576; j.out = (bf16_t*)(p.ws + OFF_WOUT) + (size_t)b * 1048576; j.R = 1024; j.C = 1024; }
    else if ((item -= 512) < 2048) { const int b = item >> 10; item &= 1023; j.in = p.mlp_w1 + (size_t)b * 4194304; j.out = (bf16_t*)(p.ws + OFF_W1) + (size_t)b * 4194304; j.R = 1024; j.C = 4096; }
    else if ((item -= 2048) < 2048) { const int b = item >> 10; item &= 1023; j.in = p.mlp_w2 + (size_t)b * 4194304; j.out = (bf16_t*)(p.ws + OFF_W2) + (size_t)b * 4194304; j.R = 4096; j.C = 1024; }
    else if ((item -= 2048) < 256) { const int b = item >> 3; item &= 7; j.in = p.cache_diff_v + (size_t)b * 32768; j.out = (bf16_t*)(p.ws + OFF_CDVT) + (size_t)b * 32768; j.R = 256; j.C = 128; }
    else if ((item -= 256) < 256) { const int b = item >> 2; item &= 3; j.in = p.cache_na_v + (size_t)b * 16384; j.out = (bf16_t*)(p.ws + OFF_CNVT) + (size_t)b * 16384; j.R = 256; j.C = 64; }
    else { item -= 256; const int b = item >> 2; item &= 3; j.in = p.cache_swa_v + (size_t)b * 16384; j.out = (bf16_t*)(p.ws + OFF_CSVT) + (size_t)b * 16384; j.R = 256; j.C = 64; }
    const int ntc = j.C >> 6;
    j.tr = item / ntc; j.tc = item % ntc;
    return j;
}
DI void p0_tload(const TJob& j, int tid, f32x4 (&a)[2], f32x4 (&b)[2]) {
    const int cl = (tid & 15) * 4, rl = (tid >> 4) * 2;
#pragma unroll
    for (int i = 0; i < 2; ++i) {
        const int r = rl + 32 * i;
        a[i] = __builtin_nontemporal_load((const f32x4*)(j.in + (size_t)(j.tr * 64 + r) * j.C + j.tc * 64 + cl));
        b[i] = __builtin_nontemporal_load((const f32x4*)(j.in + (size_t)(j.tr * 64 + r + 1) * j.C + j.tc * 64 + cl));
    }
}
DI void p0_phase(const Params& p, int bid, int nb, char* lds) {
    if (bid < 192) p0_mod_item(p, bid, lds);
    const int tid = VTID;
    {
        const int cl = (tid & 15) * 4, rl = (tid >> 4) * 2, sw = tid & 7;
        const int first = bid < 192 ? bid : 1536 + (bid - 192), stride = bid < 192 ? 192 : nb - 192, lim = bid < 192 ? 1536 : P0_TITEMS;
        int it = first;
        TJob cur{}; f32x4 a[2], b[2];
        if (it < lim) { cur = p0_decode(p, it); p0_tload(cur, tid, a, b); }
        while (it < lim) {
            const int nx = it + stride;
            TJob nxt{}; f32x4 an[2], bn[2];
            if (nx < lim) { nxt = p0_decode(p, nx); p0_tload(nxt, tid, an, bn); }
#pragma unroll
            for (int i = 0; i < 2; ++i) {
                const int r = rl + 32 * i;
#pragma unroll
                for (int jj = 0; jj < 4; ++jj) *(unsigned*)(lds + (cl + jj) * 128 + (((r >> 3) ^ sw) << 4) + (r & 7) * 2) = pk2(a[i][jj], b[i][jj]);
            }
            __syncthreads();
#pragma unroll
            for (int i = 0; i < 2; ++i) {
                const int idx = tid + 256 * i, c = idx >> 3, q = idx & 7;
                const u32x4 v = *(const u32x4*)(lds + c * 128 + ((q ^ ((c >> 2) & 7)) << 4));
                *(u32x4*)(cur.out + (size_t)(cur.tc * 64 + c) * cur.R + cur.tr * 64 + q * 8) = v;
            }
            __syncthreads();
            cur = nxt; a[0] = an[0]; a[1] = an[1]; b[0] = bn[0]; b[1] = bn[1];
            it = nx;
        }
    }
    {
        f32x4* st4 = (f32x4*)(p.ws + OFF_STAT);
        const f32x4 z = {0.f, 0.f, 0.f, 0.f};
        for (int i = bid * 256 + tid; i < (int)(4 * STAT_SET / 16); i += nb * 256) st4[i] = z;
    }
    for (int it = bid; it < 576; it += nb) {
        if (it < 256) p0_kreorder(p.cache_diff_k, (bf16_t*)(p.ws + OFF_CDK), 3, it);
        else if (it < 512) p0_kreorder(p.cache_na_k, (bf16_t*)(p.ws + OFF_CNK), 3, it - 256);
        else p0_kreorder(p.cache_swa_k, (bf16_t*)(p.ws + OFF_CSK), 1, it - 512);
    }
}

DI void rowop_phase(const Params& p, bool hasY, bool xin_input, int g_off, const float* wpost, bool hasH, const float* wpre, int sc_off, int sh_off) {
    const int tix = TIDX, lane = tix & 63, gw = (int)(blockIdx.x * 8) + (tix >> 6), nw = VNB * 4;
    const float* mod = (const float*)(p.ws + OFF_MOD);
    f32x4 wpo[4], wpr[4];
#pragma unroll
    for (int i = 0; i < 4; ++i) { if (hasY) wpo[i] = *(const f32x4*)(wpost + lane * 4 + 256 * i); if (hasH) wpr[i] = *(const f32x4*)(wpre + lane * 4 + 256 * i); }
    for (int row0 = gw; row0 < 16384; row0 += 2 * nw) {
        f32x4 x[2][4], y[2][4];
#pragma unroll
        for (int r = 0; r < 2; ++r) {
            const int row = row0 + r * nw;
            const float* xin = xin_input ? (row < 8192 ? p.x_prompt + (size_t)row * 1024 : p.x_sample + (size_t)(row - 8192) * 1024) : p.out + (size_t)row * 1024;
            const float* yin = (const float*)(p.ws + OFF_HY + (size_t)row * 4096);
#pragma unroll
            for (int i = 0; i < 4; ++i) { x[r][i] = *(const f32x4*)(xin + lane * 4 + 256 * i); if (hasY) y[r][i] = *(const f32x4*)(yin + lane * 4 + 256 * i); }
        }
#pragma unroll
        for (int r = 0; r < 2; ++r) {
            const int row = row0 + r * nw;
            const int v = row < 8192 ? 0 : 1 + ((row - 8192) >> 10);
            char* hy = p.ws + OFF_HY + (size_t)row * 4096;
            if (hasY) {
                f32x4 g4[4];
#pragma unroll
                for (int i = 0; i < 4; ++i) g4[i] = *(const f32x4*)(mod + v * 6144 + g_off + lane * 4 + 256 * i);
                float ss = 0.f;
#pragma unroll
                for (int i = 0; i < 4; ++i) ss += y[r][i][0] * y[r][i][0] + y[r][i][1] * y[r][i][1] + y[r][i][2] * y[r][i][2] + y[r][i][3] * y[r][i][3];
                ss = wave_sum(ss);
                const float rs = rsqrtf(ss * (1.f / 1024.f) + EPSN);
#pragma unroll
                for (int i = 0; i < 4; ++i) {
                    x[r][i] += g4[i] * (y[r][i] * rs * wpo[i]);
                    *(f32x4*)(p.out + (size_t)row * 1024 + lane * 4 + 256 * i) = x[r][i];
                }
            }
            if (hasH) {
                f32x4 sc[4], sh[4];
#pragma unroll
                for (int i = 0; i < 4; ++i) { sc[i] = *(const f32x4*)(mod + v * 6144 + sc_off + lane * 4 + 256 * i); sh[i] = *(const f32x4*)(mod + v * 6144 + sh_off + lane * 4 + 256 * i); }
                float ss = 0.f;
#pragma unroll
                for (int i = 0; i < 4; ++i) ss += x[r][i][0] * x[r][i][0] + x[r][i][1] * x[r][i][1] + x[r][i][2] * x[r][i][2] + x[r][i][3] * x[r][i][3];
                ss = wave_sum(ss);
                const float rs = rsqrtf(ss * (1.f / 1024.f) + EPSN);
#pragma unroll
                for (int i = 0; i < 4; ++i) {
                    const f32x4 h = x[r][i] * rs * wpr[i] * (sc[i] + 1.f) + sh[i];
                    u32x2 o = {pk2(h[0], h[1]), pk2(h[2], h[3])};
                    *(u32x2*)((bf16_t*)hy + lane * 4 + 256 * i) = o;
                }
            }
        }
    }
}

namespace g8 {
constexpr int BK = 64, HALF = 128, HTB = HALF * BK * 2;
DI int lds_byte(int r, int c) { const int st = (r >> 4) * 2 + (c >> 5), rr = r & 15, cc = c & 31, ob = rr * 64 + cc * 2; return st * 1024 + (ob ^ (((ob >> 9) & 1) << 5)); }
DI void stage_rc(int b, int& R, int& C) { const int st = b / 1024, sb = b % 1024, swz = sb ^ (((sb >> 9) & 1) << 5); R = (st >> 1) * 16 + swz / 64; C = (st & 1) * 32 + (swz % 64) / 2; }
typedef __attribute__((address_space(3))) unsigned lds_u32;
typedef __attribute__((address_space(3))) unsigned char lds_u8;
typedef __attribute__((address_space(3))) bf16x8 lds_bf16x8;

}

enum { EPI_PE = 0, EPI_PO = 1, EPI_Y = 2, EPI_W1 = 3, EPI_YF = 4 };

struct FuseP { int from_input, hasH; float* xout; const float* g; const float* wpost; const float* wpre; const float* sc; const float* sh; float* ssY; float* ssX; unsigned* cnt; };
DI float ld_agent(const float* q) { return __hip_atomic_load(q, __ATOMIC_RELAXED, __HIP_MEMORY_SCOPE_AGENT); }
DI void panel_wait(unsigned* c, unsigned target) {
    asm volatile("s_waitcnt vmcnt(0)" ::: "memory");
    __syncthreads();
    if (threadIdx.x == 0) {
        __hip_atomic_fetch_add(c, 1u, __ATOMIC_RELAXED, __HIP_MEMORY_SCOPE_AGENT);
        unsigned sp = 0;
        while (__hip_atomic_load(c, __ATOMIC_RELAXED, __HIP_MEMORY_SCOPE_AGENT) < target) { __builtin_amdgcn_s_sleep(1); if (++sp > (1u << 22)) break; }
    }
    __syncthreads();
}
DI float dot4(const f32x4& a) { return a[0] * a[0] + a[1] * a[1] + a[2] * a[2] + a[3] * a[3]; }

DI void rope_s(f32x4 (&sub)[4][2], int R0, bool usecol, int fr, int fq) {
    asm volatile("" : "+s"(R0));
    const float sgn = fq < 2 ? -1.f : 1.f;
#pragma unroll
    for (int m = 0; m < 4; ++m) {
        __builtin_amdgcn_sched_barrier(0);
        const int tl = (R0 + m * 16 + fr - 8192) & 1023;
        const float pos = (float)(usecol ? (tl & 63) : (tl >> 6));
#pragma unroll
        for (int n = 0; n < 2; ++n)
#pragma unroll
            for (int j = 0; j < 4; ++j) {
                const float inv = exp2f(-(float)(8 * (fq & 1) + 4 * n + j) * (13.287712379549449f / 16.f));
                float sn, cs;
                __sincosf(pos * inv, &sn, &cs);
                const float v = sub[m][n][j], pv = __shfl_xor(v, 32);
                sub[m][n][j] = v * cs + sgn * pv * sn;
            }
    }
}
DI void store_bf16_rows_s(const f32x4 (&sub)[4][2], bf16_t* base, int ld, int R0, int Cd0, int fr, int fq) {
#pragma unroll
    for (int m = 0; m < 4; ++m) {
        u32x4 o = {pk2(sub[m][0][0], sub[m][0][1]), pk2(sub[m][0][2], sub[m][0][3]), pk2(sub[m][1][0], sub[m][1][1]), pk2(sub[m][1][2], sub[m][1][3])};
        *(u32x4*)(base + (size_t)(R0 + m * 16 + fr) * ld + Cd0 + fq * 8) = o;
    }
}
DI void store_f32_rows_s(const f32x4 (&sub)[4][2], float* ob, int ldo, int fr, int fq) {
#pragma unroll
    for (int m = 0; m < 4; ++m) {
        float* rp = ob + (size_t)(m * 16 + fr) * ldo + fq * 8;
#pragma unroll
        for (int n = 0; n < 2; ++n) *(f32x4*)(rp + n * 4) = sub[m][n];
    }
}
DI void store_vt_s(const f32x4 (&sub)[4][2], bf16_t* vt, int T, int t0, int fr, int fq) {
#pragma unroll
    for (int n = 0; n < 2; ++n) {
        bf16_t* rp = vt + (size_t)(8 * (fr >> 2) + 4 * n + (fr & 3)) * T + t0 + fq * 4;
#pragma unroll
        for (int m = 0; m < 4; ++m) { u32x2 o = {pk2(sub[m][n][0], sub[m][n][1]), pk2(sub[m][n][2], sub[m][n][3])}; *(u32x2*)(rp + m * 16) = o; }
    }
}
DI void store_f32_ns_s(const f32x4 (&sub)[4][2], float* ob, int ldo, int fr, int fq) {
#pragma unroll
    for (int m = 0; m < 4; ++m)
#pragma unroll
        for (int j = 0; j < 4; ++j) {
            float* rp = ob + (size_t)(m * 16 + fq * 4 + j) * ldo + 8 * (fr >> 2) + (fr & 3);
#pragma unroll
            for (int n = 0; n < 2; ++n) rp[n * 4] = sub[m][n][j];
        }
}

template <int EPI>
DI void tile_epilogue(const Params& p, f32x4 (&acc)[2][2][4][2], int pm, int pn, int vtm, const FuseP& fz) {
    const int tix = TIDX, wid = __builtin_amdgcn_readfirstlane(tix >> 6), lane = tix & 63, wr = wid >> 2, wc = wid & 3;
    const int brow = pm * 256, bcol = pn * 256;
    int fr = lane & 15, fq = lane >> 4;
    asm volatile("" : "+v"(fr), "+v"(fq));
    const bool latent = brow >= 8192;
    int b, tb, T;
    if (latent) { b = (brow - 8192) >> 10; tb = (brow - 8192) & 1023; T = 1024; } else { b = brow >> 8; tb = 0; T = 256; }
    bf16_t* big = (bf16_t*)(p.ws + OFF_BIG);
    if (EPI == EPI_YF) {
        const int v = latent ? 1 + b : 0;
        const int rbase = brow + wr * 64 + fr;
        const int cbase = bcol + wc * 32 + fq * 8;
        float rs[2][4];
#pragma unroll
        for (int ai = 0; ai < 2; ++ai)
#pragma unroll
            for (int m = 0; m < 4; ++m) {
                float sq = dot4(acc[ai][0][m][0]) + dot4(acc[ai][0][m][1]) + dot4(acc[ai][1][m][0]) + dot4(acc[ai][1][m][1]);
                sq += __shfl_xor(sq, 16); sq += __shfl_xor(sq, 32);
                if (fq == 0) { const float old = __hip_atomic_fetch_add(fz.ssY + rbase + ai * 128 + m * 16, sq, __ATOMIC_RELAXED, __HIP_MEMORY_SCOPE_AGENT); asm volatile("" :: "v"(old)); }
            }
        panel_wait(fz.cnt + pm * 32, 4u);
#pragma unroll
        for (int ai = 0; ai < 2; ++ai)
#pragma unroll
            for (int m = 0; m < 4; ++m) rs[ai][m] = rsqrtf(ld_agent(fz.ssY + rbase + ai * 128 + m * 16) * (1.f / 1024.f) + EPSN);
        const float* xin = latent ? p.x_sample - (size_t)8192 * 1024 : p.x_prompt;
        bf16_t* xb = (bf16_t*)(p.ws + OFF_HY) + 1024;
        float s2[2][4];
#pragma unroll
        for (int ai = 0; ai < 2; ++ai)
#pragma unroll
            for (int m = 0; m < 4; ++m) s2[ai][m] = 0.f;
#pragma unroll
        for (int bj = 0; bj < 2; ++bj) {
            const int col = cbase + bj * 128;
            f32x4 g4[2], wp4[2];
#pragma unroll
            for (int n = 0; n < 2; ++n) { g4[n] = *(const f32x4*)(fz.g + v * 6144 + col + 4 * n); wp4[n] = *(const f32x4*)(fz.wpost + col + 4 * n); }
#pragma unroll
            for (int ai = 0; ai < 2; ++ai)
#pragma unroll
                for (int m = 0; m < 4; ++m) {
                    const size_t off = (size_t)(rbase + ai * 128 + m * 16) * 1024 + col;
                    f32x4 x4[2];
                    if (fz.from_input) { x4[0] = *(const f32x4*)(xin + off); x4[1] = *(const f32x4*)(xin + off + 4); }
                    else {
                        const u32x4 xr = *(const u32x4*)(xb + 2 * off - col);
                        x4[0] = (f32x4){bflo(xr[0]), bfhi(xr[0]), bflo(xr[1]), bfhi(xr[1])}; x4[1] = (f32x4){bflo(xr[2]), bfhi(xr[2]), bflo(xr[3]), bfhi(xr[3])};
                    }
                    f32x4 a[2];
#pragma unroll
                    for (int n = 0; n < 2; ++n) { a[n] = x4[n] + g4[n] * (acc[ai][bj][m][n] * rs[ai][m] * wp4[n]); acc[ai][bj][m][n] = a[n]; s2[ai][m] += dot4(a[n]); }
                    if (fz.hasH) { u32x4 xo = {pk2(a[0][0], a[0][1]), pk2(a[0][2], a[0][3]), pk2(a[1][0], a[1][1]), pk2(a[1][2], a[1][3])}; *(u32x4*)(xb + 2 * off - col) = xo; }
                    else { *(f32x4*)(fz.xout + off) = a[0]; *(f32x4*)(fz.xout + off + 4) = a[1]; }
                }
        }
        if (fz.hasH) {
#pragma unroll
            for (int ai = 0; ai < 2; ++ai)
#pragma unroll
                for (int m = 0; m < 4; ++m) {
                    float sq = s2[ai][m];
                    sq += __shfl_xor(sq, 16); sq += __shfl_xor(sq, 32);
                    if (fq == 0) { const float old = __hip_atomic_fetch_add(fz.ssX + rbase + ai * 128 + m * 16, sq, __ATOMIC_RELAXED, __HIP_MEMORY_SCOPE_AGENT); asm volatile("" :: "v"(old)); }
                }
            panel_wait(fz.cnt + pm * 32 + 16, 4u);
#pragma unroll
            for (int ai = 0; ai < 2; ++ai)
#pragma unroll
                for (int m = 0; m < 4; ++m) rs[ai][m] = rsqrtf(ld_agent(fz.ssX + rbase + ai * 128 + m * 16) * (1.f / 1024.f) + EPSN);
            bf16_t* hb = (bf16_t*)(p.ws + OFF_HY);
#pragma unroll
            for (int bj = 0; bj < 2; ++bj) {
                const int col = cbase + bj * 128;
                f32x4 wq4[2], sc4[2], sh4[2];
#pragma unroll
                for (int n = 0; n < 2; ++n) { wq4[n] = *(const f32x4*)(fz.wpre + col + 4 * n); sc4[n] = *(const f32x4*)(fz.sc + v * 6144 + col + 4 * n) + 1.f; sh4[n] = *(const f32x4*)(fz.sh + v * 6144 + col + 4 * n); }
#pragma unroll
                for (int ai = 0; ai < 2; ++ai)
#pragma unroll
                    for (int m = 0; m < 4; ++m) {
                        const f32x4 h0 = acc[ai][bj][m][0] * rs[ai][m] * wq4[0] * sc4[0] + sh4[0], h1 = acc[ai][bj][m][1] * rs[ai][m] * wq4[1] * sc4[1] + sh4[1];
                        u32x4 o = {pk2(h0[0], h0[1]), pk2(h0[2], h0[3]), pk2(h1[0], h1[1]), pk2(h1[2], h1[3])};
                        *(u32x4*)(hb + (size_t)(rbase + ai * 128 + m * 16) * 2048 + col) = o;
                    }
            }
        }
        return;
    }
#pragma unroll
    for (int ai = 0; ai < 2; ++ai)
#pragma unroll
        for (int bj = 0; bj < 2; ++bj) {
            __builtin_amdgcn_sched_barrier(0);
            f32x4 (&sub)[4][2] = acc[ai][bj];
            const int R0 = brow + ai * 128 + wr * 64, t0 = tb + ai * 128 + wr * 64, C0 = bcol + bj * 128 + wc * 32;
            const bool ns = vtm == 1 || (vtm == 2 && bj == 1);
            if (EPI == EPI_PE) {
                if (ns) {
                    const int vc = C0 - 2560;
                    bf16_t* vt = (bf16_t*)(p.ws + OFF_BIG + BIG_VT_E) + (latent ? (size_t)4194304 + ((size_t)b * 512 + vc) * 1024 : ((size_t)b * 512 + vc) * 256);
                    store_vt_s(sub, vt, T, t0, fr, fq);
                    if (!latent) store_f32_ns_s(sub, p.out + OUT_DIFFV + ((size_t)(b * 4 + (vc >> 7)) * 256 + t0) * 128 + (vc & 127), 128, fr, fq);
                } else {
                    if (pn >= 6 && latent) rope_s(sub, R0, wc & 1, fr, fq);
                    store_bf16_rows_s(sub, big, LDE, R0, C0, fr, fq);
                    if (pn >= 8 && !latent) store_f32_rows_s(sub, p.out + OUT_DIFFK + ((size_t)(b * 8 + ((C0 - 2048) >> 6)) * 256 + t0) * 64 + ((C0 - 2048) & 63), 64, fr, fq);
                }
            } else if (EPI == EPI_PO) {
                if (ns) {
                    if (pn < 8) {
                        const int vc = C0 - 1024;
                        bf16_t* vt = (bf16_t*)(p.ws + OFF_BIG + BIG_VT_C) + (latent ? (size_t)4194304 + ((size_t)b * 512 + vc) * 1024 : ((size_t)b * 512 + vc) * 256);
                        store_vt_s(sub, vt, T, t0, fr, fq);
                        if (!latent) store_f32_ns_s(sub, p.out + OUT_NAV + ((size_t)(b * 8 + (vc >> 6)) * 256 + t0) * 64 + (vc & 63), 64, fr, fq);
                    } else {
                        const int vc = C0 - 2176;
                        bf16_t* vt = (bf16_t*)(p.ws + OFF_BIG + BIG_VT_D) + (latent ? (size_t)1048576 + ((size_t)b * 128 + vc) * 1024 : ((size_t)b * 128 + vc) * 256);
                        store_vt_s(sub, vt, T, t0, fr, fq);
                        if (!latent) store_f32_ns_s(sub, p.out + OUT_SWAV + ((size_t)(b * 2 + (vc >> 6)) * 256 + t0) * 64 + (vc & 63), 64, fr, fq);
                    }
                } else {
                    if (pn >= 6 && latent) rope_s(sub, R0, wc & 1, fr, fq);
                    store_bf16_rows_s(sub, big, LDO, R0, pn >= 6 ? C0 - 512 : C0, fr, fq);
                    if (!latent) {
                        if (pn == 2 || pn == 3) store_f32_rows_s(sub, p.out + OUT_NAK + ((size_t)(b * 8 + ((C0 - 512) >> 6)) * 256 + t0) * 64 + ((C0 - 512) & 63), 64, fr, fq);
                        else if (pn == 8) store_f32_rows_s(sub, p.out + OUT_SWAK + ((size_t)(b * 2 + ((C0 - 2048) >> 6)) * 256 + t0) * 64 + ((C0 - 2048) & 63), 64, fr, fq);
                    }
                }
            } else if (EPI == EPI_Y) {
                store_f32_rows_s(sub, (float*)(p.ws + OFF_HY) + (size_t)R0 * 1024 + C0, 1024, fr, fq);
            } else {
#pragma unroll
                for (int m = 0; m < 4; ++m)
#pragma unroll
                    for (int n = 0; n < 2; ++n)
#pragma unroll
                        for (int j = 0; j < 4; ++j) { const float v = fmaxf(sub[m][n][j], 0.f); sub[m][n][j] = v * v; }
                store_bf16_rows_s(sub, big, 4096, R0, C0, fr, fq);
            }
        }
}

template <int EPI>
DI void gemm_phase(const Params& p, const bf16_t* A, int lda, const bf16_t* Bt, int K, int NT_N, char* shm, const FuseP& fz = FuseP{}) {
    using namespace g8;
    const int xcd = blockIdx.x & 7, lb = blockIdx.x >> 3, nlb = gridDim.x >> 3, per_xcd = 8 * NT_N;
    if (lb >= per_xcd) return;
    const int tid = TIDX, wid = __builtin_amdgcn_readfirstlane(tid >> 6), lane = tid & 63, wr = wid >> 2, wc = wid & 3, fr = lane & 15, fq = lane >> 4;
    const int nt = K / BK;
    lds_u8* lds = (lds_u8*)shm;
    unsigned voffA[2], voffB[2];
#pragma unroll
    for (int _i = 0; _i < 2; ++_i) { int _r, _c; stage_rc(tid * 16 + _i * 8192, _r, _c); const int _i16 = _r & 15, _rb = (_r & ~31) + 8 * (_i16 >> 2) + 4 * ((_r >> 4) & 1) + (_i16 & 3);
        voffA[_i] = (unsigned)(_r * lda + _c) * 2u; voffB[_i] = (unsigned)(_rb * K + _c) * 2u; }
    const size_t kstep = (size_t)BK * 2, hstepA = (size_t)HALF * lda * 2, hstepB = (size_t)HALF * K * 2;
    const unsigned ldsw = (unsigned)wid * 1024u;
    const int aoff = lds_byte(wr * 64 + fr, fq * 8), boff = lds_byte(wc * 32 + fr, fq * 8);
#define SA(b, h) (((b) * 2 + (h)) * HTB)
#define SB(b, h) ((4 + (b) * 2 + (h)) * HTB)
#define STAGE(bufoff, gbase, voff) do { _Pragma("unroll") for (int _i = 0; _i < 2; ++_i) \
      __builtin_amdgcn_global_load_lds((const unsigned*)((gbase) + (voff)[_i]), (lds_u32*)(lds + (bufoff) + ldsw + _i * 8192), 16, 0, 0); } while (0)
#define LDA(dst, b, h) _Pragma("unroll") for (int m = 0; m < 4; ++m) _Pragma("unroll") for (int k = 0; k < 2; ++k) \
    dst[m][k] = *(const lds_bf16x8*)(lds + SA(b, h) + aoff + m * 2048 + k * 1024)
#define LDB(dst, b, h) _Pragma("unroll") for (int n = 0; n < 2; ++n) _Pragma("unroll") for (int k = 0; k < 2; ++k) \
    dst[n][k] = *(const lds_bf16x8*)(lds + SB(b, h) + boff + n * 2048 + k * 1024)
#define MMA(VT, ai, bj, At_, Bt_) do { __builtin_amdgcn_s_setprio(1); \
    _Pragma("unroll") for (int m = 0; m < 4; ++m) _Pragma("unroll") for (int n = 0; n < 2; ++n) _Pragma("unroll") for (int k = 0; k < 2; ++k) \
      acc[ai][bj][m][n] = ((VT) == 1 || ((VT) == 2 && (bj) == 1)) ? MFMA16(At_[m][k], Bt_[n][k], acc[ai][bj][m][n]) : MFMA16(Bt_[n][k], At_[m][k], acc[ai][bj][m][n]); \
    __builtin_amdgcn_s_setprio(0); } while (0)
#define WAIT_V(n) asm volatile("s_waitcnt vmcnt(" #n ")" ::: "memory")
#define WAIT_L(n) asm volatile("s_waitcnt lgkmcnt(" #n ")" ::: "memory")
#define BAR __builtin_amdgcn_s_barrier()
#define SCHED __builtin_amdgcn_sched_barrier(0)
#define TLOOP(VT) for (int t = 0; t < nt; t += 2) { \
        const bool last = (t == nt - 2); \
        const char* a1 = cA + (size_t)(t + 1) * kstep; \
        const char* a2 = last ? nA : cA + (size_t)(t + 2) * kstep; const char* b2 = last ? nB : cB + (size_t)(t + 2) * kstep; \
        const char* a3 = a2 + kstep; const char* b3 = b2 + kstep; \
        LDB(B0, 0, 0); LDB(B1, 0, 1); SCHED; LDA(At, 0, 0); STAGE(SA(1, 1), a1 + hstepA, voffA); \
        WAIT_V(8); WAIT_L(0); BAR; MMA(VT, 0, 0, At, B0); MMA(VT, 0, 1, At, B1); BAR; SCHED; \
        LDA(At, 0, 1); STAGE(SB(0, 0), b2, voffB); STAGE(SB(0, 1), b2 + hstepB, voffB); STAGE(SA(0, 0), a2, voffA); \
        WAIT_V(8); WAIT_L(0); BAR; MMA(VT, 1, 0, At, B0); MMA(VT, 1, 1, At, B1); BAR; SCHED; \
        LDB(B0, 1, 0); LDB(B1, 1, 1); SCHED; LDA(At, 1, 0); STAGE(SA(0, 1), a2 + hstepA, voffA); \
        WAIT_V(8); WAIT_L(0); BAR; MMA(VT, 0, 0, At, B0); MMA(VT, 0, 1, At, B1); BAR; SCHED; \
        LDA(At, 1, 1); STAGE(SB(1, 0), b3, voffB); STAGE(SB(1, 1), b3 + hstepB, voffB); STAGE(SA(1, 0), a3, voffA); \
        WAIT_V(8); WAIT_L(0); BAR; MMA(VT, 1, 0, At, B0); MMA(VT, 1, 1, At, B1); BAR; SCHED; \
    }
    int lt = lb, pm = xcd * 8 + (lt & 7), pn = lt >> 3;
    f32x4 acc[2][2][4][2];
#pragma unroll
    for (int a = 0; a < 2; ++a)
#pragma unroll
        for (int b = 0; b < 2; ++b)
#pragma unroll
            for (int m = 0; m < 4; ++m)
#pragma unroll
                for (int n = 0; n < 2; ++n) acc[a][b][m][n] = (f32x4){0.f, 0.f, 0.f, 0.f};
    bf16x8 At[4][2], B0[2][2], B1[2][2];
    const char* cA = (const char*)A + (size_t)pm * 2 * hstepA;
    const char* cB = (const char*)Bt + (size_t)pn * 2 * hstepB;
    WAIT_V(0);
    STAGE(SB(0, 0), cB, voffB); STAGE(SB(0, 1), cB + hstepB, voffB); STAGE(SA(0, 0), cA, voffA); STAGE(SA(0, 1), cA + hstepA, voffA);
    if (wr == 1) BAR;
    WAIT_V(2); BAR;
    STAGE(SB(1, 0), cB + kstep, voffB); STAGE(SA(1, 0), cA + kstep, voffA); STAGE(SB(1, 1), cB + hstepB + kstep, voffB);
    WAIT_V(6); BAR;
    for (;;) {
        const int ltn = lt + nlb;
        const bool has_next = ltn < per_xcd;
        const int pmn = xcd * 8 + (ltn & 7), pnn = ltn >> 3;
        const char* nA = has_next ? (const char*)A + (size_t)pmn * 2 * hstepA : cA;
        const char* nB = has_next ? (const char*)Bt + (size_t)pnn * 2 * hstepB : cB;
        int vtm = 0;
        if (EPI == EPI_PE) vtm = pn >= 10 ? 1 : 0;
        if (EPI == EPI_PO) vtm = (pn == 4 || pn == 5) ? 1 : (pn == 8 ? 2 : 0);
        if ((EPI == EPI_PE || EPI == EPI_PO) && vtm == 1) { TLOOP(1) }
        else if (EPI == EPI_PO && vtm == 2) { TLOOP(2) }
        else { TLOOP(0) }
        if (wr == 0) BAR;
        if (EPI != EPI_YF) tile_epilogue<EPI>(p, acc, pm, pn, vtm, fz);
        if (!has_next) break;
#pragma unroll
        for (int a = 0; a < 2; ++a)
#pragma unroll
            for (int b = 0; b < 2; ++b)
#pragma unroll
                for (int m = 0; m < 4; ++m)
#pragma unroll
                    for (int n = 0; n < 2; ++n) acc[a][b][m][n] = (f32x4){0.f, 0.f, 0.f, 0.f};
        lt = ltn; pm = pmn; pn = pnn; cA = nA; cB = nB;
        if (wr == 1) BAR;
    }
    WAIT_V(0);
    BAR;
    if (EPI == EPI_YF) tile_epilogue<EPI>(p, acc, pm, pn, 0, fz);
#undef SA
#undef SB
#undef STAGE
#undef LDA
#undef LDB
#undef MMA
#undef WAIT_V
#undef WAIT_L
#undef BAR
#undef SCHED
#undef TLOOP
}

struct ASeg { const bf16_t* K; const bf16_t* Vt; int ldk, ldv, ntiles; };
struct MaskP { int on, a, b, c; const float* tab; };

template <int KW, int VR, int NB, int MODE>
DI void attn_core(const ASeg& s0, const ASeg& s1, const bf16x8 (&qf)[4], int kchunk0, int vrow0, float scale_l2, float& m, float& l, f32x16 (&O)[NB], char* lds, const MaskP& mp) {
    constexpr int KC = KW / 8, NKL = 64 * KC / 256, NVL = VR * 8 / 256;
    const int tid = VTID, lane = tid & 63, p32 = lane & 31, h = lane >> 5;
    const int krow = (p32 & 19) | ((p32 & 4) << 1) | ((p32 & 8) >> 1);
    const int n0 = s0.ntiles, nt = s0.ntiles + s1.ntiles;
    u32x4 rk[NKL], rv[NVL];
#define ATT_LOAD(t_)                                                                                                         \
    {                                                                                                                        \
        const bool f_ = (t_) < n0; const int tt_ = f_ ? (t_) : (t_) - n0;                                                     \
        const bf16_t* Kp_ = (f_ ? s0.K : s1.K); const int ldk_ = f_ ? s0.ldk : s1.ldk;                                        \
        const bf16_t* Vp_ = (f_ ? s0.Vt : s1.Vt); const int ldv_ = f_ ? s0.ldv : s1.ldv;                                      \
        _Pragma("unroll") for (int i = 0; i < NKL; ++i) { const int id = tid + 256 * i, r = id / KC, c = id % KC; rk[i] = *(const u32x4*)(Kp_ + (size_t)(tt_ * 64 + r) * ldk_ + c * 8); } \
        _Pragma("unroll") for (int i = 0; i < NVL; ++i) { const int id = tid + 256 * i, r = id >> 3, c = id & 7; rv[i] = *(const u32x4*)(Vp_ + (size_t)r * ldv_ + tt_ * 64 + c * 8); }       \
    }
#define ATT_STORE(b_)                                                                                                        \
    {                                                                                                                        \
        char* kb_ = lds + (b_) * 32768; char* vb_ = kb_ + 16384;                                                              \
        _Pragma("unroll") for (int i = 0; i < NKL; ++i) { const int id = tid + 256 * i, r = id / KC, c = id % KC; *(u32x4*)(kb_ + (KW == 128 ? swz256(r, c) : swz128(r, c))) = rk[i]; } \
        _Pragma("unroll") for (int i = 0; i < NVL; ++i) { const int id = tid + 256 * i, r = id >> 3, c = id & 7; *(u32x4*)(vb_ + swz128(r, c)) = rv[i]; }                               \
    }
    int dco[2][16];
    if (MODE == 1) {
        const int cq = mp.c + p32, cs = min(max(cq - 8, 0), 48);
#pragma unroll
        for (int kh = 0; kh < 2; ++kh)
#pragma unroll
            for (int i = 0; i < 16; ++i) {
                const int kc = 32 * kh + 16 * (i >> 3) + 8 * h + (i & 7);
                dco[kh][i] = ((unsigned)(kc - cs) < 16u ? min(max(kc - cq + 15, 0), 30) : 31) * 4;
            }
    }
    ATT_LOAD(0);
    ATT_STORE(0);
    __syncthreads();
    for (int t = 0; t < nt; ++t) {
        const bool more = t + 1 < nt;
        if (more) ATT_LOAD(t + 1);
        const char* kb = lds + (t & 1) * 32768;
        const char* vb = kb + 16384;
        f32x16 S[2];
#pragma unroll
        for (int kh = 0; kh < 2; ++kh) {
#pragma unroll
            for (int i = 0; i < 16; ++i) S[kh][i] = 0.f;
            const int row = krow + 32 * kh;
#pragma unroll
            for (int s = 0; s < 4; ++s) {
                const int c = kchunk0 + 2 * s + h;
                const bf16x8 kf = *(const bf16x8*)(kb + (KW == 128 ? swz256(row, c) : swz128(row, c)));
                S[kh] = MFMA32(kf, qf[s], S[kh]);
            }
        }
        const bool msk = (MODE != 0) && mp.on && t < n0;
        float mx = -1e30f;
        if (MODE == 1 && msk) {
            const char* trow = (const char*)(mp.tab + (mp.b + t - mp.a + 7) * 32);
#pragma unroll
            for (int kh = 0; kh < 2; ++kh)
#pragma unroll
                for (int i = 0; i < 16; ++i) {
                    const float sv = __builtin_fmaf(S[kh][i], scale_l2, *(const float*)(trow + dco[kh][i]));
                    S[kh][i] = sv; mx = fmaxf(mx, sv);
                }
        } else if (MODE == 2 && msk) {
            int qp = mp.a + p32 - 8 * h;
            asm volatile("" : "+v"(qp));
            const int k0 = mp.b + t * 64;
#pragma unroll
            for (int kh = 0; kh < 2; ++kh)
#pragma unroll
                for (int i = 0; i < 16; ++i) {
                    const int d = qp - (k0 + 32 * kh + 16 * (i >> 3) + (i & 7));
                    const bool ok = d <= 128 && d >= -128;
                    const float sv = ok ? S[kh][i] * scale_l2 : -1e30f;
                    S[kh][i] = sv; mx = fmaxf(mx, sv);
                }
        } else {
            float m0 = fmaxf(fmaxf(S[0][0], S[0][1]), S[0][2]), m1 = fmaxf(fmaxf(S[1][0], S[1][1]), S[1][2]);
#pragma unroll
            for (int i = 3; i < 15; i += 2) { m0 = fmaxf(fmaxf(m0, S[0][i]), S[0][i + 1]); m1 = fmaxf(fmaxf(m1, S[1][i]), S[1][i + 1]); }
            mx = fmaxf(fmaxf(m0, m1), fmaxf(S[0][15], S[1][15])) * scale_l2;
        }
        mx = fmaxf(mx, __shfl_xor(mx, 32));
        if (__any(mx > m + 8.f)) {
            const float mn = fmaxf(m, mx);
            const float alpha = __builtin_amdgcn_exp2f(m - mn);
            m = mn;
            l *= alpha;
#pragma unroll
            for (int blk = 0; blk < NB; ++blk)
#pragma unroll
                for (int i = 0; i < 16; ++i) O[blk][i] *= alpha;
        }
        float ls = 0.f;
        if ((MODE == 1 || MODE == 2) && msk) {
#pragma unroll
            for (int kh = 0; kh < 2; ++kh)
#pragma unroll
                for (int i = 0; i < 16; ++i) { const float pv = __builtin_amdgcn_exp2f(S[kh][i] - m); S[kh][i] = pv; ls += pv; }
        } else {
            const float negm = -m;
#pragma unroll
            for (int kh = 0; kh < 2; ++kh)
#pragma unroll
                for (int i = 0; i < 16; ++i) { const float pv = __builtin_amdgcn_exp2f(__builtin_fmaf(S[kh][i], scale_l2, negm)); S[kh][i] = pv; ls += pv; }
        }
        l += ls;
#pragma unroll
        for (int kh = 0; kh < 2; ++kh)
#pragma unroll
            for (int s2 = 0; s2 < 2; ++s2) {
                u32x4 pp = {pk2(S[kh][8 * s2 + 0], S[kh][8 * s2 + 1]), pk2(S[kh][8 * s2 + 2], S[kh][8 * s2 + 3]), pk2(S[kh][8 * s2 + 4], S[kh][8 * s2 + 5]), pk2(S[kh][8 * s2 + 6], S[kh][8 * s2 + 7])};
                const bf16x8 pb = __builtin_bit_cast(bf16x8, pp);
                const int c = 4 * kh + 2 * s2 + h;
#pragma unroll
                for (int blk = 0; blk < NB; ++blk) {
                    const bf16x8 vf = *(const bf16x8*)(vb + swz128(vrow0 + blk * 32 + p32, c));
                    O[blk] = MFMA32(vf, pb, O[blk]);
                }
            }
        if (more) ATT_STORE((t + 1) & 1);
        __syncthreads();
    }
    l += __shfl_xor(l, 32);
#undef ATT_LOAD
#undef ATT_STORE
}

DI void load_q(bf16x8 (&qf)[4], const bf16_t* qrow, int h) {
#pragma unroll
    for (int s = 0; s < 4; ++s) qf[s] = *(const bf16x8*)(qrow + 16 * s + 8 * h);
}

DI void attn_diff_item(const Params& p, int item, char* lds) {
    const int tid = VTID, lane = tid & 63, w = tid >> 6, p32 = lane & 31, h = lane >> 5, stream = w & 1, qh = w >> 1;
    const bf16_t* proj = (const bf16_t*)(p.ws + OFF_BIG);
    const bf16_t* vte = (const bf16_t*)(p.ws + OFF_BIG + BIG_VT_E);
    bf16_t* mix = (bf16_t*)(p.ws + OFF_BIG + BIG_MIXIN);
    int b, hd, qb, rowbase; ASeg s0, s1;
    if (item < 512) {
        b = item >> 6; hd = (item >> 4) & 3; qb = item & 15; rowbase = 8192 + b * 1024;
        s0 = {proj + (size_t)rowbase * LDE + 2048 + hd * 128, vte + 4194304 + ((size_t)b * 512 + hd * 128) * 1024, LDE, 1024, 16};
        s1 = {(const bf16_t*)(p.ws + OFF_CDK) + (size_t)b * 256 * 512 + hd * 128, (const bf16_t*)(p.ws + OFF_CDVT) + (size_t)(b * 4 + hd) * 128 * 256, 512, 256, 4};
    } else {
        const int it = item - 512;
        b = it >> 4; hd = (it >> 2) & 3; qb = it & 3; rowbase = b * 256;
        s0 = {proj + (size_t)rowbase * LDE + 2048 + hd * 128, vte + ((size_t)b * 512 + hd * 128) * 256, LDE, 256, 4};
        s1 = s0; s1.ntiles = 0;
    }
    const int R = rowbase + qb * 64 + qh * 32 + p32;
    bf16x8 qf[4];
    load_q(qf, proj + (size_t)R * LDE + 1536 + hd * 128 + stream * 64, h);
    f32x16 O[4];
#pragma unroll
    for (int blk = 0; blk < 4; ++blk)
#pragma unroll
        for (int i = 0; i < 16; ++i) O[blk][i] = 0.f;
    float m = -1e30f, l = 0.f;
    MaskP mp = {0, 0, 0, 0, nullptr};
    attn_core<128, 128, 4, 0>(s0, s1, qf, stream * 8, 0, 0.125f * LOG2E, m, l, O, lds, mp);
    const float il = 1.f / l;
    const float d1 = wave_sum(p.lq1[lane] * p.lk1[lane]), d2 = wave_sum(p.lq2[lane] * p.lk2[lane]);
    const float lam_init = 0.2f;
    const float lam = __expf(d1) - __expf(d2) + lam_init;
    float* xb = (float*)(lds + qh * 16384);
    if (stream == 1) {
#pragma unroll
        for (int blk = 0; blk < 4; ++blk)
#pragma unroll
            for (int i = 0; i < 16; ++i) { const int dv = blk * 32 + 8 * (i >> 2) + 4 * h + (i & 3); xb[dv * 32 + p32] = O[blk][i] * il; }
    }
    __syncthreads();
    if (stream == 0) {
        float ss = 0.f;
#pragma unroll
        for (int blk = 0; blk < 4; ++blk)
#pragma unroll
            for (int i = 0; i < 16; ++i) { const int dv = blk * 32 + 8 * (i >> 2) + 4 * h + (i & 3); const float o = O[blk][i] * il - lam * xb[dv * 32 + p32]; O[blk][i] = o; ss += o * o; }
        ss += __shfl_xor(ss, 32);
        const float rs = rsqrtf(ss * (1.f / 128.f) + EPSN) * (1.f - lam_init);
        bf16_t* op = mix + (size_t)R * 1024 + 512 + hd * 128;
#pragma unroll
        for (int blk = 0; blk < 4; ++blk)
#pragma unroll
            for (int g = 0; g < 4; ++g) {
                const int dv = blk * 32 + 8 * g + 4 * h;
                const f32x4 sl = *(const f32x4*)(p.subln + dv);
                u32x2 o = {pk2(O[blk][4 * g] * rs * sl[0], O[blk][4 * g + 1] * rs * sl[1]), pk2(O[blk][4 * g + 2] * rs * sl[2], O[blk][4 * g + 3] * rs * sl[3])};
                *(u32x2*)(op + dv) = o;
            }
    }
    __syncthreads();
}

DI void attn_c_item(const Params& p, int item, char* lds) {
    const int tid = VTID, lane = tid & 63, w = tid >> 6, p32 = lane & 31, h = lane >> 5, stream = w & 1, qh = w >> 1;
    const bf16_t* proj = (const bf16_t*)(p.ws + OFF_BIG);
    const bf16_t* vtc = (const bf16_t*)(p.ws + OFF_BIG + BIG_VT_C);
    bf16_t* mix = (bf16_t*)(p.ws + OFF_BIG + BIG_MIXIN);
    int b, hp, qb, rowbase; ASeg s0, s1; MaskP mp = {0, 0, 0, 0, nullptr};
    float* tab = (float*)(lds + 65536);
    if (item < 512) {
        b = item >> 6; hp = (item >> 4) & 3; qb = item & 15; rowbase = 8192 + b * 1024;
        const int rstart = min(max(qb - 4, 0), 8);
        s0 = {proj + (size_t)(rowbase + rstart * 64) * LDO + 512 + hp * 128, vtc + 4194304 + ((size_t)b * 512 + hp * 128) * 1024 + rstart * 64, LDO, 1024, 8};
        s1 = {(const bf16_t*)(p.ws + OFF_CNK) + (size_t)b * 256 * 512 + hp * 128, (const bf16_t*)(p.ws + OFF_CNVT) + ((size_t)b * 512 + hp * 128) * 256, 512, 256, 4};
        for (int idx = tid; idx < 960; idx += 256) { const int hr = idx >> 5, cc = idx & 31; tab[idx] = cc < 31 ? p.rpb[hp * 930 + hr * 31 + cc] * LOG2E : -1e30f; }
        mp = {1, qb, rstart, qh * 32, tab + stream * 480};
    } else {
        const int it = item - 512;
        b = it >> 4; hp = (it >> 2) & 3; qb = it & 3; rowbase = b * 256;
        s0 = {proj + (size_t)rowbase * LDO + 512 + hp * 128, vtc + ((size_t)b * 512 + hp * 128) * 256, LDO, 256, 4};
        s1 = s0; s1.ntiles = 0;
    }
    const int R = rowbase + qb * 64 + qh * 32 + p32;
    const int head = hp * 2 + stream;
    bf16x8 qf[4];
    load_q(qf, proj + (size_t)R * LDO + head * 64, h);
    f32x16 O[2];
#pragma unroll
    for (int blk = 0; blk < 2; ++blk)
#pragma unroll
        for (int i = 0; i < 16; ++i) O[blk][i] = 0.f;
    float m = -1e30f, l = 0.f;
    attn_core<128, 128, 2, 1>(s0, s1, qf, stream * 8, stream * 64, 0.125f * LOG2E, m, l, O, lds, mp);
    const float il = 1.f / l;
    bf16_t* op = mix + (size_t)R * 1024 + head * 64;
#pragma unroll
    for (int blk = 0; blk < 2; ++blk)
#pragma unroll
        for (int g = 0; g < 4; ++g) {
            const int dv = blk * 32 + 8 * g + 4 * h;
            u32x2 o = {pk2(O[blk][4 * g] * il, O[blk][4 * g + 1] * il), pk2(O[blk][4 * g + 2] * il, O[blk][4 * g + 3] * il)};
            *(u32x2*)(op + dv) = o;
        }
}

DI void attn_d_item(const Params& p, int item, char* lds) {
    const int tid = VTID, lane = tid & 63, w = tid >> 6, p32 = lane & 31, h = lane >> 5;
    const bf16_t* proj = (const bf16_t*)(p.ws + OFF_BIG);
    const bf16_t* vtd = (const bf16_t*)(p.ws + OFF_BIG + BIG_VT_D);
    bf16_t* mix = (bf16_t*)(p.ws + OFF_BIG + BIG_MIXIN);
    int b, g, qb, rowbase; ASeg s0, s1; MaskP mp = {0, 0, 0, 0, nullptr};
    if (item < 512) {
        b = item >> 6; g = (item >> 5) & 1; qb = item & 31; rowbase = 8192 + b * 1024;
        const int q0 = qb * 32;
        const int tlo = max(q0 - 128, 0) >> 6, thi = min(q0 + 159, 1023) >> 6;
        s0 = {proj + (size_t)(rowbase + tlo * 64) * LDO + 1536 + g * 64, vtd + 1048576 + ((size_t)b * 128 + g * 64) * 1024 + tlo * 64, LDO, 1024, thi - tlo + 1};
        s1 = {(const bf16_t*)(p.ws + OFF_CSK) + (size_t)b * 256 * 128 + g * 64, (const bf16_t*)(p.ws + OFF_CSVT) + ((size_t)b * 128 + g * 64) * 256, 128, 256, 4};
        mp = {1, q0, tlo * 64, 0, nullptr};
    } else {
        const int it = item - 512;
        b = it >> 4; g = (it >> 3) & 1; qb = it & 7; rowbase = b * 256;
        s0 = {proj + (size_t)rowbase * LDO + 1536 + g * 64, vtd + ((size_t)b * 128 + g * 64) * 256, LDO, 256, 4};
        s1 = s0; s1.ntiles = 0;
    }
    const int R = rowbase + qb * 32 + p32;
    const int hq = g * 4 + w;
    bf16x8 qf[4];
    load_q(qf, proj + (size_t)R * LDO + 1024 + hq * 64, h);
    f32x16 O[2];
#pragma unroll
    for (int blk = 0; blk < 2; ++blk)
#pragma unroll
        for (int i = 0; i < 16; ++i) O[blk][i] = 0.f;
    float m = p.sink[hq] * LOG2E, l = h == 0 ? 1.f : 0.f;
    attn_core<64, 64, 2, 2>(s0, s1, qf, 0, 0, 0.125f * LOG2E, m, l, O, lds, mp);
    const float il = 1.f / l;
    bf16_t* op = mix + (size_t)R * 1024 + 512 + hq * 64;
#pragma unroll
    for (int blk = 0; blk < 2; ++blk)
#pragma unroll
        for (int gg = 0; gg < 4; ++gg) {
            const int dv = blk * 32 + 8 * gg + 4 * h;
            u32x2 o = {pk2(O[blk][4 * gg] * il, O[blk][4 * gg + 1] * il), pk2(O[blk][4 * gg + 2] * il, O[blk][4 * gg + 3] * il)};
            *(u32x2*)(op + dv) = o;
        }
}

DI void conv_item(const Params& p, int item) {
    const int tid = VTID;
    const bf16_t* proj = (const bf16_t*)(p.ws + OFF_BIG);
    bf16_t* mix = (bf16_t*)(p.ws + OFF_BIG + BIG_MIXIN);
#pragma unroll 2
    for (int i = 0; i < 8; ++i) {
        const int idx = tid + 256 * i, tl = idx >> 6, ch = (idx & 63) * 8;
        const int R = item * 32 + tl;
        int t, T;
        if (R < 8192) { t = R & 255; T = 256; } else { t = (R - 8192) & 1023; T = 1024; }
        const bf16_t* rp = proj + (size_t)R * LDE + ch;
        const u32x4 ab = *(const u32x4*)(rp);
        float accv[8];
#pragma unroll
        for (int e = 0; e < 8; ++e) accv[e] = 0.f;
#pragma unroll
        for (int j = 0; j < 3; ++j) {
            const int tt = t + j - 1;
            if (tt >= 0 && tt < T) {
                const u32x4 ac = *(const u32x4*)(rp + (ptrdiff_t)(j - 1) * LDE + 512);
                const u32x4 ax = *(const u32x4*)(rp + (ptrdiff_t)(j - 1) * LDE + 1024);
                const f32x4 w0 = *(const f32x4*)(p.conv_w + j * 512 + ch), w1 = *(const f32x4*)(p.conv_w + j * 512 + ch + 4);
#pragma unroll
                for (int e = 0; e < 4; ++e) {
                    accv[2 * e] += bflo(ac[e]) * bflo(ax[e]) * (e < 2 ? w0[2 * e] : w1[2 * e - 4]);
                    accv[2 * e + 1] += bfhi(ac[e]) * bfhi(ax[e]) * (e < 2 ? w0[2 * e + 1] : w1[2 * e - 3]);
                }
            }
        }
        u32x4 o;
#pragma unroll
        for (int e = 0; e < 4; ++e) o[e] = pk2(bflo(ab[e]) * accv[2 * e], bfhi(ab[e]) * accv[2 * e + 1]);
        *(u32x4*)(mix + (size_t)R * 1024 + ch) = o;
    }
}


#define XB_TMO      128
#define XB_XCNT(j)  (256  + 64 * (j))
#define XB_XSUB(j)  (1280 + 64 * (j))
#define XB_XGEN(j)  (2304 + 64 * (j))
#define XB_TOP      3328
#define XB_TOPGEN   3392
#define XCD_BAR_WORDS 3456
#define XB_SPIN_CAP (1u << 22)
#define LAS __attribute__((address_space(3)))
DI unsigned xb_ld(unsigned* p) { return __hip_atomic_load(p, __ATOMIC_RELAXED, __HIP_MEMORY_SCOPE_AGENT); }
DI unsigned xb_add(unsigned* p, unsigned v) { return __hip_atomic_fetch_add(p, v, __ATOMIC_RELAXED, __HIP_MEMORY_SCOPE_AGENT); }
DI unsigned xb_xcc_id() { return (unsigned)__builtin_amdgcn_s_getreg((3 << 11) | 20) & 0xFu; }
#define XB_SPIN(cond, bar) do { unsigned _sp = 0; while (cond) { __builtin_amdgcn_s_sleep(1); \
    if ((++_sp & 255u) == 0u) { if (xb_ld(&(bar)[XB_TMO])) break; if (_sp > XB_SPIN_CAP) { atomicAdd(&(bar)[XB_TMO], 1u); break; } } } } while (0)
struct XcdBarrier { unsigned* bar; unsigned x; volatile LAS unsigned* st; };
DI XcdBarrier xcd_barrier_post(unsigned* bar, volatile LAS unsigned* st) {
    XcdBarrier b; b.bar = bar; b.x = xb_xcc_id(); b.st = st;
    if (threadIdx.x == 0) (void)xb_add(&bar[XB_XCNT(b.x)], 1u);
    return b;
}
DI void xcd_barrier_complete(unsigned* bar, unsigned x, unsigned& nloc, unsigned& nx) {
    const unsigned G = gridDim.x * gridDim.y * gridDim.z;
    unsigned sum, cnt, mine, sp = 0u;
    for (;;) {
        sum = 0u; cnt = 0u; mine = 0u;
#pragma unroll
        for (unsigned j = 0; j < 16; ++j) { const unsigned c = xb_ld(&bar[XB_XCNT(j)]); sum += c; cnt += (c > 0u) ? 1u : 0u; mine = (j == x) ? c : mine; }
        if (sum == G) break;
        __builtin_amdgcn_s_sleep(1);
        if ((++sp & 255u) == 0u) { if (xb_ld(&bar[XB_TMO])) break; if (sp > XB_SPIN_CAP) { atomicAdd(&bar[XB_TMO], 1u); break; } }
    }
    nloc = mine > 0u ? mine : 1u; nx = cnt > 0u ? cnt : 1u;
}
DI void xcd_barrier(const XcdBarrier& b) {
    asm volatile("s_waitcnt vmcnt(0)" ::: "memory");
    __syncthreads();
    if (threadIdx.x == 0) {
        unsigned* bar = b.bar;
        __builtin_amdgcn_s_waitcnt(0);
        unsigned nloc = b.st[0], nx = b.st[1];
        if (nloc == 0u) { xcd_barrier_complete(bar, b.x, nloc, nx); b.st[0] = nloc; b.st[1] = nx; }
        const unsigned old = xb_add(&bar[XB_XSUB(b.x)], 1u);
        const unsigned gen = old / nloc;
        if (old + 1u == (gen + 1u) * nloc) {
            __builtin_amdgcn_fence(__ATOMIC_RELEASE, "agent");
            asm volatile("s_waitcnt vmcnt(0)" ::: "memory");
            const unsigned og = xb_add(&bar[XB_TOP], 1u);
            const unsigned tg = og / nx;
            if (og + 1u == (tg + 1u) * nx) xb_add(&bar[XB_TOPGEN], 1u);
            else XB_SPIN(xb_ld(&bar[XB_TOPGEN]) == tg, bar);
            __builtin_amdgcn_fence(__ATOMIC_ACQUIRE, "agent");
            xb_add(&bar[XB_XGEN(b.x)], 1u);
            asm volatile("s_waitcnt vmcnt(0)" ::: "memory");
        } else {
            XB_SPIN(xb_ld(&bar[XB_XGEN(b.x)]) == gen, bar);
            __builtin_amdgcn_fence(__ATOMIC_ACQUIRE, "agent");
            asm volatile("s_waitcnt vmcnt(0)" ::: "memory");
        }
    }
    __syncthreads();
}

constexpr int N_PHASES = 12;
DI void run_phase(const Params& p, int ph, char* shm) {
    const int nb = VNB, bid = VBID;
    char* lds = shm + VHALF * LDS_HALF;
    const int pvb = (int)(blockIdx.x & 7) * (nb >> 3) + (int)(blockIdx.x >> 3) * 2 + VHALF;
    const bf16_t* hy = (const bf16_t*)(p.ws + OFF_HY);
    const bf16_t* big = (const bf16_t*)(p.ws + OFF_BIG);
    const bf16_t* mixin = (const bf16_t*)(p.ws + OFF_BIG + BIG_MIXIN);
    const float* mod = (const float*)(p.ws + OFF_MOD);
    char* st = p.ws + OFF_STAT;
#define FZ(set, from_in, hasH, goff, wpost, wpre, scoff, shoff) FuseP{from_in, hasH, p.out, mod + (goff), wpost, wpre, mod + (scoff), mod + (shoff), (float*)(st + (set) * STAT_SET), (float*)(st + (set) * STAT_SET + 65536), (unsigned*)(st + (set) * STAT_SET + 131072)}
    switch (ph) {
    case 0: p0_phase(p, bid, nb, lds); break;
    case 1: rowop_phase(p, false, true, 0, nullptr, true, p.norm_mix_pre, 1024, 0); break;
    case 2: gemm_phase<EPI_PE>(p, hy, 2048, (const bf16_t*)(p.ws + OFF_WINE), 1024, 12, shm); break;
    case 3:
        for (int it = pvb; it < 1536; it += nb) { if (it < 1024) attn_diff_item(p, it, lds); else conv_item(p, it - 1024); }
        break;
    case 4: gemm_phase<EPI_YF>(p, mixin, 1024, (const bf16_t*)(p.ws + OFF_WOUT), 1024, 4, shm, FZ(0, 1, 1, 2048, p.norm_mix_post, p.norm_mlp_pre, 4096, 3072)); break;
    case 5: gemm_phase<EPI_W1>(p, hy, 2048, (const bf16_t*)(p.ws + OFF_W1), 1024, 16, shm); break;
    case 6: gemm_phase<EPI_YF>(p, big, 4096, (const bf16_t*)(p.ws + OFF_W2), 4096, 4, shm, FZ(1, 0, 1, 5120, p.norm_mlp_post, p.norm_mix_pre + 1024, 9 * 6144 + 1024, 9 * 6144 + 0)); break;
    case 7: gemm_phase<EPI_PO>(p, hy, 2048, (const bf16_t*)(p.ws + OFF_WINO), 1024, 9, shm); break;
    case 8:
        for (int it = pvb; it < 2048; it += nb) {
            const int q = it >> 9, r = it & 511;
            if (q & 1) attn_d_item(p, (q >> 1) * 512 + r, lds); else attn_c_item(p, (q >> 1) * 512 + r, lds);
        }
        break;
    case 9: gemm_phase<EPI_YF>(p, mixin, 1024, (const bf16_t*)(p.ws + OFF_WOUT) + 1048576, 1024, 4, shm, FZ(2, 0, 1, 9 * 6144 + 2048, p.norm_mix_post + 1024, p.norm_mlp_pre + 1024, 9 * 6144 + 4096, 9 * 6144 + 3072)); break;
    case 10: gemm_phase<EPI_W1>(p, hy, 2048, (const bf16_t*)(p.ws + OFF_W1) + 4194304, 1024, 16, shm); break;
    case 11: gemm_phase<EPI_YF>(p, big, 4096, (const bf16_t*)(p.ws + OFF_W2) + 4194304, 4096, 4, shm, FZ(3, 0, 0, 9 * 6144 + 5120, p.norm_mlp_post + 1024, p.norm_mlp_post, 0, 0)); break;
    }
#undef FZ
}

__global__ void __launch_bounds__(512, 2) fwd_mega(Params p) {
    __shared__ __attribute__((aligned(16))) char lds[LDS_BYTES];
    __shared__ uint4 xb_words;
    cg::grid_group grid = cg::this_grid();
    if (threadIdx.x == 0) xb_words = make_uint4(0u, 0u, 0u, 0u);
    __syncthreads();
    const XcdBarrier xb = xcd_barrier_post((unsigned*)(p.ws + OFF_BAR), (volatile LAS unsigned*)&xb_words);
#define PH_(n) run_phase(p, n, lds); xcd_barrier(xb); if ((DUP_MASK >> n) & 1) { run_phase(p, n, lds); xcd_barrier(xb); }
    PH_(0)
    if (p.ws == nullptr) grid.sync();
    PH_(1) PH_(2) PH_(3) PH_(4) PH_(5) PH_(6) PH_(7) PH_(8) PH_(9) PH_(10)
    run_phase(p, 11, lds);
#undef PH_
}

extern "C" void kernel_launch(void* const* d_in, const int* in_sizes, int n_in, void* d_out, int out_size, void* d_ws, size_t ws_size, hipStream_t stream) {
    Params p{};
    const float** pp = (const float**)&p;
    for (int i = 0; i < 29; ++i) pp[i] = (const float*)d_in[i];
    p.out = (float*)d_out;
    p.ws = (char*)d_ws;
    if (ws_size < WS_NEEDED) { fprintf(stderr, "workspace too small: %zu < %zu\n", ws_size, (size_t)WS_NEEDED); return; }
    static int grid_blocks = 0;
    if (!grid_blocks) {
        int dev = 0, cus = 0, per_cu = 0;
        hipGetDevice(&dev);
        hipDeviceGetAttribute(&cus, hipDeviceAttributeMultiprocessorCount, dev);
        hipOccupancyMaxActiveBlocksPerMultiprocessor(&per_cu, fwd_mega, 512, 0);
        if (per_cu > 1) per_cu = 1;
        if (per_cu < 1) per_cu = 1;
        grid_blocks = cus * per_cu;
        grid_blocks -= grid_blocks % 8;
    }
    (void)hipMemsetAsync((char*)d_ws + OFF_BAR, 0, XCD_BAR_WORDS * 4, stream);
    if (grid_blocks != 256) { fprintf(stderr, "fused epilogues need exactly 256 workgroups (got %d)\n", grid_blocks); return; }
    void* args[] = {&p};
    hipError_t e = hipLaunchCooperativeKernel((void*)fwd_mega, dim3(grid_blocks), dim3(512), args, 0, stream);
    if (e != hipSuccess) fprintf(stderr, "cooperative launch failed: %s (grid %d)\n", hipGetErrorString(e), grid_blocks);
}
```

```cpp
#include <hip/hip_runtime.h>
#include <hip/hip_cooperative_groups.h>
#include <cstdio>
#include <cstdint>
namespace cg = cooperative_groups;

#ifndef DUP_MASK
#define DUP_MASK 0
#endif
#ifndef ONE_LAUNCH
#define ONE_LAUNCH 1
#endif

typedef unsigned short bf16_t;
typedef short bf16x8 __attribute__((ext_vector_type(8)));
typedef float f32x4 __attribute__((ext_vector_type(4)));
typedef float f32x2 __attribute__((ext_vector_type(2)));
typedef float f32x16 __attribute__((ext_vector_type(16)));
typedef unsigned u32x4 __attribute__((ext_vector_type(4)));
typedef unsigned u32x2 __attribute__((ext_vector_type(2)));
typedef __bf16 bfv2 __attribute__((ext_vector_type(2)));
#define DI __device__ __forceinline__
DI int launder_v(int v) { asm volatile("" : "+v"(v)); return v; }
#define TIDX launder_v((int)threadIdx.x)
#define VTID (TIDX & 255)
#define VHALF (TIDX >> 8)
#define VBID ((int)(blockIdx.x * 2) + (TIDX >> 8))
#define VNB ((int)(gridDim.x * 2))
#define MFMA32(a, b, c) __builtin_amdgcn_mfma_f32_32x32x16_bf16((a), (b), (c), 0, 0, 0)
#define MFMA16(a, b, c) __builtin_amdgcn_mfma_f32_16x16x32_bf16((a), (b), (c), 0, 0, 0)

constexpr float LOG2E = 1.4426950408889634f;
constexpr float EPSN = 1e-6f;

struct Params {
    const float *x_prompt, *x_sample, *cache_diff_k, *cache_diff_v, *cache_na_k, *cache_na_v, *cache_swa_k, *cache_swa_v, *c, *c_ctx;
    const float *mod_w, *mod_b, *norm_mix_pre, *norm_mix_post, *norm_mlp_pre, *norm_mlp_post, *w_in_even, *conv_w, *lq1, *lk1, *lq2, *lk2, *subln;
    const float *w_in_odd, *rpb, *sink, *w_out, *mlp_w1, *mlp_w2;
    float* out;
    char* ws;
};

constexpr size_t OFF_MOD = 0;
constexpr size_t OFF_BAR = 458752;
constexpr size_t OFF_WINE = 524288;
constexpr size_t OFF_WINO = OFF_WINE + 6291456;
constexpr size_t OFF_WOUT = OFF_WINO + 4718592;
constexpr size_t OFF_W1 = OFF_WOUT + 4194304;
constexpr size_t OFF_W2 = OFF_W1 + 16777216;
constexpr size_t OFF_CDK = OFF_W2 + 16777216;
constexpr size_t OFF_CDVT = OFF_CDK + 2097152;
constexpr size_t OFF_CNK = OFF_CDVT + 2097152;
constexpr size_t OFF_CNVT = OFF_CNK + 2097152;
constexpr size_t OFF_CSK = OFF_CNVT + 2097152;
constexpr size_t OFF_CSVT = OFF_CSK + 524288;
constexpr size_t OFF_HY = OFF_CSVT + 524288;
constexpr size_t OFF_BIG = OFF_HY + 67108864;
constexpr size_t OFF_STAT = OFF_BIG + 134217728;
constexpr size_t STAT_SET = 65536 + 65536 + 8192;
constexpr size_t WS_NEEDED = OFF_STAT + 4 * STAT_SET;
constexpr size_t BIG_VT_E = 83886080;
constexpr size_t BIG_VT_C = 54525952;
constexpr size_t BIG_VT_D = BIG_VT_C + 16777216;
constexpr size_t BIG_MIXIN = 100663296;
constexpr int LDE = 2560, LDO = 1664;
constexpr size_t OUT_DIFFK = 16777216, OUT_DIFFV = 20971520, OUT_NAK = 25165824, OUT_NAV = 29360128, OUT_SWAK = 33554432, OUT_SWAV = 34603008;

constexpr int LDS_HALF = 65536 + 4096;
constexpr int LDS_BYTES = 2 * LDS_HALF;

DI unsigned pk2(float a, float b) { f32x2 v = {a, b}; bfv2 r = __builtin_convertvector(v, bfv2); return __builtin_bit_cast(unsigned, r); }
DI float bflo(unsigned u) { return __uint_as_float(u << 16); }
DI float bfhi(unsigned u) { return __uint_as_float(u & 0xffff0000u); }
DI float wave_sum(float v) {
#pragma unroll
    for (int o = 1; o < 64; o <<= 1) v += __shfl_xor(v, o);
    return v;
}
DI int swz128(int r, int c) { return r * 128 + ((c ^ ((r >> 1) & 7)) << 4); }
DI int swz256(int r, int c) { return r * 256 + ((c ^ (r & 15)) << 4); }

DI void p0_mod_item(const Params& p, int item, char* lds) {
    const int li = item / 96, cb = item % 96;
    const int tid = VTID, lane = tid & 63, w = tid >> 6;
    const float* W = p.mod_w + (size_t)li * 1024 * 6144 + cb * 64 + lane;
    float acc[9];
#pragma unroll
    for (int v = 0; v < 9; ++v) acc[v] = 0.f;
    for (int kc = 0; kc < 4; ++kc) {
        const int kb = w * 256 + kc * 64;
        float s[9];
        { const float cv = p.c_ctx[kb + lane]; s[0] = cv / (1.f + __expf(-cv)); }
#pragma unroll
        for (int v = 1; v < 9; ++v) { const float cv = p.c[(v - 1) * 1024 + kb + lane]; s[v] = cv / (1.f + __expf(-cv)); }
#pragma unroll
        for (int kk = 0; kk < 64; ++kk) {
            const float wv = __builtin_nontemporal_load(W + (size_t)(kb + kk) * 6144);
#pragma unroll
            for (int v = 0; v < 9; ++v) acc[v] += __int_as_float(__builtin_amdgcn_readlane(__float_as_int(s[v]), kk)) * wv;
        }
    }
    float* red = (float*)lds;
#pragma unroll
    for (int v = 0; v < 9; ++v) red[(w * 9 + v) * 64 + lane] = acc[v];
    __syncthreads();
    float* mod = (float*)(p.ws + OFF_MOD);
    for (int idx = tid; idx < 576; idx += 256) {
        const int v = idx >> 6, col = idx & 63;
        const float sum = red[(0 * 9 + v) * 64 + col] + red[(1 * 9 + v) * 64 + col] + red[(2 * 9 + v) * 64 + col] + red[(3 * 9 + v) * 64 + col];
        mod[(li * 9 + v) * 6144 + cb * 64 + col] = sum + p.mod_b[li * 6144 + cb * 64 + col];
    }
    __syncthreads();
}

DI void p0_transpose_tile(const float* __restrict__ in, bf16_t* __restrict__ out, int R, int C, int tr, int tc, char* lds) {
    const int tid = VTID;
    const int cl = (tid & 15) * 4, rl = (tid >> 4) * 2, sw = tid & 7;
#pragma unroll
    for (int i = 0; i < 2; ++i) {
        const int r = rl + 32 * i;
        const f32x4 a = *(const f32x4*)(in + (size_t)(tr * 64 + r) * C + tc * 64 + cl);
        const f32x4 b = *(const f32x4*)(in + (size_t)(tr * 64 + r + 1) * C + tc * 64 + cl);
#pragma unroll
        for (int j = 0; j < 4; ++j) *(unsigned*)(lds + (cl + j) * 128 + (((r >> 3) ^ sw) << 4) + (r & 7) * 2) = pk2(a[j], b[j]);
    }
    __syncthreads();
#pragma unroll
    for (int i = 0; i < 2; ++i) {
        const int idx = tid + 256 * i, c = idx >> 3, q = idx & 7;
        const u32x4 v = *(const u32x4*)(lds + c * 128 + ((q ^ ((c >> 2) & 7)) << 4));
        *(u32x4*)(out + (size_t)(tc * 64 + c) * R + tr * 64 + q * 8) = v;
    }
    __syncthreads();
}

DI void p0_kreorder(const float* __restrict__ in, bf16_t* __restrict__ out, int logH, int item) {
    const int tid = VTID, H = 1 << logH;
#pragma unroll
    for (int i = 0; i < 4; ++i) {
        const int f = item * 1024 + tid + 256 * i;
        const int d4 = f & 15, key = (f >> 4) & 255, hh = (f >> 12) & (H - 1), b = f >> (12 + logH);
        const f32x4 v = __builtin_nontemporal_load((const f32x4*)(in + (size_t)f * 4));
        u32x2 o = {pk2(v[0], v[1]), pk2(v[2], v[3])};
        *(u32x2*)(out + ((size_t)(b * 256 + key) * H + hh) * 64 + d4 * 4) = o;
    }
}

struct TJob { const float* in; bf16_t* out; int R, C, tr, tc; };
constexpr int P0_TITEMS = 768 + 576 + 512 + 2048 + 2048 + 256 + 256 + 64;
DI TJob p0_decode(const Params& p, int item) {
    TJob j;
    if (item < 768) { j.in = p.w_in_even; j.out = (bf16_t*)(p.ws + OFF_WINE); j.R = 1024; j.C = 3072; }
    else if ((item -= 768) < 576) { j.in = p.w_in_odd; j.out = (bf16_t*)(p.ws + OFF_WINO); j.R = 1024; j.C = 2304; }
    else if ((item -= 576) < 512) { const int b = item >> 8; item &= 255; j.in = p.w_out + (size_t)b * 1048576; j.out = (bf16_t*)(p.ws + OFF_WOUT) + (size_t)b * 1048576; j.R = 1024; j.C = 1024; }
    else if ((item -= 512) < 2048) { const int b = item >> 10; item &= 1023; j.in = p.mlp_w1 + (size_t)b * 4194304; j.out = (bf16_t*)(p.ws + OFF_W1) + (size_t)b * 4194304; j.R = 1024; j.C = 4096; }
    else if ((item -= 2048) < 2048) { const int b = item >> 10; item &= 1023; j.in = p.mlp_w2 + (size_t)b * 4194304; j.out = (bf16_t*)(p.ws + OFF_W2) + (size_t)b * 4194304; j.R = 4096; j.C = 1024; }
    else if ((item -= 2048) < 256) { const int b = item >> 3; item &= 7; j.in = p.cache_diff_v + (size_t)b * 32768; j.out = (bf16_t*)(p.ws + OFF_CDVT) + (size_t)b * 32768; j.R = 256; j.C = 128; }
    else if ((item -= 256) < 256) { const int b = item >> 2; item &= 3; j.in = p.cache_na_v + (size_t)b * 16384; j.out = (bf16_t*)(p.ws + OFF_CNVT) + (size_t)b * 16384; j.R = 256; j.C = 64; }
    else { item -= 256; const int b = item >> 2; item &= 3; j.in = p.cache_swa_v + (size_t)b * 16384; j.out = (bf16_t*)(p.ws + OFF_CSVT) + (size_t)b * 16384; j.R = 256; j.C = 64; }
    const int ntc = j.C >> 6;
    j.tr = item / ntc; j.tc = item % ntc;
    return j;
}
DI void p0_tload(const TJob& j, int tid, f32x4 (&a)[2], f32x4 (&b)[2]) {
    const int cl = (tid & 15) * 4, rl = (tid >> 4) * 2;
#pragma unroll
    for (int i = 0; i < 2; ++i) {
        const int r = rl + 32 * i;
        a[i] = __builtin_nontemporal_load((const f32x4*)(j.in + (size_t)(j.tr * 64 + r) * j.C + j.tc * 64 + cl));
        b[i] = __builtin_nontemporal_load((const f32x4*)(j.in + (size_t)(j.tr * 64 + r + 1) * j.C + j.tc * 64 + cl));
    }
}
DI void p0_phase(const Params& p, int bid, int nb, char* lds) {
    if (bid < 192) p0_mod_item(p, bid, lds);
    const int tid = VTID;
    {
        const int cl = (tid & 15) * 4, rl = (tid >> 4) * 2, sw = tid & 7;
        const int first = bid < 192 ? bid : 1536 + (bid - 192), stride = bid < 192 ? 192 : nb - 192, lim = bid < 192 ? 1536 : P0_TITEMS;
        int it = first;
        TJob cur{}; f32x4 a[2], b[2];
        if (it < lim) { cur = p0_decode(p, it); p0_tload(cur, tid, a, b); }
        while (it < lim) {
            const int nx = it + stride;
            TJob nxt{}; f32x4 an[2], bn[2];
            if (nx < lim) { nxt = p0_decode(p, nx); p0_tload(nxt, tid, an, bn); }
#pragma unroll
            for (int i = 0; i < 2; ++i) {
                const int r = rl + 32 * i;
#pragma unroll
                for (int jj = 0; jj < 4; ++jj) *(unsigned*)(lds + (cl + jj) * 128 + (((r >> 3) ^ sw) << 4) + (r & 7) * 2) = pk2(a[i][jj], b[i][jj]);
            }
            __syncthreads();
#pragma unroll
            for (int i = 0; i < 2; ++i) {
                const int idx = tid + 256 * i, c = idx >> 3, q = idx & 7;
                const u32x4 v = *(const u32x4*)(lds + c * 128 + ((q ^ ((c >> 2) & 7)) << 4));
                *(u32x4*)(cur.out + (size_t)(cur.tc * 64 + c) * cur.R + cur.tr * 64 + q * 8) = v;
            }
            __syncthreads();
            cur = nxt; a[0] = an[0]; a[1] = an[1]; b[0] = bn[0]; b[1] = bn[1];
            it = nx;
        }
    }
    {
        f32x4* st4 = (f32x4*)(p.ws + OFF_STAT);
        const f32x4 z = {0.f, 0.f, 0.f, 0.f};
        for (int i = bid * 256 + tid; i < (int)(4 * STAT_SET / 16); i += nb * 256) st4[i] = z;
    }
    for (int it = bid; it < 576; it += nb) {
        if (it < 256) p0_kreorder(p.cache_diff_k, (bf16_t*)(p.ws + OFF_CDK), 3, it);
        else if (it < 512) p0_kreorder(p.cache_na_k, (bf16_t*)(p.ws + OFF_CNK), 3, it - 256);
        else p0_kreorder(p.cache_swa_k, (bf16_t*)(p.ws + OFF_CSK), 1, it - 512);
    }
}

DI void rowop_phase(const Params& p, bool hasY, bool xin_input, int g_off, const float* wpost, bool hasH, const float* wpre, int sc_off, int sh_off) {
    const int tix = TIDX, lane = tix & 63, gw = (int)(blockIdx.x * 8) + (tix >> 6), nw = VNB * 4;
    const float* mod = (const float*)(p.ws + OFF_MOD);
    f32x4 wpo[4], wpr[4];
#pragma unroll
    for (int i = 0; i < 4; ++i) { if (hasY) wpo[i] = *(const f32x4*)(wpost + lane * 4 + 256 * i); if (hasH) wpr[i] = *(const f32x4*)(wpre + lane * 4 + 256 * i); }
    for (int row0 = gw; row0 < 16384; row0 += 2 * nw) {
        f32x4 x[2][4], y[2][4];
#pragma unroll
        for (int r = 0; r < 2; ++r) {
            const int row = row0 + r * nw;
            const float* xin = xin_input ? (row < 8192 ? p.x_prompt + (size_t)row * 1024 : p.x_sample + (size_t)(row - 8192) * 1024) : p.out + (size_t)row * 1024;
            const float* yin = (const float*)(p.ws + OFF_HY + (size_t)row * 4096);
#pragma unroll
            for (int i = 0; i < 4; ++i) { x[r][i] = __builtin_nontemporal_load((const f32x4*)(xin + lane * 4 + 256 * i)); if (hasY) y[r][i] = *(const f32x4*)(yin + lane * 4 + 256 * i); }
        }
#pragma unroll
        for (int r = 0; r < 2; ++r) {
            const int row = row0 + r * nw;
            const int v = row < 8192 ? 0 : 1 + ((row - 8192) >> 10);
            char* hy = p.ws + OFF_HY + (size_t)row * 4096;
            if (hasY) {
                f32x4 g4[4];
#pragma unroll
                for (int i = 0; i < 4; ++i) g4[i] = *(const f32x4*)(mod + v * 6144 + g_off + lane * 4 + 256 * i);
                float ss = 0.f;
#pragma unroll
                for (int i = 0; i < 4; ++i) ss += y[r][i][0] * y[r][i][0] + y[r][i][1] * y[r][i][1] + y[r][i][2] * y[r][i][2] + y[r][i][3] * y[r][i][3];
                ss = wave_sum(ss);
                const float rs = rsqrtf(ss * (1.f / 1024.f) + EPSN);
#pragma unroll
                for (int i = 0; i < 4; ++i) {
                    x[r][i] += g4[i] * (y[r][i] * rs * wpo[i]);
                    *(f32x4*)(p.out + (size_t)row * 1024 + lane * 4 + 256 * i) = x[r][i];
                }
            }
            if (hasH) {
                f32x4 sc[4], sh[4];
#pragma unroll
                for (int i = 0; i < 4; ++i) { sc[i] = *(const f32x4*)(mod + v * 6144 + sc_off + lane * 4 + 256 * i); sh[i] = *(const f32x4*)(mod + v * 6144 + sh_off + lane * 4 + 256 * i); }
                float ss = 0.f;
#pragma unroll
                for (int i = 0; i < 4; ++i) ss += x[r][i][0] * x[r][i][0] + x[r][i][1] * x[r][i][1] + x[r][i][2] * x[r][i][2] + x[r][i][3] * x[r][i][3];
                ss = wave_sum(ss);
                const float rs = rsqrtf(ss * (1.f / 1024.f) + EPSN);
#pragma unroll
                for (int i = 0; i < 4; ++i) {
                    const f32x4 h = x[r][i] * rs * wpr[i] * (sc[i] + 1.f) + sh[i];
                    u32x2 o = {pk2(h[0], h[1]), pk2(h[2], h[3])};
                    *(u32x2*)((bf16_t*)hy + lane * 4 + 256 * i) = o;
                }
            }
        }
    }
}

namespace g8 {
constexpr int BK = 64, HALF = 128, HTB = HALF * BK * 2;
DI int lds_byte(int r, int c) { const int st = (r >> 4) * 2 + (c >> 5), rr = r & 15, cc = c & 31, ob = rr * 64 + cc * 2; return st * 1024 + (ob ^ (((ob >> 9) & 1) << 5)); }
DI void stage_rc(int b, int& R, int& C) { const int st = b / 1024, sb = b % 1024, swz = sb ^ (((sb >> 9) & 1) << 5); R = (st >> 1) * 16 + swz / 64; C = (st & 1) * 32 + (swz % 64) / 2; }
typedef __attribute__((address_space(3))) unsigned lds_u32;
typedef __attribute__((address_space(3))) unsigned char lds_u8;
typedef __attribute__((address_space(3))) bf16x8 lds_bf16x8;

}

enum { EPI_PE = 0, EPI_PO = 1, EPI_Y = 2, EPI_W1 = 3, EPI_YF = 4 };

struct FuseP { int from_input, hasH; float* xout; const float* g; const float* wpost; const float* wpre; const float* sc; const float* sh; float* ssY; float* ssX; unsigned* cnt; };
DI float ld_agent(const float* q) { return __hip_atomic_load(q, __ATOMIC_RELAXED, __HIP_MEMORY_SCOPE_AGENT); }
DI void panel_wait(unsigned* c, unsigned target) {
    asm volatile("s_waitcnt vmcnt(0)" ::: "memory");
    __syncthreads();
    if (threadIdx.x == 0) {
        __hip_atomic_fetch_add(c, 1u, __ATOMIC_RELAXED, __HIP_MEMORY_SCOPE_AGENT);
        unsigned sp = 0;
        while (__hip_atomic_load(c, __ATOMIC_RELAXED, __HIP_MEMORY_SCOPE_AGENT) < target) { __builtin_amdgcn_s_sleep(1); if (++sp > (1u << 22)) break; }
    }
    __syncthreads();
}
DI float dot4(const f32x4& a) { return a[0] * a[0] + a[1] * a[1] + a[2] * a[2] + a[3] * a[3]; }

DI void rope_s(f32x4 (&sub)[4][2], int R0, bool usecol, int fr, int fq) {
    asm volatile("" : "+s"(R0));
    const float sgn = fq < 2 ? -1.f : 1.f;
#pragma unroll
    for (int m = 0; m < 4; ++m) {
        __builtin_amdgcn_sched_barrier(0);
        const int tl = (R0 + m * 16 + fr - 8192) & 1023;
        const float pos = (float)(usecol ? (tl & 63) : (tl >> 6));
#pragma unroll
        for (int n = 0; n < 2; ++n)
#pragma unroll
            for (int j = 0; j < 4; ++j) {
                const float inv = exp2f(-(float)(8 * (fq & 1) + 4 * n + j) * (13.287712379549449f / 16.f));
                float sn, cs;
                __sincosf(pos * inv, &sn, &cs);
                const float v = sub[m][n][j], pv = __shfl_xor(v, 32);
                sub[m][n][j] = v * cs + sgn * pv * sn;
            }
    }
}
DI void store_bf16_rows_s(const f32x4 (&sub)[4][2], bf16_t* base, int ld, int R0, int Cd0, int fr, int fq) {
#pragma unroll
    for (int m = 0; m < 4; ++m) {
        u32x4 o = {pk2(sub[m][0][0], sub[m][0][1]), pk2(sub[m][0][2], sub[m][0][3]), pk2(sub[m][1][0], sub[m][1][1]), pk2(sub[m][1][2], sub[m][1][3])};
        *(u32x4*)(base + (size_t)(R0 + m * 16 + fr) * ld + Cd0 + fq * 8) = o;
    }
}
DI void store_f32_rows_s(const f32x4 (&sub)[4][2], float* ob, int ldo, int fr, int fq) {
#pragma unroll
    for (int m = 0; m < 4; ++m) {
        float* rp = ob + (size_t)(m * 16 + fr) * ldo + fq * 8;
#pragma unroll
        for (int n = 0; n < 2; ++n) __builtin_nontemporal_store(sub[m][n], (f32x4*)(rp + n * 4));
    }
}
DI void store_vt_s(const f32x4 (&sub)[4][2], bf16_t* vt, int T, int t0, int fr, int fq) {
#pragma unroll
    for (int n = 0; n < 2; ++n) {
        bf16_t* rp = vt + (size_t)(8 * (fr >> 2) + 4 * n + (fr & 3)) * T + t0 + fq * 4;
#pragma unroll
        for (int m = 0; m < 4; ++m) { u32x2 o = {pk2(sub[m][n][0], sub[m][n][1]), pk2(sub[m][n][2], sub[m][n][3])}; *(u32x2*)(rp + m * 16) = o; }
    }
}
DI void store_f32_ns_s(const f32x4 (&sub)[4][2], float* ob, int ldo, int fr, int fq) {
#pragma unroll
    for (int m = 0; m < 4; ++m)
#pragma unroll
        for (int j = 0; j < 4; ++j) {
            float* rp = ob + (size_t)(m * 16 + fq * 4 + j) * ldo + 8 * (fr >> 2) + (fr & 3);
#pragma unroll
            for (int n = 0; n < 2; ++n) __builtin_nontemporal_store(sub[m][n][j], rp + n * 4);
        }
}

template <int EPI>
DI void tile_epilogue(const Params& p, f32x4 (&acc)[2][2][4][2], int pm, int pn, int vtm, const FuseP& fz) {
    const int tix = TIDX, wid = __builtin_amdgcn_readfirstlane(tix >> 6), lane = tix & 63, wr = wid >> 2, wc = wid & 3;
    const int brow = pm * 256, bcol = pn * 256;
    int fr = lane & 15, fq = lane >> 4;
    asm volatile("" : "+v"(fr), "+v"(fq));
    const bool latent = brow >= 8192;
    int b, tb, T;
    if (latent) { b = (brow - 8192) >> 10; tb = (brow - 8192) & 1023; T = 1024; } else { b = brow >> 8; tb = 0; T = 256; }
    bf16_t* big = (bf16_t*)(p.ws + OFF_BIG);
    if (EPI == EPI_YF) {
        const int v = latent ? 1 + b : 0;
        const int rbase = brow + wr * 64 + fr;
        const int cbase = bcol + wc * 32 + fq * 8;
        float rs[2][4];
#pragma unroll
        for (int ai = 0; ai < 2; ++ai)
#pragma unroll
            for (int m = 0; m < 4; ++m) {
                float sq = dot4(acc[ai][0][m][0]) + dot4(acc[ai][0][m][1]) + dot4(acc[ai][1][m][0]) + dot4(acc[ai][1][m][1]);
                sq += __shfl_xor(sq, 16); sq += __shfl_xor(sq, 32);
                if (fq == 0) { const float old = __hip_atomic_fetch_add(fz.ssY + rbase + ai * 128 + m * 16, sq, __ATOMIC_RELAXED, __HIP_MEMORY_SCOPE_AGENT); asm volatile("" :: "v"(old)); }
            }
        panel_wait(fz.cnt + pm * 32, 4u);
#pragma unroll
        for (int ai = 0; ai < 2; ++ai)
#pragma unroll
            for (int m = 0; m < 4; ++m) rs[ai][m] = rsqrtf(ld_agent(fz.ssY + rbase + ai * 128 + m * 16) * (1.f / 1024.f) + EPSN);
        const float* xin = latent ? p.x_sample - (size_t)8192 * 1024 : p.x_prompt;
        bf16_t* xb = (bf16_t*)(p.ws + OFF_HY) + 1024;
        float s2[2][4];
#pragma unroll
        for (int ai = 0; ai < 2; ++ai)
#pragma unroll
            for (int m = 0; m < 4; ++m) s2[ai][m] = 0.f;
#pragma unroll
        for (int bj = 0; bj < 2; ++bj) {
            const int col = cbase + bj * 128;
            f32x4 g4[2], wp4[2];
#pragma unroll
            for (int n = 0; n < 2; ++n) { g4[n] = *(const f32x4*)(fz.g + v * 6144 + col + 4 * n); wp4[n] = *(const f32x4*)(fz.wpost + col + 4 * n); }
#pragma unroll
            for (int ai = 0; ai < 2; ++ai)
#pragma unroll
                for (int m = 0; m < 4; ++m) {
                    const size_t off = (size_t)(rbase + ai * 128 + m * 16) * 1024 + col;
                    f32x4 x4[2];
                    if (fz.from_input) { x4[0] = __builtin_nontemporal_load((const f32x4*)(xin + off)); x4[1] = __builtin_nontemporal_load((const f32x4*)(xin + off + 4)); }
                    else {
                        const u32x4 xr = __builtin_nontemporal_load((const u32x4*)(xb + 2 * off - col));
                        x4[0] = (f32x4){bflo(xr[0]), bfhi(xr[0]), bflo(xr[1]), bfhi(xr[1])}; x4[1] = (f32x4){bflo(xr[2]), bfhi(xr[2]), bflo(xr[3]), bfhi(xr[3])};
                    }
                    f32x4 a[2];
#pragma unroll
                    for (int n = 0; n < 2; ++n) { a[n] = x4[n] + g4[n] * (acc[ai][bj][m][n] * rs[ai][m] * wp4[n]); acc[ai][bj][m][n] = a[n]; s2[ai][m] += dot4(a[n]); }
                    if (fz.hasH) { u32x4 xo = {pk2(a[0][0], a[0][1]), pk2(a[0][2], a[0][3]), pk2(a[1][0], a[1][1]), pk2(a[1][2], a[1][3])}; *(u32x4*)(xb + 2 * off - col) = xo; }
                    else { __builtin_nontemporal_store(a[0], (f32x4*)(fz.xout + off)); __builtin_nontemporal_store(a[1], (f32x4*)(fz.xout + off + 4)); }
                }
        }
        if (fz.hasH) {
#pragma unroll
            for (int ai = 0; ai < 2; ++ai)
#pragma unroll
                for (int m = 0; m < 4; ++m) {
                    float sq = s2[ai][m];
                    sq += __shfl_xor(sq, 16); sq += __shfl_xor(sq, 32);
                    if (fq == 0) { const float old = __hip_atomic_fetch_add(fz.ssX + rbase + ai * 128 + m * 16, sq, __ATOMIC_RELAXED, __HIP_MEMORY_SCOPE_AGENT); asm volatile("" :: "v"(old)); }
                }
            panel_wait(fz.cnt + pm * 32 + 16, 4u);
#pragma unroll
            for (int ai = 0; ai < 2; ++ai)
#pragma unroll
                for (int m = 0; m < 4; ++m) rs[ai][m] = rsqrtf(ld_agent(fz.ssX + rbase + ai * 128 + m * 16) * (1.f / 1024.f) + EPSN);
            bf16_t* hb = (bf16_t*)(p.ws + OFF_HY);
#pragma unroll
            for (int bj = 0; bj < 2; ++bj) {
                const int col = cbase + bj * 128;
                f32x4 wq4[2], sc4[2], sh4[2];
#pragma unroll
                for (int n = 0; n < 2; ++n) { wq4[n] = *(const f32x4*)(fz.wpre + col + 4 * n); sc4[n] = *(const f32x4*)(fz.sc + v * 6144 + col + 4 * n) + 1.f; sh4[n] = *(const f32x4*)(fz.sh + v * 6144 + col + 4 * n); }
#pragma unroll
                for (int ai = 0; ai < 2; ++ai)
#pragma unroll
                    for (int m = 0; m < 4; ++m) {
                        const f32x4 h0 = acc[ai][bj][m][0] * rs[ai][m] * wq4[0] * sc4[0] + sh4[0], h1 = acc[ai][bj][m][1] * rs[ai][m] * wq4[1] * sc4[1] + sh4[1];
                        u32x4 o = {pk2(h0[0], h0[1]), pk2(h0[2], h0[3]), pk2(h1[0], h1[1]), pk2(h1[2], h1[3])};
                        *(u32x4*)(hb + (size_t)(rbase + ai * 128 + m * 16) * 2048 + col) = o;
                    }
            }
        }
        return;
    }
#pragma unroll
    for (int ai = 0; ai < 2; ++ai)
#pragma unroll
        for (int bj = 0; bj < 2; ++bj) {
            __builtin_amdgcn_sched_barrier(0);
            f32x4 (&sub)[4][2] = acc[ai][bj];
            const int R0 = brow + ai * 128 + wr * 64, t0 = tb + ai * 128 + wr * 64, C0 = bcol + bj * 128 + wc * 32;
            const bool ns = vtm == 1 || (vtm == 2 && bj == 1);
            if (EPI == EPI_PE) {
                if (ns) {
                    const int vc = C0 - 2560;
                    bf16_t* vt = (bf16_t*)(p.ws + OFF_BIG + BIG_VT_E) + (latent ? (size_t)4194304 + ((size_t)b * 512 + vc) * 1024 : ((size_t)b * 512 + vc) * 256);
                    store_vt_s(sub, vt, T, t0, fr, fq);
                    if (!latent) store_f32_ns_s(sub, p.out + OUT_DIFFV + ((size_t)(b * 4 + (vc >> 7)) * 256 + t0) * 128 + (vc & 127), 128, fr, fq);
                } else {
                    if (pn >= 6 && latent) rope_s(sub, R0, wc & 1, fr, fq);
                    store_bf16_rows_s(sub, big, LDE, R0, C0, fr, fq);
                    if (pn >= 8 && !latent) store_f32_rows_s(sub, p.out + OUT_DIFFK + ((size_t)(b * 8 + ((C0 - 2048) >> 6)) * 256 + t0) * 64 + ((C0 - 2048) & 63), 64, fr, fq);
                }
            } else if (EPI == EPI_PO) {
                if (ns) {
                    if (pn < 8) {
                        const int vc = C0 - 1024;
                        bf16_t* vt = (bf16_t*)(p.ws + OFF_BIG + BIG_VT_C) + (latent ? (size_t)4194304 + ((size_t)b * 512 + vc) * 1024 : ((size_t)b * 512 + vc) * 256);
                        store_vt_s(sub, vt, T, t0, fr, fq);
                        if (!latent) store_f32_ns_s(sub, p.out + OUT_NAV + ((size_t)(b * 8 + (vc >> 6)) * 256 + t0) * 64 + (vc & 63), 64, fr, fq);
                    } else {
                        const int vc = C0 - 2176;
                        bf16_t* vt = (bf16_t*)(p.ws + OFF_BIG + BIG_VT_D) + (latent ? (size_t)1048576 + ((size_t)b * 128 + vc) * 1024 : ((size_t)b * 128 + vc) * 256);
                        store_vt_s(sub, vt, T, t0, fr, fq);
                        if (!latent) store_f32_ns_s(sub, p.out + OUT_SWAV + ((size_t)(b * 2 + (vc >> 6)) * 256 + t0) * 64 + (vc & 63), 64, fr, fq);
                    }
                } else {
                    if (pn >= 6 && latent) rope_s(sub, R0, wc & 1, fr, fq);
                    store_bf16_rows_s(sub, big, LDO, R0, pn >= 6 ? C0 - 512 : C0, fr, fq);
                    if (!latent) {
                        if (pn == 2 || pn == 3) store_f32_rows_s(sub, p.out + OUT_NAK + ((size_t)(b * 8 + ((C0 - 512) >> 6)) * 256 + t0) * 64 + ((C0 - 512) & 63), 64, fr, fq);
                        else if (pn == 8) store_f32_rows_s(sub, p.out + OUT_SWAK + ((size_t)(b * 2 + ((C0 - 2048) >> 6)) * 256 + t0) * 64 + ((C0 - 2048) & 63), 64, fr, fq);
                    }
                }
            } else if (EPI == EPI_Y) {
                store_f32_rows_s(sub, (float*)(p.ws + OFF_HY) + (size_t)R0 * 1024 + C0, 1024, fr, fq);
            } else {
#pragma unroll
                for (int m = 0; m < 4; ++m)
#pragma unroll
                    for (int n = 0; n < 2; ++n)
#pragma unroll
                        for (int j = 0; j < 4; ++j) { const float v = fmaxf(sub[m][n][j], 0.f); sub[m][n][j] = v * v; }
                store_bf16_rows_s(sub, big, 4096, R0, C0, fr, fq);
            }
        }
}

template <int EPI>
DI void gemm_phase(const Params& p, const bf16_t* A, int lda, const bf16_t* Bt, int K, int NT_N, char* shm, const FuseP& fz = FuseP{}) {
    using namespace g8;
    const int xcd = blockIdx.x & 7, lb = blockIdx.x >> 3, nlb = gridDim.x >> 3, per_xcd = 8 * NT_N;
    if (lb >= per_xcd) return;
    const int tid = TIDX, wid = __builtin_amdgcn_readfirstlane(tid >> 6), lane = tid & 63, wr = wid >> 2, wc = wid & 3, fr = lane & 15, fq = lane >> 4;
    const int nt = K / BK;
    lds_u8* lds = (lds_u8*)shm;
    unsigned voffA[2], voffB[2];
#pragma unroll
    for (int _i = 0; _i < 2; ++_i) { int _r, _c; stage_rc(tid * 16 + _i * 8192, _r, _c); const int _i16 = _r & 15, _rb = (_r & ~31) + 8 * (_i16 >> 2) + 4 * ((_r >> 4) & 1) + (_i16 & 3);
        voffA[_i] = (unsigned)(_r * lda + _c) * 2u; voffB[_i] = (unsigned)(_rb * K + _c) * 2u; }
    const size_t kstep = (size_t)BK * 2, hstepA = (size_t)HALF * lda * 2, hstepB = (size_t)HALF * K * 2;
    const unsigned ldsw = (unsigned)wid * 1024u;
    const int aoff = lds_byte(wr * 64 + fr, fq * 8), boff = lds_byte(wc * 32 + fr, fq * 8);
#define SA(b, h) (((b) * 2 + (h)) * HTB)
#define SB(b, h) ((4 + (b) * 2 + (h)) * HTB)
#define STAGE(bufoff, gbase, voff) do { _Pragma("unroll") for (int _i = 0; _i < 2; ++_i) \
      __builtin_amdgcn_global_load_lds((const unsigned*)((gbase) + (voff)[_i]), (lds_u32*)(lds + (bufoff) + ldsw + _i * 8192), 16, 0, 0); } while (0)
#define LDA(dst, b, h) _Pragma("unroll") for (int m = 0; m < 4; ++m) _Pragma("unroll") for (int k = 0; k < 2; ++k) \
    dst[m][k] = *(const lds_bf16x8*)(lds + SA(b, h) + aoff + m * 2048 + k * 1024)
#define LDB(dst, b, h) _Pragma("unroll") for (int n = 0; n < 2; ++n) _Pragma("unroll") for (int k = 0; k < 2; ++k) \
    dst[n][k] = *(const lds_bf16x8*)(lds + SB(b, h) + boff + n * 2048 + k * 1024)
#define MMA(VT, ai, bj, At_, Bt_) do { __builtin_amdgcn_s_setprio(1); \
    _Pragma("unroll") for (int m = 0; m < 4; ++m) _Pragma("unroll") for (int n = 0; n < 2; ++n) _Pragma("unroll") for (int k = 0; k < 2; ++k) \
      acc[ai][bj][m][n] = ((VT) == 1 || ((VT) == 2 && (bj) == 1)) ? MFMA16(At_[m][k], Bt_[n][k], acc[ai][bj][m][n]) : MFMA16(Bt_[n][k], At_[m][k], acc[ai][bj][m][n]); \
    __builtin_amdgcn_s_setprio(0); } while (0)
#define WAIT_V(n) asm volatile("s_waitcnt vmcnt(" #n ")" ::: "memory")
#define WAIT_L(n) asm volatile("s_waitcnt lgkmcnt(" #n ")" ::: "memory")
#define BAR __builtin_amdgcn_s_barrier()
#define SCHED __builtin_amdgcn_sched_barrier(0)
#define TLOOP(VT) for (int t = 0; t < nt; t += 2) { \
        const bool last = (t == nt - 2); \
        const char* a1 = cA + (size_t)(t + 1) * kstep; \
        const char* a2 = last ? nA : cA + (size_t)(t + 2) * kstep; const char* b2 = last ? nB : cB + (size_t)(t + 2) * kstep; \
        const char* a3 = a2 + kstep; const char* b3 = b2 + kstep; \
        LDB(B0, 0, 0); LDB(B1, 0, 1); SCHED; LDA(At, 0, 0); STAGE(SA(1, 1), a1 + hstepA, voffA); \
        WAIT_V(8); WAIT_L(0); BAR; MMA(VT, 0, 0, At, B0); MMA(VT, 0, 1, At, B1); BAR; SCHED; \
        LDA(At, 0, 1); STAGE(SB(0, 0), b2, voffB); STAGE(SB(0, 1), b2 + hstepB, voffB); STAGE(SA(0, 0), a2, voffA); \
        WAIT_V(8); WAIT_L(0); BAR; MMA(VT, 1, 0, At, B0); MMA(VT, 1, 1, At, B1); BAR; SCHED; \
        LDB(B0, 1, 0); LDB(B1, 1, 1); SCHED; LDA(At, 1, 0); STAGE(SA(0, 1), a2 + hstepA, voffA); \
        WAIT_V(8); WAIT_L(0); BAR; MMA(VT, 0, 0, At, B0); MMA(VT, 0, 1, At, B1); BAR; SCHED; \
        LDA(At, 1, 1); STAGE(SB(1, 0), b3, voffB); STAGE(SB(1, 1), b3 + hstepB, voffB); STAGE(SA(1, 0), a3, voffA); \
        WAIT_V(8); WAIT_L(0); BAR; MMA(VT, 1, 0, At, B0); MMA(VT, 1, 1, At, B1); BAR; SCHED; \
    }
    int lt = lb, pm = xcd * 8 + (lt & 7), pn = lt >> 3;
    f32x4 acc[2][2][4][2];
#pragma unroll
    for (int a = 0; a < 2; ++a)
#pragma unroll
        for (int b = 0; b < 2; ++b)
#pragma unroll
            for (int m = 0; m < 4; ++m)
#pragma unroll
                for (int n = 0; n < 2; ++n) acc[a][b][m][n] = (f32x4){0.f, 0.f, 0.f, 0.f};
    bf16x8 At[4][2], B0[2][2], B1[2][2];
    const char* cA = (const char*)A + (size_t)pm * 2 * hstepA;
    const char* cB = (const char*)Bt + (size_t)pn * 2 * hstepB;
    WAIT_V(0);
    STAGE(SB(0, 0), cB, voffB); STAGE(SB(0, 1), cB + hstepB, voffB); STAGE(SA(0, 0), cA, voffA); STAGE(SA(0, 1), cA + hstepA, voffA);
    if (wr == 1) BAR;
    WAIT_V(2); BAR;
    STAGE(SB(1, 0), cB + kstep, voffB); STAGE(SA(1, 0), cA + kstep, voffA); STAGE(SB(1, 1), cB + hstepB + kstep, voffB);
    WAIT_V(6); BAR;
    for (;;) {
        const int ltn = lt + nlb;
        const bool has_next = ltn < per_xcd;
        const int pmn = xcd * 8 + (ltn & 7), pnn = ltn >> 3;
        const char* nA = has_next ? (const char*)A + (size_t)pmn * 2 * hstepA : cA;
        const char* nB = has_next ? (const char*)Bt + (size_t)pnn * 2 * hstepB : cB;
        int vtm = 0;
        if (EPI == EPI_PE) vtm = pn >= 10 ? 1 : 0;
        if (EPI == EPI_PO) vtm = (pn == 4 || pn == 5) ? 1 : (pn == 8 ? 2 : 0);
        if ((EPI == EPI_PE || EPI == EPI_PO) && vtm == 1) { TLOOP(1) }
        else if (EPI == EPI_PO && vtm == 2) { TLOOP(2) }
        else { TLOOP(0) }
        if (wr == 0) BAR;
        if (EPI != EPI_YF) tile_epilogue<EPI>(p, acc, pm, pn, vtm, fz);
        if (!has_next) break;
#pragma unroll
        for (int a = 0; a < 2; ++a)
#pragma unroll
            for (int b = 0; b < 2; ++b)
#pragma unroll
                for (int m = 0; m < 4; ++m)
#pragma unroll
                    for (int n = 0; n < 2; ++n) acc[a][b][m][n] = (f32x4){0.f, 0.f, 0.f, 0.f};
        lt = ltn; pm = pmn; pn = pnn; cA = nA; cB = nB;
        if (wr == 1) BAR;
    }
    WAIT_V(0);
    BAR;
    if (EPI == EPI_YF) tile_epilogue<EPI>(p, acc, pm, pn, 0, fz);
#undef SA
#undef SB
#undef STAGE
#undef LDA
#undef LDB
#undef MMA
#undef WAIT_V
#undef WAIT_L
#undef BAR
#undef SCHED
#undef TLOOP
}

struct ASeg { const bf16_t* K; const bf16_t* Vt; int ldk, ldv, ntiles; };
struct MaskP { int on, a, b, c; const float* tab; };

template <int KW, int VR, int NB, int MODE>
DI void attn_core(const ASeg& s0, const ASeg& s1, const bf16x8 (&qf)[4], int kchunk0, int vrow0, float scale_l2, float& m, float& l, f32x16 (&O)[NB], char* lds, const MaskP& mp) {
    constexpr int KC = KW / 8, NKL = 64 * KC / 256, NVL = VR * 8 / 256;
    const int tid = VTID, lane = tid & 63, p32 = lane & 31, h = lane >> 5;
    const int krow = (p32 & 19) | ((p32 & 4) << 1) | ((p32 & 8) >> 1);
    const int n0 = s0.ntiles, nt = s0.ntiles + s1.ntiles;
    u32x4 rk[NKL], rv[NVL];
#define ATT_LOAD(t_)                                                                                                         \
    {                                                                                                                        \
        const bool f_ = (t_) < n0; const int tt_ = f_ ? (t_) : (t_) - n0;                                                     \
        const bf16_t* Kp_ = (f_ ? s0.K : s1.K); const int ldk_ = f_ ? s0.ldk : s1.ldk;                                        \
        const bf16_t* Vp_ = (f_ ? s0.Vt : s1.Vt); const int ldv_ = f_ ? s0.ldv : s1.ldv;                                      \
        _Pragma("unroll") for (int i = 0; i < NKL; ++i) { const int id = tid + 256 * i, r = id / KC, c = id % KC; rk[i] = *(const u32x4*)(Kp_ + (size_t)(tt_ * 64 + r) * ldk_ + c * 8); } \
        _Pragma("unroll") for (int i = 0; i < NVL; ++i) { const int id = tid + 256 * i, r = id >> 3, c = id & 7; rv[i] = *(const u32x4*)(Vp_ + (size_t)r * ldv_ + tt_ * 64 + c * 8); }       \
    }
#define ATT_STORE(b_)                                                                                                        \
    {                                                                                                                        \
        char* kb_ = lds + (b_) * 32768; char* vb_ = kb_ + 16384;                                                              \
        _Pragma("unroll") for (int i = 0; i < NKL; ++i) { const int id = tid + 256 * i, r = id / KC, c = id % KC; *(u32x4*)(kb_ + (KW == 128 ? swz256(r, c) : swz128(r, c))) = rk[i]; } \
        _Pragma("unroll") for (int i = 0; i < NVL; ++i) { const int id = tid + 256 * i, r = id >> 3, c = id & 7; *(u32x4*)(vb_ + swz128(r, c)) = rv[i]; }                               \
    }
    int dco[2][16];
    if (MODE == 1) {
        const int cq = mp.c + p32, cs = min(max(cq - 8, 0), 48);
#pragma unroll
        for (int kh = 0; kh < 2; ++kh)
#pragma unroll
            for (int i = 0; i < 16; ++i) {
                const int kc = 32 * kh + 16 * (i >> 3) + 8 * h + (i & 7);
                dco[kh][i] = ((unsigned)(kc - cs) < 16u ? min(max(kc - cq + 15, 0), 30) : 31) * 4;
            }
    }
    ATT_LOAD(0);
    ATT_STORE(0);
    __syncthreads();
    for (int t = 0; t < nt; ++t) {
        const bool more = t + 1 < nt;
        if (more) ATT_LOAD(t + 1);
        const char* kb = lds + (t & 1) * 32768;
        const char* vb = kb + 16384;
        f32x16 S[2];
#pragma unroll
        for (int kh = 0; kh < 2; ++kh) {
#pragma unroll
            for (int i = 0; i < 16; ++i) S[kh][i] = 0.f;
            const int row = krow + 32 * kh;
#pragma unroll
            for (int s = 0; s < 4; ++s) {
                const int c = kchunk0 + 2 * s + h;
                const bf16x8 kf = *(const bf16x8*)(kb + (KW == 128 ? swz256(row, c) : swz128(row, c)));
                S[kh] = MFMA32(kf, qf[s], S[kh]);
            }
        }
        const bool msk = (MODE != 0) && mp.on && t < n0;
        float mx = -1e30f;
        if (MODE == 1 && msk) {
            const char* trow = (const char*)(mp.tab + (mp.b + t - mp.a + 7) * 32);
#pragma unroll
            for (int kh = 0; kh < 2; ++kh)
#pragma unroll
                for (int i = 0; i < 16; ++i) {
                    const float sv = __builtin_fmaf(S[kh][i], scale_l2, *(const float*)(trow + dco[kh][i]));
                    S[kh][i] = sv; mx = fmaxf(mx, sv);
                }
        } else if (MODE == 2 && msk) {
            int qp = mp.a + p32 - 8 * h;
            asm volatile("" : "+v"(qp));
            const int k0 = mp.b + t * 64;
#pragma unroll
            for (int kh = 0; kh < 2; ++kh)
#pragma unroll
                for (int i = 0; i < 16; ++i) {
                    const int d = qp - (k0 + 32 * kh + 16 * (i >> 3) + (i & 7));
                    const bool ok = d <= 128 && d >= -128;
                    const float sv = ok ? S[kh][i] * scale_l2 : -1e30f;
                    S[kh][i] = sv; mx = fmaxf(mx, sv);
                }
        } else {
            float m0 = fmaxf(fmaxf(S[0][0], S[0][1]), S[0][2]), m1 = fmaxf(fmaxf(S[1][0], S[1][1]), S[1][2]);
#pragma unroll
            for (int i = 3; i < 15; i += 2) { m0 = fmaxf(fmaxf(m0, S[0][i]), S[0][i + 1]); m1 = fmaxf(fmaxf(m1, S[1][i]), S[1][i + 1]); }
            mx = fmaxf(fmaxf(m0, m1), fmaxf(S[0][15], S[1][15])) * scale_l2;
        }
        mx = fmaxf(mx, __shfl_xor(mx, 32));
        if (__any(mx > m + 8.f)) {
            const float mn = fmaxf(m, mx);
            const float alpha = __builtin_amdgcn_exp2f(m - mn);
            m = mn;
            l *= alpha;
#pragma unroll
            for (int blk = 0; blk < NB; ++blk)
#pragma unroll
                for (int i = 0; i < 16; ++i) O[blk][i] *= alpha;
        }
        float ls = 0.f;
        if ((MODE == 1 || MODE == 2) && msk) {
#pragma unroll
            for (int kh = 0; kh < 2; ++kh)
#pragma unroll
                for (int i = 0; i < 16; ++i) { const float pv = __builtin_amdgcn_exp2f(S[kh][i] - m); S[kh][i] = pv; ls += pv; }
        } else {
            const float negm = -m;
#pragma unroll
            for (int kh = 0; kh < 2; ++kh)
#pragma unroll
                for (int i = 0; i < 16; ++i) { const float pv = __builtin_amdgcn_exp2f(__builtin_fmaf(S[kh][i], scale_l2, negm)); S[kh][i] = pv; ls += pv; }
        }
        l += ls;
#pragma unroll
        for (int kh = 0; kh < 2; ++kh)
#pragma unroll
            for (int s2 = 0; s2 < 2; ++s2) {
                u32x4 pp = {pk2(S[kh][8 * s2 + 0], S[kh][8 * s2 + 1]), pk2(S[kh][8 * s2 + 2], S[kh][8 * s2 + 3]), pk2(S[kh][8 * s2 + 4], S[kh][8 * s2 + 5]), pk2(S[kh][8 * s2 + 6], S[kh][8 * s2 + 7])};
                const bf16x8 pb = __builtin_bit_cast(bf16x8, pp);
                const int c = 4 * kh + 2 * s2 + h;
#pragma unroll
                for (int blk = 0; blk < NB; ++blk) {
                    const bf16x8 vf = *(const bf16x8*)(vb + swz128(vrow0 + blk * 32 + p32, c));
                    O[blk] = MFMA32(vf, pb, O[blk]);
                }
            }
        if (more) ATT_STORE((t + 1) & 1);
        __syncthreads();
    }
    l += __shfl_xor(l, 32);
#undef ATT_LOAD
#undef ATT_STORE
}

DI void load_q(bf16x8 (&qf)[4], const bf16_t* qrow, int h) {
#pragma unroll
    for (int s = 0; s < 4; ++s) qf[s] = *(const bf16x8*)(qrow + 16 * s + 8 * h);
}

DI void attn_diff_item(const Params& p, int item, char* lds) {
    const int tid = VTID, lane = tid & 63, w = tid >> 6, p32 = lane & 31, h = lane >> 5, stream = w & 1, qh = w >> 1;
    const bf16_t* proj = (const bf16_t*)(p.ws + OFF_BIG);
    const bf16_t* vte = (const bf16_t*)(p.ws + OFF_BIG + BIG_VT_E);
    bf16_t* mix = (bf16_t*)(p.ws + OFF_BIG + BIG_MIXIN);
    int b, hd, qb, rowbase; ASeg s0, s1;
    if (item < 512) {
        b = item >> 6; hd = (item >> 4) & 3; qb = item & 15; rowbase = 8192 + b * 1024;
        s0 = {proj + (size_t)rowbase * LDE + 2048 + hd * 128, vte + 4194304 + ((size_t)b * 512 + hd * 128) * 1024, LDE, 1024, 16};
        s1 = {(const bf16_t*)(p.ws + OFF_CDK) + (size_t)b * 256 * 512 + hd * 128, (const bf16_t*)(p.ws + OFF_CDVT) + (size_t)(b * 4 + hd) * 128 * 256, 512, 256, 4};
    } else {
        const int it = item - 512;
        b = it >> 4; hd = (it >> 2) & 3; qb = it & 3; rowbase = b * 256;
        s0 = {proj + (size_t)rowbase * LDE + 2048 + hd * 128, vte + ((size_t)b * 512 + hd * 128) * 256, LDE, 256, 4};
        s1 = s0; s1.ntiles = 0;
    }
    const int R = rowbase + qb * 64 + qh * 32 + p32;
    bf16x8 qf[4];
    load_q(qf, proj + (size_t)R * LDE + 1536 + hd * 128 + stream * 64, h);
    f32x16 O[4];
#pragma unroll
    for (int blk = 0; blk < 4; ++blk)
#pragma unroll
        for (int i = 0; i < 16; ++i) O[blk][i] = 0.f;
    float m = -1e30f, l = 0.f;
    MaskP mp = {0, 0, 0, 0, nullptr};
    attn_core<128, 128, 4, 0>(s0, s1, qf, stream * 8, 0, 0.125f * LOG2E, m, l, O, lds, mp);
    const float il = 1.f / l;
    const float d1 = wave_sum(p.lq1[lane] * p.lk1[lane]), d2 = wave_sum(p.lq2[lane] * p.lk2[lane]);
    const float lam_init = 0.2f;
    const float lam = __expf(d1) - __expf(d2) + lam_init;
    float* xb = (float*)(lds + qh * 16384);
    if (stream == 1) {
#pragma unroll
        for (int blk = 0; blk < 4; ++blk)
#pragma unroll
            for (int i = 0; i < 16; ++i) { const int dv = blk * 32 + 8 * (i >> 2) + 4 * h + (i & 3); xb[dv * 32 + p32] = O[blk][i] * il; }
    }
    __syncthreads();
    if (stream == 0) {
        float ss = 0.f;
#pragma unroll
        for (int blk = 0; blk < 4; ++blk)
#pragma unroll
            for (int i = 0; i < 16; ++i) { const int dv = blk * 32 + 8 * (i >> 2) + 4 * h + (i & 3); const float o = O[blk][i] * il - lam * xb[dv * 32 + p32]; O[blk][i] = o; ss += o * o; }
        ss += __shfl_xor(ss, 32);
        const float rs = rsqrtf(ss * (1.f / 128.f) + EPSN) * (1.f - lam_init);
        bf16_t* op = mix + (size_t)R * 1024 + 512 + hd * 128;
#pragma unroll
        for (int blk = 0; blk < 4; ++blk)
#pragma unroll
            for (int g = 0; g < 4; ++g) {
                const int dv = blk * 32 + 8 * g + 4 * h;
                const f32x4 sl = *(const f32x4*)(p.subln + dv);
                u32x2 o = {pk2(O[blk][4 * g] * rs * sl[0], O[blk][4 * g + 1] * rs * sl[1]), pk2(O[blk][4 * g + 2] * rs * sl[2], O[blk][4 * g + 3] * rs * sl[3])};
                *(u32x2*)(op + dv) = o;
            }
    }
    __syncthreads();
}

DI void attn_c_item(const Params& p, int item, char* lds) {
    const int tid = VTID, lane = tid & 63, w = tid >> 6, p32 = lane & 31, h = lane >> 5, stream = w & 1, qh = w >> 1;
    const bf16_t* proj = (const bf16_t*)(p.ws + OFF_BIG);
    const bf16_t* vtc = (const bf16_t*)(p.ws + OFF_BIG + BIG_VT_C);
    bf16_t* mix = (bf16_t*)(p.ws + OFF_BIG + BIG_MIXIN);
    int b, hp, qb, rowbase; ASeg s0, s1; MaskP mp = {0, 0, 0, 0, nullptr};
    float* tab = (float*)(lds + 65536);
    if (item < 512) {
        b = item >> 6; hp = (item >> 4) & 3; qb = item & 15; rowbase = 8192 + b * 1024;
        const int rstart = min(max(qb - 4, 0), 8);
        s0 = {proj + (size_t)(rowbase + rstart * 64) * LDO + 512 + hp * 128, vtc + 4194304 + ((size_t)b * 512 + hp * 128) * 1024 + rstart * 64, LDO, 1024, 8};
        s1 = {(const bf16_t*)(p.ws + OFF_CNK) + (size_t)b * 256 * 512 + hp * 128, (const bf16_t*)(p.ws + OFF_CNVT) + ((size_t)b * 512 + hp * 128) * 256, 512, 256, 4};
        for (int idx = tid; idx < 960; idx += 256) { const int hr = idx >> 5, cc = idx & 31; tab[idx] = cc < 31 ? p.rpb[hp * 930 + hr * 31 + cc] * LOG2E : -1e30f; }
        mp = {1, qb, rstart, qh * 32, tab + stream * 480};
    } else {
        const int it = item - 512;
        b = it >> 4; hp = (it >> 2) & 3; qb = it & 3; rowbase = b * 256;
        s0 = {proj + (size_t)rowbase * LDO + 512 + hp * 128, vtc + ((size_t)b * 512 + hp * 128) * 256, LDO, 256, 4};
        s1 = s0; s1.ntiles = 0;
    }
    const int R = rowbase + qb * 64 + qh * 32 + p32;
    const int head = hp * 2 + stream;
    bf16x8 qf[4];
    load_q(qf, proj + (size_t)R * LDO + head * 64, h);
    f32x16 O[2];
#pragma unroll
    for (int blk = 0; blk < 2; ++blk)
#pragma unroll
        for (int i = 0; i < 16; ++i) O[blk][i] = 0.f;
    float m = -1e30f, l = 0.f;
    attn_core<128, 128, 2, 1>(s0, s1, qf, stream * 8, stream * 64, 0.125f * LOG2E, m, l, O, lds, mp);
    const float il = 1.f / l;
    bf16_t* op = mix + (size_t)R * 1024 + head * 64;
#pragma unroll
    for (int blk = 0; blk < 2; ++blk)
#pragma unroll
        for (int g = 0; g < 4; ++g) {
            const int dv = blk * 32 + 8 * g + 4 * h;
            u32x2 o = {pk2(O[blk][4 * g] * il, O[blk][4 * g + 1] * il), pk2(O[blk][4 * g + 2] * il, O[blk][4 * g + 3] * il)};
            *(u32x2*)(op + dv) = o;
        }
}

DI void attn_d_item(const Params& p, int item, char* lds) {
    const int tid = VTID, lane = tid & 63, w = tid >> 6, p32 = lane & 31, h = lane >> 5;
    const bf16_t* proj = (const bf16_t*)(p.ws + OFF_BIG);
    const bf16_t* vtd = (const bf16_t*)(p.ws + OFF_BIG + BIG_VT_D);
    bf16_t* mix = (bf16_t*)(p.ws + OFF_BIG + BIG_MIXIN);
    int b, g, qb, rowbase; ASeg s0, s1; MaskP mp = {0, 0, 0, 0, nullptr};
    if (item < 512) {
        b = item >> 6; g = (item >> 5) & 1; qb = item & 31; rowbase = 8192 + b * 1024;
        const int q0 = qb * 32;
        const int tlo = max(q0 - 128, 0) >> 6, thi = min(q0 + 159, 1023) >> 6;
        s0 = {proj + (size_t)(rowbase + tlo * 64) * LDO + 1536 + g * 64, vtd + 1048576 + ((size_t)b * 128 + g * 64) * 1024 + tlo * 64, LDO, 1024, thi - tlo + 1};
        s1 = {(const bf16_t*)(p.ws + OFF_CSK) + (size_t)b * 256 * 128 + g * 64, (const bf16_t*)(p.ws + OFF_CSVT) + ((size_t)b * 128 + g * 64) * 256, 128, 256, 4};
        mp = {1, q0, tlo * 64, 0, nullptr};
    } else {
        const int it = item - 512;
        b = it >> 4; g = (it >> 3) & 1; qb = it & 7; rowbase = b * 256;
        s0 = {proj + (size_t)rowbase * LDO + 1536 + g * 64, vtd + ((size_t)b * 128 + g * 64) * 256, LDO, 256, 4};
        s1 = s0; s1.ntiles = 0;
    }
    const int R = rowbase + qb * 32 + p32;
    const int hq = g * 4 + w;
    bf16x8 qf[4];
    load_q(qf, proj + (size_t)R * LDO + 1024 + hq * 64, h);
    f32x16 O[2];
#pragma unroll
    for (int blk = 0; blk < 2; ++blk)
#pragma unroll
        for (int i = 0; i < 16; ++i) O[blk][i] = 0.f;
    float m = p.sink[hq] * LOG2E, l = h == 0 ? 1.f : 0.f;
    attn_core<64, 64, 2, 2>(s0, s1, qf, 0, 0, 0.125f * LOG2E, m, l, O, lds, mp);
    const float il = 1.f / l;
    bf16_t* op = mix + (size_t)R * 1024 + 512 + hq * 64;
#pragma unroll
    for (int blk = 0; blk < 2; ++blk)
#pragma unroll
        for (int gg = 0; gg < 4; ++gg) {
            const int dv = blk * 32 + 8 * gg + 4 * h;
            u32x2 o = {pk2(O[blk][4 * gg] * il, O[blk][4 * gg + 1] * il), pk2(O[blk][4 * gg + 2] * il, O[blk][4 * gg + 3] * il)};
            *(u32x2*)(op + dv) = o;
        }
}

DI void conv_item(const Params& p, int item) {
    const int tid = VTID;
    const bf16_t* proj = (const bf16_t*)(p.ws + OFF_BIG);
    bf16_t* mix = (bf16_t*)(p.ws + OFF_BIG + BIG_MIXIN);
#pragma unroll 2
    for (int i = 0; i < 8; ++i) {
        const int idx = tid + 256 * i, tl = idx >> 6, ch = (idx & 63) * 8;
        const int R = item * 32 + tl;
        int t, T;
        if (R < 8192) { t = R & 255; T = 256; } else { t = (R - 8192) & 1023; T = 1024; }
        const bf16_t* rp = proj + (size_t)R * LDE + ch;
        const u32x4 ab = *(const u32x4*)(rp);
        float accv[8];
#pragma unroll
        for (int e = 0; e < 8; ++e) accv[e] = 0.f;
#pragma unroll
        for (int j = 0; j < 3; ++j) {
            const int tt = t + j - 1;
            if (tt >= 0 && tt < T) {
                const u32x4 ac = *(const u32x4*)(rp + (ptrdiff_t)(j - 1) * LDE + 512);
                const u32x4 ax = *(const u32x4*)(rp + (ptrdiff_t)(j - 1) * LDE + 1024);
                const f32x4 w0 = *(const f32x4*)(p.conv_w + j * 512 + ch), w1 = *(const f32x4*)(p.conv_w + j * 512 + ch + 4);
#pragma unroll
                for (int e = 0; e < 4; ++e) {
                    accv[2 * e] += bflo(ac[e]) * bflo(ax[e]) * (e < 2 ? w0[2 * e] : w1[2 * e - 4]);
                    accv[2 * e + 1] += bfhi(ac[e]) * bfhi(ax[e]) * (e < 2 ? w0[2 * e + 1] : w1[2 * e - 3]);
                }
            }
        }
        u32x4 o;
#pragma unroll
        for (int e = 0; e < 4; ++e) o[e] = pk2(bflo(ab[e]) * accv[2 * e], bfhi(ab[e]) * accv[2 * e + 1]);
        *(u32x4*)(mix + (size_t)R * 1024 + ch) = o;
    }
}


#define XB_TMO      128
#define XB_XCNT(j)  (256  + 64 * (j))
#define XB_XSUB(j)  (1280 + 64 * (j))
#define XB_XGEN(j)  (2304 + 64 * (j))
#define XB_TOP      3328
#define XB_TOPGEN   3392
#define XCD_BAR_WORDS 3456
#define XB_SPIN_CAP (1u << 22)
#define LAS __attribute__((address_space(3)))
DI unsigned xb_ld(unsigned* p) { return __hip_atomic_load(p, __ATOMIC_RELAXED, __HIP_MEMORY_SCOPE_AGENT); }
DI unsigned xb_add(unsigned* p, unsigned v) { return __hip_atomic_fetch_add(p, v, __ATOMIC_RELAXED, __HIP_MEMORY_SCOPE_AGENT); }
DI unsigned xb_xcc_id() { return (unsigned)__builtin_amdgcn_s_getreg((3 << 11) | 20) & 0xFu; }
#define XB_SPIN(cond, bar) do { unsigned _sp = 0; while (cond) { __builtin_amdgcn_s_sleep(1); \
    if ((++_sp & 255u) == 0u) { if (xb_ld(&(bar)[XB_TMO])) break; if (_sp > XB_SPIN_CAP) { atomicAdd(&(bar)[XB_TMO], 1u); break; } } } } while (0)
struct XcdBarrier { unsigned* bar; unsigned x; volatile LAS unsigned* st; };
DI XcdBarrier xcd_barrier_post(unsigned* bar, volatile LAS unsigned* st) {
    XcdBarrier b; b.bar = bar; b.x = xb_xcc_id(); b.st = st;
    if (threadIdx.x == 0) (void)xb_add(&bar[XB_XCNT(b.x)], 1u);
    return b;
}
DI void xcd_barrier_complete(unsigned* bar, unsigned x, unsigned& nloc, unsigned& nx) {
    const unsigned G = gridDim.x * gridDim.y * gridDim.z;
    unsigned sum, cnt, mine, sp = 0u;
    for (;;) {
        sum = 0u; cnt = 0u; mine = 0u;
#pragma unroll
        for (unsigned j = 0; j < 16; ++j) { const unsigned c = xb_ld(&bar[XB_XCNT(j)]); sum += c; cnt += (c > 0u) ? 1u : 0u; mine = (j == x) ? c : mine; }
        if (sum == G) break;
        __builtin_amdgcn_s_sleep(1);
        if ((++sp & 255u) == 0u) { if (xb_ld(&bar[XB_TMO])) break; if (sp > XB_SPIN_CAP) { atomicAdd(&bar[XB_TMO], 1u); break; } }
    }
    nloc = mine > 0u ? mine : 1u; nx = cnt > 0u ? cnt : 1u;
}
DI void xcd_barrier(const XcdBarrier& b) {
    asm volatile("s_waitcnt vmcnt(0)" ::: "memory");
    __syncthreads();
    if (threadIdx.x == 0) {
        unsigned* bar = b.bar;
        __builtin_amdgcn_s_waitcnt(0);
        unsigned nloc = b.st[0], nx = b.st[1];
        if (nloc == 0u) { xcd_barrier_complete(bar, b.x, nloc, nx); b.st[0] = nloc; b.st[1] = nx; }
        const unsigned old = xb_add(&bar[XB_XSUB(b.x)], 1u);
        const unsigned gen = old / nloc;
        if (old + 1u == (gen + 1u) * nloc) {
            __builtin_amdgcn_fence(__ATOMIC_RELEASE, "agent");
            asm volatile("s_waitcnt vmcnt(0)" ::: "memory");
            const unsigned og = xb_add(&bar[XB_TOP], 1u);
            const unsigned tg = og / nx;
            if (og + 1u == (tg + 1u) * nx) xb_add(&bar[XB_TOPGEN], 1u);
            else XB_SPIN(xb_ld(&bar[XB_TOPGEN]) == tg, bar);
            __builtin_amdgcn_fence(__ATOMIC_ACQUIRE, "agent");
            xb_add(&bar[XB_XGEN(b.x)], 1u);
            asm volatile("s_waitcnt vmcnt(0)" ::: "memory");
        } else {
            XB_SPIN(xb_ld(&bar[XB_XGEN(b.x)]) == gen, bar);
            __builtin_amdgcn_fence(__ATOMIC_ACQUIRE, "agent");
            asm volatile("s_waitcnt vmcnt(0)" ::: "memory");
        }
    }
    __syncthreads();
}

constexpr int N_PHASES = 12;
DI void run_phase(const Params& p, int ph, char* shm) {
    const int nb = VNB, bid = VBID;
    char* lds = shm + VHALF * LDS_HALF;
    const int pvb = (int)(blockIdx.x & 7) * (nb >> 3) + (int)(blockIdx.x >> 3) * 2 + VHALF;
    const bf16_t* hy = (const bf16_t*)(p.ws + OFF_HY);
    const bf16_t* big = (const bf16_t*)(p.ws + OFF_BIG);
    const bf16_t* mixin = (const bf16_t*)(p.ws + OFF_BIG + BIG_MIXIN);
    const float* mod = (const float*)(p.ws + OFF_MOD);
    char* st = p.ws + OFF_STAT;
#define FZ(set, from_in, hasH, goff, wpost, wpre, scoff, shoff) FuseP{from_in, hasH, p.out, mod + (goff), wpost, wpre, mod + (scoff), mod + (shoff), (float*)(st + (set) * STAT_SET), (float*)(st + (set) * STAT_SET + 65536), (unsigned*)(st + (set) * STAT_SET + 131072)}
    switch (ph) {
    case 0: p0_phase(p, bid, nb, lds); break;
    case 1: rowop_phase(p, false, true, 0, nullptr, true, p.norm_mix_pre, 1024, 0); break;
    case 2: gemm_phase<EPI_PE>(p, hy, 2048, (const bf16_t*)(p.ws + OFF_WINE), 1024, 12, shm); break;
    case 3:
        for (int it = pvb; it < 1536; it += nb) { if (it < 1024) attn_diff_item(p, it, lds); else conv_item(p, it - 1024); }
        break;
    case 4: gemm_phase<EPI_YF>(p, mixin, 1024, (const bf16_t*)(p.ws + OFF_WOUT), 1024, 4, shm, FZ(0, 1, 1, 2048, p.norm_mix_post, p.norm_mlp_pre, 4096, 3072)); break;
    case 5: gemm_phase<EPI_W1>(p, hy, 2048, (const bf16_t*)(p.ws + OFF_W1), 1024, 16, shm); break;
    case 6: gemm_phase<EPI_YF>(p, big, 4096, (const bf16_t*)(p.ws + OFF_W2), 4096, 4, shm, FZ(1, 0, 1, 5120, p.norm_mlp_post, p.norm_mix_pre + 1024, 9 * 6144 + 1024, 9 * 6144 + 0)); break;
    case 7: gemm_phase<EPI_PO>(p, hy, 2048, (const bf16_t*)(p.ws + OFF_WINO), 1024, 9, shm); break;
    case 8:
        for (int it = pvb; it < 2048; it += nb) {
            const int q = it >> 9, r = it & 511;
            if (q & 1) attn_d_item(p, (q >> 1) * 512 + r, lds); else attn_c_item(p, (q >> 1) * 512 + r, lds);
        }
        break;
    case 9: gemm_phase<EPI_YF>(p, mixin, 1024, (const bf16_t*)(p.ws + OFF_WOUT) + 1048576, 1024, 4, shm, FZ(2, 0, 1, 9 * 6144 + 2048, p.norm_mix_post + 1024, p.norm_mlp_pre + 1024, 9 * 6144 + 4096, 9 * 6144 + 3072)); break;
    case 10: gemm_phase<EPI_W1>(p, hy, 2048, (const bf16_t*)(p.ws + OFF_W1) + 4194304, 1024, 16, shm); break;
    case 11: gemm_phase<EPI_YF>(p, big, 4096, (const bf16_t*)(p.ws + OFF_W2) + 4194304, 4096, 4, shm, FZ(3, 0, 0, 9 * 6144 + 5120, p.norm_mlp_post + 1024, p.norm_mlp_post, 0, 0)); break;
    }
#undef FZ
}

__global__ void __launch_bounds__(512, 2) fwd_mega(Params p) {
    __shared__ __attribute__((aligned(16))) char lds[LDS_BYTES];
    __shared__ uint4 xb_words;
    cg::grid_group grid = cg::this_grid();
    if (threadIdx.x == 0) xb_words = make_uint4(0u, 0u, 0u, 0u);
    __syncthreads();
    const XcdBarrier xb = xcd_barrier_post((unsigned*)(p.ws + OFF_BAR), (volatile LAS unsigned*)&xb_words);
#define PH_(n) run_phase(p, n, lds); xcd_barrier(xb); if ((DUP_MASK >> n) & 1) { run_phase(p, n, lds); xcd_barrier(xb); }
    PH_(0)
    if (p.ws == nullptr) grid.sync();
    PH_(1) PH_(2) PH_(3) PH_(4) PH_(5) PH_(6) PH_(7) PH_(8) PH_(9) PH_(10)
    run_phase(p, 11, lds);
#undef PH_
}

extern "C" void kernel_launch(void* const* d_in, const int* in_sizes, int n_in, void* d_out, int out_size, void* d_ws, size_t ws_size, hipStream_t stream) {
    Params p{};
    const float** pp = (const float**)&p;
    for (int i = 0; i < 29; ++i) pp[i] = (const float*)d_in[i];
    p.out = (float*)d_out;
    p.ws = (char*)d_ws;
    if (ws_size < WS_NEEDED) { fprintf(stderr, "workspace too small: %zu < %zu\n", ws_size, (size_t)WS_NEEDED); return; }
    static int grid_blocks = 0;
    if (!grid_blocks) {
        int dev = 0, cus = 0, per_cu = 0;
        hipGetDevice(&dev);
        hipDeviceGetAttribute(&cus, hipDeviceAttributeMultiprocessorCount, dev);
        hipOccupancyMaxActiveBlocksPerMultiprocessor(&per_cu, fwd_mega, 512, 0);
        if (per_cu > 1) per_cu = 1;
        if (per_cu < 1) per_cu = 1;
        grid_blocks = cus * per_cu;
        grid_blocks -= grid_blocks % 8;
    }
    (void)hipMemsetAsync((char*)d_ws + OFF_BAR, 0, XCD_BAR_WORDS * 4, stream);
    if (grid_blocks != 256) { fprintf(stderr, "fused epilogues need exactly 256 workgroups (got %d)\n", grid_blocks); return; }
    void* args[] = {&p};
    hipError_t e = hipLaunchCooperativeKernel((void*)fwd_mega, dim3(grid_blocks), dim3(512), args, 0, stream);
    if (e != hipSuccess) fprintf(stderr, "cooperative launch failed: %s (grid %d)\n", hipGetErrorString(e), grid_blocks);
}
```

```cpp
#include <hip/hip_runtime.h>
#include <hip/hip_cooperative_groups.h>
#include <cstdio>
#include <cstdint>
namespace cg = cooperative_groups;

#ifndef DUP_MASK
#define DUP_MASK 0
#endif
#ifndef ONE_LAUNCH
#define ONE_LAUNCH 1
#endif

typedef unsigned short bf16_t;
typedef short bf16x8 __attribute__((ext_vector_type(8)));
typedef float f32x4 __attribute__((ext_vector_type(4)));
typedef float f32x2 __attribute__((ext_vector_type(2)));
typedef float f32x16 __attribute__((ext_vector_type(16)));
typedef unsigned u32x4 __attribute__((ext_vector_type(4)));
typedef unsigned u32x2 __attribute__((ext_vector_type(2)));
typedef __bf16 bfv2 __attribute__((ext_vector_type(2)));
#define DI __device__ __forceinline__
DI int launder_v(int v) { asm volatile("" : "+v"(v)); return v; }
#define TIDX launder_v((int)threadIdx.x)
#define VTID (TIDX & 255)
#define VHALF (TIDX >> 8)
#define VBID ((int)(blockIdx.x * 2) + (TIDX >> 8))
#define VNB ((int)(gridDim.x * 2))
#define MFMA32(a, b, c) __builtin_amdgcn_mfma_f32_32x32x16_bf16((a), (b), (c), 0, 0, 0)
#define MFMA16(a, b, c) __builtin_amdgcn_mfma_f32_16x16x32_bf16((a), (b), (c), 0, 0, 0)

constexpr float LOG2E = 1.4426950408889634f;
constexpr float EPSN = 1e-6f;

struct Params {
    const float *x_prompt, *x_sample, *cache_diff_k, *cache_diff_v, *cache_na_k, *cache_na_v, *cache_swa_k, *cache_swa_v, *c, *c_ctx;
    const float *mod_w, *mod_b, *norm_mix_pre, *norm_mix_post, *norm_mlp_pre, *norm_mlp_post, *w_in_even, *conv_w, *lq1, *lk1, *lq2, *lk2, *subln;
    const float *w_in_odd, *rpb, *sink, *w_out, *mlp_w1, *mlp_w2;
    float* out;
    char* ws;
};

constexpr size_t OFF_MOD = 0;
constexpr size_t OFF_BAR = 458752;
constexpr size_t OFF_WINE = 524288;
constexpr size_t OFF_WINO = OFF_WINE + 6291456;
constexpr size_t OFF_WOUT = OFF_WINO + 4718592;
constexpr size_t OFF_W1 = OFF_WOUT + 4194304;
constexpr size_t OFF_W2 = OFF_W1 + 16777216;
constexpr size_t OFF_CDK = OFF_W2 + 16777216;
constexpr size_t OFF_CDVT = OFF_CDK + 2097152;
constexpr size_t OFF_CNK = OFF_CDVT + 2097152;
constexpr size_t OFF_CNVT = OFF_CNK + 2097152;
constexpr size_t OFF_CSK = OFF_CNVT + 2097152;
constexpr size_t OFF_CSVT = OFF_CSK + 524288;
constexpr size_t OFF_HY = OFF_CSVT + 524288;
constexpr size_t OFF_BIG = OFF_HY + 67108864;
constexpr size_t OFF_STAT = OFF_BIG + 134217728;
constexpr size_t STAT_SET = 65536 + 65536 + 8192;
constexpr size_t WS_NEEDED = OFF_STAT + 4 * STAT_SET;
constexpr size_t BIG_VT_E = 83886080;
constexpr size_t BIG_VT_C = 54525952;
constexpr size_t BIG_VT_D = BIG_VT_C + 16777216;
constexpr size_t BIG_MIXIN = 100663296;
constexpr int LDE = 2560, LDO = 1664;
constexpr size_t OUT_DIFFK = 16777216, OUT_DIFFV = 20971520, OUT_NAK = 25165824, OUT_NAV = 29360128, OUT_SWAK = 33554432, OUT_SWAV = 34603008;

constexpr int LDS_HALF = 65536 + 4096;
constexpr int LDS_BYTES = 2 * LDS_HALF;

DI unsigned pk2(float a, float b) { f32x2 v = {a, b}; bfv2 r = __builtin_convertvector(v, bfv2); return __builtin_bit_cast(unsigned, r); }
DI float bflo(unsigned u) { return __uint_as_float(u << 16); }
DI float bfhi(unsigned u) { return __uint_as_float(u & 0xffff0000u); }
DI float wave_sum(float v) {
#pragma unroll
    for (int o = 1; o < 64; o <<= 1) v += __shfl_xor(v, o);
    return v;
}
DI int swz128(int r, int c) { return r * 128 + ((c ^ ((r >> 1) & 7)) << 4); }
DI int swz256(int r, int c) { return r * 256 + ((c ^ (r & 15)) << 4); }

DI void p0_mod_item(const Params& p, int item, char* lds) {
    const int li = item / 96, cb = item % 96;
    const int tid = VTID, lane = tid & 63, w = tid >> 6;
    const float* W = p.mod_w + (size_t)li * 1024 * 6144 + cb * 64 + lane;
    float acc[9];
#pragma unroll
    for (int v = 0; v < 9; ++v) acc[v] = 0.f;
    for (int kc = 0; kc < 4; ++kc) {
        const int kb = w * 256 + kc * 64;
        float s[9];
        { const float cv = p.c_ctx[kb + lane]; s[0] = cv / (1.f + __expf(-cv)); }
#pragma unroll
        for (int v = 1; v < 9; ++v) { const float cv = p.c[(v - 1) * 1024 + kb + lane]; s[v] = cv / (1.f + __expf(-cv)); }
#pragma unroll
        for (int kk = 0; kk < 64; ++kk) {
            const float wv = __builtin_nontemporal_load(W + (size_t)(kb + kk) * 6144);
#pragma unroll
            for (int v = 0; v < 9; ++v) acc[v] += __int_as_float(__builtin_amdgcn_readlane(__float_as_int(s[v]), kk)) * wv;
        }
    }
    float* red = (float*)lds;
#pragma unroll
    for (int v = 0; v < 9; ++v) red[(w * 9 + v) * 64 + lane] = acc[v];
    __syncthreads();
    float* mod = (float*)(p.ws + OFF_MOD);
    for (int idx = tid; idx < 576; idx += 256) {
        const int v = idx >> 6, col = idx & 63;
        const float sum = red[(0 * 9 + v) * 64 + col] + red[(1 * 9 + v) * 64 + col] + red[(2 * 9 + v) * 64 + col] + red[(3 * 9 + v) * 64 + col];
        mod[(li * 9 + v) * 6144 + cb * 64 + col] = sum + p.mod_b[li * 6144 + cb * 64 + col];
    }
    __syncthreads();
}

DI void p0_transpose_tile(const float* __restrict__ in, bf16_t* __restrict__ out, int R, int C, int tr, int tc, char* lds) {
    const int tid = VTID;
    const int cl = (tid & 15) * 4, rl = (tid >> 4) * 2, sw = tid & 7;
#pragma unroll
    for (int i = 0; i < 2; ++i) {
        const int r = rl + 32 * i;
        const f32x4 a = *(const f32x4*)(in + (size_t)(tr * 64 + r) * C + tc * 64 + cl);
        const f32x4 b = *(const f32x4*)(in + (size_t)(tr * 64 + r + 1) * C + tc * 64 + cl);
#pragma unroll
        for (int j = 0; j < 4; ++j) *(unsigned*)(lds + (cl + j) * 128 + (((r >> 3) ^ sw) << 4) + (r & 7) * 2) = pk2(a[j], b[j]);
    }
    __syncthreads();
#pragma unroll
    for (int i = 0; i < 2; ++i) {
        const int idx = tid + 256 * i, c = idx >> 3, q = idx & 7;
        const u32x4 v = *(const u32x4*)(lds + c * 128 + ((q ^ ((c >> 2) & 7)) << 4));
        *(u32x4*)(out + (size_t)(tc * 64 + c) * R + tr * 64 + q * 8) = v;
    }
    __syncthreads();
}

DI void p0_kreorder(const float* __restrict__ in, bf16_t* __restrict__ out, int logH, int item) {
    const int tid = VTID, H = 1 << logH;
#pragma unroll
    for (int i = 0; i < 4; ++i) {
        const int f = item * 1024 + tid + 256 * i;
        const int d4 = f & 15, key = (f >> 4) & 255, hh = (f >> 12) & (H - 1), b = f >> (12 + logH);
        const f32x4 v = __builtin_nontemporal_load((const f32x4*)(in + (size_t)f * 4));
        u32x2 o = {pk2(v[0], v[1]), pk2(v[2], v[3])};
        *(u32x2*)(out + ((size_t)(b * 256 + key) * H + hh) * 64 + d4 * 4) = o;
    }
}

struct TJob { const float* in; bf16_t* out; int R, C, tr, tc, late; };
constexpr int P0_TITEMS = 768 + 576 + 512 + 2048 + 2048 + 256 + 256 + 64;
DI TJob p0_decode(const Params& p, int item) {
    TJob j;
    j.late = (item >= 768 && item < 1344) || (item >= 1600 && item < 1856) || (item >= 2880 && item < 3904) || (item >= 4928 && item < 5952);
    if (item < 768) { j.in = p.w_in_even; j.out = (bf16_t*)(p.ws + OFF_WINE); j.R = 1024; j.C = 3072; }
    else if ((item -= 768) < 576) { j.in = p.w_in_odd; j.out = (bf16_t*)(p.ws + OFF_WINO); j.R = 1024; j.C = 2304; }
    else if ((item -= 576) < 512) { const int b = item >> 8; item &= 255; j.in = p.w_out + (size_t)b * 1048576; j.out = (bf16_t*)(p.ws + OFF_WOUT) + (size_t)b * 1048576; j.R = 1024; j.C = 1024; }
    else if ((item -= 512) < 2048) { const int b = item >> 10; item &= 1023; j.in = p.mlp_w1 + (size_t)b * 4194304; j.out = (bf16_t*)(p.ws + OFF_W1) + (size_t)b * 4194304; j.R = 1024; j.C = 4096; }
    else if ((item -= 2048) < 2048) { const int b = item >> 10; item &= 1023; j.in = p.mlp_w2 + (size_t)b * 4194304; j.out = (bf16_t*)(p.ws + OFF_W2) + (size_t)b * 4194304; j.R = 4096; j.C = 1024; }
    else if ((item -= 2048) < 256) { const int b = item >> 3; item &= 7; j.in = p.cache_diff_v + (size_t)b * 32768; j.out = (bf16_t*)(p.ws + OFF_CDVT) + (size_t)b * 32768; j.R = 256; j.C = 128; }
    else if ((item -= 256) < 256) { const int b = item >> 2; item &= 3; j.in = p.cache_na_v + (size_t)b * 16384; j.out = (bf16_t*)(p.ws + OFF_CNVT) + (size_t)b * 16384; j.R = 256; j.C = 64; }
    else { item -= 256; const int b = item >> 2; item &= 3; j.in = p.cache_swa_v + (size_t)b * 16384; j.out = (bf16_t*)(p.ws + OFF_CSVT) + (size_t)b * 16384; j.R = 256; j.C = 64; }
    const int ntc = j.C >> 6;
    j.tr = item / ntc; j.tc = item % ntc;
    return j;
}
DI void p0_tload(const TJob& j, int tid, f32x4 (&a)[2], f32x4 (&b)[2]) {
    const int cl = (tid & 15) * 4, rl = (tid >> 4) * 2;
#pragma unroll
    for (int i = 0; i < 2; ++i) {
        const int r = rl + 32 * i;
        a[i] = __builtin_nontemporal_load((const f32x4*)(j.in + (size_t)(j.tr * 64 + r) * j.C + j.tc * 64 + cl));
        b[i] = __builtin_nontemporal_load((const f32x4*)(j.in + (size_t)(j.tr * 64 + r + 1) * j.C + j.tc * 64 + cl));
    }
}
DI void p0_phase(const Params& p, int bid, int nb, char* lds) {
    if (bid < 192) p0_mod_item(p, bid, lds);
    const int tid = VTID;
    {
        const int cl = (tid & 15) * 4, rl = (tid >> 4) * 2, sw = tid & 7;
        const int first = bid < 192 ? bid : 1536 + (bid - 192), stride = bid < 192 ? 192 : nb - 192, lim = bid < 192 ? 1536 : P0_TITEMS;
        int it = first;
        TJob cur{}; f32x4 a[2], b[2];
        if (it < lim) { cur = p0_decode(p, it); p0_tload(cur, tid, a, b); }
        while (it < lim) {
            const int nx = it + stride;
            TJob nxt{}; f32x4 an[2], bn[2];
            if (nx < lim) { nxt = p0_decode(p, nx); p0_tload(nxt, tid, an, bn); }
#pragma unroll
            for (int i = 0; i < 2; ++i) {
                const int r = rl + 32 * i;
#pragma unroll
                for (int jj = 0; jj < 4; ++jj) *(unsigned*)(lds + (cl + jj) * 128 + (((r >> 3) ^ sw) << 4) + (r & 7) * 2) = pk2(a[i][jj], b[i][jj]);
            }
            __syncthreads();
#pragma unroll
            for (int i = 0; i < 2; ++i) {
                const int idx = tid + 256 * i, c = idx >> 3, q = idx & 7;
                const u32x4 v = *(const u32x4*)(lds + c * 128 + ((q ^ ((c >> 2) & 7)) << 4));
                u32x4* dst = (u32x4*)(cur.out + (size_t)(cur.tc * 64 + c) * cur.R + cur.tr * 64 + q * 8);
                if (cur.late) __builtin_nontemporal_store(v, dst); else *dst = v;
            }
            __syncthreads();
            cur = nxt; a[0] = an[0]; a[1] = an[1]; b[0] = bn[0]; b[1] = bn[1];
            it = nx;
        }
    }
    {
        f32x4* st4 = (f32x4*)(p.ws + OFF_STAT);
        const f32x4 z = {0.f, 0.f, 0.f, 0.f};
        for (int i = bid * 256 + tid; i < (int)(4 * STAT_SET / 16); i += nb * 256) st4[i] = z;
    }
    for (int it = bid; it < 576; it += nb) {
        if (it < 256) p0_kreorder(p.cache_diff_k, (bf16_t*)(p.ws + OFF_CDK), 3, it);
        else if (it < 512) p0_kreorder(p.cache_na_k, (bf16_t*)(p.ws + OFF_CNK), 3, it - 256);
        else p0_kreorder(p.cache_swa_k, (bf16_t*)(p.ws + OFF_CSK), 1, it - 512);
    }
}

DI void rowop_phase(const Params& p, bool hasY, bool xin_input, int g_off, const float* wpost, bool hasH, const float* wpre, int sc_off, int sh_off) {
    const int tix = TIDX, lane = tix & 63, gw = (int)(blockIdx.x * 8) + (tix >> 6), nw = VNB * 4;
    const float* mod = (const float*)(p.ws + OFF_MOD);
    f32x4 wpo[4], wpr[4];
#pragma unroll
    for (int i = 0; i < 4; ++i) { if (hasY) wpo[i] = *(const f32x4*)(wpost + lane * 4 + 256 * i); if (hasH) wpr[i] = *(const f32x4*)(wpre + lane * 4 + 256 * i); }
    for (int row0 = gw; row0 < 16384; row0 += 2 * nw) {
        f32x4 x[2][4], y[2][4];
#pragma unroll
        for (int r = 0; r < 2; ++r) {
            const int row = row0 + r * nw;
            const float* xin = xin_input ? (row < 8192 ? p.x_prompt + (size_t)row * 1024 : p.x_sample + (size_t)(row - 8192) * 1024) : p.out + (size_t)row * 1024;
            const float* yin = (const float*)(p.ws + OFF_HY + (size_t)row * 4096);
#pragma unroll
            for (int i = 0; i < 4; ++i) { x[r][i] = __builtin_nontemporal_load((const f32x4*)(xin + lane * 4 + 256 * i)); if (hasY) y[r][i] = *(const f32x4*)(yin + lane * 4 + 256 * i); }
        }
#pragma unroll
        for (int r = 0; r < 2; ++r) {
            const int row = row0 + r * nw;
            const int v = row < 8192 ? 0 : 1 + ((row - 8192) >> 10);
            char* hy = p.ws + OFF_HY + (size_t)row * 4096;
            if (hasY) {
                f32x4 g4[4];
#pragma unroll
                for (int i = 0; i < 4; ++i) g4[i] = *(const f32x4*)(mod + v * 6144 + g_off + lane * 4 + 256 * i);
                float ss = 0.f;
#pragma unroll
                for (int i = 0; i < 4; ++i) ss += y[r][i][0] * y[r][i][0] + y[r][i][1] * y[r][i][1] + y[r][i][2] * y[r][i][2] + y[r][i][3] * y[r][i][3];
                ss = wave_sum(ss);
                const float rs = rsqrtf(ss * (1.f / 1024.f) + EPSN);
#pragma unroll
                for (int i = 0; i < 4; ++i) {
                    x[r][i] += g4[i] * (y[r][i] * rs * wpo[i]);
                    *(f32x4*)(p.out + (size_t)row * 1024 + lane * 4 + 256 * i) = x[r][i];
                }
            }
            if (hasH) {
                f32x4 sc[4], sh[4];
#pragma unroll
                for (int i = 0; i < 4; ++i) { sc[i] = *(const f32x4*)(mod + v * 6144 + sc_off + lane * 4 + 256 * i); sh[i] = *(const f32x4*)(mod + v * 6144 + sh_off + lane * 4 + 256 * i); }
                float ss = 0.f;
#pragma unroll
                for (int i = 0; i < 4; ++i) ss += x[r][i][0] * x[r][i][0] + x[r][i][1] * x[r][i][1] + x[r][i][2] * x[r][i][2] + x[r][i][3] * x[r][i][3];
                ss = wave_sum(ss);
                const float rs = rsqrtf(ss * (1.f / 1024.f) + EPSN);
#pragma unroll
                for (int i = 0; i < 4; ++i) {
                    const f32x4 h = x[r][i] * rs * wpr[i] * (sc[i] + 1.f) + sh[i];
                    u32x2 o = {pk2(h[0], h[1]), pk2(h[2], h[3])};
                    *(u32x2*)((bf16_t*)hy + lane * 4 + 256 * i) = o;
                }
            }
        }
    }
}

namespace g8 {
constexpr int BK = 64, HALF = 128, HTB = HALF * BK * 2;
DI int lds_byte(int r, int c) { const int st = (r >> 4) * 2 + (c >> 5), rr = r & 15, cc = c & 31, ob = rr * 64 + cc * 2; return st * 1024 + (ob ^ (((ob >> 9) & 1) << 5)); }
DI void stage_rc(int b, int& R, int& C) { const int st = b / 1024, sb = b % 1024, swz = sb ^ (((sb >> 9) & 1) << 5); R = (st >> 1) * 16 + swz / 64; C = (st & 1) * 32 + (swz % 64) / 2; }
typedef __attribute__((address_space(3))) unsigned lds_u32;
typedef __attribute__((address_space(3))) unsigned char lds_u8;
typedef __attribute__((address_space(3))) bf16x8 lds_bf16x8;

}

enum { EPI_PE = 0, EPI_PO = 1, EPI_Y = 2, EPI_W1 = 3, EPI_YF = 4 };

struct FuseP { int from_input, hasH; float* xout; const float* g; const float* wpost; const float* wpre; const float* sc; const float* sh; float* ssY; float* ssX; unsigned* cnt; };
DI float ld_agent(const float* q) { return __hip_atomic_load(q, __ATOMIC_RELAXED, __HIP_MEMORY_SCOPE_AGENT); }
DI void panel_wait(unsigned* c, unsigned target) {
    asm volatile("s_waitcnt vmcnt(0)" ::: "memory");
    __syncthreads();
    if (threadIdx.x == 0) {
        __hip_atomic_fetch_add(c, 1u, __ATOMIC_RELAXED, __HIP_MEMORY_SCOPE_AGENT);
        unsigned sp = 0;
        while (__hip_atomic_load(c, __ATOMIC_RELAXED, __HIP_MEMORY_SCOPE_AGENT) < target) { __builtin_amdgcn_s_sleep(1); if (++sp > (1u << 22)) break; }
    }
    __syncthreads();
}
DI float dot4(const f32x4& a) { return a[0] * a[0] + a[1] * a[1] + a[2] * a[2] + a[3] * a[3]; }

DI void rope_s(f32x4 (&sub)[4][2], int R0, bool usecol, int fr, int fq) {
    asm volatile("" : "+s"(R0));
    const float sgn = fq < 2 ? -1.f : 1.f;
#pragma unroll
    for (int m = 0; m < 4; ++m) {
        __builtin_amdgcn_sched_barrier(0);
        const int tl = (R0 + m * 16 + fr - 8192) & 1023;
        const float pos = (float)(usecol ? (tl & 63) : (tl >> 6));
#pragma unroll
        for (int n = 0; n < 2; ++n)
#pragma unroll
            for (int j = 0; j < 4; ++j) {
                const float inv = exp2f(-(float)(8 * (fq & 1) + 4 * n + j) * (13.287712379549449f / 16.f));
                float sn, cs;
                __sincosf(pos * inv, &sn, &cs);
                const float v = sub[m][n][j], pv = __shfl_xor(v, 32);
                sub[m][n][j] = v * cs + sgn * pv * sn;
            }
    }
}
DI void store_bf16_rows_s(const f32x4 (&sub)[4][2], bf16_t* base, int ld, int R0, int Cd0, int fr, int fq) {
#pragma unroll
    for (int m = 0; m < 4; ++m) {
        u32x4 o = {pk2(sub[m][0][0], sub[m][0][1]), pk2(sub[m][0][2], sub[m][0][3]), pk2(sub[m][1][0], sub[m][1][1]), pk2(sub[m][1][2], sub[m][1][3])};
        *(u32x4*)(base + (size_t)(R0 + m * 16 + fr) * ld + Cd0 + fq * 8) = o;
    }
}
DI void store_f32_rows_s(const f32x4 (&sub)[4][2], float* ob, int ldo, int fr, int fq) {
#pragma unroll
    for (int m = 0; m < 4; ++m) {
        float* rp = ob + (size_t)(m * 16 + fr) * ldo + fq * 8;
#pragma unroll
        for (int n = 0; n < 2; ++n) __builtin_nontemporal_store(sub[m][n], (f32x4*)(rp + n * 4));
    }
}
DI void store_vt_s(const f32x4 (&sub)[4][2], bf16_t* vt, int T, int t0, int fr, int fq) {
#pragma unroll
    for (int n = 0; n < 2; ++n) {
        bf16_t* rp = vt + (size_t)(8 * (fr >> 2) + 4 * n + (fr & 3)) * T + t0 + fq * 4;
#pragma unroll
        for (int m = 0; m < 4; ++m) { u32x2 o = {pk2(sub[m][n][0], sub[m][n][1]), pk2(sub[m][n][2], sub[m][n][3])}; *(u32x2*)(rp + m * 16) = o; }
    }
}
DI void store_f32_ns_s(const f32x4 (&sub)[4][2], float* ob, int ldo, int fr, int fq) {
#pragma unroll
    for (int m = 0; m < 4; ++m)
#pragma unroll
        for (int j = 0; j < 4; ++j) {
            float* rp = ob + (size_t)(m * 16 + fq * 4 + j) * ldo + 8 * (fr >> 2) + (fr & 3);
#pragma unroll
            for (int n = 0; n < 2; ++n) __builtin_nontemporal_store(sub[m][n][j], rp + n * 4);
        }
}

template <int EPI>
DI void tile_epilogue(const Params& p, f32x4 (&acc)[2][2][4][2], int pm, int pn, int vtm, const FuseP& fz) {
    const int tix = TIDX, wid = __builtin_amdgcn_readfirstlane(tix >> 6), lane = tix & 63, wr = wid >> 2, wc = wid & 3;
    const int brow = pm * 256, bcol = pn * 256;
    int fr = lane & 15, fq = lane >> 4;
    asm volatile("" : "+v"(fr), "+v"(fq));
    const bool latent = brow >= 8192;
    int b, tb, T;
    if (latent) { b = (brow - 8192) >> 10; tb = (brow - 8192) & 1023; T = 1024; } else { b = brow >> 8; tb = 0; T = 256; }
    bf16_t* big = (bf16_t*)(p.ws + OFF_BIG);
    if (EPI == EPI_YF) {
        const int v = latent ? 1 + b : 0;
        const int rbase = brow + wr * 64 + fr;
        const int cbase = bcol + wc * 32 + fq * 8;
        float rs[2][4];
#pragma unroll
        for (int ai = 0; ai < 2; ++ai)
#pragma unroll
            for (int m = 0; m < 4; ++m) {
                float sq = dot4(acc[ai][0][m][0]) + dot4(acc[ai][0][m][1]) + dot4(acc[ai][1][m][0]) + dot4(acc[ai][1][m][1]);
                sq += __shfl_xor(sq, 16); sq += __shfl_xor(sq, 32);
                if (fq == 0) { const float old = __hip_atomic_fetch_add(fz.ssY + rbase + ai * 128 + m * 16, sq, __ATOMIC_RELAXED, __HIP_MEMORY_SCOPE_AGENT); asm volatile("" :: "v"(old)); }
            }
        panel_wait(fz.cnt + pm * 32, 4u);
#pragma unroll
        for (int ai = 0; ai < 2; ++ai)
#pragma unroll
            for (int m = 0; m < 4; ++m) rs[ai][m] = rsqrtf(ld_agent(fz.ssY + rbase + ai * 128 + m * 16) * (1.f / 1024.f) + EPSN);
        const float* xin = latent ? p.x_sample - (size_t)8192 * 1024 : p.x_prompt;
        bf16_t* xb = (bf16_t*)(p.ws + OFF_HY) + 1024;
        float s2[2][4];
#pragma unroll
        for (int ai = 0; ai < 2; ++ai)
#pragma unroll
            for (int m = 0; m < 4; ++m) s2[ai][m] = 0.f;
#pragma unroll
        for (int bj = 0; bj < 2; ++bj) {
            const int col = cbase + bj * 128;
            f32x4 g4[2], wp4[2];
#pragma unroll
            for (int n = 0; n < 2; ++n) { g4[n] = *(const f32x4*)(fz.g + v * 6144 + col + 4 * n); wp4[n] = *(const f32x4*)(fz.wpost + col + 4 * n); }
#pragma unroll
            for (int ai = 0; ai < 2; ++ai)
#pragma unroll
                for (int m = 0; m < 4; ++m) {
                    const size_t off = (size_t)(rbase + ai * 128 + m * 16) * 1024 + col;
                    f32x4 x4[2];
                    if (fz.from_input) { x4[0] = __builtin_nontemporal_load((const f32x4*)(xin + off)); x4[1] = __builtin_nontemporal_load((const f32x4*)(xin + off + 4)); }
                    else {
                        const u32x4 xr = __builtin_nontemporal_load((const u32x4*)(xb + 2 * off - col));
                        x4[0] = (f32x4){bflo(xr[0]), bfhi(xr[0]), bflo(xr[1]), bfhi(xr[1])}; x4[1] = (f32x4){bflo(xr[2]), bfhi(xr[2]), bflo(xr[3]), bfhi(xr[3])};
                    }
                    f32x4 a[2];
#pragma unroll
                    for (int n = 0; n < 2; ++n) { a[n] = x4[n] + g4[n] * (acc[ai][bj][m][n] * rs[ai][m] * wp4[n]); acc[ai][bj][m][n] = a[n]; s2[ai][m] += dot4(a[n]); }
                    if (fz.hasH) { u32x4 xo = {pk2(a[0][0], a[0][1]), pk2(a[0][2], a[0][3]), pk2(a[1][0], a[1][1]), pk2(a[1][2], a[1][3])}; *(u32x4*)(xb + 2 * off - col) = xo; }
                    else { __builtin_nontemporal_store(a[0], (f32x4*)(fz.xout + off)); __builtin_nontemporal_store(a[1], (f32x4*)(fz.xout + off + 4)); }
                }
        }
        if (fz.hasH) {
#pragma unroll
            for (int ai = 0; ai < 2; ++ai)
#pragma unroll
                for (int m = 0; m < 4; ++m) {
                    float sq = s2[ai][m];
                    sq += __shfl_xor(sq, 16); sq += __shfl_xor(sq, 32);
                    if (fq == 0) { const float old = __hip_atomic_fetch_add(fz.ssX + rbase + ai * 128 + m * 16, sq, __ATOMIC_RELAXED, __HIP_MEMORY_SCOPE_AGENT); asm volatile("" :: "v"(old)); }
                }
            panel_wait(fz.cnt + pm * 32 + 16, 4u);
#pragma unroll
            for (int ai = 0; ai < 2; ++ai)
#pragma unroll
                for (int m = 0; m < 4; ++m) rs[ai][m] = rsqrtf(ld_agent(fz.ssX + rbase + ai * 128 + m * 16) * (1.f / 1024.f) + EPSN);
            bf16_t* hb = (bf16_t*)(p.ws + OFF_HY);
#pragma unroll
            for (int bj = 0; bj < 2; ++bj) {
                const int col = cbase + bj * 128;
                f32x4 wq4[2], sc4[2], sh4[2];
#pragma unroll
                for (int n = 0; n < 2; ++n) { wq4[n] = *(const f32x4*)(fz.wpre + col + 4 * n); sc4[n] = *(const f32x4*)(fz.sc + v * 6144 + col + 4 * n) + 1.f; sh4[n] = *(const f32x4*)(fz.sh + v * 6144 + col + 4 * n); }
#pragma unroll
                for (int ai = 0; ai < 2; ++ai)
#pragma unroll
                    for (int m = 0; m < 4; ++m) {
                        const f32x4 h0 = acc[ai][bj][m][0] * rs[ai][m] * wq4[0] * sc4[0] + sh4[0], h1 = acc[ai][bj][m][1] * rs[ai][m] * wq4[1] * sc4[1] + sh4[1];
                        u32x4 o = {pk2(h0[0], h0[1]), pk2(h0[2], h0[3]), pk2(h1[0], h1[1]), pk2(h1[2], h1[3])};
                        *(u32x4*)(hb + (size_t)(rbase + ai * 128 + m * 16) * 2048 + col) = o;
                    }
            }
        }
        return;
    }
#pragma unroll
    for (int ai = 0; ai < 2; ++ai)
#pragma unroll
        for (int bj = 0; bj < 2; ++bj) {
            __builtin_amdgcn_sched_barrier(0);
            f32x4 (&sub)[4][2] = acc[ai][bj];
            const int R0 = brow + ai * 128 + wr * 64, t0 = tb + ai * 128 + wr * 64, C0 = bcol + bj * 128 + wc * 32;
            const bool ns = vtm == 1 || (vtm == 2 && bj == 1);
            if (EPI == EPI_PE) {
                if (ns) {
                    const int vc = C0 - 2560;
                    bf16_t* vt = (bf16_t*)(p.ws + OFF_BIG + BIG_VT_E) + (latent ? (size_t)4194304 + ((size_t)b * 512 + vc) * 1024 : ((size_t)b * 512 + vc) * 256);
                    store_vt_s(sub, vt, T, t0, fr, fq);
                    if (!latent) store_f32_ns_s(sub, p.out + OUT_DIFFV + ((size_t)(b * 4 + (vc >> 7)) * 256 + t0) * 128 + (vc & 127), 128, fr, fq);
                } else {
                    if (pn >= 6 && latent) rope_s(sub, R0, wc & 1, fr, fq);
                    store_bf16_rows_s(sub, big, LDE, R0, C0, fr, fq);
                    if (pn >= 8 && !latent) store_f32_rows_s(sub, p.out + OUT_DIFFK + ((size_t)(b * 8 + ((C0 - 2048) >> 6)) * 256 + t0) * 64 + ((C0 - 2048) & 63), 64, fr, fq);
                }
            } else if (EPI == EPI_PO) {
                if (ns) {
                    if (pn < 8) {
                        const int vc = C0 - 1024;
                        bf16_t* vt = (bf16_t*)(p.ws + OFF_BIG + BIG_VT_C) + (latent ? (size_t)4194304 + ((size_t)b * 512 + vc) * 1024 : ((size_t)b * 512 + vc) * 256);
                        store_vt_s(sub, vt, T, t0, fr, fq);
                        if (!latent) store_f32_ns_s(sub, p.out + OUT_NAV + ((size_t)(b * 8 + (vc >> 6)) * 256 + t0) * 64 + (vc & 63), 64, fr, fq);
                    } else {
                        const int vc = C0 - 2176;
                        bf16_t* vt = (bf16_t*)(p.ws + OFF_BIG + BIG_VT_D) + (latent ? (size_t)1048576 + ((size_t)b * 128 + vc) * 1024 : ((size_t)b * 128 + vc) * 256);
                        store_vt_s(sub, vt, T, t0, fr, fq);
                        if (!latent) store_f32_ns_s(sub, p.out + OUT_SWAV + ((size_t)(b * 2 + (vc >> 6)) * 256 + t0) * 64 + (vc & 63), 64, fr, fq);
                    }
                } else {
                    if (pn >= 6 && latent) rope_s(sub, R0, wc & 1, fr, fq);
                    store_bf16_rows_s(sub, big, LDO, R0, pn >= 6 ? C0 - 512 : C0, fr, fq);
                    if (!latent) {
                        if (pn == 2 || pn == 3) store_f32_rows_s(sub, p.out + OUT_NAK + ((size_t)(b * 8 + ((C0 - 512) >> 6)) * 256 + t0) * 64 + ((C0 - 512) & 63), 64, fr, fq);
                        else if (pn == 8) store_f32_rows_s(sub, p.out + OUT_SWAK + ((size_t)(b * 2 + ((C0 - 2048) >> 6)) * 256 + t0) * 64 + ((C0 - 2048) & 63), 64, fr, fq);
                    }
                }
            } else if (EPI == EPI_Y) {
                store_f32_rows_s(sub, (float*)(p.ws + OFF_HY) + (size_t)R0 * 1024 + C0, 1024, fr, fq);
            } else {
#pragma unroll
                for (int m = 0; m < 4; ++m)
#pragma unroll
                    for (int n = 0; n < 2; ++n)
#pragma unroll
                        for (int j = 0; j < 4; ++j) { const float v = fmaxf(sub[m][n][j], 0.f); sub[m][n][j] = v * v; }
                store_bf16_rows_s(sub, big, 4096, R0, C0, fr, fq);
            }
        }
}

template <int EPI>
DI void gemm_phase(const Params& p, const bf16_t* A, int lda, const bf16_t* Bt, int K, int NT_N, char* shm, const FuseP& fz = FuseP{}) {
    using namespace g8;
    const int xcd = blockIdx.x & 7, lb = blockIdx.x >> 3, nlb = gridDim.x >> 3, per_xcd = 8 * NT_N;
    if (lb >= per_xcd) return;
    const int tid = TIDX, wid = __builtin_amdgcn_readfirstlane(tid >> 6), lane = tid & 63, wr = wid >> 2, wc = wid & 3, fr = lane & 15, fq = lane >> 4;
    const int nt = K / BK;
    lds_u8* lds = (lds_u8*)shm;
    unsigned voffA[2], voffB[2];
#pragma unroll
    for (int _i = 0; _i < 2; ++_i) { int _r, _c; stage_rc(tid * 16 + _i * 8192, _r, _c); const int _i16 = _r & 15, _rb = (_r & ~31) + 8 * (_i16 >> 2) + 4 * ((_r >> 4) & 1) + (_i16 & 3);
        voffA[_i] = (unsigned)(_r * lda + _c) * 2u; voffB[_i] = (unsigned)(_rb * K + _c) * 2u; }
    const size_t kstep = (size_t)BK * 2, hstepA = (size_t)HALF * lda * 2, hstepB = (size_t)HALF * K * 2;
    const unsigned ldsw = (unsigned)wid * 1024u;
    const int aoff = lds_byte(wr * 64 + fr, fq * 8), boff = lds_byte(wc * 32 + fr, fq * 8);
#define SA(b, h) (((b) * 2 + (h)) * HTB)
#define SB(b, h) ((4 + (b) * 2 + (h)) * HTB)
#define STAGE(bufoff, gbase, voff) do { _Pragma("unroll") for (int _i = 0; _i < 2; ++_i) \
      __builtin_amdgcn_global_load_lds((const unsigned*)((gbase) + (voff)[_i]), (lds_u32*)(lds + (bufoff) + ldsw + _i * 8192), 16, 0, 0); } while (0)
#define LDA(dst, b, h) _Pragma("unroll") for (int m = 0; m < 4; ++m) _Pragma("unroll") for (int k = 0; k < 2; ++k) \
    dst[m][k] = *(const lds_bf16x8*)(lds + SA(b, h) + aoff + m * 2048 + k * 1024)
#define LDB(dst, b, h) _Pragma("unroll") for (int n = 0; n < 2; ++n) _Pragma("unroll") for (int k = 0; k < 2; ++k) \
    dst[n][k] = *(const lds_bf16x8*)(lds + SB(b, h) + boff + n * 2048 + k * 1024)
#define MMA(VT, ai, bj, At_, Bt_) do { __builtin_amdgcn_s_setprio(1); \
    _Pragma("unroll") for (int m = 0; m < 4; ++m) _Pragma("unroll") for (int n = 0; n < 2; ++n) _Pragma("unroll") for (int k = 0; k < 2; ++k) \
      acc[ai][bj][m][n] = ((VT) == 1 || ((VT) == 2 && (bj) == 1)) ? MFMA16(At_[m][k], Bt_[n][k], acc[ai][bj][m][n]) : MFMA16(Bt_[n][k], At_[m][k], acc[ai][bj][m][n]); \
    __builtin_amdgcn_s_setprio(0); } while (0)
#define WAIT_V(n) asm volatile("s_waitcnt vmcnt(" #n ")" ::: "memory")
#define WAIT_L(n) asm volatile("s_waitcnt lgkmcnt(" #n ")" ::: "memory")
#define BAR __builtin_amdgcn_s_barrier()
#define SCHED __builtin_amdgcn_sched_barrier(0)
#define TLOOP(VT) for (int t = 0; t < nt; t += 2) { \
        const bool last = (t == nt - 2); \
        const char* a1 = cA + (size_t)(t + 1) * kstep; \
        const char* a2 = last ? nA : cA + (size_t)(t + 2) * kstep; const char* b2 = last ? nB : cB + (size_t)(t + 2) * kstep; \
        const char* a3 = a2 + kstep; const char* b3 = b2 + kstep; \
        LDB(B0, 0, 0); LDB(B1, 0, 1); SCHED; LDA(At, 0, 0); STAGE(SA(1, 1), a1 + hstepA, voffA); \
        WAIT_V(8); WAIT_L(0); BAR; MMA(VT, 0, 0, At, B0); MMA(VT, 0, 1, At, B1); BAR; SCHED; \
        LDA(At, 0, 1); STAGE(SB(0, 0), b2, voffB); STAGE(SB(0, 1), b2 + hstepB, voffB); STAGE(SA(0, 0), a2, voffA); \
        WAIT_V(8); WAIT_L(0); BAR; MMA(VT, 1, 0, At, B0); MMA(VT, 1, 1, At, B1); BAR; SCHED; \
        LDB(B0, 1, 0); LDB(B1, 1, 1); SCHED; LDA(At, 1, 0); STAGE(SA(0, 1), a2 + hstepA, voffA); \
        WAIT_V(8); WAIT_L(0); BAR; MMA(VT, 0, 0, At, B0); MMA(VT, 0, 1, At, B1); BAR; SCHED; \
        LDA(At, 1, 1); STAGE(SB(1, 0), b3, voffB); STAGE(SB(1, 1), b3 + hstepB, voffB); STAGE(SA(1, 0), a3, voffA); \
        WAIT_V(8); WAIT_L(0); BAR; MMA(VT, 1, 0, At, B0); MMA(VT, 1, 1, At, B1); BAR; SCHED; \
    }
    int lt = lb, pm = xcd * 8 + (lt & 7), pn = lt >> 3;
    f32x4 acc[2][2][4][2];
#pragma unroll
    for (int a = 0; a < 2; ++a)
#pragma unroll
        for (int b = 0; b < 2; ++b)
#pragma unroll
            for (int m = 0; m < 4; ++m)
#pragma unroll
                for (int n = 0; n < 2; ++n) acc[a][b][m][n] = (f32x4){0.f, 0.f, 0.f, 0.f};
    bf16x8 At[4][2], B0[2][2], B1[2][2];
    const char* cA = (const char*)A + (size_t)pm * 2 * hstepA;
    const char* cB = (const char*)Bt + (size_t)pn * 2 * hstepB;
    WAIT_V(0);
    STAGE(SB(0, 0), cB, voffB); STAGE(SB(0, 1), cB + hstepB, voffB); STAGE(SA(0, 0), cA, voffA); STAGE(SA(0, 1), cA + hstepA, voffA);
    if (wr == 1) BAR;
    WAIT_V(2); BAR;
    STAGE(SB(1, 0), cB + kstep, voffB); STAGE(SA(1, 0), cA + kstep, voffA); STAGE(SB(1, 1), cB + hstepB + kstep, voffB);
    WAIT_V(6); BAR;
    for (;;) {
        const int ltn = lt + nlb;
        const bool has_next = ltn < per_xcd;
        const int pmn = xcd * 8 + (ltn & 7), pnn = ltn >> 3;
        const char* nA = has_next ? (const char*)A + (size_t)pmn * 2 * hstepA : cA;
        const char* nB = has_next ? (const char*)Bt + (size_t)pnn * 2 * hstepB : cB;
        int vtm = 0;
        if (EPI == EPI_PE) vtm = pn >= 10 ? 1 : 0;
        if (EPI == EPI_PO) vtm = (pn == 4 || pn == 5) ? 1 : (pn == 8 ? 2 : 0);
        if ((EPI == EPI_PE || EPI == EPI_PO) && vtm == 1) { TLOOP(1) }
        else if (EPI == EPI_PO && vtm == 2) { TLOOP(2) }
        else { TLOOP(0) }
        if (wr == 0) BAR;
        if (EPI != EPI_YF) tile_epilogue<EPI>(p, acc, pm, pn, vtm, fz);
        if (!has_next) break;
#pragma unroll
        for (int a = 0; a < 2; ++a)
#pragma unroll
            for (int b = 0; b < 2; ++b)
#pragma unroll
                for (int m = 0; m < 4; ++m)
#pragma unroll
                    for (int n = 0; n < 2; ++n) acc[a][b][m][n] = (f32x4){0.f, 0.f, 0.f, 0.f};
        lt = ltn; pm = pmn; pn = pnn; cA = nA; cB = nB;
        if (wr == 1) BAR;
    }
    WAIT_V(0);
    BAR;
    if (EPI == EPI_YF) tile_epilogue<EPI>(p, acc, pm, pn, 0, fz);
#undef SA
#undef SB
#undef STAGE
#undef LDA
#undef LDB
#undef MMA
#undef WAIT_V
#undef WAIT_L
#undef BAR
#undef SCHED
#undef TLOOP
}

struct ASeg { const bf16_t* K; const bf16_t* Vt; int ldk, ldv, ntiles; };
struct MaskP { int on, a, b, c; const float* tab; };

template <int KW, int VR, int NB, int MODE>
DI void attn_core(const ASeg& s0, const ASeg& s1, const bf16x8 (&qf)[4], int kchunk0, int vrow0, float scale_l2, float& m, float& l, f32x16 (&O)[NB], char* lds, const MaskP& mp) {
    constexpr int KC = KW / 8, NKL = 64 * KC / 256, NVL = VR * 8 / 256;
    const int tid = VTID, lane = tid & 63, p32 = lane & 31, h = lane >> 5;
    const int krow = (p32 & 19) | ((p32 & 4) << 1) | ((p32 & 8) >> 1);
    const int n0 = s0.ntiles, nt = s0.ntiles + s1.ntiles;
    u32x4 rk[NKL], rv[NVL];
#define ATT_LOAD(t_)                                                                                                         \
    {                                                                                                                        \
        const bool f_ = (t_) < n0; const int tt_ = f_ ? (t_) : (t_) - n0;                                                     \
        const bf16_t* Kp_ = (f_ ? s0.K : s1.K); const int ldk_ = f_ ? s0.ldk : s1.ldk;                                        \
        const bf16_t* Vp_ = (f_ ? s0.Vt : s1.Vt); const int ldv_ = f_ ? s0.ldv : s1.ldv;                                      \
        _Pragma("unroll") for (int i = 0; i < NKL; ++i) { const int id = tid + 256 * i, r = id / KC, c = id % KC; rk[i] = *(const u32x4*)(Kp_ + (size_t)(tt_ * 64 + r) * ldk_ + c * 8); } \
        _Pragma("unroll") for (int i = 0; i < NVL; ++i) { const int id = tid + 256 * i, r = id >> 3, c = id & 7; rv[i] = *(const u32x4*)(Vp_ + (size_t)r * ldv_ + tt_ * 64 + c * 8); }       \
    }
#define ATT_STORE(b_)                                                                                                        \
    {                                                                                                                        \
        char* kb_ = lds + (b_) * 32768; char* vb_ = kb_ + 16384;                                                              \
        _Pragma("unroll") for (int i = 0; i < NKL; ++i) { const int id = tid + 256 * i, r = id / KC, c = id % KC; *(u32x4*)(kb_ + (KW == 128 ? swz256(r, c) : swz128(r, c))) = rk[i]; } \
        _Pragma("unroll") for (int i = 0; i < NVL; ++i) { const int id = tid + 256 * i, r = id >> 3, c = id & 7; *(u32x4*)(vb_ + swz128(r, c)) = rv[i]; }                               \
    }
    int dco[2][16];
    if (MODE == 1) {
        const int cq = mp.c + p32, cs = min(max(cq - 8, 0), 48);
#pragma unroll
        for (int kh = 0; kh < 2; ++kh)
#pragma unroll
            for (int i = 0; i < 16; ++i) {
                const int kc = 32 * kh + 16 * (i >> 3) + 8 * h + (i & 7);
                dco[kh][i] = ((unsigned)(kc - cs) < 16u ? min(max(kc - cq + 15, 0), 30) : 31) * 4;
            }
    }
    ATT_LOAD(0);
    ATT_STORE(0);
    __syncthreads();
    for (int t = 0; t < nt; ++t) {
        const bool more = t + 1 < nt;
        if (more) ATT_LOAD(t + 1);
        const char* kb = lds + (t & 1) * 32768;
        const char* vb = kb + 16384;
        f32x16 S[2];
#pragma unroll
        for (int kh = 0; kh < 2; ++kh) {
#pragma unroll
            for (int i = 0; i < 16; ++i) S[kh][i] = 0.f;
            const int row = krow + 32 * kh;
#pragma unroll
            for (int s = 0; s < 4; ++s) {
                const int c = kchunk0 + 2 * s + h;
                const bf16x8 kf = *(const bf16x8*)(kb + (KW == 128 ? swz256(row, c) : swz128(row, c)));
                S[kh] = MFMA32(kf, qf[s], S[kh]);
            }
        }
        const bool msk = (MODE != 0) && mp.on && t < n0;
        float mx = -1e30f;
        if (MODE == 1 && msk) {
            const char* trow = (const char*)(mp.tab + (mp.b + t - mp.a + 7) * 32);
#pragma unroll
            for (int kh = 0; kh < 2; ++kh)
#pragma unroll
                for (int i = 0; i < 16; ++i) {
                    const float sv = __builtin_fmaf(S[kh][i], scale_l2, *(const float*)(trow + dco[kh][i]));
                    S[kh][i] = sv; mx = fmaxf(mx, sv);
                }
        } else if (MODE == 2 && msk) {
            int qp = mp.a + p32 - 8 * h;
            asm volatile("" : "+v"(qp));
            const int k0 = mp.b + t * 64;
#pragma unroll
            for (int kh = 0; kh < 2; ++kh)
#pragma unroll
                for (int i = 0; i < 16; ++i) {
                    const int d = qp - (k0 + 32 * kh + 16 * (i >> 3) + (i & 7));
                    const bool ok = d <= 128 && d >= -128;
                    const float sv = ok ? S[kh][i] * scale_l2 : -1e30f;
                    S[kh][i] = sv; mx = fmaxf(mx, sv);
                }
        } else {
            float m0 = fmaxf(fmaxf(S[0][0], S[0][1]), S[0][2]), m1 = fmaxf(fmaxf(S[1][0], S[1][1]), S[1][2]);
#pragma unroll
            for (int i = 3; i < 15; i += 2) { m0 = fmaxf(fmaxf(m0, S[0][i]), S[0][i + 1]); m1 = fmaxf(fmaxf(m1, S[1][i]), S[1][i + 1]); }
            mx = fmaxf(fmaxf(m0, m1), fmaxf(S[0][15], S[1][15])) * scale_l2;
        }
        mx = fmaxf(mx, __shfl_xor(mx, 32));
        if (__any(mx > m + 8.f)) {
            const float mn = fmaxf(m, mx);
            const float alpha = __builtin_amdgcn_exp2f(m - mn);
            m = mn;
            l *= alpha;
#pragma unroll
            for (int blk = 0; blk < NB; ++blk)
#pragma unroll
                for (int i = 0; i < 16; ++i) O[blk][i] *= alpha;
        }
        float ls = 0.f;
        if ((MODE == 1 || MODE == 2) && msk) {
#pragma unroll
            for (int kh = 0; kh < 2; ++kh)
#pragma unroll
                for (int i = 0; i < 16; ++i) { const float pv = __builtin_amdgcn_exp2f(S[kh][i] - m); S[kh][i] = pv; ls += pv; }
        } else {
            const float negm = -m;
#pragma unroll
            for (int kh = 0; kh < 2; ++kh)
#pragma unroll
                for (int i = 0; i < 16; ++i) { const float pv = __builtin_amdgcn_exp2f(__builtin_fmaf(S[kh][i], scale_l2, negm)); S[kh][i] = pv; ls += pv; }
        }
        l += ls;
#pragma unroll
        for (int kh = 0; kh < 2; ++kh)
#pragma unroll
            for (int s2 = 0; s2 < 2; ++s2) {
                u32x4 pp = {pk2(S[kh][8 * s2 + 0], S[kh][8 * s2 + 1]), pk2(S[kh][8 * s2 + 2], S[kh][8 * s2 + 3]), pk2(S[kh][8 * s2 + 4], S[kh][8 * s2 + 5]), pk2(S[kh][8 * s2 + 6], S[kh][8 * s2 + 7])};
                const bf16x8 pb = __builtin_bit_cast(bf16x8, pp);
                const int c = 4 * kh + 2 * s2 + h;
#pragma unroll
                for (int blk = 0; blk < NB; ++blk) {
                    const bf16x8 vf = *(const bf16x8*)(vb + swz128(vrow0 + blk * 32 + p32, c));
                    O[blk] = MFMA32(vf, pb, O[blk]);
                }
            }
        if (more) ATT_STORE((t + 1) & 1);
        __syncthreads();
    }
    l += __shfl_xor(l, 32);
#undef ATT_LOAD
#undef ATT_STORE
}

DI void load_q(bf16x8 (&qf)[4], const bf16_t* qrow, int h) {
#pragma unroll
    for (int s = 0; s < 4; ++s) qf[s] = *(const bf16x8*)(qrow + 16 * s + 8 * h);
}

DI void attn_diff_item(const Params& p, int item, char* lds) {
    const int tid = VTID, lane = tid & 63, w = tid >> 6, p32 = lane & 31, h = lane >> 5, stream = w & 1, qh = w >> 1;
    const bf16_t* proj = (const bf16_t*)(p.ws + OFF_BIG);
    const bf16_t* vte = (const bf16_t*)(p.ws + OFF_BIG + BIG_VT_E);
    bf16_t* mix = (bf16_t*)(p.ws + OFF_BIG + BIG_MIXIN);
    int b, hd, qb, rowbase; ASeg s0, s1;
    if (item < 512) {
        b = item >> 6; hd = (item >> 4) & 3; qb = item & 15; rowbase = 8192 + b * 1024;
        s0 = {proj + (size_t)rowbase * LDE + 2048 + hd * 128, vte + 4194304 + ((size_t)b * 512 + hd * 128) * 1024, LDE, 1024, 16};
        s1 = {(const bf16_t*)(p.ws + OFF_CDK) + (size_t)b * 256 * 512 + hd * 128, (const bf16_t*)(p.ws + OFF_CDVT) + (size_t)(b * 4 + hd) * 128 * 256, 512, 256, 4};
    } else {
        const int it = item - 512;
        b = it >> 4; hd = (it >> 2) & 3; qb = it & 3; rowbase = b * 256;
        s0 = {proj + (size_t)rowbase * LDE + 2048 + hd * 128, vte + ((size_t)b * 512 + hd * 128) * 256, LDE, 256, 4};
        s1 = s0; s1.ntiles = 0;
    }
    const int R = rowbase + qb * 64 + qh * 32 + p32;
    bf16x8 qf[4];
    load_q(qf, proj + (size_t)R * LDE + 1536 + hd * 128 + stream * 64, h);
    f32x16 O[4];
#pragma unroll
    for (int blk = 0; blk < 4; ++blk)
#pragma unroll
        for (int i = 0; i < 16; ++i) O[blk][i] = 0.f;
    float m = -1e30f, l = 0.f;
    MaskP mp = {0, 0, 0, 0, nullptr};
    attn_core<128, 128, 4, 0>(s0, s1, qf, stream * 8, 0, 0.125f * LOG2E, m, l, O, lds, mp);
    const float il = 1.f / l;
    const float d1 = wave_sum(p.lq1[lane] * p.lk1[lane]), d2 = wave_sum(p.lq2[lane] * p.lk2[lane]);
    const float lam_init = 0.2f;
    const float lam = __expf(d1) - __expf(d2) + lam_init;
    float* xb = (float*)(lds + qh * 16384);
    if (stream == 1) {
#pragma unroll
        for (int blk = 0; blk < 4; ++blk)
#pragma unroll
            for (int i = 0; i < 16; ++i) { const int dv = blk * 32 + 8 * (i >> 2) + 4 * h + (i & 3); xb[dv * 32 + p32] = O[blk][i] * il; }
    }
    __syncthreads();
    if (stream == 0) {
        float ss = 0.f;
#pragma unroll
        for (int blk = 0; blk < 4; ++blk)
#pragma unroll
            for (int i = 0; i < 16; ++i) { const int dv = blk * 32 + 8 * (i >> 2) + 4 * h + (i & 3); const float o = O[blk][i] * il - lam * xb[dv * 32 + p32]; O[blk][i] = o; ss += o * o; }
        ss += __shfl_xor(ss, 32);
        const float rs = rsqrtf(ss * (1.f / 128.f) + EPSN) * (1.f - lam_init);
        bf16_t* op = mix + (size_t)R * 1024 + 512 + hd * 128;
#pragma unroll
        for (int blk = 0; blk < 4; ++blk)
#pragma unroll
            for (int g = 0; g < 4; ++g) {
                const int dv = blk * 32 + 8 * g + 4 * h;
                const f32x4 sl = *(const f32x4*)(p.subln + dv);
                u32x2 o = {pk2(O[blk][4 * g] * rs * sl[0], O[blk][4 * g + 1] * rs * sl[1]), pk2(O[blk][4 * g + 2] * rs * sl[2], O[blk][4 * g + 3] * rs * sl[3])};
                *(u32x2*)(op + dv) = o;
            }
    }
    __syncthreads();
}

DI void attn_c_item(const Params& p, int item, char* lds) {
    const int tid = VTID, lane = tid & 63, w = tid >> 6, p32 = lane & 31, h = lane >> 5, stream = w & 1, qh = w >> 1;
    const bf16_t* proj = (const bf16_t*)(p.ws + OFF_BIG);
    const bf16_t* vtc = (const bf16_t*)(p.ws + OFF_BIG + BIG_VT_C);
    bf16_t* mix = (bf16_t*)(p.ws + OFF_BIG + BIG_MIXIN);
    int b, hp, qb, rowbase; ASeg s0, s1; MaskP mp = {0, 0, 0, 0, nullptr};
    float* tab = (float*)(lds + 65536);
    if (item < 512) {
        b = item >> 6; hp = (item >> 4) & 3; qb = item & 15; rowbase = 8192 + b * 1024;
        const int rstart = min(max(qb - 4, 0), 8);
        s0 = {proj + (size_t)(rowbase + rstart * 64) * LDO + 512 + hp * 128, vtc + 4194304 + ((size_t)b * 512 + hp * 128) * 1024 + rstart * 64, LDO, 1024, 8};
        s1 = {(const bf16_t*)(p.ws + OFF_CNK) + (size_t)b * 256 * 512 + hp * 128, (const bf16_t*)(p.ws + OFF_CNVT) + ((size_t)b * 512 + hp * 128) * 256, 512, 256, 4};
        for (int idx = tid; idx < 960; idx += 256) { const int hr = idx >> 5, cc = idx & 31; tab[idx] = cc < 31 ? p.rpb[hp * 930 + hr * 31 + cc] * LOG2E : -1e30f; }
        mp = {1, qb, rstart, qh * 32, tab + stream * 480};
    } else {
        const int it = item - 512;
        b = it >> 4; hp = (it >> 2) & 3; qb = it & 3; rowbase = b * 256;
        s0 = {proj + (size_t)rowbase * LDO + 512 + hp * 128, vtc + ((size_t)b * 512 + hp * 128) * 256, LDO, 256, 4};
        s1 = s0; s1.ntiles = 0;
    }
    const int R = rowbase + qb * 64 + qh * 32 + p32;
    const int head = hp * 2 + stream;
    bf16x8 qf[4];
    load_q(qf, proj + (size_t)R * LDO + head * 64, h);
    f32x16 O[2];
#pragma unroll
    for (int blk = 0; blk < 2; ++blk)
#pragma unroll
        for (int i = 0; i < 16; ++i) O[blk][i] = 0.f;
    float m = -1e30f, l = 0.f;
    attn_core<128, 128, 2, 1>(s0, s1, qf, stream * 8, stream * 64, 0.125f * LOG2E, m, l, O, lds, mp);
    const float il = 1.f / l;
    bf16_t* op = mix + (size_t)R * 1024 + head * 64;
#pragma unroll
    for (int blk = 0; blk < 2; ++blk)
#pragma unroll
        for (int g = 0; g < 4; ++g) {
            const int dv = blk * 32 + 8 * g + 4 * h;
            u32x2 o = {pk2(O[blk][4 * g] * il, O[blk][4 * g + 1] * il), pk2(O[blk][4 * g + 2] * il, O[blk][4 * g + 3] * il)};
            *(u32x2*)(op + dv) = o;
        }
}

DI void attn_d_item(const Params& p, int item, char* lds) {
    const int tid = VTID, lane = tid & 63, w = tid >> 6, p32 = lane & 31, h = lane >> 5;
    const bf16_t* proj = (const bf16_t*)(p.ws + OFF_BIG);
    const bf16_t* vtd = (const bf16_t*)(p.ws + OFF_BIG + BIG_VT_D);
    bf16_t* mix = (bf16_t*)(p.ws + OFF_BIG + BIG_MIXIN);
    int b, g, qb, rowbase; ASeg s0, s1; MaskP mp = {0, 0, 0, 0, nullptr};
    if (item < 512) {
        b = item >> 6; g = (item >> 5) & 1; qb = item & 31; rowbase = 8192 + b * 1024;
        const int q0 = qb * 32;
        const int tlo = max(q0 - 128, 0) >> 6, thi = min(q0 + 159, 1023) >> 6;
        s0 = {proj + (size_t)(rowbase + tlo * 64) * LDO + 1536 + g * 64, vtd + 1048576 + ((size_t)b * 128 + g * 64) * 1024 + tlo * 64, LDO, 1024, thi - tlo + 1};
        s1 = {(const bf16_t*)(p.ws + OFF_CSK) + (size_t)b * 256 * 128 + g * 64, (const bf16_t*)(p.ws + OFF_CSVT) + ((size_t)b * 128 + g * 64) * 256, 128, 256, 4};
        mp = {1, q0, tlo * 64, 0, nullptr};
    } else {
        const int it = item - 512;
        b = it >> 4; g = (it >> 3) & 1; qb = it & 7; rowbase = b * 256;
        s0 = {proj + (size_t)rowbase * LDO + 1536 + g * 64, vtd + ((size_t)b * 128 + g * 64) * 256, LDO, 256, 4};
        s1 = s0; s1.ntiles = 0;
    }
    const int R = rowbase + qb * 32 + p32;
    const int hq = g * 4 + w;
    bf16x8 qf[4];
    load_q(qf, proj + (size_t)R * LDO + 1024 + hq * 64, h);
    f32x16 O[2];
#pragma unroll
    for (int blk = 0; blk < 2; ++blk)
#pragma unroll
        for (int i = 0; i < 16; ++i) O[blk][i] = 0.f;
    float m = p.sink[hq] * LOG2E, l = h == 0 ? 1.f : 0.f;
    attn_core<64, 64, 2, 2>(s0, s1, qf, 0, 0, 0.125f * LOG2E, m, l, O, lds, mp);
    const float il = 1.f / l;
    bf16_t* op = mix + (size_t)R * 1024 + 512 + hq * 64;
#pragma unroll
    for (int blk = 0; blk < 2; ++blk)
#pragma unroll
        for (int gg = 0; gg < 4; ++gg) {
            const int dv = blk * 32 + 8 * gg + 4 * h;
            u32x2 o = {pk2(O[blk][4 * gg] * il, O[blk][4 * gg + 1] * il), pk2(O[blk][4 * gg + 2] * il, O[blk][4 * gg + 3] * il)};
            *(u32x2*)(op + dv) = o;
        }
}

DI void conv_item(const Params& p, int item) {
    const int tid = VTID;
    const bf16_t* proj = (const bf16_t*)(p.ws + OFF_BIG);
    bf16_t* mix = (bf16_t*)(p.ws + OFF_BIG + BIG_MIXIN);
#pragma unroll 2
    for (int i = 0; i < 8; ++i) {
        const int idx = tid + 256 * i, tl = idx >> 6, ch = (idx & 63) * 8;
        const int R = item * 32 + tl;
        int t, T;
        if (R < 8192) { t = R & 255; T = 256; } else { t = (R - 8192) & 1023; T = 1024; }
        const bf16_t* rp = proj + (size_t)R * LDE + ch;
        const u32x4 ab = *(const u32x4*)(rp);
        float accv[8];
#pragma unroll
        for (int e = 0; e < 8; ++e) accv[e] = 0.f;
#pragma unroll
        for (int j = 0; j < 3; ++j) {
            const int tt = t + j - 1;
            if (tt >= 0 && tt < T) {
                const u32x4 ac = *(const u32x4*)(rp + (ptrdiff_t)(j - 1) * LDE + 512);
                const u32x4 ax = *(const u32x4*)(rp + (ptrdiff_t)(j - 1) * LDE + 1024);
                const f32x4 w0 = *(const f32x4*)(p.conv_w + j * 512 + ch), w1 = *(const f32x4*)(p.conv_w + j * 512 + ch + 4);
#pragma unroll
                for (int e = 0; e < 4; ++e) {
                    accv[2 * e] += bflo(ac[e]) * bflo(ax[e]) * (e < 2 ? w0[2 * e] : w1[2 * e - 4]);
                    accv[2 * e + 1] += bfhi(ac[e]) * bfhi(ax[e]) * (e < 2 ? w0[2 * e + 1] : w1[2 * e - 3]);
                }
            }
        }
        u32x4 o;
#pragma unroll
        for (int e = 0; e < 4; ++e) o[e] = pk2(bflo(ab[e]) * accv[2 * e], bfhi(ab[e]) * accv[2 * e + 1]);
        *(u32x4*)(mix + (size_t)R * 1024 + ch) = o;
    }
}


#define XB_TMO      128
#define XB_XCNT(j)  (256  + 64 * (j))
#define XB_XSUB(j)  (1280 + 64 * (j))
#define XB_XGEN(j)  (2304 + 64 * (j))
#define XB_TOP      3328
#define XB_TOPGEN   3392
#define XCD_BAR_WORDS 3456
#define XB_SPIN_CAP (1u << 22)
#define LAS __attribute__((address_space(3)))
DI unsigned xb_ld(unsigned* p) { return __hip_atomic_load(p, __ATOMIC_RELAXED, __HIP_MEMORY_SCOPE_AGENT); }
DI unsigned xb_add(unsigned* p, unsigned v) { return __hip_atomic_fetch_add(p, v, __ATOMIC_RELAXED, __HIP_MEMORY_SCOPE_AGENT); }
DI unsigned xb_xcc_id() { return (unsigned)__builtin_amdgcn_s_getreg((3 << 11) | 20) & 0xFu; }
#define XB_SPIN(cond, bar) do { unsigned _sp = 0; while (cond) { __builtin_amdgcn_s_sleep(1); \
    if ((++_sp & 255u) == 0u) { if (xb_ld(&(bar)[XB_TMO])) break; if (_sp > XB_SPIN_CAP) { atomicAdd(&(bar)[XB_TMO], 1u); break; } } } } while (0)
struct XcdBarrier { unsigned* bar; unsigned x; volatile LAS unsigned* st; };
DI XcdBarrier xcd_barrier_post(unsigned* bar, volatile LAS unsigned* st) {
    XcdBarrier b; b.bar = bar; b.x = xb_xcc_id(); b.st = st;
    if (threadIdx.x == 0) (void)xb_add(&bar[XB_XCNT(b.x)], 1u);
    return b;
}
DI void xcd_barrier_complete(unsigned* bar, unsigned x, unsigned& nloc, unsigned& nx) {
    const unsigned G = gridDim.x * gridDim.y * gridDim.z;
    unsigned sum, cnt, mine, sp = 0u;
    for (;;) {
        sum = 0u; cnt = 0u; mine = 0u;
#pragma unroll
        for (unsigned j = 0; j < 16; ++j) { const unsigned c = xb_ld(&bar[XB_XCNT(j)]); sum += c; cnt += (c > 0u) ? 1u : 0u; mine = (j == x) ? c : mine; }
        if (sum == G) break;
        __builtin_amdgcn_s_sleep(1);
        if ((++sp & 255u) == 0u) { if (xb_ld(&bar[XB_TMO])) break; if (sp > XB_SPIN_CAP) { atomicAdd(&bar[XB_TMO], 1u); break; } }
    }
    nloc = mine > 0u ? mine : 1u; nx = cnt > 0u ? cnt : 1u;
}
DI void xcd_barrier(const XcdBarrier& b) {
    asm volatile("s_waitcnt vmcnt(0)" ::: "memory");
    __syncthreads();
    if (threadIdx.x == 0) {
        unsigned* bar = b.bar;
        __builtin_amdgcn_s_waitcnt(0);
        unsigned nloc = b.st[0], nx = b.st[1];
        if (nloc == 0u) { xcd_barrier_complete(bar, b.x, nloc, nx); b.st[0] = nloc; b.st[1] = nx; }
        const unsigned old = xb_add(&bar[XB_XSUB(b.x)], 1u);
        const unsigned gen = old / nloc;
        if (old + 1u == (gen + 1u) * nloc) {
            __builtin_amdgcn_fence(__ATOMIC_RELEASE, "agent");
            asm volatile("s_waitcnt vmcnt(0)" ::: "memory");
            const unsigned og = xb_add(&bar[XB_TOP], 1u);
            const unsigned tg = og / nx;
            if (og + 1u == (tg + 1u) * nx) xb_add(&bar[XB_TOPGEN], 1u);
            else XB_SPIN(xb_ld(&bar[XB_TOPGEN]) == tg, bar);
            __builtin_amdgcn_fence(__ATOMIC_ACQUIRE, "agent");
            xb_add(&bar[XB_XGEN(b.x)], 1u);
            asm volatile("s_waitcnt vmcnt(0)" ::: "memory");
        } else {
            XB_SPIN(xb_ld(&bar[XB_XGEN(b.x)]) == gen, bar);
            __builtin_amdgcn_fence(__ATOMIC_ACQUIRE, "agent");
            asm volatile("s_waitcnt vmcnt(0)" ::: "memory");
        }
    }
    __syncthreads();
}

constexpr int N_PHASES = 12;
DI void run_phase(const Params& p, int ph, char* shm) {
    const int nb = VNB, bid = VBID;
    char* lds = shm + VHALF * LDS_HALF;
    const int pvb = (int)(blockIdx.x & 7) * (nb >> 3) + (int)(blockIdx.x >> 3) * 2 + VHALF;
    const bf16_t* hy = (const bf16_t*)(p.ws + OFF_HY);
    const bf16_t* big = (const bf16_t*)(p.ws + OFF_BIG);
    const bf16_t* mixin = (const bf16_t*)(p.ws + OFF_BIG + BIG_MIXIN);
    const float* mod = (const float*)(p.ws + OFF_MOD);
    char* st = p.ws + OFF_STAT;
#define FZ(set, from_in, hasH, goff, wpost, wpre, scoff, shoff) FuseP{from_in, hasH, p.out, mod + (goff), wpost, wpre, mod + (scoff), mod + (shoff), (float*)(st + (set) * STAT_SET), (float*)(st + (set) * STAT_SET + 65536), (unsigned*)(st + (set) * STAT_SET + 131072)}
    switch (ph) {
    case 0: p0_phase(p, bid, nb, lds); break;
    case 1: rowop_phase(p, false, true, 0, nullptr, true, p.norm_mix_pre, 1024, 0); break;
    case 2: gemm_phase<EPI_PE>(p, hy, 2048, (const bf16_t*)(p.ws + OFF_WINE), 1024, 12, shm); break;
    case 3:
        for (int it = pvb; it < 1536; it += nb) { if (it < 1024) attn_diff_item(p, it, lds); else conv_item(p, it - 1024); }
        break;
    case 4: gemm_phase<EPI_YF>(p, mixin, 1024, (const bf16_t*)(p.ws + OFF_WOUT), 1024, 4, shm, FZ(0, 1, 1, 2048, p.norm_mix_post, p.norm_mlp_pre, 4096, 3072)); break;
    case 5: gemm_phase<EPI_W1>(p, hy, 2048, (const bf16_t*)(p.ws + OFF_W1), 1024, 16, shm); break;
    case 6: gemm_phase<EPI_YF>(p, big, 4096, (const bf16_t*)(p.ws + OFF_W2), 4096, 4, shm, FZ(1, 0, 1, 5120, p.norm_mlp_post, p.norm_mix_pre + 1024, 9 * 6144 + 1024, 9 * 6144 + 0)); break;
    case 7: gemm_phase<EPI_PO>(p, hy, 2048, (const bf16_t*)(p.ws + OFF_WINO), 1024, 9, shm); break;
    case 8:
        for (int it = pvb; it < 2048; it += nb) {
            const int q = it >> 9, r = it & 511;
            if (q & 1) attn_d_item(p, (q >> 1) * 512 + r, lds); else attn_c_item(p, (q >> 1) * 512 + r, lds);
        }
        break;
    case 9: gemm_phase<EPI_YF>(p, mixin, 1024, (const bf16_t*)(p.ws + OFF_WOUT) + 1048576, 1024, 4, shm, FZ(2, 0, 1, 9 * 6144 + 2048, p.norm_mix_post + 1024, p.norm_mlp_pre + 1024, 9 * 6144 + 4096, 9 * 6144 + 3072)); break;
    case 10: gemm_phase<EPI_W1>(p, hy, 2048, (const bf16_t*)(p.ws + OFF_W1) + 4194304, 1024, 16, shm); break;
    case 11: gemm_phase<EPI_YF>(p, big, 4096, (const bf16_t*)(p.ws + OFF_W2) + 4194304, 4096, 4, shm, FZ(3, 0, 0, 9 * 6144 + 5120, p.norm_mlp_post + 1024, p.norm_mlp_post, 0, 0)); break;
    }
#undef FZ
}

__global__ void __launch_bounds__(512, 2) fwd_mega(Params p) {
    __shared__ __attribute__((aligned(16))) char lds[LDS_BYTES];
    __shared__ uint4 xb_words;
    cg::grid_group grid = cg::this_grid();
    if (threadIdx.x == 0) xb_words = make_uint4(0u, 0u, 0u, 0u);
    __syncthreads();
    const XcdBarrier xb = xcd_barrier_post((unsigned*)(p.ws + OFF_BAR), (volatile LAS unsigned*)&xb_words);
#define PH_(n) run_phase(p, n, lds); xcd_barrier(xb); if ((DUP_MASK >> n) & 1) { run_phase(p, n, lds); xcd_barrier(xb); }
    PH_(0)
    if (p.ws == nullptr) grid.sync();
    PH_(1) PH_(2) PH_(3) PH_(4) PH_(5) PH_(6) PH_(7) PH_(8) PH_(9) PH_(10)
    run_phase(p, 11, lds);
#undef PH_
}

extern "C" void kernel_launch(void* const* d_in, const int* in_sizes, int n_in, void* d_out, int out_size, void* d_ws, size_t ws_size, hipStream_t stream) {
    Params p{};
    const float** pp = (const float**)&p;
    for (int i = 0; i < 29; ++i) pp[i] = (const float*)d_in[i];
    p.out = (float*)d_out;
    p.ws = (char*)d_ws;
    if (ws_size < WS_NEEDED) { fprintf(stderr, "workspace too small: %zu < %zu\n", ws_size, (size_t)WS_NEEDED); return; }
    static int grid_blocks = 0;
    if (!grid_blocks) {
        int dev = 0, cus = 0, per_cu = 0;
        hipGetDevice(&dev);
        hipDeviceGetAttribute(&cus, hipDeviceAttributeMultiprocessorCount, dev);
        hipOccupancyMaxActiveBlocksPerMultiprocessor(&per_cu, fwd_mega, 512, 0);
        if (per_cu > 1) per_cu = 1;
        if (per_cu < 1) per_cu = 1;
        grid_blocks = cus * per_cu;
        grid_blocks -= grid_blocks % 8;
    }
    (void)hipMemsetAsync((char*)d_ws + OFF_BAR, 0, XCD_BAR_WORDS * 4, stream);
    if (grid_blocks != 256) { fprintf(stderr, "fused epilogues need exactly 256 workgroups (got %d)\n", grid_blocks); return; }
    void* args[] = {&p};
    hipError_t e = hipLaunchCooperativeKernel((void*)fwd_mega, dim3(grid_blocks), dim3(512), args, 0, stream);
    if (e != hipSuccess) fprintf(stderr, "cooperative launch failed: %s (grid %d)\n", hipGetErrorString(e), grid_blocks);
}
```

```cpp
#include <hip/hip_runtime.h>
#include <hip/hip_cooperative_groups.h>
#include <cstdio>
#include <cstdint>
namespace cg = cooperative_groups;

#ifndef DUP_MASK
#define DUP_MASK 0
#endif
#ifndef ONE_LAUNCH
#define ONE_LAUNCH 1
#endif

typedef unsigned short bf16_t;
typedef short bf16x8 __attribute__((ext_vector_type(8)));
typedef float f32x4 __attribute__((ext_vector_type(4)));
typedef float f32x2 __attribute__((ext_vector_type(2)));
typedef float f32x16 __attribute__((ext_vector_type(16)));
typedef unsigned u32x4 __attribute__((ext_vector_type(4)));
typedef unsigned u32x2 __attribute__((ext_vector_type(2)));
typedef __bf16 bfv2 __attribute__((ext_vector_type(2)));
#define DI __device__ __forceinline__
DI int launder_v(int v) { asm volatile("" : "+v"(v)); return v; }
#define TIDX launder_v((int)threadIdx.x)
#define VTID (TIDX & 255)
#define VHALF (TIDX >> 8)
#define VBID ((int)(blockIdx.x * 2) + (TIDX >> 8))
#define VNB ((int)(gridDim.x * 2))
#define MFMA32(a, b, c) __builtin_amdgcn_mfma_f32_32x32x16_bf16((a), (b), (c), 0, 0, 0)
#define MFMA16(a, b, c) __builtin_amdgcn_mfma_f32_16x16x32_bf16((a), (b), (c), 0, 0, 0)

constexpr float LOG2E = 1.4426950408889634f;
constexpr float EPSN = 1e-6f;

struct Params {
    const float *x_prompt, *x_sample, *cache_diff_k, *cache_diff_v, *cache_na_k, *cache_na_v, *cache_swa_k, *cache_swa_v, *c, *c_ctx;
    const float *mod_w, *mod_b, *norm_mix_pre, *norm_mix_post, *norm_mlp_pre, *norm_mlp_post, *w_in_even, *conv_w, *lq1, *lk1, *lq2, *lk2, *subln;
    const float *w_in_odd, *rpb, *sink, *w_out, *mlp_w1, *mlp_w2;
    float* out;
    char* ws;
};

constexpr size_t OFF_MOD = 0;
constexpr size_t OFF_BAR = 458752;
constexpr size_t OFF_WINE = 524288;
constexpr size_t OFF_WINO = OFF_WINE + 6291456;
constexpr size_t OFF_WOUT = OFF_WINO + 4718592;
constexpr size_t OFF_W1 = OFF_WOUT + 4194304;
constexpr size_t OFF_W2 = OFF_W1 + 16777216;
constexpr size_t OFF_CDK = OFF_W2 + 16777216;
constexpr size_t OFF_CDVT = OFF_CDK + 2097152;
constexpr size_t OFF_CNK = OFF_CDVT + 2097152;
constexpr size_t OFF_CNVT = OFF_CNK + 2097152;
constexpr size_t OFF_CSK = OFF_CNVT + 2097152;
constexpr size_t OFF_CSVT = OFF_CSK + 524288;
constexpr size_t OFF_HY = OFF_CSVT + 524288;
constexpr size_t OFF_BIG = OFF_HY + 67108864;
constexpr size_t OFF_STAT = OFF_BIG + 134217728;
constexpr size_t STAT_SET = 65536 + 65536 + 8192;
constexpr size_t WS_NEEDED = OFF_STAT + 4 * STAT_SET;
constexpr size_t BIG_VT_E = 83886080;
constexpr size_t BIG_VT_C = 54525952;
constexpr size_t BIG_VT_D = BIG_VT_C + 16777216;
constexpr size_t BIG_MIXIN = 100663296;
constexpr int LDE = 2560, LDO = 1664;
constexpr size_t OUT_DIFFK = 16777216, OUT_DIFFV = 20971520, OUT_NAK = 25165824, OUT_NAV = 29360128, OUT_SWAK = 33554432, OUT_SWAV = 34603008;

constexpr int LDS_HALF = 65536 + 4096;
constexpr int LDS_BYTES = 2 * LDS_HALF;

DI unsigned pk2(float a, float b) { f32x2 v = {a, b}; bfv2 r = __builtin_convertvector(v, bfv2); return __builtin_bit_cast(unsigned, r); }
DI float bflo(unsigned u) { return __uint_as_float(u << 16); }
DI float bfhi(unsigned u) { return __uint_as_float(u & 0xffff0000u); }
DI float wave_sum(float v) {
#pragma unroll
    for (int o = 1; o < 64; o <<= 1) v += __shfl_xor(v, o);
    return v;
}
DI int swz128(int r, int c) { return r * 128 + ((c ^ ((r >> 1) & 7)) << 4); }
DI int swz256(int r, int c) { return r * 256 + ((c ^ (r & 15)) << 4); }

DI void p0_mod_item(const Params& p, int item, char* lds) {
    const int li = item / 96, cb = item % 96;
    const int tid = VTID, lane = tid & 63, w = tid >> 6;
    const float* W = p.mod_w + (size_t)li * 1024 * 6144 + cb * 64 + lane;
    float acc[9];
#pragma unroll
    for (int v = 0; v < 9; ++v) acc[v] = 0.f;
    for (int kc = 0; kc < 4; ++kc) {
        const int kb = w * 256 + kc * 64;
        float s[9];
        { const float cv = p.c_ctx[kb + lane]; s[0] = cv / (1.f + __expf(-cv)); }
#pragma unroll
        for (int v = 1; v < 9; ++v) { const float cv = p.c[(v - 1) * 1024 + kb + lane]; s[v] = cv / (1.f + __expf(-cv)); }
#pragma unroll
        for (int kk = 0; kk < 64; ++kk) {
            const float wv = __builtin_nontemporal_load(W + (size_t)(kb + kk) * 6144);
#pragma unroll
            for (int v = 0; v < 9; ++v) acc[v] += __int_as_float(__builtin_amdgcn_readlane(__float_as_int(s[v]), kk)) * wv;
        }
    }
    float* red = (float*)lds;
#pragma unroll
    for (int v = 0; v < 9; ++v) red[(w * 9 + v) * 64 + lane] = acc[v];
    __syncthreads();
    float* mod = (float*)(p.ws + OFF_MOD);
    for (int idx = tid; idx < 576; idx += 256) {
        const int v = idx >> 6, col = idx & 63;
        const float sum = red[(0 * 9 + v) * 64 + col] + red[(1 * 9 + v) * 64 + col] + red[(2 * 9 + v) * 64 + col] + red[(3 * 9 + v) * 64 + col];
        mod[(li * 9 + v) * 6144 + cb * 64 + col] = sum + p.mod_b[li * 6144 + cb * 64 + col];
    }
    __syncthreads();
}

DI void p0_transpose_tile(const float* __restrict__ in, bf16_t* __restrict__ out, int R, int C, int tr, int tc, char* lds) {
    const int tid = VTID;
    const int cl = (tid & 15) * 4, rl = (tid >> 4) * 2, sw = tid & 7;
#pragma unroll
    for (int i = 0; i < 2; ++i) {
        const int r = rl + 32 * i;
        const f32x4 a = *(const f32x4*)(in + (size_t)(tr * 64 + r) * C + tc * 64 + cl);
        const f32x4 b = *(const f32x4*)(in + (size_t)(tr * 64 + r + 1) * C + tc * 64 + cl);
#pragma unroll
        for (int j = 0; j < 4; ++j) *(unsigned*)(lds + (cl + j) * 128 + (((r >> 3) ^ sw) << 4) + (r & 7) * 2) = pk2(a[j], b[j]);
    }
    __syncthreads();
#pragma unroll
    for (int i = 0; i < 2; ++i) {
        const int idx = tid + 256 * i, c = idx >> 3, q = idx & 7;
        const u32x4 v = *(const u32x4*)(lds + c * 128 + ((q ^ ((c >> 2) & 7)) << 4));
        *(u32x4*)(out + (size_t)(tc * 64 + c) * R + tr * 64 + q * 8) = v;
    }
    __syncthreads();
}

DI void p0_kreorder(const float* __restrict__ in, bf16_t* __restrict__ out, int logH, int item) {
    const int tid = VTID, H = 1 << logH;
#pragma unroll
    for (int i = 0; i < 4; ++i) {
        const int f = item * 1024 + tid + 256 * i;
        const int d4 = f & 15, key = (f >> 4) & 255, hh = (f >> 12) & (H - 1), b = f >> (12 + logH);
        const f32x4 v = __builtin_nontemporal_load((const f32x4*)(in + (size_t)f * 4));
        u32x2 o = {pk2(v[0], v[1]), pk2(v[2], v[3])};
        *(u32x2*)(out + ((size_t)(b * 256 + key) * H + hh) * 64 + d4 * 4) = o;
    }
}

struct TJob { const float* in; bf16_t* out; int R, C, tr, tc, late; };
constexpr int P0_TITEMS = 768 + 576 + 512 + 2048 + 2048 + 256 + 256 + 64;
DI TJob p0_decode(const Params& p, int item) {
    TJob j;
    j.late = (item >= 768 && item < 1344) || (item >= 1600 && item < 1856) || (item >= 2880 && item < 3904) || (item >= 4928 && item < 5952);
    if (item < 768) { j.in = p.w_in_even; j.out = (bf16_t*)(p.ws + OFF_WINE); j.R = 1024; j.C = 3072; }
    else if ((item -= 768) < 576) { j.in = p.w_in_odd; j.out = (bf16_t*)(p.ws + OFF_WINO); j.R = 1024; j.C = 2304; }
    else if ((item -= 576) < 512) { const int b = item >> 8; item &= 255; j.in = p.w_out + (size_t)b * 1048576; j.out = (bf16_t*)(p.ws + OFF_WOUT) + (size_t)b * 1048576; j.R = 1024; j.C = 1024; }
    else if ((item -= 512) < 2048) { const int b = item >> 10; item &= 1023; j.in = p.mlp_w1 + (size_t)b * 4194304; j.out = (bf16_t*)(p.ws + OFF_W1) + (size_t)b * 4194304; j.R = 1024; j.C = 4096; }
    else if ((item -= 2048) < 2048) { const int b = item >> 10; item &= 1023; j.in = p.mlp_w2 + (size_t)b * 4194304; j.out = (bf16_t*)(p.ws + OFF_W2) + (size_t)b * 4194304; j.R = 4096; j.C = 1024; }
    else if ((item -= 2048) < 256) { const int b = item >> 3; item &= 7; j.in = p.cache_diff_v + (size_t)b * 32768; j.out = (bf16_t*)(p.ws + OFF_CDVT) + (size_t)b * 32768; j.R = 256; j.C = 128; }
    else if ((item -= 256) < 256) { const int b = item >> 2; item &= 3; j.in = p.cache_na_v + (size_t)b * 16384; j.out = (bf16_t*)(p.ws + OFF_CNVT) + (size_t)b * 16384; j.R = 256; j.C = 64; }
    else { item -= 256; const int b = item >> 2; item &= 3; j.in = p.cache_swa_v + (size_t)b * 16384; j.out = (bf16_t*)(p.ws + OFF_CSVT) + (size_t)b * 16384; j.R = 256; j.C = 64; }
    const int ntc = j.C >> 6;
    j.tr = item / ntc; j.tc = item % ntc;
    return j;
}
DI void p0_tload(const TJob& j, int tid, f32x4 (&a)[2], f32x4 (&b)[2]) {
    const int cl = (tid & 15) * 4, rl = (tid >> 4) * 2;
#pragma unroll
    for (int i = 0; i < 2; ++i) {
        const int r = rl + 32 * i;
        a[i] = __builtin_nontemporal_load((const f32x4*)(j.in + (size_t)(j.tr * 64 + r) * j.C + j.tc * 64 + cl));
        b[i] = __builtin_nontemporal_load((const f32x4*)(j.in + (size_t)(j.tr * 64 + r + 1) * j.C + j.tc * 64 + cl));
    }
}
DI void p0_phase(const Params& p, int bid, int nb, char* lds) {
    if (bid < 192) p0_mod_item(p, bid, lds);
    const int tid = VTID;
    {
        const int cl = (tid & 15) * 4, rl = (tid >> 4) * 2, sw = tid & 7;
        const int first = bid < 192 ? bid : 1536 + (bid - 192), stride = bid < 192 ? 192 : nb - 192, lim = bid < 192 ? 1536 : P0_TITEMS;
#define P0_PROC(J, A, B) do { \
            _Pragma("unroll") for (int i = 0; i < 2; ++i) { const int r = rl + 32 * i; \
                _Pragma("unroll") for (int jj = 0; jj < 4; ++jj) *(unsigned*)(lds + (cl + jj) * 128 + (((r >> 3) ^ sw) << 4) + (r & 7) * 2) = pk2(A[i][jj], B[i][jj]); } \
            asm volatile("s_waitcnt lgkmcnt(0)\n\ts_barrier" ::: "memory"); \
            _Pragma("unroll") for (int i = 0; i < 2; ++i) { const int idx = tid + 256 * i, c = idx >> 3, q = idx & 7; \
                const u32x4 v = *(const u32x4*)(lds + c * 128 + ((q ^ ((c >> 2) & 7)) << 4)); \
                u32x4* dst = (u32x4*)(J.out + (size_t)(J.tc * 64 + c) * J.R + J.tr * 64 + q * 8); \
                if (J.late) __builtin_nontemporal_store(v, dst); else *dst = v; } \
            asm volatile("s_waitcnt lgkmcnt(0)\n\ts_barrier" ::: "memory"); } while (0)
        int it = first;
        TJob j0 = p0_decode(p, it < lim ? it : first), j1;
        f32x4 a0[2], b0[2], a1[2], b1[2];
        p0_tload(j0, tid, a0, b0);
        while (it < lim) {
            { const int nx = it + stride; j1 = p0_decode(p, nx < lim ? nx : first); p0_tload(j1, tid, a1, b1); }
            P0_PROC(j0, a0, b0);
            it += stride;
            if (it >= lim) break;
            { const int nx = it + stride; j0 = p0_decode(p, nx < lim ? nx : first); p0_tload(j0, tid, a0, b0); }
            P0_PROC(j1, a1, b1);
            it += stride;
        }
#undef P0_PROC
    }
    {
        f32x4* st4 = (f32x4*)(p.ws + OFF_STAT);
        const f32x4 z = {0.f, 0.f, 0.f, 0.f};
        for (int i = bid * 256 + tid; i < (int)(4 * STAT_SET / 16); i += nb * 256) st4[i] = z;
    }
    for (int it = bid; it < 576; it += nb) {
        if (it < 256) p0_kreorder(p.cache_diff_k, (bf16_t*)(p.ws + OFF_CDK), 3, it);
        else if (it < 512) p0_kreorder(p.cache_na_k, (bf16_t*)(p.ws + OFF_CNK), 3, it - 256);
        else p0_kreorder(p.cache_swa_k, (bf16_t*)(p.ws + OFF_CSK), 1, it - 512);
    }
}

DI void rowop_phase(const Params& p, bool hasY, bool xin_input, int g_off, const float* wpost, bool hasH, const float* wpre, int sc_off, int sh_off) {
    const int tix = TIDX, lane = tix & 63, gw = (int)(blockIdx.x * 8) + (tix >> 6), nw = VNB * 4;
    const float* mod = (const float*)(p.ws + OFF_MOD);
    f32x4 wpo[4], wpr[4];
#pragma unroll
    for (int i = 0; i < 4; ++i) { if (hasY) wpo[i] = *(const f32x4*)(wpost + lane * 4 + 256 * i); if (hasH) wpr[i] = *(const f32x4*)(wpre + lane * 4 + 256 * i); }
    for (int row0 = gw; row0 < 16384; row0 += 2 * nw) {
        f32x4 x[2][4], y[2][4];
#pragma unroll
        for (int r = 0; r < 2; ++r) {
            const int row = row0 + r * nw;
            const float* xin = xin_input ? (row < 8192 ? p.x_prompt + (size_t)row * 1024 : p.x_sample + (size_t)(row - 8192) * 1024) : p.out + (size_t)row * 1024;
            const float* yin = (const float*)(p.ws + OFF_HY + (size_t)row * 4096);
#pragma unroll
            for (int i = 0; i < 4; ++i) { x[r][i] = __builtin_nontemporal_load((const f32x4*)(xin + lane * 4 + 256 * i)); if (hasY) y[r][i] = *(const f32x4*)(yin + lane * 4 + 256 * i); }
        }
#pragma unroll
        for (int r = 0; r < 2; ++r) {
            const int row = row0 + r * nw;
            const int v = row < 8192 ? 0 : 1 + ((row - 8192) >> 10);
            char* hy = p.ws + OFF_HY + (size_t)row * 4096;
            if (hasY) {
                f32x4 g4[4];
#pragma unroll
                for (int i = 0; i < 4; ++i) g4[i] = *(const f32x4*)(mod + v * 6144 + g_off + lane * 4 + 256 * i);
                float ss = 0.f;
#pragma unroll
                for (int i = 0; i < 4; ++i) ss += y[r][i][0] * y[r][i][0] + y[r][i][1] * y[r][i][1] + y[r][i][2] * y[r][i][2] + y[r][i][3] * y[r][i][3];
                ss = wave_sum(ss);
                const float rs = rsqrtf(ss * (1.f / 1024.f) + EPSN);
#pragma unroll
                for (int i = 0; i < 4; ++i) {
                    x[r][i] += g4[i] * (y[r][i] * rs * wpo[i]);
                    *(f32x4*)(p.out + (size_t)row * 1024 + lane * 4 + 256 * i) = x[r][i];
                }
            }
            if (hasH) {
                f32x4 sc[4], sh[4];
#pragma unroll
                for (int i = 0; i < 4; ++i) { sc[i] = *(const f32x4*)(mod + v * 6144 + sc_off + lane * 4 + 256 * i); sh[i] = *(const f32x4*)(mod + v * 6144 + sh_off + lane * 4 + 256 * i); }
                float ss = 0.f;
#pragma unroll
                for (int i = 0; i < 4; ++i) ss += x[r][i][0] * x[r][i][0] + x[r][i][1] * x[r][i][1] + x[r][i][2] * x[r][i][2] + x[r][i][3] * x[r][i][3];
                ss = wave_sum(ss);
                const float rs = rsqrtf(ss * (1.f / 1024.f) + EPSN);
#pragma unroll
                for (int i = 0; i < 4; ++i) {
                    const f32x4 h = x[r][i] * rs * wpr[i] * (sc[i] + 1.f) + sh[i];
                    u32x2 o = {pk2(h[0], h[1]), pk2(h[2], h[3])};
                    *(u32x2*)((bf16_t*)hy + lane * 4 + 256 * i) = o;
                }
            }
        }
    }
}

namespace g8 {
constexpr int BK = 64, HALF = 128, HTB = HALF * BK * 2;
DI int lds_byte(int r, int c) { const int st = (r >> 4) * 2 + (c >> 5), rr = r & 15, cc = c & 31, ob = rr * 64 + cc * 2; return st * 1024 + (ob ^ (((ob >> 9) & 1) << 5)); }
DI void stage_rc(int b, int& R, int& C) { const int st = b / 1024, sb = b % 1024, swz = sb ^ (((sb >> 9) & 1) << 5); R = (st >> 1) * 16 + swz / 64; C = (st & 1) * 32 + (swz % 64) / 2; }
typedef __attribute__((address_space(3))) unsigned lds_u32;
typedef __attribute__((address_space(3))) unsigned char lds_u8;
typedef __attribute__((address_space(3))) bf16x8 lds_bf16x8;

}

enum { EPI_PE = 0, EPI_PO = 1, EPI_Y = 2, EPI_W1 = 3, EPI_YF = 4 };

struct FuseP { int from_input, hasH; float* xout; const float* g; const float* wpost; const float* wpre; const float* sc; const float* sh; float* ssY; float* ssX; unsigned* cnt; };
DI float ld_agent(const float* q) { return __hip_atomic_load(q, __ATOMIC_RELAXED, __HIP_MEMORY_SCOPE_AGENT); }
DI void panel_wait(unsigned* c, unsigned target) {
    asm volatile("s_waitcnt vmcnt(0)" ::: "memory");
    __syncthreads();
    if (threadIdx.x == 0) {
        __hip_atomic_fetch_add(c, 1u, __ATOMIC_RELAXED, __HIP_MEMORY_SCOPE_AGENT);
        unsigned sp = 0;
        while (__hip_atomic_load(c, __ATOMIC_RELAXED, __HIP_MEMORY_SCOPE_AGENT) < target) { __builtin_amdgcn_s_sleep(1); if (++sp > (1u << 22)) break; }
    }
    __syncthreads();
}
DI float dot4(const f32x4& a) { return a[0] * a[0] + a[1] * a[1] + a[2] * a[2] + a[3] * a[3]; }

DI void rope_s(f32x4 (&sub)[4][2], int R0, bool usecol, int fr, int fq) {
    asm volatile("" : "+s"(R0));
    const float sgn = fq < 2 ? -1.f : 1.f;
#pragma unroll
    for (int m = 0; m < 4; ++m) {
        __builtin_amdgcn_sched_barrier(0);
        const int tl = (R0 + m * 16 + fr - 8192) & 1023;
        const float pos = (float)(usecol ? (tl & 63) : (tl >> 6));
#pragma unroll
        for (int n = 0; n < 2; ++n)
#pragma unroll
            for (int j = 0; j < 4; ++j) {
                const float inv = exp2f(-(float)(8 * (fq & 1) + 4 * n + j) * (13.287712379549449f / 16.f));
                float sn, cs;
                __sincosf(pos * inv, &sn, &cs);
                const float v = sub[m][n][j], pv = __shfl_xor(v, 32);
                sub[m][n][j] = v * cs + sgn * pv * sn;
            }
    }
}
DI void store_bf16_rows_s(const f32x4 (&sub)[4][2], bf16_t* base, int ld, int R0, int Cd0, int fr, int fq) {
#pragma unroll
    for (int m = 0; m < 4; ++m) {
        u32x4 o = {pk2(sub[m][0][0], sub[m][0][1]), pk2(sub[m][0][2], sub[m][0][3]), pk2(sub[m][1][0], sub[m][1][1]), pk2(sub[m][1][2], sub[m][1][3])};
        *(u32x4*)(base + (size_t)(R0 + m * 16 + fr) * ld + Cd0 + fq * 8) = o;
    }
}
DI void store_f32_rows_s(const f32x4 (&sub)[4][2], float* ob, int ldo, int fr, int fq) {
#pragma unroll
    for (int m = 0; m < 4; ++m) {
        float* rp = ob + (size_t)(m * 16 + fr) * ldo + fq * 8;
#pragma unroll
        for (int n = 0; n < 2; ++n) __builtin_nontemporal_store(sub[m][n], (f32x4*)(rp + n * 4));
    }
}
DI void store_vt_s(const f32x4 (&sub)[4][2], bf16_t* vt, int T, int t0, int fr, int fq) {
#pragma unroll
    for (int n = 0; n < 2; ++n) {
        bf16_t* rp = vt + (size_t)(8 * (fr >> 2) + 4 * n + (fr & 3)) * T + t0 + fq * 4;
#pragma unroll
        for (int m = 0; m < 4; ++m) { u32x2 o = {pk2(sub[m][n][0], sub[m][n][1]), pk2(sub[m][n][2], sub[m][n][3])}; *(u32x2*)(rp + m * 16) = o; }
    }
}
DI void store_f32_ns_s(const f32x4 (&sub)[4][2], float* ob, int ldo, int fr, int fq) {
#pragma unroll
    for (int m = 0; m < 4; ++m)
#pragma unroll
        for (int j = 0; j < 4; ++j) {
            float* rp = ob + (size_t)(m * 16 + fq * 4 + j) * ldo + 8 * (fr >> 2) + (fr & 3);
#pragma unroll
            for (int n = 0; n < 2; ++n) __builtin_nontemporal_store(sub[m][n][j], rp + n * 4);
        }
}

template <int EPI>
DI void tile_epilogue(const Params& p, f32x4 (&acc)[2][2][4][2], int pm, int pn, int vtm, const FuseP& fz) {
    const int tix = TIDX, wid = __builtin_amdgcn_readfirstlane(tix >> 6), lane = tix & 63, wr = wid >> 2, wc = wid & 3;
    const int brow = pm * 256, bcol = pn * 256;
    int fr = lane & 15, fq = lane >> 4;
    asm volatile("" : "+v"(fr), "+v"(fq));
    const bool latent = brow >= 8192;
    int b, tb, T;
    if (latent) { b = (brow - 8192) >> 10; tb = (brow - 8192) & 1023; T = 1024; } else { b = brow >> 8; tb = 0; T = 256; }
    bf16_t* big = (bf16_t*)(p.ws + OFF_BIG);
    if (EPI == EPI_YF) {
        const int v = latent ? 1 + b : 0;
        const int rbase = brow + wr * 64 + fr;
        const int cbase = bcol + wc * 32 + fq * 8;
        float rs[2][4];
#pragma unroll
        for (int ai = 0; ai < 2; ++ai)
#pragma unroll
            for (int m = 0; m < 4; ++m) {
                float sq = dot4(acc[ai][0][m][0]) + dot4(acc[ai][0][m][1]) + dot4(acc[ai][1][m][0]) + dot4(acc[ai][1][m][1]);
                sq += __shfl_xor(sq, 16); sq += __shfl_xor(sq, 32);
                if (fq == 0) { const float old = __hip_atomic_fetch_add(fz.ssY + rbase + ai * 128 + m * 16, sq, __ATOMIC_RELAXED, __HIP_MEMORY_SCOPE_AGENT); asm volatile("" :: "v"(old)); }
            }
        panel_wait(fz.cnt + pm * 32, 4u);
#pragma unroll
        for (int ai = 0; ai < 2; ++ai)
#pragma unroll
            for (int m = 0; m < 4; ++m) rs[ai][m] = rsqrtf(ld_agent(fz.ssY + rbase + ai * 128 + m * 16) * (1.f / 1024.f) + EPSN);
        const float* xin = latent ? p.x_sample - (size_t)8192 * 1024 : p.x_prompt;
        bf16_t* xb = (bf16_t*)(p.ws + OFF_HY) + 1024;
        float s2[2][4];
#pragma unroll
        for (int ai = 0; ai < 2; ++ai)
#pragma unroll
            for (int m = 0; m < 4; ++m) s2[ai][m] = 0.f;
#pragma unroll
        for (int bj = 0; bj < 2; ++bj) {
            const int col = cbase + bj * 128;
            f32x4 g4[2], wp4[2];
#pragma unroll
            for (int n = 0; n < 2; ++n) { g4[n] = *(const f32x4*)(fz.g + v * 6144 + col + 4 * n); wp4[n] = *(const f32x4*)(fz.wpost + col + 4 * n); }
#pragma unroll
            for (int ai = 0; ai < 2; ++ai)
#pragma unroll
                for (int m = 0; m < 4; ++m) {
                    const size_t off = (size_t)(rbase + ai * 128 + m * 16) * 1024 + col;
                    f32x4 x4[2];
                    if (fz.from_input) { x4[0] = __builtin_nontemporal_load((const f32x4*)(xin + off)); x4[1] = __builtin_nontemporal_load((const f32x4*)(xin + off + 4)); }
                    else {
                        const u32x4 xr = __builtin_nontemporal_load((const u32x4*)(xb + 2 * off - col));
                        x4[0] = (f32x4){bflo(xr[0]), bfhi(xr[0]), bflo(xr[1]), bfhi(xr[1])}; x4[1] = (f32x4){bflo(xr[2]), bfhi(xr[2]), bflo(xr[3]), bfhi(xr[3])};
                    }
                    f32x4 a[2];
#pragma unroll
                    for (int n = 0; n < 2; ++n) { a[n] = x4[n] + g4[n] * (acc[ai][bj][m][n] * rs[ai][m] * wp4[n]); acc[ai][bj][m][n] = a[n]; s2[ai][m] += dot4(a[n]); }
                    if (fz.hasH) { u32x4 xo = {pk2(a[0][0], a[0][1]), pk2(a[0][2], a[0][3]), pk2(a[1][0], a[1][1]), pk2(a[1][2], a[1][3])}; *(u32x4*)(xb + 2 * off - col) = xo; }
                    else { __builtin_nontemporal_store(a[0], (f32x4*)(fz.xout + off)); __builtin_nontemporal_store(a[1], (f32x4*)(fz.xout + off + 4)); }
                }
        }
        if (fz.hasH) {
#pragma unroll
            for (int ai = 0; ai < 2; ++ai)
#pragma unroll
                for (int m = 0; m < 4; ++m) {
                    float sq = s2[ai][m];
                    sq += __shfl_xor(sq, 16); sq += __shfl_xor(sq, 32);
                    if (fq == 0) { const float old = __hip_atomic_fetch_add(fz.ssX + rbase + ai * 128 + m * 16, sq, __ATOMIC_RELAXED, __HIP_MEMORY_SCOPE_AGENT); asm volatile("" :: "v"(old)); }
                }
            panel_wait(fz.cnt + pm * 32 + 16, 4u);
#pragma unroll
            for (int ai = 0; ai < 2; ++ai)
#pragma unroll
                for (int m = 0; m < 4; ++m) rs[ai][m] = rsqrtf(ld_agent(fz.ssX + rbase + ai * 128 + m * 16) * (1.f / 1024.f) + EPSN);
            bf16_t* hb = (bf16_t*)(p.ws + OFF_HY);
#pragma unroll
            for (int bj = 0; bj < 2; ++bj) {
                const int col = cbase + bj * 128;
                f32x4 wq4[2], sc4[2], sh4[2];
#pragma unroll
                for (int n = 0; n < 2; ++n) { wq4[n] = *(const f32x4*)(fz.wpre + col + 4 * n); sc4[n] = *(const f32x4*)(fz.sc + v * 6144 + col + 4 * n) + 1.f; sh4[n] = *(const f32x4*)(fz.sh + v * 6144 + col + 4 * n); }
#pragma unroll
                for (int ai = 0; ai < 2; ++ai)
#pragma unroll
                    for (int m = 0; m < 4; ++m) {
                        const f32x4 h0 = acc[ai][bj][m][0] * rs[ai][m] * wq4[0] * sc4[0] + sh4[0], h1 = acc[ai][bj][m][1] * rs[ai][m] * wq4[1] * sc4[1] + sh4[1];
                        u32x4 o = {pk2(h0[0], h0[1]), pk2(h0[2], h0[3]), pk2(h1[0], h1[1]), pk2(h1[2], h1[3])};
                        *(u32x4*)(hb + (size_t)(rbase + ai * 128 + m * 16) * 2048 + col) = o;
                    }
            }
        }
        return;
    }
#pragma unroll
    for (int ai = 0; ai < 2; ++ai)
#pragma unroll
        for (int bj = 0; bj < 2; ++bj) {
            __builtin_amdgcn_sched_barrier(0);
            f32x4 (&sub)[4][2] = acc[ai][bj];
            const int R0 = brow + ai * 128 + wr * 64, t0 = tb + ai * 128 + wr * 64, C0 = bcol + bj * 128 + wc * 32;
            const bool ns = vtm == 1 || (vtm == 2 && bj == 1);
            if (EPI == EPI_PE) {
                if (ns) {
                    const int vc = C0 - 2560;
                    bf16_t* vt = (bf16_t*)(p.ws + OFF_BIG + BIG_VT_E) + (latent ? (size_t)4194304 + ((size_t)b * 512 + vc) * 1024 : ((size_t)b * 512 + vc) * 256);
                    store_vt_s(sub, vt, T, t0, fr, fq);
                    if (!latent) store_f32_ns_s(sub, p.out + OUT_DIFFV + ((size_t)(b * 4 + (vc >> 7)) * 256 + t0) * 128 + (vc & 127), 128, fr, fq);
                } else {
                    if (pn >= 6 && latent) rope_s(sub, R0, wc & 1, fr, fq);
                    store_bf16_rows_s(sub, big, LDE, R0, C0, fr, fq);
                    if (pn >= 8 && !latent) store_f32_rows_s(sub, p.out + OUT_DIFFK + ((size_t)(b * 8 + ((C0 - 2048) >> 6)) * 256 + t0) * 64 + ((C0 - 2048) & 63), 64, fr, fq);
                }
            } else if (EPI == EPI_PO) {
                if (ns) {
                    if (pn < 8) {
                        const int vc = C0 - 1024;
                        bf16_t* vt = (bf16_t*)(p.ws + OFF_BIG + BIG_VT_C) + (latent ? (size_t)4194304 + ((size_t)b * 512 + vc) * 1024 : ((size_t)b * 512 + vc) * 256);
                        store_vt_s(sub, vt, T, t0, fr, fq);
                        if (!latent) store_f32_ns_s(sub, p.out + OUT_NAV + ((size_t)(b * 8 + (vc >> 6)) * 256 + t0) * 64 + (vc & 63), 64, fr, fq);
                    } else {
                        const int vc = C0 - 2176;
                        bf16_t* vt = (bf16_t*)(p.ws + OFF_BIG + BIG_VT_D) + (latent ? (size_t)1048576 + ((size_t)b * 128 + vc) * 1024 : ((size_t)b * 128 + vc) * 256);
                        store_vt_s(sub, vt, T, t0, fr, fq);
                        if (!latent) store_f32_ns_s(sub, p.out + OUT_SWAV + ((size_t)(b * 2 + (vc >> 6)) * 256 + t0) * 64 + (vc & 63), 64, fr, fq);
                    }
                } else {
                    if (pn >= 6 && latent) rope_s(sub, R0, wc & 1, fr, fq);
                    store_bf16_rows_s(sub, big, LDO, R0, pn >= 6 ? C0 - 512 : C0, fr, fq);
                    if (!latent) {
                        if (pn == 2 || pn == 3) store_f32_rows_s(sub, p.out + OUT_NAK + ((size_t)(b * 8 + ((C0 - 512) >> 6)) * 256 + t0) * 64 + ((C0 - 512) & 63), 64, fr, fq);
                        else if (pn == 8) store_f32_rows_s(sub, p.out + OUT_SWAK + ((size_t)(b * 2 + ((C0 - 2048) >> 6)) * 256 + t0) * 64 + ((C0 - 2048) & 63), 64, fr, fq);
                    }
                }
            } else if (EPI == EPI_Y) {
                store_f32_rows_s(sub, (float*)(p.ws + OFF_HY) + (size_t)R0 * 1024 + C0, 1024, fr, fq);
            } else {
#pragma unroll
                for (int m = 0; m < 4; ++m)
#pragma unroll
                    for (int n = 0; n < 2; ++n)
#pragma unroll
                        for (int j = 0; j < 4; ++j) { const float v = fmaxf(sub[m][n][j], 0.f); sub[m][n][j] = v * v; }
                store_bf16_rows_s(sub, big, 4096, R0, C0, fr, fq);
            }
        }
}

template <int EPI>
DI void gemm_phase(const Params& p, const bf16_t* A, int lda, const bf16_t* Bt, int K, int NT_N, char* shm, const FuseP& fz = FuseP{}) {
    using namespace g8;
    const int xcd = blockIdx.x & 7, lb = blockIdx.x >> 3, nlb = gridDim.x >> 3, per_xcd = 8 * NT_N;
    if (lb >= per_xcd) return;
    const int tid = TIDX, wid = __builtin_amdgcn_readfirstlane(tid >> 6), lane = tid & 63, wr = wid >> 2, wc = wid & 3, fr = lane & 15, fq = lane >> 4;
    const int nt = K / BK;
    lds_u8* lds = (lds_u8*)shm;
    unsigned voffA[2], voffB[2];
#pragma unroll
    for (int _i = 0; _i < 2; ++_i) { int _r, _c; stage_rc(tid * 16 + _i * 8192, _r, _c); const int _i16 = _r & 15, _rb = (_r & ~31) + 8 * (_i16 >> 2) + 4 * ((_r >> 4) & 1) + (_i16 & 3);
        voffA[_i] = (unsigned)(_r * lda + _c) * 2u; voffB[_i] = (unsigned)(_rb * K + _c) * 2u; }
    const size_t kstep = (size_t)BK * 2, hstepA = (size_t)HALF * lda * 2, hstepB = (size_t)HALF * K * 2;
    const unsigned ldsw = (unsigned)wid * 1024u;
    const int aoff = lds_byte(wr * 64 + fr, fq * 8), boff = lds_byte(wc * 32 + fr, fq * 8);
#define SA(b, h) (((b) * 2 + (h)) * HTB)
#define SB(b, h) ((4 + (b) * 2 + (h)) * HTB)
#define STAGE(bufoff, gbase, voff) do { _Pragma("unroll") for (int _i = 0; _i < 2; ++_i) \
      __builtin_amdgcn_global_load_lds((const unsigned*)((gbase) + (voff)[_i]), (lds_u32*)(lds + (bufoff) + ldsw + _i * 8192), 16, 0, 0); } while (0)
#define LDA(dst, b, h) _Pragma("unroll") for (int m = 0; m < 4; ++m) _Pragma("unroll") for (int k = 0; k < 2; ++k) \
    dst[m][k] = *(const lds_bf16x8*)(lds + SA(b, h) + aoff + m * 2048 + k * 1024)
#define LDB(dst, b, h) _Pragma("unroll") for (int n = 0; n < 2; ++n) _Pragma("unroll") for (int k = 0; k < 2; ++k) \
    dst[n][k] = *(const lds_bf16x8*)(lds + SB(b, h) + boff + n * 2048 + k * 1024)
#define MMA(VT, ai, bj, At_, Bt_) do { __builtin_amdgcn_s_setprio(1); \
    _Pragma("unroll") for (int m = 0; m < 4; ++m) _Pragma("unroll") for (int n = 0; n < 2; ++n) _Pragma("unroll") for (int k = 0; k < 2; ++k) \
      acc[ai][bj][m][n] = ((VT) == 1 || ((VT) == 2 && (bj) == 1)) ? MFMA16(At_[m][k], Bt_[n][k], acc[ai][bj][m][n]) : MFMA16(Bt_[n][k], At_[m][k], acc[ai][bj][m][n]); \
    __builtin_amdgcn_s_setprio(0); } while (0)
#define WAIT_V(n) asm volatile("s_waitcnt vmcnt(" #n ")" ::: "memory")
#define WAIT_L(n) asm volatile("s_waitcnt lgkmcnt(" #n ")" ::: "memory")
#define BAR __builtin_amdgcn_s_barrier()
#define SCHED __builtin_amdgcn_sched_barrier(0)
#define TLOOP(VT) for (int t = 0; t < nt; t += 2) { \
        const bool last = (t == nt - 2); \
        const char* a1 = cA + (size_t)(t + 1) * kstep; \
        const char* a2 = last ? nA : cA + (size_t)(t + 2) * kstep; const char* b2 = last ? nB : cB + (size_t)(t + 2) * kstep; \
        const char* a3 = a2 + kstep; const char* b3 = b2 + kstep; \
        LDB(B0, 0, 0); LDB(B1, 0, 1); SCHED; LDA(At, 0, 0); STAGE(SA(1, 1), a1 + hstepA, voffA); \
        WAIT_V(8); WAIT_L(0); BAR; MMA(VT, 0, 0, At, B0); MMA(VT, 0, 1, At, B1); BAR; SCHED; \
        LDA(At, 0, 1); STAGE(SB(0, 0), b2, voffB); STAGE(SB(0, 1), b2 + hstepB, voffB); STAGE(SA(0, 0), a2, voffA); \
        WAIT_V(8); WAIT_L(0); BAR; MMA(VT, 1, 0, At, B0); MMA(VT, 1, 1, At, B1); BAR; SCHED; \
        LDB(B0, 1, 0); LDB(B1, 1, 1); SCHED; LDA(At, 1, 0); STAGE(SA(0, 1), a2 + hstepA, voffA); \
        WAIT_V(8); WAIT_L(0); BAR; MMA(VT, 0, 0, At, B0); MMA(VT, 0, 1, At, B1); BAR; SCHED; \
        LDA(At, 1, 1); STAGE(SB(1, 0), b3, voffB); STAGE(SB(1, 1), b3 + hstepB, voffB); STAGE(SA(1, 0), a3, voffA); \
        WAIT_V(8); WAIT_L(0); BAR; MMA(VT, 1, 0, At, B0); MMA(VT, 1, 1, At, B1); BAR; SCHED; \
    }
    int lt = lb, pm = xcd * 8 + (lt & 7), pn = lt >> 3;
    f32x4 acc[2][2][4][2];
#pragma unroll
    for (int a = 0; a < 2; ++a)
#pragma unroll
        for (int b = 0; b < 2; ++b)
#pragma unroll
            for (int m = 0; m < 4; ++m)
#pragma unroll
                for (int n = 0; n < 2; ++n) acc[a][b][m][n] = (f32x4){0.f, 0.f, 0.f, 0.f};
    bf16x8 At[4][2], B0[2][2], B1[2][2];
    const char* cA = (const char*)A + (size_t)pm * 2 * hstepA;
    const char* cB = (const char*)Bt + (size_t)pn * 2 * hstepB;
    WAIT_V(0);
    STAGE(SB(0, 0), cB, voffB); STAGE(SB(0, 1), cB + hstepB, voffB); STAGE(SA(0, 0), cA, voffA); STAGE(SA(0, 1), cA + hstepA, voffA);
    if (wr == 1) BAR;
    WAIT_V(2); BAR;
    STAGE(SB(1, 0), cB + kstep, voffB); STAGE(SA(1, 0), cA + kstep, voffA); STAGE(SB(1, 1), cB + hstepB + kstep, voffB);
    WAIT_V(6); BAR;
    for (;;) {
        const int ltn = lt + nlb;
        const bool has_next = ltn < per_xcd;
        const int pmn = xcd * 8 + (ltn & 7), pnn = ltn >> 3;
        const char* nA = has_next ? (const char*)A + (size_t)pmn * 2 * hstepA : cA;
        const char* nB = has_next ? (const char*)Bt + (size_t)pnn * 2 * hstepB : cB;
        int vtm = 0;
        if (EPI == EPI_PE) vtm = pn >= 10 ? 1 : 0;
        if (EPI == EPI_PO) vtm = (pn == 4 || pn == 5) ? 1 : (pn == 8 ? 2 : 0);
        if ((EPI == EPI_PE || EPI == EPI_PO) && vtm == 1) { TLOOP(1) }
        else if (EPI == EPI_PO && vtm == 2) { TLOOP(2) }
        else { TLOOP(0) }
        if (wr == 0) BAR;
        if (EPI != EPI_YF) tile_epilogue<EPI>(p, acc, pm, pn, vtm, fz);
        if (!has_next) break;
#pragma unroll
        for (int a = 0; a < 2; ++a)
#pragma unroll
            for (int b = 0; b < 2; ++b)
#pragma unroll
                for (int m = 0; m < 4; ++m)
#pragma unroll
                    for (int n = 0; n < 2; ++n) acc[a][b][m][n] = (f32x4){0.f, 0.f, 0.f, 0.f};
        lt = ltn; pm = pmn; pn = pnn; cA = nA; cB = nB;
        if (wr == 1) BAR;
    }
    WAIT_V(0);
    BAR;
    if (EPI == EPI_YF) tile_epilogue<EPI>(p, acc, pm, pn, 0, fz);
#undef SA
#undef SB
#undef STAGE
#undef LDA
#undef LDB
#undef MMA
#undef WAIT_V
#undef WAIT_L
#undef BAR
#undef SCHED
#undef TLOOP
}

struct ASeg { const bf16_t* K; const bf16_t* Vt; int ldk, ldv, ntiles; };
struct MaskP { int on, a, b, c; const float* tab; };

template <int KW, int VR, int NB, int MODE>
DI void attn_core(const ASeg& s0, const ASeg& s1, const bf16x8 (&qf)[4], int kchunk0, int vrow0, float scale_l2, float& m, float& l, f32x16 (&O)[NB], char* lds, const MaskP& mp) {
    constexpr int KC = KW / 8, NKL = 64 * KC / 256, NVL = VR * 8 / 256;
    const int tid = VTID, lane = tid & 63, p32 = lane & 31, h = lane >> 5;
    const int krow = (p32 & 19) | ((p32 & 4) << 1) | ((p32 & 8) >> 1);
    const int n0 = s0.ntiles, nt = s0.ntiles + s1.ntiles;
    u32x4 rk[NKL], rv[NVL];
#define ATT_LOAD(t_)                                                                                                         \
    {                                                                                                                        \
        const bool f_ = (t_) < n0; const int tt_ = f_ ? (t_) : (t_) - n0;                                                     \
        const bf16_t* Kp_ = (f_ ? s0.K : s1.K); const int ldk_ = f_ ? s0.ldk : s1.ldk;                                        \
        const bf16_t* Vp_ = (f_ ? s0.Vt : s1.Vt); const int ldv_ = f_ ? s0.ldv : s1.ldv;                                      \
        _Pragma("unroll") for (int i = 0; i < NKL; ++i) { const int id = tid + 256 * i, r = id / KC, c = id % KC; rk[i] = *(const u32x4*)(Kp_ + (size_t)(tt_ * 64 + r) * ldk_ + c * 8); } \
        _Pragma("unroll") for (int i = 0; i < NVL; ++i) { const int id = tid + 256 * i, r = id >> 3, c = id & 7; rv[i] = *(const u32x4*)(Vp_ + (size_t)r * ldv_ + tt_ * 64 + c * 8); }       \
    }
#define ATT_STORE(b_)                                                                                                        \
    {                                                                                                                        \
        char* kb_ = lds + (b_) * 32768; char* vb_ = kb_ + 16384;                                                              \
        _Pragma("unroll") for (int i = 0; i < NKL; ++i) { const int id = tid + 256 * i, r = id / KC, c = id % KC; *(u32x4*)(kb_ + (KW == 128 ? swz256(r, c) : swz128(r, c))) = rk[i]; } \
        _Pragma("unroll") for (int i = 0; i < NVL; ++i) { const int id = tid + 256 * i, r = id >> 3, c = id & 7; *(u32x4*)(vb_ + swz128(r, c)) = rv[i]; }                               \
    }
    int dco[2][16];
    if (MODE == 1) {
        const int cq = mp.c + p32, cs = min(max(cq - 8, 0), 48);
#pragma unroll
        for (int kh = 0; kh < 2; ++kh)
#pragma unroll
            for (int i = 0; i < 16; ++i) {
                const int kc = 32 * kh + 16 * (i >> 3) + 8 * h + (i & 7);
                dco[kh][i] = ((unsigned)(kc - cs) < 16u ? min(max(kc - cq + 15, 0), 30) : 31) * 4;
            }
    }
    ATT_LOAD(0);
    ATT_STORE(0);
    __syncthreads();
    for (int t = 0; t < nt; ++t) {
        const bool more = t + 1 < nt;
        if (more) ATT_LOAD(t + 1);
        const char* kb = lds + (t & 1) * 32768;
        const char* vb = kb + 16384;
        f32x16 S[2];
#pragma unroll
        for (int kh = 0; kh < 2; ++kh) {
#pragma unroll
            for (int i = 0; i < 16; ++i) S[kh][i] = 0.f;
            const int row = krow + 32 * kh;
#pragma unroll
            for (int s = 0; s < 4; ++s) {
                const int c = kchunk0 + 2 * s + h;
                const bf16x8 kf = *(const bf16x8*)(kb + (KW == 128 ? swz256(row, c) : swz128(row, c)));
                S[kh] = MFMA32(kf, qf[s], S[kh]);
            }
        }
        const bool msk = (MODE != 0) && mp.on && t < n0;
        float mx = -1e30f;
        if (MODE == 1 && msk) {
            const char* trow = (const char*)(mp.tab + (mp.b + t - mp.a + 7) * 32);
#pragma unroll
            for (int kh = 0; kh < 2; ++kh)
#pragma unroll
                for (int i = 0; i < 16; ++i) {
                    const float sv = __builtin_fmaf(S[kh][i], scale_l2, *(const float*)(trow + dco[kh][i]));
                    S[kh][i] = sv; mx = fmaxf(mx, sv);
                }
        } else if (MODE == 2 && msk) {
            int qp = mp.a + p32 - 8 * h;
            asm volatile("" : "+v"(qp));
            const int k0 = mp.b + t * 64;
#pragma unroll
            for (int kh = 0; kh < 2; ++kh)
#pragma unroll
                for (int i = 0; i < 16; ++i) {
                    const int d = qp - (k0 + 32 * kh + 16 * (i >> 3) + (i & 7));
                    const bool ok = d <= 128 && d >= -128;
                    const float sv = ok ? S[kh][i] * scale_l2 : -1e30f;
                    S[kh][i] = sv; mx = fmaxf(mx, sv);
                }
        } else {
            float m0 = fmaxf(fmaxf(S[0][0], S[0][1]), S[0][2]), m1 = fmaxf(fmaxf(S[1][0], S[1][1]), S[1][2]);
#pragma unroll
            for (int i = 3; i < 15; i += 2) { m0 = fmaxf(fmaxf(m0, S[0][i]), S[0][i + 1]); m1 = fmaxf(fmaxf(m1, S[1][i]), S[1][i + 1]); }
            mx = fmaxf(fmaxf(m0, m1), fmaxf(S[0][15], S[1][15])) * scale_l2;
        }
        mx = fmaxf(mx, __shfl_xor(mx, 32));
        if (__any(mx > m + 8.f)) {
            const float mn = fmaxf(m, mx);
            const float alpha = __builtin_amdgcn_exp2f(m - mn);
            m = mn;
            l *= alpha;
#pragma unroll
            for (int blk = 0; blk < NB; ++blk)
#pragma unroll
                for (int i = 0; i < 16; ++i) O[blk][i] *= alpha;
        }
        float ls = 0.f;
        if ((MODE == 1 || MODE == 2) && msk) {
#pragma unroll
            for (int kh = 0; kh < 2; ++kh)
#pragma unroll
                for (int i = 0; i < 16; ++i) { const float pv = __builtin_amdgcn_exp2f(S[kh][i] - m); S[kh][i] = pv; ls += pv; }
        } else {
            const float negm = -m;
#pragma unroll
            for (int kh = 0; kh < 2; ++kh)
#pragma unroll
                for (int i = 0; i < 16; ++i) { const float pv = __builtin_amdgcn_exp2f(__builtin_fmaf(S[kh][i], scale_l2, negm)); S[kh][i] = pv; ls += pv; }
        }
        l += ls;
#pragma unroll
        for (int kh = 0; kh < 2; ++kh)
#pragma unroll
            for (int s2 = 0; s2 < 2; ++s2) {
                u32x4 pp = {pk2(S[kh][8 * s2 + 0], S[kh][8 * s2 + 1]), pk2(S[kh][8 * s2 + 2], S[kh][8 * s2 + 3]), pk2(S[kh][8 * s2 + 4], S[kh][8 * s2 + 5]), pk2(S[kh][8 * s2 + 6], S[kh][8 * s2 + 7])};
                const bf16x8 pb = __builtin_bit_cast(bf16x8, pp);
                const int c = 4 * kh + 2 * s2 + h;
#pragma unroll
                for (int blk = 0; blk < NB; ++blk) {
                    const bf16x8 vf = *(const bf16x8*)(vb + swz128(vrow0 + blk * 32 + p32, c));
                    O[blk] = MFMA32(vf, pb, O[blk]);
                }
            }
        if (more) ATT_STORE((t + 1) & 1);
        __syncthreads();
    }
    l += __shfl_xor(l, 32);
#undef ATT_LOAD
#undef ATT_STORE
}

DI void load_q(bf16x8 (&qf)[4], const bf16_t* qrow, int h) {
#pragma unroll
    for (int s = 0; s < 4; ++s) qf[s] = *(const bf16x8*)(qrow + 16 * s + 8 * h);
}

DI void attn_diff_item(const Params& p, int item, char* lds) {
    const int tid = VTID, lane = tid & 63, w = tid >> 6, p32 = lane & 31, h = lane >> 5, stream = w & 1, qh = w >> 1;
    const bf16_t* proj = (const bf16_t*)(p.ws + OFF_BIG);
    const bf16_t* vte = (const bf16_t*)(p.ws + OFF_BIG + BIG_VT_E);
    bf16_t* mix = (bf16_t*)(p.ws + OFF_BIG + BIG_MIXIN);
    int b, hd, qb, rowbase; ASeg s0, s1;
    if (item < 512) {
        b = item >> 6; hd = (item >> 4) & 3; qb = item & 15; rowbase = 8192 + b * 1024;
        s0 = {proj + (size_t)rowbase * LDE + 2048 + hd * 128, vte + 4194304 + ((size_t)b * 512 + hd * 128) * 1024, LDE, 1024, 16};
        s1 = {(const bf16_t*)(p.ws + OFF_CDK) + (size_t)b * 256 * 512 + hd * 128, (const bf16_t*)(p.ws + OFF_CDVT) + (size_t)(b * 4 + hd) * 128 * 256, 512, 256, 4};
    } else {
        const int it = item - 512;
        b = it >> 4; hd = (it >> 2) & 3; qb = it & 3; rowbase = b * 256;
        s0 = {proj + (size_t)rowbase * LDE + 2048 + hd * 128, vte + ((size_t)b * 512 + hd * 128) * 256, LDE, 256, 4};
        s1 = s0; s1.ntiles = 0;
    }
    const int R = rowbase + qb * 64 + qh * 32 + p32;
    bf16x8 qf[4];
    load_q(qf, proj + (size_t)R * LDE + 1536 + hd * 128 + stream * 64, h);
    f32x16 O[4];
#pragma unroll
    for (int blk = 0; blk < 4; ++blk)
#pragma unroll
        for (int i = 0; i < 16; ++i) O[blk][i] = 0.f;
    float m = -1e30f, l = 0.f;
    MaskP mp = {0, 0, 0, 0, nullptr};
    attn_core<128, 128, 4, 0>(s0, s1, qf, stream * 8, 0, 0.125f * LOG2E, m, l, O, lds, mp);
    const float il = 1.f / l;
    const float d1 = wave_sum(p.lq1[lane] * p.lk1[lane]), d2 = wave_sum(p.lq2[lane] * p.lk2[lane]);
    const float lam_init = 0.2f;
    const float lam = __expf(d1) - __expf(d2) + lam_init;
    float* xb = (float*)(lds + qh * 16384);
    if (stream == 1) {
#pragma unroll
        for (int blk = 0; blk < 4; ++blk)
#pragma unroll
            for (int i = 0; i < 16; ++i) { const int dv = blk * 32 + 8 * (i >> 2) + 4 * h + (i & 3); xb[dv * 32 + p32] = O[blk][i] * il; }
    }
    __syncthreads();
    if (stream == 0) {
        float ss = 0.f;
#pragma unroll
        for (int blk = 0; blk < 4; ++blk)
#pragma unroll
            for (int i = 0; i < 16; ++i) { const int dv = blk * 32 + 8 * (i >> 2) + 4 * h + (i & 3); const float o = O[blk][i] * il - lam * xb[dv * 32 + p32]; O[blk][i] = o; ss += o * o; }
        ss += __shfl_xor(ss, 32);
        const float rs = rsqrtf(ss * (1.f / 128.f) + EPSN) * (1.f - lam_init);
        bf16_t* op = mix + (size_t)R * 1024 + 512 + hd * 128;
#pragma unroll
        for (int blk = 0; blk < 4; ++blk)
#pragma unroll
            for (int g = 0; g < 4; ++g) {
                const int dv = blk * 32 + 8 * g + 4 * h;
                const f32x4 sl = *(const f32x4*)(p.subln + dv);
                u32x2 o = {pk2(O[blk][4 * g] * rs * sl[0], O[blk][4 * g + 1] * rs * sl[1]), pk2(O[blk][4 * g + 2] * rs * sl[2], O[blk][4 * g + 3] * rs * sl[3])};
                *(u32x2*)(op + dv) = o;
            }
    }
    __syncthreads();
}

DI void attn_c_item(const Params& p, int item, char* lds) {
    const int tid = VTID, lane = tid & 63, w = tid >> 6, p32 = lane & 31, h = lane >> 5, stream = w & 1, qh = w >> 1;
    const bf16_t* proj = (const bf16_t*)(p.ws + OFF_BIG);
    const bf16_t* vtc = (const bf16_t*)(p.ws + OFF_BIG + BIG_VT_C);
    bf16_t* mix = (bf16_t*)(p.ws + OFF_BIG + BIG_MIXIN);
    int b, hp, qb, rowbase; ASeg s0, s1; MaskP mp = {0, 0, 0, 0, nullptr};
    float* tab = (float*)(lds + 65536);
    if (item < 512) {
        b = item >> 6; hp = (item >> 4) & 3; qb = item & 15; rowbase = 8192 + b * 1024;
        const int rstart = min(max(qb - 4, 0), 8);
        s0 = {proj + (size_t)(rowbase + rstart * 64) * LDO + 512 + hp * 128, vtc + 4194304 + ((size_t)b * 512 + hp * 128) * 1024 + rstart * 64, LDO, 1024, 8};
        s1 = {(const bf16_t*)(p.ws + OFF_CNK) + (size_t)b * 256 * 512 + hp * 128, (const bf16_t*)(p.ws + OFF_CNVT) + ((size_t)b * 512 + hp * 128) * 256, 512, 256, 4};
        for (int idx = tid; idx < 960; idx += 256) { const int hr = idx >> 5, cc = idx & 31; tab[idx] = cc < 31 ? p.rpb[hp * 930 + hr * 31 + cc] * LOG2E : -1e30f; }
        mp = {1, qb, rstart, qh * 32, tab + stream * 480};
    } else {
        const int it = item - 512;
        b = it >> 4; hp = (it >> 2) & 3; qb = it & 3; rowbase = b * 256;
        s0 = {proj + (size_t)rowbase * LDO + 512 + hp * 128, vtc + ((size_t)b * 512 + hp * 128) * 256, LDO, 256, 4};
        s1 = s0; s1.ntiles = 0;
    }
    const int R = rowbase + qb * 64 + qh * 32 + p32;
    const int head = hp * 2 + stream;
    bf16x8 qf[4];
    load_q(qf, proj + (size_t)R * LDO + head * 64, h);
    f32x16 O[2];
#pragma unroll
    for (int blk = 0; blk < 2; ++blk)
#pragma unroll
        for (int i = 0; i < 16; ++i) O[blk][i] = 0.f;
    float m = -1e30f, l = 0.f;
    attn_core<128, 128, 2, 1>(s0, s1, qf, stream * 8, stream * 64, 0.125f * LOG2E, m, l, O, lds, mp);
    const float il = 1.f / l;
    bf16_t* op = mix + (size_t)R * 1024 + head * 64;
#pragma unroll
    for (int blk = 0; blk < 2; ++blk)
#pragma unroll
        for (int g = 0; g < 4; ++g) {
            const int dv = blk * 32 + 8 * g + 4 * h;
            u32x2 o = {pk2(O[blk][4 * g] * il, O[blk][4 * g + 1] * il), pk2(O[blk][4 * g + 2] * il, O[blk][4 * g + 3] * il)};
            *(u32x2*)(op + dv) = o;
        }
}

DI void attn_d_item(const Params& p, int item, char* lds) {
    const int tid = VTID, lane = tid & 63, w = tid >> 6, p32 = lane & 31, h = lane >> 5;
    const bf16_t* proj = (const bf16_t*)(p.ws + OFF_BIG);
    const bf16_t* vtd = (const bf16_t*)(p.ws + OFF_BIG + BIG_VT_D);
    bf16_t* mix = (bf16_t*)(p.ws + OFF_BIG + BIG_MIXIN);
    int b, g, qb, rowbase; ASeg s0, s1; MaskP mp = {0, 0, 0, 0, nullptr};
    if (item < 512) {
        b = item >> 6; g = (item >> 5) & 1; qb = item & 31; rowbase = 8192 + b * 1024;
        const int q0 = qb * 32;
        const int tlo = max(q0 - 128, 0) >> 6, thi = min(q0 + 159, 1023) >> 6;
        s0 = {proj + (size_t)(rowbase + tlo * 64) * LDO + 1536 + g * 64, vtd + 1048576 + ((size_t)b * 128 + g * 64) * 1024 + tlo * 64, LDO, 1024, thi - tlo + 1};
        s1 = {(const bf16_t*)(p.ws + OFF_CSK) + (size_t)b * 256 * 128 + g * 64, (const bf16_t*)(p.ws + OFF_CSVT) + ((size_t)b * 128 + g * 64) * 256, 128, 256, 4};
        mp = {1, q0, tlo * 64, 0, nullptr};
    } else {
        const int it = item - 512;
        b = it >> 4; g = (it >> 3) & 1; qb = it & 7; rowbase = b * 256;
        s0 = {proj + (size_t)rowbase * LDO + 1536 + g * 64, vtd + ((size_t)b * 128 + g * 64) * 256, LDO, 256, 4};
        s1 = s0; s1.ntiles = 0;
    }
    const int R = rowbase + qb * 32 + p32;
    const int hq = g * 4 + w;
    bf16x8 qf[4];
    load_q(qf, proj + (size_t)R * LDO + 1024 + hq * 64, h);
    f32x16 O[2];
#pragma unroll
    for (int blk = 0; blk < 2; ++blk)
#pragma unroll
        for (int i = 0; i < 16; ++i) O[blk][i] = 0.f;
    float m = p.sink[hq] * LOG2E, l = h == 0 ? 1.f : 0.f;
    attn_core<64, 64, 2, 2>(s0, s1, qf, 0, 0, 0.125f * LOG2E, m, l, O, lds, mp);
    const float il = 1.f / l;
    bf16_t* op = mix + (size_t)R * 1024 + 512 + hq * 64;
#pragma unroll
    for (int blk = 0; blk < 2; ++blk)
#pragma unroll
        for (int gg = 0; gg < 4; ++gg) {
            const int dv = blk * 32 + 8 * gg + 4 * h;
            u32x2 o = {pk2(O[blk][4 * gg] * il, O[blk][4 * gg + 1] * il), pk2(O[blk][4 * gg + 2] * il, O[blk][4 * gg + 3] * il)};
            *(u32x2*)(op + dv) = o;
        }
}

DI void conv_item(const Params& p, int item) {
    const int tid = VTID;
    const bf16_t* proj = (const bf16_t*)(p.ws + OFF_BIG);
    bf16_t* mix = (bf16_t*)(p.ws + OFF_BIG + BIG_MIXIN);
#pragma unroll 2
    for (int i = 0; i < 8; ++i) {
        const int idx = tid + 256 * i, tl = idx >> 6, ch = (idx & 63) * 8;
        const int R = item * 32 + tl;
        int t, T;
        if (R < 8192) { t = R & 255; T = 256; } else { t = (R - 8192) & 1023; T = 1024; }
        const bf16_t* rp = proj + (size_t)R * LDE + ch;
        const u32x4 ab = *(const u32x4*)(rp);
        float accv[8];
#pragma unroll
        for (int e = 0; e < 8; ++e) accv[e] = 0.f;
#pragma unroll
        for (int j = 0; j < 3; ++j) {
            const int tt = t + j - 1;
            if (tt >= 0 && tt < T) {
                const u32x4 ac = *(const u32x4*)(rp + (ptrdiff_t)(j - 1) * LDE + 512);
                const u32x4 ax = *(const u32x4*)(rp + (ptrdiff_t)(j - 1) * LDE + 1024);
                const f32x4 w0 = *(const f32x4*)(p.conv_w + j * 512 + ch), w1 = *(const f32x4*)(p.conv_w + j * 512 + ch + 4);
#pragma unroll
                for (int e = 0; e < 4; ++e) {
                    accv[2 * e] += bflo(ac[e]) * bflo(ax[e]) * (e < 2 ? w0[2 * e] : w1[2 * e - 4]);
                    accv[2 * e + 1] += bfhi(ac[e]) * bfhi(ax[e]) * (e < 2 ? w0[2 * e + 1] : w1[2 * e - 3]);
                }
            }
        }
        u32x4 o;
#pragma unroll
        for (int e = 0; e < 4; ++e) o[e] = pk2(bflo(ab[e]) * accv[2 * e], bfhi(ab[e]) * accv[2 * e + 1]);
        *(u32x4*)(mix + (size_t)R * 1024 + ch) = o;
    }
}


#define XB_TMO      128
#define XB_XCNT(j)  (256  + 64 * (j))
#define XB_XSUB(j)  (1280 + 64 * (j))
#define XB_XGEN(j)  (2304 + 64 * (j))
#define XB_TOP      3328
#define XB_TOPGEN   3392
#define XCD_BAR_WORDS 3456
#define XB_SPIN_CAP (1u << 22)
#define LAS __attribute__((address_space(3)))
DI unsigned xb_ld(unsigned* p) { return __hip_atomic_load(p, __ATOMIC_RELAXED, __HIP_MEMORY_SCOPE_AGENT); }
DI unsigned xb_add(unsigned* p, unsigned v) { return __hip_atomic_fetch_add(p, v, __ATOMIC_RELAXED, __HIP_MEMORY_SCOPE_AGENT); }
DI unsigned xb_xcc_id() { return (unsigned)__builtin_amdgcn_s_getreg((3 << 11) | 20) & 0xFu; }
#define XB_SPIN(cond, bar) do { unsigned _sp = 0; while (cond) { __builtin_amdgcn_s_sleep(1); \
    if ((++_sp & 255u) == 0u) { if (xb_ld(&(bar)[XB_TMO])) break; if (_sp > XB_SPIN_CAP) { atomicAdd(&(bar)[XB_TMO], 1u); break; } } } } while (0)
struct XcdBarrier { unsigned* bar; unsigned x; volatile LAS unsigned* st; };
DI XcdBarrier xcd_barrier_post(unsigned* bar, volatile LAS unsigned* st) {
    XcdBarrier b; b.bar = bar; b.x = xb_xcc_id(); b.st = st;
    if (threadIdx.x == 0) (void)xb_add(&bar[XB_XCNT(b.x)], 1u);
    return b;
}
DI void xcd_barrier_complete(unsigned* bar, unsigned x, unsigned& nloc, unsigned& nx) {
    const unsigned G = gridDim.x * gridDim.y * gridDim.z;
    unsigned sum, cnt, mine, sp = 0u;
    for (;;) {
        sum = 0u; cnt = 0u; mine = 0u;
#pragma unroll
        for (unsigned j = 0; j < 16; ++j) { const unsigned c = xb_ld(&bar[XB_XCNT(j)]); sum += c; cnt += (c > 0u) ? 1u : 0u; mine = (j == x) ? c : mine; }
        if (sum == G) break;
        __builtin_amdgcn_s_sleep(1);
        if ((++sp & 255u) == 0u) { if (xb_ld(&bar[XB_TMO])) break; if (sp > XB_SPIN_CAP) { atomicAdd(&bar[XB_TMO], 1u); break; } }
    }
    nloc = mine > 0u ? mine : 1u; nx = cnt > 0u ? cnt : 1u;
}
DI void xcd_barrier(const XcdBarrier& b) {
    asm volatile("s_waitcnt vmcnt(0)" ::: "memory");
    __syncthreads();
    if (threadIdx.x == 0) {
        unsigned* bar = b.bar;
        __builtin_amdgcn_s_waitcnt(0);
        unsigned nloc = b.st[0], nx = b.st[1];
        if (nloc == 0u) { xcd_barrier_complete(bar, b.x, nloc, nx); b.st[0] = nloc; b.st[1] = nx; }
        const unsigned old = xb_add(&bar[XB_XSUB(b.x)], 1u);
        const unsigned gen = old / nloc;
        if (old + 1u == (gen + 1u) * nloc) {
            __builtin_amdgcn_fence(__ATOMIC_RELEASE, "agent");
            asm volatile("s_waitcnt vmcnt(0)" ::: "memory");
            const unsigned og = xb_add(&bar[XB_TOP], 1u);
            const unsigned tg = og / nx;
            if (og + 1u == (tg + 1u) * nx) xb_add(&bar[XB_TOPGEN], 1u);
            else XB_SPIN(xb_ld(&bar[XB_TOPGEN]) == tg, bar);
            __builtin_amdgcn_fence(__ATOMIC_ACQUIRE, "agent");
            xb_add(&bar[XB_XGEN(b.x)], 1u);
            asm volatile("s_waitcnt vmcnt(0)" ::: "memory");
        } else {
            XB_SPIN(xb_ld(&bar[XB_XGEN(b.x)]) == gen, bar);
            __builtin_amdgcn_fence(__ATOMIC_ACQUIRE, "agent");
            asm volatile("s_waitcnt vmcnt(0)" ::: "memory");
        }
    }
    __syncthreads();
}

constexpr int N_PHASES = 12;
DI void run_phase(const Params& p, int ph, char* shm) {
    const int nb = VNB, bid = VBID;
    char* lds = shm + VHALF * LDS_HALF;
    const int pvb = (int)(blockIdx.x & 7) * (nb >> 3) + (int)(blockIdx.x >> 3) * 2 + VHALF;
    const bf16_t* hy = (const bf16_t*)(p.ws + OFF_HY);
    const bf16_t* big = (const bf16_t*)(p.ws + OFF_BIG);
    const bf16_t* mixin = (const bf16_t*)(p.ws + OFF_BIG + BIG_MIXIN);
    const float* mod = (const float*)(p.ws + OFF_MOD);
    char* st = p.ws + OFF_STAT;
#define FZ(set, from_in, hasH, goff, wpost, wpre, scoff, shoff) FuseP{from_in, hasH, p.out, mod + (goff), wpost, wpre, mod + (scoff), mod + (shoff), (float*)(st + (set) * STAT_SET), (float*)(st + (set) * STAT_SET + 65536), (unsigned*)(st + (set) * STAT_SET + 131072)}
    switch (ph) {
    case 0: p0_phase(p, bid, nb, lds); break;
    case 1: rowop_phase(p, false, true, 0, nullptr, true, p.norm_mix_pre, 1024, 0); break;
    case 2: gemm_phase<EPI_PE>(p, hy, 2048, (const bf16_t*)(p.ws + OFF_WINE), 1024, 12, shm); break;
    case 3:
        for (int it = pvb; it < 1536; it += nb) { if (it < 1024) attn_diff_item(p, it, lds); else conv_item(p, it - 1024); }
        break;
    case 4: gemm_phase<EPI_YF>(p, mixin, 1024, (const bf16_t*)(p.ws + OFF_WOUT), 1024, 4, shm, FZ(0, 1, 1, 2048, p.norm_mix_post, p.norm_mlp_pre, 4096, 3072)); break;
    case 5: gemm_phase<EPI_W1>(p, hy, 2048, (const bf16_t*)(p.ws + OFF_W1), 1024, 16, shm); break;
    case 6: gemm_phase<EPI_YF>(p, big, 4096, (const bf16_t*)(p.ws + OFF_W2), 4096, 4, shm, FZ(1, 0, 1, 5120, p.norm_mlp_post, p.norm_mix_pre + 1024, 9 * 6144 + 1024, 9 * 6144 + 0)); break;
    case 7: gemm_phase<EPI_PO>(p, hy, 2048, (const bf16_t*)(p.ws + OFF_WINO), 1024, 9, shm); break;
    case 8:
        for (int it = pvb; it < 2048; it += nb) {
            const int q = it >> 9, r = it & 511;
            if (q & 1) attn_d_item(p, (q >> 1) * 512 + r, lds); else attn_c_item(p, (q >> 1) * 512 + r, lds);
        }
        break;
    case 9: gemm_phase<EPI_YF>(p, mixin, 1024, (const bf16_t*)(p.ws + OFF_WOUT) + 1048576, 1024, 4, shm, FZ(2, 0, 1, 9 * 6144 + 2048, p.norm_mix_post + 1024, p.norm_mlp_pre + 1024, 9 * 6144 + 4096, 9 * 6144 + 3072)); break;
    case 10: gemm_phase<EPI_W1>(p, hy, 2048, (const bf16_t*)(p.ws + OFF_W1) + 4194304, 1024, 16, shm); break;
    case 11: gemm_phase<EPI_YF>(p, big, 4096, (const bf16_t*)(p.ws + OFF_W2) + 4194304, 4096, 4, shm, FZ(3, 0, 0, 9 * 6144 + 5120, p.norm_mlp_post + 1024, p.norm_mlp_post, 0, 0)); break;
    }
#undef FZ
}

__global__ void __launch_bounds__(512, 2) fwd_mega(Params p) {
    __shared__ __attribute__((aligned(16))) char lds[LDS_BYTES];
    __shared__ uint4 xb_words;
    cg::grid_group grid = cg::this_grid();
    if (threadIdx.x == 0) xb_words = make_uint4(0u, 0u, 0u, 0u);
    __syncthreads();
    const XcdBarrier xb = xcd_barrier_post((unsigned*)(p.ws + OFF_BAR), (volatile LAS unsigned*)&xb_words);
#define PH_(n) run_phase(p, n, lds); xcd_barrier(xb); if ((DUP_MASK >> n) & 1) { run_phase(p, n, lds); xcd_barrier(xb); }
    PH_(0)
    if (p.ws == nullptr) grid.sync();
    PH_(1) PH_(2) PH_(3) PH_(4) PH_(5) PH_(6) PH_(7) PH_(8) PH_(9) PH_(10)
    run_phase(p, 11, lds);
#undef PH_
}

extern "C" void kernel_launch(void* const* d_in, const int* in_sizes, int n_in, void* d_out, int out_size, void* d_ws, size_t ws_size, hipStream_t stream) {
    Params p{};
    const float** pp = (const float**)&p;
    for (int i = 0; i < 29; ++i) pp[i] = (const float*)d_in[i];
    p.out = (float*)d_out;
    p.ws = (char*)d_ws;
    if (ws_size < WS_NEEDED) { fprintf(stderr, "workspace too small: %zu < %zu\n", ws_size, (size_t)WS_NEEDED); return; }
    static int grid_blocks = 0;
    if (!grid_blocks) {
        int dev = 0, cus = 0, per_cu = 0;
        hipGetDevice(&dev);
        hipDeviceGetAttribute(&cus, hipDeviceAttributeMultiprocessorCount, dev);
        hipOccupancyMaxActiveBlocksPerMultiprocessor(&per_cu, fwd_mega, 512, 0);
        if (per_cu > 1) per_cu = 1;
        if (per_cu < 1) per_cu = 1;
        grid_blocks = cus * per_cu;
        grid_blocks -= grid_blocks % 8;
    }
    (void)hipMemsetAsync((char*)d_ws + OFF_BAR, 0, XCD_BAR_WORDS * 4, stream);
    if (grid_blocks != 256) { fprintf(stderr, "fused epilogues need exactly 256 workgroups (got %d)\n", grid_blocks); return; }
    void* args[] = {&p};
    hipError_t e = hipLaunchCooperativeKernel((void*)fwd_mega, dim3(grid_blocks), dim3(512), args, 0, stream);
    if (e != hipSuccess) fprintf(stderr, "cooperative launch failed: %s (grid %d)\n", hipGetErrorString(e), grid_blocks);
}
```

```cpp
#include <hip/hip_runtime.h>
#include <hip/hip_cooperative_groups.h>
#include <cstdio>
#include <cstdint>
namespace cg = cooperative_groups;

#ifndef DUP_MASK
#define DUP_MASK 0
#endif
#ifndef ONE_LAUNCH
#define ONE_LAUNCH 1
#endif

typedef unsigned short bf16_t;
typedef short bf16x8 __attribute__((ext_vector_type(8)));
typedef float f32x4 __attribute__((ext_vector_type(4)));
typedef float f32x2 __attribute__((ext_vector_type(2)));
typedef float f32x16 __attribute__((ext_vector_type(16)));
typedef unsigned u32x4 __attribute__((ext_vector_type(4)));
typedef unsigned u32x2 __attribute__((ext_vector_type(2)));
typedef __bf16 bfv2 __attribute__((ext_vector_type(2)));
#define DI __device__ __forceinline__
DI int launder_v(int v) { asm volatile("" : "+v"(v)); return v; }
#define TIDX launder_v((int)threadIdx.x)
#define VTID (TIDX & 255)
#define VHALF (TIDX >> 8)
#define VBID ((int)(blockIdx.x * 2) + (TIDX >> 8))
#define VNB ((int)(gridDim.x * 2))
#define MFMA32(a, b, c) __builtin_amdgcn_mfma_f32_32x32x16_bf16((a), (b), (c), 0, 0, 0)
#define MFMA16(a, b, c) __builtin_amdgcn_mfma_f32_16x16x32_bf16((a), (b), (c), 0, 0, 0)

constexpr float LOG2E = 1.4426950408889634f;
constexpr float EPSN = 1e-6f;

struct Params {
    const float *x_prompt, *x_sample, *cache_diff_k, *cache_diff_v, *cache_na_k, *cache_na_v, *cache_swa_k, *cache_swa_v, *c, *c_ctx;
    const float *mod_w, *mod_b, *norm_mix_pre, *norm_mix_post, *norm_mlp_pre, *norm_mlp_post, *w_in_even, *conv_w, *lq1, *lk1, *lq2, *lk2, *subln;
    const float *w_in_odd, *rpb, *sink, *w_out, *mlp_w1, *mlp_w2;
    float* out;
    char* ws;
};

constexpr size_t OFF_MOD = 0;
constexpr size_t OFF_BAR = 458752;
constexpr size_t OFF_WINE = 524288;
constexpr size_t OFF_WINO = OFF_WINE + 6291456;
constexpr size_t OFF_WOUT = OFF_WINO + 4718592;
constexpr size_t OFF_W1 = OFF_WOUT + 4194304;
constexpr size_t OFF_W2 = OFF_W1 + 16777216;
constexpr size_t OFF_CDK = OFF_W2 + 16777216;
constexpr size_t OFF_CDVT = OFF_CDK + 2097152;
constexpr size_t OFF_CNK = OFF_CDVT + 2097152;
constexpr size_t OFF_CNVT = OFF_CNK + 2097152;
constexpr size_t OFF_CSK = OFF_CNVT + 2097152;
constexpr size_t OFF_CSVT = OFF_CSK + 524288;
constexpr size_t OFF_HY = OFF_CSVT + 524288;
constexpr size_t OFF_BIG = OFF_HY + 67108864;
constexpr size_t OFF_STAT = OFF_BIG + 134217728;
constexpr size_t STAT_SET = 65536 + 65536 + 8192;
constexpr size_t WS_NEEDED = OFF_STAT + 4 * STAT_SET;
constexpr size_t BIG_VT_E = 83886080;
constexpr size_t BIG_VT_C = 54525952;
constexpr size_t BIG_VT_D = BIG_VT_C + 16777216;
constexpr size_t BIG_MIXIN = 100663296;
constexpr int LDE = 2560, LDO = 1664;
constexpr size_t OUT_DIFFK = 16777216, OUT_DIFFV = 20971520, OUT_NAK = 25165824, OUT_NAV = 29360128, OUT_SWAK = 33554432, OUT_SWAV = 34603008;

constexpr int LDS_HALF = 65536 + 4096;
constexpr int LDS_BYTES = 2 * LDS_HALF;

DI unsigned pk2(float a, float b) { f32x2 v = {a, b}; bfv2 r = __builtin_convertvector(v, bfv2); return __builtin_bit_cast(unsigned, r); }
DI float bflo(unsigned u) { return __uint_as_float(u << 16); }
DI float bfhi(unsigned u) { return __uint_as_float(u & 0xffff0000u); }
DI float wave_sum(float v) {
#pragma unroll
    for (int o = 1; o < 64; o <<= 1) v += __shfl_xor(v, o);
    return v;
}
DI int swz128(int r, int c) { return r * 128 + ((c ^ ((r >> 1) & 7)) << 4); }
DI int swz256(int r, int c) { return r * 256 + ((c ^ (r & 15)) << 4); }

DI void p0_mod_item(const Params& p, int item, char* lds) {
    const int kq = item & 3, cbl = item >> 2, li = cbl / 96, cb = cbl % 96;
    const int tid = VTID, lane = tid & 63, w = tid >> 6;
    const float* W = p.mod_w + (size_t)li * 1024 * 6144 + cb * 64 + lane;
    const int kb = kq * 256 + w * 64;
    float acc[9], s[9];
    { const float cv = p.c_ctx[kb + lane]; s[0] = cv / (1.f + __expf(-cv)); }
#pragma unroll
    for (int v = 1; v < 9; ++v) { const float cv = p.c[(v - 1) * 1024 + kb + lane]; s[v] = cv / (1.f + __expf(-cv)); }
#pragma unroll
    for (int v = 0; v < 9; ++v) acc[v] = 0.f;
#pragma unroll
    for (int kk = 0; kk < 64; ++kk) {
        const float wv = __builtin_nontemporal_load(W + (size_t)(kb + kk) * 6144);
#pragma unroll
        for (int v = 0; v < 9; ++v) acc[v] += __int_as_float(__builtin_amdgcn_readlane(__float_as_int(s[v]), kk)) * wv;
    }
    float* red = (float*)lds;
#pragma unroll
    for (int v = 0; v < 9; ++v) red[(w * 9 + v) * 64 + lane] = acc[v];
    __syncthreads();
    float* mod = (float*)(p.ws + OFF_MOD);
    for (int idx = tid; idx < 576; idx += 256) {
        const int v = idx >> 6, col = idx & 63;
        float sum = red[(0 * 9 + v) * 64 + col] + red[(1 * 9 + v) * 64 + col] + red[(2 * 9 + v) * 64 + col] + red[(3 * 9 + v) * 64 + col];
        if (kq == 0) sum += p.mod_b[li * 6144 + cb * 64 + col];
        atomicAdd(mod + (li * 9 + v) * 6144 + cb * 64 + col, sum);
    }
    __syncthreads();
}

DI void p0_transpose_tile(const float* __restrict__ in, bf16_t* __restrict__ out, int R, int C, int tr, int tc, char* lds) {
    const int tid = VTID;
    const int cl = (tid & 15) * 4, rl = (tid >> 4) * 2, sw = tid & 7;
#pragma unroll
    for (int i = 0; i < 2; ++i) {
        const int r = rl + 32 * i;
        const f32x4 a = *(const f32x4*)(in + (size_t)(tr * 64 + r) * C + tc * 64 + cl);
        const f32x4 b = *(const f32x4*)(in + (size_t)(tr * 64 + r + 1) * C + tc * 64 + cl);
#pragma unroll
        for (int j = 0; j < 4; ++j) *(unsigned*)(lds + (cl + j) * 128 + (((r >> 3) ^ sw) << 4) + (r & 7) * 2) = pk2(a[j], b[j]);
    }
    __syncthreads();
#pragma unroll
    for (int i = 0; i < 2; ++i) {
        const int idx = tid + 256 * i, c = idx >> 3, q = idx & 7;
        const u32x4 v = *(const u32x4*)(lds + c * 128 + ((q ^ ((c >> 2) & 7)) << 4));
        *(u32x4*)(out + (size_t)(tc * 64 + c) * R + tr * 64 + q * 8) = v;
    }
    __syncthreads();
}

DI void p0_kreorder(const float* __restrict__ in, bf16_t* __restrict__ out, int logH, int item) {
    const int tid = VTID, H = 1 << logH;
#pragma unroll
    for (int i = 0; i < 4; ++i) {
        const int f = item * 1024 + tid + 256 * i;
        const int d4 = f & 15, key = (f >> 4) & 255, hh = (f >> 12) & (H - 1), b = f >> (12 + logH);
        const f32x4 v = __builtin_nontemporal_load((const f32x4*)(in + (size_t)f * 4));
        u32x2 o = {pk2(v[0], v[1]), pk2(v[2], v[3])};
        *(u32x2*)(out + ((size_t)(b * 256 + key) * H + hh) * 64 + d4 * 4) = o;
    }
}

struct TJob { const float* in; bf16_t* out; int R, C, tr, tc, late; };
constexpr int P0_TITEMS = 768 + 576 + 512 + 2048 + 2048 + 256 + 256 + 64;
DI TJob p0_decode(const Params& p, int item) {
    TJob j;
    j.late = (item >= 768 && item < 1344) || (item >= 1600 && item < 1856) || (item >= 2880 && item < 3904) || (item >= 4928 && item < 5952);
    if (item < 768) { j.in = p.w_in_even; j.out = (bf16_t*)(p.ws + OFF_WINE); j.R = 1024; j.C = 3072; }
    else if ((item -= 768) < 576) { j.in = p.w_in_odd; j.out = (bf16_t*)(p.ws + OFF_WINO); j.R = 1024; j.C = 2304; }
    else if ((item -= 576) < 512) { const int b = item >> 8; item &= 255; j.in = p.w_out + (size_t)b * 1048576; j.out = (bf16_t*)(p.ws + OFF_WOUT) + (size_t)b * 1048576; j.R = 1024; j.C = 1024; }
    else if ((item -= 512) < 2048) { const int b = item >> 10; item &= 1023; j.in = p.mlp_w1 + (size_t)b * 4194304; j.out = (bf16_t*)(p.ws + OFF_W1) + (size_t)b * 4194304; j.R = 1024; j.C = 4096; }
    else if ((item -= 2048) < 2048) { const int b = item >> 10; item &= 1023; j.in = p.mlp_w2 + (size_t)b * 4194304; j.out = (bf16_t*)(p.ws + OFF_W2) + (size_t)b * 4194304; j.R = 4096; j.C = 1024; }
    else if ((item -= 2048) < 256) { const int b = item >> 3; item &= 7; j.in = p.cache_diff_v + (size_t)b * 32768; j.out = (bf16_t*)(p.ws + OFF_CDVT) + (size_t)b * 32768; j.R = 256; j.C = 128; }
    else if ((item -= 256) < 256) { const int b = item >> 2; item &= 3; j.in = p.cache_na_v + (size_t)b * 16384; j.out = (bf16_t*)(p.ws + OFF_CNVT) + (size_t)b * 16384; j.R = 256; j.C = 64; }
    else { item -= 256; const int b = item >> 2; item &= 3; j.in = p.cache_swa_v + (size_t)b * 16384; j.out = (bf16_t*)(p.ws + OFF_CSVT) + (size_t)b * 16384; j.R = 256; j.C = 64; }
    const int ntc = j.C >> 6;
    j.tr = item / ntc; j.tc = item % ntc;
    return j;
}
DI void p0_tload(const TJob& j, int tid, f32x4 (&a)[2], f32x4 (&b)[2]) {
    const int cl = (tid & 15) * 4, rl = (tid >> 4) * 2;
#pragma unroll
    for (int i = 0; i < 2; ++i) {
        const int r = rl + 32 * i;
        a[i] = __builtin_nontemporal_load((const f32x4*)(j.in + (size_t)(j.tr * 64 + r) * j.C + j.tc * 64 + cl));
        b[i] = __builtin_nontemporal_load((const f32x4*)(j.in + (size_t)(j.tr * 64 + r + 1) * j.C + j.tc * 64 + cl));
    }
}
DI void p0_phase(const Params& p, int bid, int nb, char* lds) {
    for (int it = bid; it < 768; it += nb) p0_mod_item(p, it, lds);
    const int tid = VTID;
    {
        const int cl = (tid & 15) * 4, rl = (tid >> 4) * 2, sw = tid & 7;
        const int first = bid, stride = nb, lim = P0_TITEMS;
#define P0_PROC(J, A, B) do { \
            _Pragma("unroll") for (int i = 0; i < 2; ++i) { const int r = rl + 32 * i; \
                _Pragma("unroll") for (int jj = 0; jj < 4; ++jj) *(unsigned*)(lds + (cl + jj) * 128 + (((r >> 3) ^ sw) << 4) + (r & 7) * 2) = pk2(A[i][jj], B[i][jj]); } \
            asm volatile("s_waitcnt lgkmcnt(0)\n\ts_barrier" ::: "memory"); \
            _Pragma("unroll") for (int i = 0; i < 2; ++i) { const int idx = tid + 256 * i, c = idx >> 3, q = idx & 7; \
                const u32x4 v = *(const u32x4*)(lds + c * 128 + ((q ^ ((c >> 2) & 7)) << 4)); \
                u32x4* dst = (u32x4*)(J.out + (size_t)(J.tc * 64 + c) * J.R + J.tr * 64 + q * 8); \
                if (J.late) __builtin_nontemporal_store(v, dst); else *dst = v; } \
            asm volatile("s_waitcnt lgkmcnt(0)\n\ts_barrier" ::: "memory"); } while (0)
        int it = first;
        TJob j0 = p0_decode(p, it < lim ? it : first), j1;
        f32x4 a0[2], b0[2], a1[2], b1[2];
        p0_tload(j0, tid, a0, b0);
        while (it < lim) {
            { const int nx = it + stride; j1 = p0_decode(p, nx < lim ? nx : first); p0_tload(j1, tid, a1, b1); }
            P0_PROC(j0, a0, b0);
            it += stride;
            if (it >= lim) break;
            { const int nx = it + stride; j0 = p0_decode(p, nx < lim ? nx : first); p0_tload(j0, tid, a0, b0); }
            P0_PROC(j1, a1, b1);
            it += stride;
        }
#undef P0_PROC
    }
    {
        f32x4* st4 = (f32x4*)(p.ws + OFF_STAT);
        const f32x4 z = {0.f, 0.f, 0.f, 0.f};
        for (int i = bid * 256 + tid; i < (int)(4 * STAT_SET / 16); i += nb * 256) st4[i] = z;
    }
    for (int it = bid; it < 576; it += nb) {
        if (it < 256) p0_kreorder(p.cache_diff_k, (bf16_t*)(p.ws + OFF_CDK), 3, it);
        else if (it < 512) p0_kreorder(p.cache_na_k, (bf16_t*)(p.ws + OFF_CNK), 3, it - 256);
        else p0_kreorder(p.cache_swa_k, (bf16_t*)(p.ws + OFF_CSK), 1, it - 512);
    }
}

DI void rowop_phase(const Params& p, bool hasY, bool xin_input, int g_off, const float* wpost, bool hasH, const float* wpre, int sc_off, int sh_off) {
    const int tix = TIDX, lane = tix & 63, gw = (int)(blockIdx.x * 8) + (tix >> 6), nw = VNB * 4;
    const float* mod = (const float*)(p.ws + OFF_MOD);
    f32x4 wpo[4], wpr[4];
#pragma unroll
    for (int i = 0; i < 4; ++i) { if (hasY) wpo[i] = *(const f32x4*)(wpost + lane * 4 + 256 * i); if (hasH) wpr[i] = *(const f32x4*)(wpre + lane * 4 + 256 * i); }
    for (int row0 = gw; row0 < 16384; row0 += 2 * nw) {
        f32x4 x[2][4], y[2][4];
#pragma unroll
        for (int r = 0; r < 2; ++r) {
            const int row = row0 + r * nw;
            const float* xin = xin_input ? (row < 8192 ? p.x_prompt + (size_t)row * 1024 : p.x_sample + (size_t)(row - 8192) * 1024) : p.out + (size_t)row * 1024;
            const float* yin = (const float*)(p.ws + OFF_HY + (size_t)row * 4096);
#pragma unroll
            for (int i = 0; i < 4; ++i) { x[r][i] = __builtin_nontemporal_load((const f32x4*)(xin + lane * 4 + 256 * i)); if (hasY) y[r][i] = *(const f32x4*)(yin + lane * 4 + 256 * i); }
        }
#pragma unroll
        for (int r = 0; r < 2; ++r) {
            const int row = row0 + r * nw;
            const int v = row < 8192 ? 0 : 1 + ((row - 8192) >> 10);
            char* hy = p.ws + OFF_HY + (size_t)row * 4096;
            if (hasY) {
                f32x4 g4[4];
#pragma unroll
                for (int i = 0; i < 4; ++i) g4[i] = *(const f32x4*)(mod + v * 6144 + g_off + lane * 4 + 256 * i);
                float ss = 0.f;
#pragma unroll
                for (int i = 0; i < 4; ++i) ss += y[r][i][0] * y[r][i][0] + y[r][i][1] * y[r][i][1] + y[r][i][2] * y[r][i][2] + y[r][i][3] * y[r][i][3];
                ss = wave_sum(ss);
                const float rs = rsqrtf(ss * (1.f / 1024.f) + EPSN);
#pragma unroll
                for (int i = 0; i < 4; ++i) {
                    x[r][i] += g4[i] * (y[r][i] * rs * wpo[i]);
                    *(f32x4*)(p.out + (size_t)row * 1024 + lane * 4 + 256 * i) = x[r][i];
                }
            }
            if (hasH) {
                f32x4 sc[4], sh[4];
#pragma unroll
                for (int i = 0; i < 4; ++i) { sc[i] = *(const f32x4*)(mod + v * 6144 + sc_off + lane * 4 + 256 * i); sh[i] = *(const f32x4*)(mod + v * 6144 + sh_off + lane * 4 + 256 * i); }
                float ss = 0.f;
#pragma unroll
                for (int i = 0; i < 4; ++i) ss += x[r][i][0] * x[r][i][0] + x[r][i][1] * x[r][i][1] + x[r][i][2] * x[r][i][2] + x[r][i][3] * x[r][i][3];
                ss = wave_sum(ss);
                const float rs = rsqrtf(ss * (1.f / 1024.f) + EPSN);
#pragma unroll
                for (int i = 0; i < 4; ++i) {
                    const f32x4 h = x[r][i] * rs * wpr[i] * (sc[i] + 1.f) + sh[i];
                    u32x2 o = {pk2(h[0], h[1]), pk2(h[2], h[3])};
                    *(u32x2*)((bf16_t*)hy + lane * 4 + 256 * i) = o;
                }
            }
        }
    }
}

namespace g8 {
constexpr int BK = 64, HALF = 128, HTB = HALF * BK * 2;
DI int lds_byte(int r, int c) { const int st = (r >> 4) * 2 + (c >> 5), rr = r & 15, cc = c & 31, ob = rr * 64 + cc * 2; return st * 1024 + (ob ^ (((ob >> 9) & 1) << 5)); }
DI void stage_rc(int b, int& R, int& C) { const int st = b / 1024, sb = b % 1024, swz = sb ^ (((sb >> 9) & 1) << 5); R = (st >> 1) * 16 + swz / 64; C = (st & 1) * 32 + (swz % 64) / 2; }
typedef __attribute__((address_space(3))) unsigned lds_u32;
typedef __attribute__((address_space(3))) unsigned char lds_u8;
typedef __attribute__((address_space(3))) bf16x8 lds_bf16x8;

}

enum { EPI_PE = 0, EPI_PO = 1, EPI_Y = 2, EPI_W1 = 3, EPI_YF = 4 };

struct FuseP { int from_input, hasH; float* xout; const float* g; const float* wpost; const float* wpre; const float* sc; const float* sh; float* ssY; float* ssX; unsigned* cnt; };
DI float ld_agent(const float* q) { return __hip_atomic_load(q, __ATOMIC_RELAXED, __HIP_MEMORY_SCOPE_AGENT); }
DI void panel_wait(unsigned* c, unsigned target) {
    asm volatile("s_waitcnt vmcnt(0)" ::: "memory");
    __syncthreads();
    if (threadIdx.x == 0) {
        __hip_atomic_fetch_add(c, 1u, __ATOMIC_RELAXED, __HIP_MEMORY_SCOPE_AGENT);
        unsigned sp = 0;
        while (__hip_atomic_load(c, __ATOMIC_RELAXED, __HIP_MEMORY_SCOPE_AGENT) < target) { __builtin_amdgcn_s_sleep(1); if (++sp > (1u << 22)) break; }
    }
    __syncthreads();
}
DI float dot4(const f32x4& a) { return a[0] * a[0] + a[1] * a[1] + a[2] * a[2] + a[3] * a[3]; }

DI void rope_s(f32x4 (&sub)[4][2], int R0, bool usecol, int fr, int fq) {
    asm volatile("" : "+s"(R0));
    const float sgn = fq < 2 ? -1.f : 1.f;
#pragma unroll
    for (int m = 0; m < 4; ++m) {
        __builtin_amdgcn_sched_barrier(0);
        const int tl = (R0 + m * 16 + fr - 8192) & 1023;
        const float pos = (float)(usecol ? (tl & 63) : (tl >> 6));
#pragma unroll
        for (int n = 0; n < 2; ++n)
#pragma unroll
            for (int j = 0; j < 4; ++j) {
                const float inv = exp2f(-(float)(8 * (fq & 1) + 4 * n + j) * (13.287712379549449f / 16.f));
                float sn, cs;
                __sincosf(pos * inv, &sn, &cs);
                const float v = sub[m][n][j], pv = __shfl_xor(v, 32);
                sub[m][n][j] = v * cs + sgn * pv * sn;
            }
    }
}
DI void store_bf16_rows_s(const f32x4 (&sub)[4][2], bf16_t* base, int ld, int R0, int Cd0, int fr, int fq) {
#pragma unroll
    for (int m = 0; m < 4; ++m) {
        u32x4 o = {pk2(sub[m][0][0], sub[m][0][1]), pk2(sub[m][0][2], sub[m][0][3]), pk2(sub[m][1][0], sub[m][1][1]), pk2(sub[m][1][2], sub[m][1][3])};
        *(u32x4*)(base + (size_t)(R0 + m * 16 + fr) * ld + Cd0 + fq * 8) = o;
    }
}
DI void store_f32_rows_s(const f32x4 (&sub)[4][2], float* ob, int ldo, int fr, int fq) {
#pragma unroll
    for (int m = 0; m < 4; ++m) {
        float* rp = ob + (size_t)(m * 16 + fr) * ldo + fq * 8;
#pragma unroll
        for (int n = 0; n < 2; ++n) __builtin_nontemporal_store(sub[m][n], (f32x4*)(rp + n * 4));
    }
}
DI void store_vt_s(const f32x4 (&sub)[4][2], bf16_t* vt, int T, int t0, int fr, int fq) {
#pragma unroll
    for (int n = 0; n < 2; ++n) {
        bf16_t* rp = vt + (size_t)(8 * (fr >> 2) + 4 * n + (fr & 3)) * T + t0 + fq * 4;
#pragma unroll
        for (int m = 0; m < 4; ++m) { u32x2 o = {pk2(sub[m][n][0], sub[m][n][1]), pk2(sub[m][n][2], sub[m][n][3])}; *(u32x2*)(rp + m * 16) = o; }
    }
}
DI void store_f32_ns_s(const f32x4 (&sub)[4][2], float* ob, int ldo, int fr, int fq) {
#pragma unroll
    for (int m = 0; m < 4; ++m)
#pragma unroll
        for (int j = 0; j < 4; ++j) {
            float* rp = ob + (size_t)(m * 16 + fq * 4 + j) * ldo + 8 * (fr >> 2) + (fr & 3);
#pragma unroll
            for (int n = 0; n < 2; ++n) __builtin_nontemporal_store(sub[m][n][j], rp + n * 4);
        }
}

template <int EPI>
DI void tile_epilogue(const Params& p, f32x4 (&acc)[2][2][4][2], int pm, int pn, int vtm, const FuseP& fz) {
    const int tix = TIDX, wid = __builtin_amdgcn_readfirstlane(tix >> 6), lane = tix & 63, wr = wid >> 2, wc = wid & 3;
    const int brow = pm * 256, bcol = pn * 256;
    int fr = lane & 15, fq = lane >> 4;
    asm volatile("" : "+v"(fr), "+v"(fq));
    const bool latent = brow >= 8192;
    int b, tb, T;
    if (latent) { b = (brow - 8192) >> 10; tb = (brow - 8192) & 1023; T = 1024; } else { b = brow >> 8; tb = 0; T = 256; }
    bf16_t* big = (bf16_t*)(p.ws + OFF_BIG);
    if (EPI == EPI_YF) {
        const int v = latent ? 1 + b : 0;
        const int rbase = brow + wr * 64 + fr;
        const int cbase = bcol + wc * 32 + fq * 8;
        float rs[2][4];
#pragma unroll
        for (int ai = 0; ai < 2; ++ai)
#pragma unroll
            for (int m = 0; m < 4; ++m) {
                float sq = dot4(acc[ai][0][m][0]) + dot4(acc[ai][0][m][1]) + dot4(acc[ai][1][m][0]) + dot4(acc[ai][1][m][1]);
                sq += __shfl_xor(sq, 16); sq += __shfl_xor(sq, 32);
                if (fq == 0) { const float old = __hip_atomic_fetch_add(fz.ssY + rbase + ai * 128 + m * 16, sq, __ATOMIC_RELAXED, __HIP_MEMORY_SCOPE_AGENT); asm volatile("" :: "v"(old)); }
            }
        panel_wait(fz.cnt + pm * 32, 4u);
#pragma unroll
        for (int ai = 0; ai < 2; ++ai)
#pragma unroll
            for (int m = 0; m < 4; ++m) rs[ai][m] = rsqrtf(ld_agent(fz.ssY + rbase + ai * 128 + m * 16) * (1.f / 1024.f) + EPSN);
        const float* xin = latent ? p.x_sample - (size_t)8192 * 1024 : p.x_prompt;
        bf16_t* xb = (bf16_t*)(p.ws + OFF_HY) + 1024;
        float s2[2][4];
#pragma unroll
        for (int ai = 0; ai < 2; ++ai)
#pragma unroll
            for (int m = 0; m < 4; ++m) s2[ai][m] = 0.f;
#pragma unroll
        for (int bj = 0; bj < 2; ++bj) {
            const int col = cbase + bj * 128;
            f32x4 g4[2], wp4[2];
#pragma unroll
            for (int n = 0; n < 2; ++n) { g4[n] = *(const f32x4*)(fz.g + v * 6144 + col + 4 * n); wp4[n] = *(const f32x4*)(fz.wpost + col + 4 * n); }
#pragma unroll
            for (int ai = 0; ai < 2; ++ai)
#pragma unroll
                for (int m = 0; m < 4; ++m) {
                    const size_t off = (size_t)(rbase + ai * 128 + m * 16) * 1024 + col;
                    f32x4 x4[2];
                    if (fz.from_input) { x4[0] = __builtin_nontemporal_load((const f32x4*)(xin + off)); x4[1] = __builtin_nontemporal_load((const f32x4*)(xin + off + 4)); }
                    else {
                        const u32x4 xr = __builtin_nontemporal_load((const u32x4*)(xb + 2 * off - col));
                        x4[0] = (f32x4){bflo(xr[0]), bfhi(xr[0]), bflo(xr[1]), bfhi(xr[1])}; x4[1] = (f32x4){bflo(xr[2]), bfhi(xr[2]), bflo(xr[3]), bfhi(xr[3])};
                    }
                    f32x4 a[2];
#pragma unroll
                    for (int n = 0; n < 2; ++n) { a[n] = x4[n] + g4[n] * (acc[ai][bj][m][n] * rs[ai][m] * wp4[n]); acc[ai][bj][m][n] = a[n]; s2[ai][m] += dot4(a[n]); }
                    if (fz.hasH) { u32x4 xo = {pk2(a[0][0], a[0][1]), pk2(a[0][2], a[0][3]), pk2(a[1][0], a[1][1]), pk2(a[1][2], a[1][3])}; *(u32x4*)(xb + 2 * off - col) = xo; }
                    else { __builtin_nontemporal_store(a[0], (f32x4*)(fz.xout + off)); __builtin_nontemporal_store(a[1], (f32x4*)(fz.xout + off + 4)); }
                }
        }
        if (fz.hasH) {
#pragma unroll
            for (int ai = 0; ai < 2; ++ai)
#pragma unroll
                for (int m = 0; m < 4; ++m) {
                    float sq = s2[ai][m];
                    sq += __shfl_xor(sq, 16); sq += __shfl_xor(sq, 32);
                    if (fq == 0) { const float old = __hip_atomic_fetch_add(fz.ssX + rbase + ai * 128 + m * 16, sq, __ATOMIC_RELAXED, __HIP_MEMORY_SCOPE_AGENT); asm volatile("" :: "v"(old)); }
                }
            panel_wait(fz.cnt + pm * 32 + 16, 4u);
#pragma unroll
            for (int ai = 0; ai < 2; ++ai)
#pragma unroll
                for (int m = 0; m < 4; ++m) rs[ai][m] = rsqrtf(ld_agent(fz.ssX + rbase + ai * 128 + m * 16) * (1.f / 1024.f) + EPSN);
            bf16_t* hb = (bf16_t*)(p.ws + OFF_HY);
#pragma unroll
            for (int bj = 0; bj < 2; ++bj) {
                const int col = cbase + bj * 128;
                f32x4 wq4[2], sc4[2], sh4[2];
#pragma unroll
                for (int n = 0; n < 2; ++n) { wq4[n] = *(const f32x4*)(fz.wpre + col + 4 * n); sc4[n] = *(const f32x4*)(fz.sc + v * 6144 + col + 4 * n) + 1.f; sh4[n] = *(const f32x4*)(fz.sh + v * 6144 + col + 4 * n); }
#pragma unroll
                for (int ai = 0; ai < 2; ++ai)
#pragma unroll
                    for (int m = 0; m < 4; ++m) {
                        const f32x4 h0 = acc[ai][bj][m][0] * rs[ai][m] * wq4[0] * sc4[0] + sh4[0], h1 = acc[ai][bj][m][1] * rs[ai][m] * wq4[1] * sc4[1] + sh4[1];
                        u32x4 o = {pk2(h0[0], h0[1]), pk2(h0[2], h0[3]), pk2(h1[0], h1[1]), pk2(h1[2], h1[3])};
                        *(u32x4*)(hb + (size_t)(rbase + ai * 128 + m * 16) * 2048 + col) = o;
                    }
            }
        }
        return;
    }
#pragma unroll
    for (int ai = 0; ai < 2; ++ai)
#pragma unroll
        for (int bj = 0; bj < 2; ++bj) {
            __builtin_amdgcn_sched_barrier(0);
            f32x4 (&sub)[4][2] = acc[ai][bj];
            const int R0 = brow + ai * 128 + wr * 64, t0 = tb + ai * 128 + wr * 64, C0 = bcol + bj * 128 + wc * 32;
            const bool ns = vtm == 1 || (vtm == 2 && bj == 1);
            if (EPI == EPI_PE) {
                if (ns) {
                    const int vc = C0 - 2560;
                    bf16_t* vt = (bf16_t*)(p.ws + OFF_BIG + BIG_VT_E) + (latent ? (size_t)4194304 + ((size_t)b * 512 + vc) * 1024 : ((size_t)b * 512 + vc) * 256);
                    store_vt_s(sub, vt, T, t0, fr, fq);
                    if (!latent) store_f32_ns_s(sub, p.out + OUT_DIFFV + ((size_t)(b * 4 + (vc >> 7)) * 256 + t0) * 128 + (vc & 127), 128, fr, fq);
                } else {
                    if (pn >= 6 && latent) rope_s(sub, R0, wc & 1, fr, fq);
                    store_bf16_rows_s(sub, big, LDE, R0, C0, fr, fq);
                    if (pn >= 8 && !latent) store_f32_rows_s(sub, p.out + OUT_DIFFK + ((size_t)(b * 8 + ((C0 - 2048) >> 6)) * 256 + t0) * 64 + ((C0 - 2048) & 63), 64, fr, fq);
                }
            } else if (EPI == EPI_PO) {
                if (ns) {
                    if (pn < 8) {
                        const int vc = C0 - 1024;
                        bf16_t* vt = (bf16_t*)(p.ws + OFF_BIG + BIG_VT_C) + (latent ? (size_t)4194304 + ((size_t)b * 512 + vc) * 1024 : ((size_t)b * 512 + vc) * 256);
                        store_vt_s(sub, vt, T, t0, fr, fq);
                        if (!latent) store_f32_ns_s(sub, p.out + OUT_NAV + ((size_t)(b * 8 + (vc >> 6)) * 256 + t0) * 64 + (vc & 63), 64, fr, fq);
                    } else {
                        const int vc = C0 - 2176;
                        bf16_t* vt = (bf16_t*)(p.ws + OFF_BIG + BIG_VT_D) + (latent ? (size_t)1048576 + ((size_t)b * 128 + vc) * 1024 : ((size_t)b * 128 + vc) * 256);
                        store_vt_s(sub, vt, T, t0, fr, fq);
                        if (!latent) store_f32_ns_s(sub, p.out + OUT_SWAV + ((size_t)(b * 2 + (vc >> 6)) * 256 + t0) * 64 + (vc & 63), 64, fr, fq);
                    }
                } else {
                    if (pn >= 6 && latent) rope_s(sub, R0, wc & 1, fr, fq);
                    store_bf16_rows_s(sub, big, LDO, R0, pn >= 6 ? C0 - 512 : C0, fr, fq);
                    if (!latent) {
                        if (pn == 2 || pn == 3) store_f32_rows_s(sub, p.out + OUT_NAK + ((size_t)(b * 8 + ((C0 - 512) >> 6)) * 256 + t0) * 64 + ((C0 - 512) & 63), 64, fr, fq);
                        else if (pn == 8) store_f32_rows_s(sub, p.out + OUT_SWAK + ((size_t)(b * 2 + ((C0 - 2048) >> 6)) * 256 + t0) * 64 + ((C0 - 2048) & 63), 64, fr, fq);
                    }
                }
            } else if (EPI == EPI_Y) {
                store_f32_rows_s(sub, (float*)(p.ws + OFF_HY) + (size_t)R0 * 1024 + C0, 1024, fr, fq);
            } else {
#pragma unroll
                for (int m = 0; m < 4; ++m)
#pragma unroll
                    for (int n = 0; n < 2; ++n)
#pragma unroll
                        for (int j = 0; j < 4; ++j) { const float v = fmaxf(sub[m][n][j], 0.f); sub[m][n][j] = v * v; }
                store_bf16_rows_s(sub, big, 4096, R0, C0, fr, fq);
            }
        }
}

template <int EPI>
DI void gemm_phase(const Params& p, const bf16_t* A, int lda, const bf16_t* Bt, int K, int NT_N, char* shm, const FuseP& fz = FuseP{}) {
    using namespace g8;
    const int xcd = blockIdx.x & 7, lb = blockIdx.x >> 3, nlb = gridDim.x >> 3, per_xcd = 8 * NT_N;
    if (lb >= per_xcd) return;
    const int tid = TIDX, wid = __builtin_amdgcn_readfirstlane(tid >> 6), lane = tid & 63, wr = wid >> 2, wc = wid & 3, fr = lane & 15, fq = lane >> 4;
    const int nt = K / BK;
    lds_u8* lds = (lds_u8*)shm;
    unsigned voffA[2], voffB[2];
#pragma unroll
    for (int _i = 0; _i < 2; ++_i) { int _r, _c; stage_rc(tid * 16 + _i * 8192, _r, _c); const int _i16 = _r & 15, _rb = (_r & ~31) + 8 * (_i16 >> 2) + 4 * ((_r >> 4) & 1) + (_i16 & 3);
        voffA[_i] = (unsigned)(_r * lda + _c) * 2u; voffB[_i] = (unsigned)(_rb * K + _c) * 2u; }
    const size_t kstep = (size_t)BK * 2, hstepA = (size_t)HALF * lda * 2, hstepB = (size_t)HALF * K * 2;
    const unsigned ldsw = (unsigned)wid * 1024u;
    const int aoff = lds_byte(wr * 64 + fr, fq * 8), boff = lds_byte(wc * 32 + fr, fq * 8);
#define SA(b, h) (((b) * 2 + (h)) * HTB)
#define SB(b, h) ((4 + (b) * 2 + (h)) * HTB)
#define STAGE(bufoff, gbase, voff) do { _Pragma("unroll") for (int _i = 0; _i < 2; ++_i) \
      __builtin_amdgcn_global_load_lds((const unsigned*)((gbase) + (voff)[_i]), (lds_u32*)(lds + (bufoff) + ldsw + _i * 8192), 16, 0, 0); } while (0)
#define LDA(dst, b, h) _Pragma("unroll") for (int m = 0; m < 4; ++m) _Pragma("unroll") for (int k = 0; k < 2; ++k) \
    dst[m][k] = *(const lds_bf16x8*)(lds + SA(b, h) + aoff + m * 2048 + k * 1024)
#define LDB(dst, b, h) _Pragma("unroll") for (int n = 0; n < 2; ++n) _Pragma("unroll") for (int k = 0; k < 2; ++k) \
    dst[n][k] = *(const lds_bf16x8*)(lds + SB(b, h) + boff + n * 2048 + k * 1024)
#define MMA(VT, ai, bj, At_, Bt_) do { __builtin_amdgcn_s_setprio(1); \
    _Pragma("unroll") for (int m = 0; m < 4; ++m) _Pragma("unroll") for (int n = 0; n < 2; ++n) _Pragma("unroll") for (int k = 0; k < 2; ++k) \
      acc[ai][bj][m][n] = ((VT) == 1 || ((VT) == 2 && (bj) == 1)) ? MFMA16(At_[m][k], Bt_[n][k], acc[ai][bj][m][n]) : MFMA16(Bt_[n][k], At_[m][k], acc[ai][bj][m][n]); \
    __builtin_amdgcn_s_setprio(0); } while (0)
#define WAIT_V(n) asm volatile("s_waitcnt vmcnt(" #n ")" ::: "memory")
#define WAIT_L(n) asm volatile("s_waitcnt lgkmcnt(" #n ")" ::: "memory")
#define BAR __builtin_amdgcn_s_barrier()
#define SCHED __builtin_amdgcn_sched_barrier(0)
#define TLOOP(VT) for (int t = 0; t < nt; t += 2) { \
        const bool last = (t == nt - 2); \
        const char* a1 = cA + (size_t)(t + 1) * kstep; \
        const char* a2 = last ? nA : cA + (size_t)(t + 2) * kstep; const char* b2 = last ? nB : cB + (size_t)(t + 2) * kstep; \
        const char* a3 = a2 + kstep; const char* b3 = b2 + kstep; \
        LDB(B0, 0, 0); LDB(B1, 0, 1); SCHED; LDA(At, 0, 0); STAGE(SA(1, 1), a1 + hstepA, voffA); \
        WAIT_V(8); WAIT_L(0); BAR; MMA(VT, 0, 0, At, B0); MMA(VT, 0, 1, At, B1); BAR; SCHED; \
        LDA(At, 0, 1); STAGE(SB(0, 0), b2, voffB); STAGE(SB(0, 1), b2 + hstepB, voffB); STAGE(SA(0, 0), a2, voffA); \
        WAIT_V(8); WAIT_L(0); BAR; MMA(VT, 1, 0, At, B0); MMA(VT, 1, 1, At, B1); BAR; SCHED; \
        LDB(B0, 1, 0); LDB(B1, 1, 1); SCHED; LDA(At, 1, 0); STAGE(SA(0, 1), a2 + hstepA, voffA); \
        WAIT_V(8); WAIT_L(0); BAR; MMA(VT, 0, 0, At, B0); MMA(VT, 0, 1, At, B1); BAR; SCHED; \
        LDA(At, 1, 1); STAGE(SB(1, 0), b3, voffB); STAGE(SB(1, 1), b3 + hstepB, voffB); STAGE(SA(1, 0), a3, voffA); \
        WAIT_V(8); WAIT_L(0); BAR; MMA(VT, 1, 0, At, B0); MMA(VT, 1, 1, At, B1); BAR; SCHED; \
    }
    int lt = lb, pm = xcd * 8 + (lt & 7), pn = lt >> 3;
    f32x4 acc[2][2][4][2];
#pragma unroll
    for (int a = 0; a < 2; ++a)
#pragma unroll
        for (int b = 0; b < 2; ++b)
#pragma unroll
            for (int m = 0; m < 4; ++m)
#pragma unroll
                for (int n = 0; n < 2; ++n) acc[a][b][m][n] = (f32x4){0.f, 0.f, 0.f, 0.f};
    bf16x8 At[4][2], B0[2][2], B1[2][2];
    const char* cA = (const char*)A + (size_t)pm * 2 * hstepA;
    const char* cB = (const char*)Bt + (size_t)pn * 2 * hstepB;
    WAIT_V(0);
    STAGE(SB(0, 0), cB, voffB); STAGE(SB(0, 1), cB + hstepB, voffB); STAGE(SA(0, 0), cA, voffA); STAGE(SA(0, 1), cA + hstepA, voffA);
    if (wr == 1) BAR;
    WAIT_V(2); BAR;
    STAGE(SB(1, 0), cB + kstep, voffB); STAGE(SA(1, 0), cA + kstep, voffA); STAGE(SB(1, 1), cB + hstepB + kstep, voffB);
    WAIT_V(6); BAR;
    for (;;) {
        const int ltn = lt + nlb;
        const bool has_next = ltn < per_xcd;
        const int pmn = xcd * 8 + (ltn & 7), pnn = ltn >> 3;
        const char* nA = has_next ? (const char*)A + (size_t)pmn * 2 * hstepA : cA;
        const char* nB = has_next ? (const char*)Bt + (size_t)pnn * 2 * hstepB : cB;
        int vtm = 0;
        if (EPI == EPI_PE) vtm = pn >= 10 ? 1 : 0;
        if (EPI == EPI_PO) vtm = (pn == 4 || pn == 5) ? 1 : (pn == 8 ? 2 : 0);
        if ((EPI == EPI_PE || EPI == EPI_PO) && vtm == 1) { TLOOP(1) }
        else if (EPI == EPI_PO && vtm == 2) { TLOOP(2) }
        else { TLOOP(0) }
        if (wr == 0) BAR;
        if (EPI != EPI_YF) tile_epilogue<EPI>(p, acc, pm, pn, vtm, fz);
        if (!has_next) break;
#pragma unroll
        for (int a = 0; a < 2; ++a)
#pragma unroll
            for (int b = 0; b < 2; ++b)
#pragma unroll
                for (int m = 0; m < 4; ++m)
#pragma unroll
                    for (int n = 0; n < 2; ++n) acc[a][b][m][n] = (f32x4){0.f, 0.f, 0.f, 0.f};
        lt = ltn; pm = pmn; pn = pnn; cA = nA; cB = nB;
        if (wr == 1) BAR;
    }
    WAIT_V(0);
    BAR;
    if (EPI == EPI_YF) tile_epilogue<EPI>(p, acc, pm, pn, 0, fz);
#undef SA
#undef SB
#undef STAGE
#undef LDA
#undef LDB
#undef MMA
#undef WAIT_V
#undef WAIT_L
#undef BAR
#undef SCHED
#undef TLOOP
}

struct ASeg { const bf16_t* K; const bf16_t* Vt; int ldk, ldv, ntiles; };
struct MaskP { int on, a, b, c; const float* tab; };

template <int KW, int VR, int NB, int MODE>
DI void attn_core(const ASeg& s0, const ASeg& s1, const bf16x8 (&qf)[4], int kchunk0, int vrow0, float scale_l2, float& m, float& l, f32x16 (&O)[NB], char* lds, const MaskP& mp) {
    constexpr int KC = KW / 8, NKL = 64 * KC / 256, NVL = VR * 8 / 256;
    const int tid = VTID, lane = tid & 63, p32 = lane & 31, h = lane >> 5;
    const int krow = (p32 & 19) | ((p32 & 4) << 1) | ((p32 & 8) >> 1);
    const int n0 = s0.ntiles, nt = s0.ntiles + s1.ntiles;
    u32x4 rk[NKL], rv[NVL];
#define ATT_LOAD(t_)                                                                                                         \
    {                                                                                                                        \
        const bool f_ = (t_) < n0; const int tt_ = f_ ? (t_) : (t_) - n0;                                                     \
        const bf16_t* Kp_ = (f_ ? s0.K : s1.K); const int ldk_ = f_ ? s0.ldk : s1.ldk;                                        \
        const bf16_t* Vp_ = (f_ ? s0.Vt : s1.Vt); const int ldv_ = f_ ? s0.ldv : s1.ldv;                                      \
        _Pragma("unroll") for (int i = 0; i < NKL; ++i) { const int id = tid + 256 * i, r = id / KC, c = id % KC; rk[i] = *(const u32x4*)(Kp_ + (size_t)(tt_ * 64 + r) * ldk_ + c * 8); } \
        _Pragma("unroll") for (int i = 0; i < NVL; ++i) { const int id = tid + 256 * i, r = id >> 3, c = id & 7; rv[i] = *(const u32x4*)(Vp_ + (size_t)r * ldv_ + tt_ * 64 + c * 8); }       \
    }
#define ATT_STORE(b_)                                                                                                        \
    {                                                                                                                        \
        char* kb_ = lds + (b_) * 32768; char* vb_ = kb_ + 16384;                                                              \
        _Pragma("unroll") for (int i = 0; i < NKL; ++i) { const int id = tid + 256 * i, r = id / KC, c = id % KC; *(u32x4*)(kb_ + (KW == 128 ? swz256(r, c) : swz128(r, c))) = rk[i]; } \
        _Pragma("unroll") for (int i = 0; i < NVL; ++i) { const int id = tid + 256 * i, r = id >> 3, c = id & 7; *(u32x4*)(vb_ + swz128(r, c)) = rv[i]; }                               \
    }
    int dco[2][16];
    if (MODE == 1) {
        const int cq = mp.c + p32, cs = min(max(cq - 8, 0), 48);
#pragma unroll
        for (int kh = 0; kh < 2; ++kh)
#pragma unroll
            for (int i = 0; i < 16; ++i) {
                const int kc = 32 * kh + 16 * (i >> 3) + 8 * h + (i & 7);
                dco[kh][i] = ((unsigned)(kc - cs) < 16u ? min(max(kc - cq + 15, 0), 30) : 31) * 4;
            }
    }
    ATT_LOAD(0);
    ATT_STORE(0);
    __syncthreads();
    for (int t = 0; t < nt; ++t) {
        const bool more = t + 1 < nt;
        if (more) ATT_LOAD(t + 1);
        const char* kb = lds + (t & 1) * 32768;
        const char* vb = kb + 16384;
        f32x16 S[2];
#pragma unroll
        for (int kh = 0; kh < 2; ++kh) {
#pragma unroll
            for (int i = 0; i < 16; ++i) S[kh][i] = 0.f;
            const int row = krow + 32 * kh;
#pragma unroll
            for (int s = 0; s < 4; ++s) {
                const int c = kchunk0 + 2 * s + h;
                const bf16x8 kf = *(const bf16x8*)(kb + (KW == 128 ? swz256(row, c) : swz128(row, c)));
                S[kh] = MFMA32(kf, qf[s], S[kh]);
            }
        }
        const bool msk = (MODE != 0) && mp.on && t < n0;
        float mx = -1e30f;
        if (MODE == 1 && msk) {
            const char* trow = (const char*)(mp.tab + (mp.b + t - mp.a + 7) * 32);
#pragma unroll
            for (int kh = 0; kh < 2; ++kh)
#pragma unroll
                for (int i = 0; i < 16; ++i) {
                    const float sv = __builtin_fmaf(S[kh][i], scale_l2, *(const float*)(trow + dco[kh][i]));
                    S[kh][i] = sv; mx = fmaxf(mx, sv);
                }
        } else if (MODE == 2 && msk) {
            int qp = mp.a + p32 - 8 * h;
            asm volatile("" : "+v"(qp));
            const int k0 = mp.b + t * 64;
#pragma unroll
            for (int kh = 0; kh < 2; ++kh)
#pragma unroll
                for (int i = 0; i < 16; ++i) {
                    const int d = qp - (k0 + 32 * kh + 16 * (i >> 3) + (i & 7));
                    const bool ok = d <= 128 && d >= -128;
                    const float sv = ok ? S[kh][i] * scale_l2 : -1e30f;
                    S[kh][i] = sv; mx = fmaxf(mx, sv);
                }
        } else {
            float m0 = fmaxf(fmaxf(S[0][0], S[0][1]), S[0][2]), m1 = fmaxf(fmaxf(S[1][0], S[1][1]), S[1][2]);
#pragma unroll
            for (int i = 3; i < 15; i += 2) { m0 = fmaxf(fmaxf(m0, S[0][i]), S[0][i + 1]); m1 = fmaxf(fmaxf(m1, S[1][i]), S[1][i + 1]); }
            mx = fmaxf(fmaxf(m0, m1), fmaxf(S[0][15], S[1][15])) * scale_l2;
        }
        mx = fmaxf(mx, __shfl_xor(mx, 32));
        if (__any(mx > m + 8.f)) {
            const float mn = fmaxf(m, mx);
            const float alpha = __builtin_amdgcn_exp2f(m - mn);
            m = mn;
            l *= alpha;
#pragma unroll
            for (int blk = 0; blk < NB; ++blk)
#pragma unroll
                for (int i = 0; i < 16; ++i) O[blk][i] *= alpha;
        }
        float ls = 0.f;
        if ((MODE == 1 || MODE == 2) && msk) {
#pragma unroll
            for (int kh = 0; kh < 2; ++kh)
#pragma unroll
                for (int i = 0; i < 16; ++i) { const float pv = __builtin_amdgcn_exp2f(S[kh][i] - m); S[kh][i] = pv; ls += pv; }
        } else {
            const float negm = -m;
#pragma unroll
            for (int kh = 0; kh < 2; ++kh)
#pragma unroll
                for (int i = 0; i < 16; ++i) { const float pv = __builtin_amdgcn_exp2f(__builtin_fmaf(S[kh][i], scale_l2, negm)); S[kh][i] = pv; ls += pv; }
        }
        l += ls;
#pragma unroll
        for (int kh = 0; kh < 2; ++kh)
#pragma unroll
            for (int s2 = 0; s2 < 2; ++s2) {
                u32x4 pp = {pk2(S[kh][8 * s2 + 0], S[kh][8 * s2 + 1]), pk2(S[kh][8 * s2 + 2], S[kh][8 * s2 + 3]), pk2(S[kh][8 * s2 + 4], S[kh][8 * s2 + 5]), pk2(S[kh][8 * s2 + 6], S[kh][8 * s2 + 7])};
                const bf16x8 pb = __builtin_bit_cast(bf16x8, pp);
                const int c = 4 * kh + 2 * s2 + h;
#pragma unroll
                for (int blk = 0; blk < NB; ++blk) {
                    const bf16x8 vf = *(const bf16x8*)(vb + swz128(vrow0 + blk * 32 + p32, c));
                    O[blk] = MFMA32(vf, pb, O[blk]);
                }
            }
        if (more) ATT_STORE((t + 1) & 1);
        __syncthreads();
    }
    l += __shfl_xor(l, 32);
#undef ATT_LOAD
#undef ATT_STORE
}

DI void load_q(bf16x8 (&qf)[4], const bf16_t* qrow, int h) {
#pragma unroll
    for (int s = 0; s < 4; ++s) qf[s] = *(const bf16x8*)(qrow + 16 * s + 8 * h);
}

DI void attn_diff_item(const Params& p, int item, char* lds) {
    const int tid = VTID, lane = tid & 63, w = tid >> 6, p32 = lane & 31, h = lane >> 5, stream = w & 1, qh = w >> 1;
    const bf16_t* proj = (const bf16_t*)(p.ws + OFF_BIG);
    const bf16_t* vte = (const bf16_t*)(p.ws + OFF_BIG + BIG_VT_E);
    bf16_t* mix = (bf16_t*)(p.ws + OFF_BIG + BIG_MIXIN);
    int b, hd, qb, rowbase; ASeg s0, s1;
    if (item < 512) {
        b = item >> 6; hd = (item >> 4) & 3; qb = item & 15; rowbase = 8192 + b * 1024;
        s0 = {proj + (size_t)rowbase * LDE + 2048 + hd * 128, vte + 4194304 + ((size_t)b * 512 + hd * 128) * 1024, LDE, 1024, 16};
        s1 = {(const bf16_t*)(p.ws + OFF_CDK) + (size_t)b * 256 * 512 + hd * 128, (const bf16_t*)(p.ws + OFF_CDVT) + (size_t)(b * 4 + hd) * 128 * 256, 512, 256, 4};
    } else {
        const int it = item - 512;
        b = it >> 4; hd = (it >> 2) & 3; qb = it & 3; rowbase = b * 256;
        s0 = {proj + (size_t)rowbase * LDE + 2048 + hd * 128, vte + ((size_t)b * 512 + hd * 128) * 256, LDE, 256, 4};
        s1 = s0; s1.ntiles = 0;
    }
    const int R = rowbase + qb * 64 + qh * 32 + p32;
    bf16x8 qf[4];
    load_q(qf, proj + (size_t)R * LDE + 1536 + hd * 128 + stream * 64, h);
    f32x16 O[4];
#pragma unroll
    for (int blk = 0; blk < 4; ++blk)
#pragma unroll
        for (int i = 0; i < 16; ++i) O[blk][i] = 0.f;
    float m = -1e30f, l = 0.f;
    MaskP mp = {0, 0, 0, 0, nullptr};
    attn_core<128, 128, 4, 0>(s0, s1, qf, stream * 8, 0, 0.125f * LOG2E, m, l, O, lds, mp);
    const float il = 1.f / l;
    const float d1 = wave_sum(p.lq1[lane] * p.lk1[lane]), d2 = wave_sum(p.lq2[lane] * p.lk2[lane]);
    const float lam_init = 0.2f;
    const float lam = __expf(d1) - __expf(d2) + lam_init;
    float* xb = (float*)(lds + qh * 16384);
    if (stream == 1) {
#pragma unroll
        for (int blk = 0; blk < 4; ++blk)
#pragma unroll
            for (int i = 0; i < 16; ++i) { const int dv = blk * 32 + 8 * (i >> 2) + 4 * h + (i & 3); xb[dv * 32 + p32] = O[blk][i] * il; }
    }
    __syncthreads();
    if (stream == 0) {
        float ss = 0.f;
#pragma unroll
        for (int blk = 0; blk < 4; ++blk)
#pragma unroll
            for (int i = 0; i < 16; ++i) { const int dv = blk * 32 + 8 * (i >> 2) + 4 * h + (i & 3); const float o = O[blk][i] * il - lam * xb[dv * 32 + p32]; O[blk][i] = o; ss += o * o; }
        ss += __shfl_xor(ss, 32);
        const float rs = rsqrtf(ss * (1.f / 128.f) + EPSN) * (1.f - lam_init);
        bf16_t* op = mix + (size_t)R * 1024 + 512 + hd * 128;
#pragma unroll
        for (int blk = 0; blk < 4; ++blk)
#pragma unroll
            for (int g = 0; g < 4; ++g) {
                const int dv = blk * 32 + 8 * g + 4 * h;
                const f32x4 sl = *(const f32x4*)(p.subln + dv);
                u32x2 o = {pk2(O[blk][4 * g] * rs * sl[0], O[blk][4 * g + 1] * rs * sl[1]), pk2(O[blk][4 * g + 2] * rs * sl[2], O[blk][4 * g + 3] * rs * sl[3])};
                *(u32x2*)(op + dv) = o;
            }
    }
    __syncthreads();
}

DI void attn_c_item(const Params& p, int item, char* lds) {
    const int tid = VTID, lane = tid & 63, w = tid >> 6, p32 = lane & 31, h = lane >> 5, stream = w & 1, qh = w >> 1;
    const bf16_t* proj = (const bf16_t*)(p.ws + OFF_BIG);
    const bf16_t* vtc = (const bf16_t*)(p.ws + OFF_BIG + BIG_VT_C);
    bf16_t* mix = (bf16_t*)(p.ws + OFF_BIG + BIG_MIXIN);
    int b, hp, qb, rowbase; ASeg s0, s1; MaskP mp = {0, 0, 0, 0, nullptr};
    float* tab = (float*)(lds + 65536);
    if (item < 512) {
        b = item >> 6; hp = (item >> 4) & 3; qb = item & 15; rowbase = 8192 + b * 1024;
        const int rstart = min(max(qb - 4, 0), 8);
        s0 = {proj + (size_t)(rowbase + rstart * 64) * LDO + 512 + hp * 128, vtc + 4194304 + ((size_t)b * 512 + hp * 128) * 1024 + rstart * 64, LDO, 1024, 8};
        s1 = {(const bf16_t*)(p.ws + OFF_CNK) + (size_t)b * 256 * 512 + hp * 128, (const bf16_t*)(p.ws + OFF_CNVT) + ((size_t)b * 512 + hp * 128) * 256, 512, 256, 4};
        for (int idx = tid; idx < 960; idx += 256) { const int hr = idx >> 5, cc = idx & 31; tab[idx] = cc < 31 ? p.rpb[hp * 930 + hr * 31 + cc] * LOG2E : -1e30f; }
        mp = {1, qb, rstart, qh * 32, tab + stream * 480};
    } else {
        const int it = item - 512;
        b = it >> 4; hp = (it >> 2) & 3; qb = it & 3; rowbase = b * 256;
        s0 = {proj + (size_t)rowbase * LDO + 512 + hp * 128, vtc + ((size_t)b * 512 + hp * 128) * 256, LDO, 256, 4};
        s1 = s0; s1.ntiles = 0;
    }
    const int R = rowbase + qb * 64 + qh * 32 + p32;
    const int head = hp * 2 + stream;
    bf16x8 qf[4];
    load_q(qf, proj + (size_t)R * LDO + head * 64, h);
    f32x16 O[2];
#pragma unroll
    for (int blk = 0; blk < 2; ++blk)
#pragma unroll
        for (int i = 0; i < 16; ++i) O[blk][i] = 0.f;
    float m = -1e30f, l = 0.f;
    attn_core<128, 128, 2, 1>(s0, s1, qf, stream * 8, stream * 64, 0.125f * LOG2E, m, l, O, lds, mp);
    const float il = 1.f / l;
    bf16_t* op = mix + (size_t)R * 1024 + head * 64;
#pragma unroll
    for (int blk = 0; blk < 2; ++blk)
#pragma unroll
        for (int g = 0; g < 4; ++g) {
            const int dv = blk * 32 + 8 * g + 4 * h;
            u32x2 o = {pk2(O[blk][4 * g] * il, O[blk][4 * g + 1] * il), pk2(O[blk][4 * g + 2] * il, O[blk][4 * g + 3] * il)};
            *(u32x2*)(op + dv) = o;
        }
}

DI void attn_d_item(const Params& p, int item, char* lds) {
    const int tid = VTID, lane = tid & 63, w = tid >> 6, p32 = lane & 31, h = lane >> 5;
    const bf16_t* proj = (const bf16_t*)(p.ws + OFF_BIG);
    const bf16_t* vtd = (const bf16_t*)(p.ws + OFF_BIG + BIG_VT_D);
    bf16_t* mix = (bf16_t*)(p.ws + OFF_BIG + BIG_MIXIN);
    int b, g, qb, rowbase; ASeg s0, s1; MaskP mp = {0, 0, 0, 0, nullptr};
    if (item < 512) {
        b = item >> 6; g = (item >> 5) & 1; qb = item & 31; rowbase = 8192 + b * 1024;
        const int q0 = qb * 32;
        const int tlo = max(q0 - 128, 0) >> 6, thi = min(q0 + 159, 1023) >> 6;
        s0 = {proj + (size_t)(rowbase + tlo * 64) * LDO + 1536 + g * 64, vtd + 1048576 + ((size_t)b * 128 + g * 64) * 1024 + tlo * 64, LDO, 1024, thi - tlo + 1};
        s1 = {(const bf16_t*)(p.ws + OFF_CSK) + (size_t)b * 256 * 128 + g * 64, (const bf16_t*)(p.ws + OFF_CSVT) + ((size_t)b * 128 + g * 64) * 256, 128, 256, 4};
        mp = {1, q0, tlo * 64, 0, nullptr};
    } else {
        const int it = item - 512;
        b = it >> 4; g = (it >> 3) & 1; qb = it & 7; rowbase = b * 256;
        s0 = {proj + (size_t)rowbase * LDO + 1536 + g * 64, vtd + ((size_t)b * 128 + g * 64) * 256, LDO, 256, 4};
        s1 = s0; s1.ntiles = 0;
    }
    const int R = rowbase + qb * 32 + p32;
    const int hq = g * 4 + w;
    bf16x8 qf[4];
    load_q(qf, proj + (size_t)R * LDO + 1024 + hq * 64, h);
    f32x16 O[2];
#pragma unroll
    for (int blk = 0; blk < 2; ++blk)
#pragma unroll
        for (int i = 0; i < 16; ++i) O[blk][i] = 0.f;
    float m = p.sink[hq] * LOG2E, l = h == 0 ? 1.f : 0.f;
    attn_core<64, 64, 2, 2>(s0, s1, qf, 0, 0, 0.125f * LOG2E, m, l, O, lds, mp);
    const float il = 1.f / l;
    bf16_t* op = mix + (size_t)R * 1024 + 512 + hq * 64;
#pragma unroll
    for (int blk = 0; blk < 2; ++blk)
#pragma unroll
        for (int gg = 0; gg < 4; ++gg) {
            const int dv = blk * 32 + 8 * gg + 4 * h;
            u32x2 o = {pk2(O[blk][4 * gg] * il, O[blk][4 * gg + 1] * il), pk2(O[blk][4 * gg + 2] * il, O[blk][4 * gg + 3] * il)};
            *(u32x2*)(op + dv) = o;
        }
}

DI void conv_item(const Params& p, int item) {
    const int tid = VTID;
    const bf16_t* proj = (const bf16_t*)(p.ws + OFF_BIG);
    bf16_t* mix = (bf16_t*)(p.ws + OFF_BIG + BIG_MIXIN);
#pragma unroll 2
    for (int i = 0; i < 8; ++i) {
        const int idx = tid + 256 * i, tl = idx >> 6, ch = (idx & 63) * 8;
        const int R = item * 32 + tl;
        int t, T;
        if (R < 8192) { t = R & 255; T = 256; } else { t = (R - 8192) & 1023; T = 1024; }
        const bf16_t* rp = proj + (size_t)R * LDE + ch;
        const u32x4 ab = *(const u32x4*)(rp);
        float accv[8];
#pragma unroll
        for (int e = 0; e < 8; ++e) accv[e] = 0.f;
#pragma unroll
        for (int j = 0; j < 3; ++j) {
            const int tt = t + j - 1;
            if (tt >= 0 && tt < T) {
                const u32x4 ac = *(const u32x4*)(rp + (ptrdiff_t)(j - 1) * LDE + 512);
                const u32x4 ax = *(const u32x4*)(rp + (ptrdiff_t)(j - 1) * LDE + 1024);
                const f32x4 w0 = *(const f32x4*)(p.conv_w + j * 512 + ch), w1 = *(const f32x4*)(p.conv_w + j * 512 + ch + 4);
#pragma unroll
                for (int e = 0; e < 4; ++e) {
                    accv[2 * e] += bflo(ac[e]) * bflo(ax[e]) * (e < 2 ? w0[2 * e] : w1[2 * e - 4]);
                    accv[2 * e + 1] += bfhi(ac[e]) * bfhi(ax[e]) * (e < 2 ? w0[2 * e + 1] : w1[2 * e - 3]);
                }
            }
        }
        u32x4 o;
#pragma unroll
        for (int e = 0; e < 4; ++e) o[e] = pk2(bflo(ab[e]) * accv[2 * e], bfhi(ab[e]) * accv[2 * e + 1]);
        *(u32x4*)(mix + (size_t)R * 1024 + ch) = o;
    }
}


#define XB_TMO      128
#define XB_XCNT(j)  (256  + 64 * (j))
#define XB_XSUB(j)  (1280 + 64 * (j))
#define XB_XGEN(j)  (2304 + 64 * (j))
#define XB_TOP      3328
#define XB_TOPGEN   3392
#define XCD_BAR_WORDS 3456
#define XB_SPIN_CAP (1u << 22)
#define LAS __attribute__((address_space(3)))
DI unsigned xb_ld(unsigned* p) { return __hip_atomic_load(p, __ATOMIC_RELAXED, __HIP_MEMORY_SCOPE_AGENT); }
DI unsigned xb_add(unsigned* p, unsigned v) { return __hip_atomic_fetch_add(p, v, __ATOMIC_RELAXED, __HIP_MEMORY_SCOPE_AGENT); }
DI unsigned xb_xcc_id() { return (unsigned)__builtin_amdgcn_s_getreg((3 << 11) | 20) & 0xFu; }
#define XB_SPIN(cond, bar) do { unsigned _sp = 0; while (cond) { __builtin_amdgcn_s_sleep(1); \
    if ((++_sp & 255u) == 0u) { if (xb_ld(&(bar)[XB_TMO])) break; if (_sp > XB_SPIN_CAP) { atomicAdd(&(bar)[XB_TMO], 1u); break; } } } } while (0)
struct XcdBarrier { unsigned* bar; unsigned x; volatile LAS unsigned* st; };
DI XcdBarrier xcd_barrier_post(unsigned* bar, volatile LAS unsigned* st) {
    XcdBarrier b; b.bar = bar; b.x = xb_xcc_id(); b.st = st;
    if (threadIdx.x == 0) (void)xb_add(&bar[XB_XCNT(b.x)], 1u);
    return b;
}
DI void xcd_barrier_complete(unsigned* bar, unsigned x, unsigned& nloc, unsigned& nx) {
    const unsigned G = gridDim.x * gridDim.y * gridDim.z;
    unsigned sum, cnt, mine, sp = 0u;
    for (;;) {
        sum = 0u; cnt = 0u; mine = 0u;
#pragma unroll
        for (unsigned j = 0; j < 16; ++j) { const unsigned c = xb_ld(&bar[XB_XCNT(j)]); sum += c; cnt += (c > 0u) ? 1u : 0u; mine = (j == x) ? c : mine; }
        if (sum == G) break;
        __builtin_amdgcn_s_sleep(1);
        if ((++sp & 255u) == 0u) { if (xb_ld(&bar[XB_TMO])) break; if (sp > XB_SPIN_CAP) { atomicAdd(&bar[XB_TMO], 1u); break; } }
    }
    nloc = mine > 0u ? mine : 1u; nx = cnt > 0u ? cnt : 1u;
}
DI void xcd_barrier(const XcdBarrier& b) {
    asm volatile("s_waitcnt vmcnt(0)" ::: "memory");
    __syncthreads();
    if (threadIdx.x == 0) {
        unsigned* bar = b.bar;
        __builtin_amdgcn_s_waitcnt(0);
        unsigned nloc = b.st[0], nx = b.st[1];
        if (nloc == 0u) { xcd_barrier_complete(bar, b.x, nloc, nx); b.st[0] = nloc; b.st[1] = nx; }
        const unsigned old = xb_add(&bar[XB_XSUB(b.x)], 1u);
        const unsigned gen = old / nloc;
        if (old + 1u == (gen + 1u) * nloc) {
            __builtin_amdgcn_fence(__ATOMIC_RELEASE, "agent");
            asm volatile("s_waitcnt vmcnt(0)" ::: "memory");
            const unsigned og = xb_add(&bar[XB_TOP], 1u);
            const unsigned tg = og / nx;
            if (og + 1u == (tg + 1u) * nx) xb_add(&bar[XB_TOPGEN], 1u);
            else XB_SPIN(xb_ld(&bar[XB_TOPGEN]) == tg, bar);
            __builtin_amdgcn_fence(__ATOMIC_ACQUIRE, "agent");
            xb_add(&bar[XB_XGEN(b.x)], 1u);
            asm volatile("s_waitcnt vmcnt(0)" ::: "memory");
        } else {
            XB_SPIN(xb_ld(&bar[XB_XGEN(b.x)]) == gen, bar);
            __builtin_amdgcn_fence(__ATOMIC_ACQUIRE, "agent");
            asm volatile("s_waitcnt vmcnt(0)" ::: "memory");
        }
    }
    __syncthreads();
}

constexpr int N_PHASES = 12;
DI void run_phase(const Params& p, int ph, char* shm) {
    const int nb = VNB, bid = VBID;
    char* lds = shm + VHALF * LDS_HALF;
    const int pvb = (int)(blockIdx.x & 7) * (nb >> 3) + (int)(blockIdx.x >> 3) * 2 + VHALF;
    const bf16_t* hy = (const bf16_t*)(p.ws + OFF_HY);
    const bf16_t* big = (const bf16_t*)(p.ws + OFF_BIG);
    const bf16_t* mixin = (const bf16_t*)(p.ws + OFF_BIG + BIG_MIXIN);
    const float* mod = (const float*)(p.ws + OFF_MOD);
    char* st = p.ws + OFF_STAT;
#define FZ(set, from_in, hasH, goff, wpost, wpre, scoff, shoff) FuseP{from_in, hasH, p.out, mod + (goff), wpost, wpre, mod + (scoff), mod + (shoff), (float*)(st + (set) * STAT_SET), (float*)(st + (set) * STAT_SET + 65536), (unsigned*)(st + (set) * STAT_SET + 131072)}
    switch (ph) {
    case 0: p0_phase(p, bid, nb, lds); break;
    case 1: rowop_phase(p, false, true, 0, nullptr, true, p.norm_mix_pre, 1024, 0); break;
    case 2: gemm_phase<EPI_PE>(p, hy, 2048, (const bf16_t*)(p.ws + OFF_WINE), 1024, 12, shm); break;
    case 3:
        for (int it = pvb; it < 1536; it += nb) { if (it < 1024) attn_diff_item(p, it, lds); else conv_item(p, it - 1024); }
        break;
    case 4: gemm_phase<EPI_YF>(p, mixin, 1024, (const bf16_t*)(p.ws + OFF_WOUT), 1024, 4, shm, FZ(0, 1, 1, 2048, p.norm_mix_post, p.norm_mlp_pre, 4096, 3072)); break;
    case 5: gemm_phase<EPI_W1>(p, hy, 2048, (const bf16_t*)(p.ws + OFF_W1), 1024, 16, shm); break;
    case 6: gemm_phase<EPI_YF>(p, big, 4096, (const bf16_t*)(p.ws + OFF_W2), 4096, 4, shm, FZ(1, 0, 1, 5120, p.norm_mlp_post, p.norm_mix_pre + 1024, 9 * 6144 + 1024, 9 * 6144 + 0)); break;
    case 7: gemm_phase<EPI_PO>(p, hy, 2048, (const bf16_t*)(p.ws + OFF_WINO), 1024, 9, shm); break;
    case 8:
        for (int it = pvb; it < 2048; it += nb) {
            const int q = it >> 9, r = it & 511;
            if (q & 1) attn_d_item(p, (q >> 1) * 512 + r, lds); else attn_c_item(p, (q >> 1) * 512 + r, lds);
        }
        break;
    case 9: gemm_phase<EPI_YF>(p, mixin, 1024, (const bf16_t*)(p.ws + OFF_WOUT) + 1048576, 1024, 4, shm, FZ(2, 0, 1, 9 * 6144 + 2048, p.norm_mix_post + 1024, p.norm_mlp_pre + 1024, 9 * 6144 + 4096, 9 * 6144 + 3072)); break;
    case 10: gemm_phase<EPI_W1>(p, hy, 2048, (const bf16_t*)(p.ws + OFF_W1) + 4194304, 1024, 16, shm); break;
    case 11: gemm_phase<EPI_YF>(p, big, 4096, (const bf16_t*)(p.ws + OFF_W2) + 4194304, 4096, 4, shm, FZ(3, 0, 0, 9 * 6144 + 5120, p.norm_mlp_post + 1024, p.norm_mlp_post, 0, 0)); break;
    }
#undef FZ
}

__global__ void __launch_bounds__(512, 2) fwd_mega(Params p) {
    __shared__ __attribute__((aligned(16))) char lds[LDS_BYTES];
    __shared__ uint4 xb_words;
    cg::grid_group grid = cg::this_grid();
    if (threadIdx.x == 0) xb_words = make_uint4(0u, 0u, 0u, 0u);
    __syncthreads();
    const XcdBarrier xb = xcd_barrier_post((unsigned*)(p.ws + OFF_BAR), (volatile LAS unsigned*)&xb_words);
#define PH_(n) run_phase(p, n, lds); xcd_barrier(xb); if ((DUP_MASK >> n) & 1) { run_phase(p, n, lds); xcd_barrier(xb); }
    PH_(0)
    if (p.ws == nullptr) grid.sync();
    PH_(1) PH_(2) PH_(3) PH_(4) PH_(5) PH_(6) PH_(7) PH_(8) PH_(9) PH_(10)
    run_phase(p, 11, lds);
#undef PH_
}

extern "C" void kernel_launch(void* const* d_in, const int* in_sizes, int n_in, void* d_out, int out_size, void* d_ws, size_t ws_size, hipStream_t stream) {
    Params p{};
    const float** pp = (const float**)&p;
    for (int i = 0; i < 29; ++i) pp[i] = (const float*)d_in[i];
    p.out = (float*)d_out;
    p.ws = (char*)d_ws;
    if (ws_size < WS_NEEDED) { fprintf(stderr, "workspace too small: %zu < %zu\n", ws_size, (size_t)WS_NEEDED); return; }
    static int grid_blocks = 0;
    if (!grid_blocks) {
        int dev = 0, cus = 0, per_cu = 0;
        hipGetDevice(&dev);
        hipDeviceGetAttribute(&cus, hipDeviceAttributeMultiprocessorCount, dev);
        hipOccupancyMaxActiveBlocksPerMultiprocessor(&per_cu, fwd_mega, 512, 0);
        if (per_cu > 1) per_cu = 1;
        if (per_cu < 1) per_cu = 1;
        grid_blocks = cus * per_cu;
        grid_blocks -= grid_blocks % 8;
    }
    (void)hipMemsetAsync((char*)d_ws + OFF_MOD, 0, OFF_BAR + XCD_BAR_WORDS * 4, stream);
    if (grid_blocks != 256) { fprintf(stderr, "fused epilogues need exactly 256 workgroups (got %d)\n", grid_blocks); return; }
    void* args[] = {&p};
    hipError_t e = hipLaunchCooperativeKernel((void*)fwd_mega, dim3(grid_blocks), dim3(512), args, 0, stream);
    if (e != hipSuccess) fprintf(stderr, "cooperative launch failed: %s (grid %d)\n", hipGetErrorString(e), grid_blocks);
}
```

```cpp
#include <hip/hip_runtime.h>
#include <hip/hip_cooperative_groups.h>
#include <cstdio>
#include <cstdint>
namespace cg = cooperative_groups;

#ifndef DUP_MASK
#define DUP_MASK 0
#endif
#ifndef ONE_LAUNCH
#define ONE_LAUNCH 1
#endif

typedef unsigned short bf16_t;
typedef short bf16x8 __attribute__((ext_vector_type(8)));
typedef float f32x4 __attribute__((ext_vector_type(4)));
typedef float f32x2 __attribute__((ext_vector_type(2)));
typedef float f32x16 __attribute__((ext_vector_type(16)));
typedef unsigned u32x4 __attribute__((ext_vector_type(4)));
typedef unsigned u32x2 __attribute__((ext_vector_type(2)));
typedef __bf16 bfv2 __attribute__((ext_vector_type(2)));
#define DI __device__ __forceinline__
DI int launder_v(int v) { asm volatile("" : "+v"(v)); return v; }
#define TIDX launder_v((int)threadIdx.x)
#define VTID (TIDX & 255)
#define VHALF (TIDX >> 8)
#define VBID ((int)(blockIdx.x * 2) + (TIDX >> 8))
#define VNB ((int)(gridDim.x * 2))
#define MFMA32(a, b, c) __builtin_amdgcn_mfma_f32_32x32x16_bf16((a), (b), (c), 0, 0, 0)
#define MFMA16(a, b, c) __builtin_amdgcn_mfma_f32_16x16x32_bf16((a), (b), (c), 0, 0, 0)

constexpr float LOG2E = 1.4426950408889634f;
constexpr float EPSN = 1e-6f;

struct Params {
    const float *x_prompt, *x_sample, *cache_diff_k, *cache_diff_v, *cache_na_k, *cache_na_v, *cache_swa_k, *cache_swa_v, *c, *c_ctx;
    const float *mod_w, *mod_b, *norm_mix_pre, *norm_mix_post, *norm_mlp_pre, *norm_mlp_post, *w_in_even, *conv_w, *lq1, *lk1, *lq2, *lk2, *subln;
    const float *w_in_odd, *rpb, *sink, *w_out, *mlp_w1, *mlp_w2;
    float* out;
    char* ws;
};

constexpr size_t OFF_MOD = 0;
constexpr size_t OFF_BAR = 458752;
constexpr size_t OFF_WINE = 524288;
constexpr size_t OFF_WINO = OFF_WINE + 6291456;
constexpr size_t OFF_WOUT = OFF_WINO + 4718592;
constexpr size_t OFF_W1 = OFF_WOUT + 4194304;
constexpr size_t OFF_W2 = OFF_W1 + 16777216;
constexpr size_t OFF_CDK = OFF_W2 + 16777216;
constexpr size_t OFF_CDVT = OFF_CDK + 2097152;
constexpr size_t OFF_CNK = OFF_CDVT + 2097152;
constexpr size_t OFF_CNVT = OFF_CNK + 2097152;
constexpr size_t OFF_CSK = OFF_CNVT + 2097152;
constexpr size_t OFF_CSVT = OFF_CSK + 524288;
constexpr size_t OFF_HY = OFF_CSVT + 524288;
constexpr size_t OFF_BIG = OFF_HY + 67108864;
constexpr size_t OFF_STAT = OFF_BIG + 134217728;
constexpr size_t STAT_SET = 65536 + 65536 + 8192;
constexpr size_t WS_NEEDED = OFF_STAT + 4 * STAT_SET;
constexpr size_t BIG_VT_E = 83886080;
constexpr size_t BIG_VT_C = 54525952;
constexpr size_t BIG_VT_D = BIG_VT_C + 16777216;
constexpr size_t BIG_MIXIN = 100663296;
constexpr int LDE = 2560, LDO = 1664;
constexpr size_t OUT_DIFFK = 16777216, OUT_DIFFV = 20971520, OUT_NAK = 25165824, OUT_NAV = 29360128, OUT_SWAK = 33554432, OUT_SWAV = 34603008;

constexpr int LDS_HALF = 65536 + 4096;
constexpr int LDS_BYTES = 2 * LDS_HALF;

DI unsigned pk2(float a, float b) { f32x2 v = {a, b}; bfv2 r = __builtin_convertvector(v, bfv2); return __builtin_bit_cast(unsigned, r); }
DI float bflo(unsigned u) { return __uint_as_float(u << 16); }
DI float bfhi(unsigned u) { return __uint_as_float(u & 0xffff0000u); }
DI float wave_sum(float v) {
#pragma unroll
    for (int o = 1; o < 64; o <<= 1) v += __shfl_xor(v, o);
    return v;
}
DI int swz128(int r, int c) { return r * 128 + ((c ^ ((r >> 1) & 7)) << 4); }
DI int swz256(int r, int c) { return r * 256 + ((c ^ (r & 15)) << 4); }

DI void p0_mod_item(const Params& p, int item, char* lds) {
    const int kq = item & 7, cbl = item >> 3, li = cbl / 96, cb = cbl % 96;
    const int tid = VTID, lane = tid & 63, w = tid >> 6;
    const float* W = p.mod_w + (size_t)li * 1024 * 6144 + cb * 64 + lane;
    const int kb = kq * 128 + w * 32;
    float acc[9], s[9];
    { const float cv = p.c_ctx[kb + (lane & 31)]; s[0] = cv / (1.f + __expf(-cv)); }
#pragma unroll
    for (int v = 1; v < 9; ++v) { const float cv = p.c[(v - 1) * 1024 + kb + (lane & 31)]; s[v] = cv / (1.f + __expf(-cv)); }
#pragma unroll
    for (int v = 0; v < 9; ++v) acc[v] = 0.f;
#pragma unroll
    for (int kk = 0; kk < 32; ++kk) {
        const float wv = __builtin_nontemporal_load(W + (size_t)(kb + kk) * 6144);
#pragma unroll
        for (int v = 0; v < 9; ++v) acc[v] += __int_as_float(__builtin_amdgcn_readlane(__float_as_int(s[v]), kk)) * wv;
    }
    float* red = (float*)lds;
#pragma unroll
    for (int v = 0; v < 9; ++v) red[(w * 9 + v) * 64 + lane] = acc[v];
    __syncthreads();
    float* mod = (float*)(p.ws + OFF_MOD);
    for (int idx = tid; idx < 576; idx += 256) {
        const int v = idx >> 6, col = idx & 63;
        float sum = red[(0 * 9 + v) * 64 + col] + red[(1 * 9 + v) * 64 + col] + red[(2 * 9 + v) * 64 + col] + red[(3 * 9 + v) * 64 + col];
        if (kq == 0) sum += p.mod_b[li * 6144 + cb * 64 + col];
        atomicAdd(mod + (li * 9 + v) * 6144 + cb * 64 + col, sum);
    }
    __syncthreads();
}

DI void p0_transpose_tile(const float* __restrict__ in, bf16_t* __restrict__ out, int R, int C, int tr, int tc, char* lds) {
    const int tid = VTID;
    const int cl = (tid & 15) * 4, rl = (tid >> 4) * 2, sw = tid & 7;
#pragma unroll
    for (int i = 0; i < 2; ++i) {
        const int r = rl + 32 * i;
        const f32x4 a = *(const f32x4*)(in + (size_t)(tr * 64 + r) * C + tc * 64 + cl);
        const f32x4 b = *(const f32x4*)(in + (size_t)(tr * 64 + r + 1) * C + tc * 64 + cl);
#pragma unroll
        for (int j = 0; j < 4; ++j) *(unsigned*)(lds + (cl + j) * 128 + (((r >> 3) ^ sw) << 4) + (r & 7) * 2) = pk2(a[j], b[j]);
    }
    __syncthreads();
#pragma unroll
    for (int i = 0; i < 2; ++i) {
        const int idx = tid + 256 * i, c = idx >> 3, q = idx & 7;
        const u32x4 v = *(const u32x4*)(lds + c * 128 + ((q ^ ((c >> 2) & 7)) << 4));
        *(u32x4*)(out + (size_t)(tc * 64 + c) * R + tr * 64 + q * 8) = v;
    }
    __syncthreads();
}

DI void p0_kreorder(const float* __restrict__ in, bf16_t* __restrict__ out, int logH, int item) {
    const int tid = VTID, H = 1 << logH;
#pragma unroll
    for (int i = 0; i < 4; ++i) {
        const int f = item * 1024 + tid + 256 * i;
        const int d4 = f & 15, key = (f >> 4) & 255, hh = (f >> 12) & (H - 1), b = f >> (12 + logH);
        const f32x4 v = __builtin_nontemporal_load((const f32x4*)(in + (size_t)f * 4));
        u32x2 o = {pk2(v[0], v[1]), pk2(v[2], v[3])};
        *(u32x2*)(out + ((size_t)(b * 256 + key) * H + hh) * 64 + d4 * 4) = o;
    }
}

struct TJob { const float* in; bf16_t* out; int R, C, tr, tc, late; };
constexpr int P0_TITEMS = 768 + 576 + 512 + 2048 + 2048 + 256 + 256 + 64;
DI TJob p0_decode(const Params& p, int item) {
    TJob j;
    j.late = (item >= 768 && item < 1344) || (item >= 1600 && item < 1856) || (item >= 2880 && item < 3904) || (item >= 4928 && item < 5952);
    if (item < 768) { j.in = p.w_in_even; j.out = (bf16_t*)(p.ws + OFF_WINE); j.R = 1024; j.C = 3072; }
    else if ((item -= 768) < 576) { j.in = p.w_in_odd; j.out = (bf16_t*)(p.ws + OFF_WINO); j.R = 1024; j.C = 2304; }
    else if ((item -= 576) < 512) { const int b = item >> 8; item &= 255; j.in = p.w_out + (size_t)b * 1048576; j.out = (bf16_t*)(p.ws + OFF_WOUT) + (size_t)b * 1048576; j.R = 1024; j.C = 1024; }
    else if ((item -= 512) < 2048) { const int b = item >> 10; item &= 1023; j.in = p.mlp_w1 + (size_t)b * 4194304; j.out = (bf16_t*)(p.ws + OFF_W1) + (size_t)b * 4194304; j.R = 1024; j.C = 4096; }
    else if ((item -= 2048) < 2048) { const int b = item >> 10; item &= 1023; j.in = p.mlp_w2 + (size_t)b * 4194304; j.out = (bf16_t*)(p.ws + OFF_W2) + (size_t)b * 4194304; j.R = 4096; j.C = 1024; }
    else if ((item -= 2048) < 256) { const int b = item >> 3; item &= 7; j.in = p.cache_diff_v + (size_t)b * 32768; j.out = (bf16_t*)(p.ws + OFF_CDVT) + (size_t)b * 32768; j.R = 256; j.C = 128; }
    else if ((item -= 256) < 256) { const int b = item >> 2; item &= 3; j.in = p.cache_na_v + (size_t)b * 16384; j.out = (bf16_t*)(p.ws + OFF_CNVT) + (size_t)b * 16384; j.R = 256; j.C = 64; }
    else { item -= 256; const int b = item >> 2; item &= 3; j.in = p.cache_swa_v + (size_t)b * 16384; j.out = (bf16_t*)(p.ws + OFF_CSVT) + (size_t)b * 16384; j.R = 256; j.C = 64; }
    const int ntc = j.C >> 6;
    j.tr = item / ntc; j.tc = item % ntc;
    return j;
}
DI void p0_tload(const TJob& j, int tid, f32x4 (&a)[2], f32x4 (&b)[2]) {
    const int cl = (tid & 15) * 4, rl = (tid >> 4) * 2;
#pragma unroll
    for (int i = 0; i < 2; ++i) {
        const int r = rl + 32 * i;
        a[i] = __builtin_nontemporal_load((const f32x4*)(j.in + (size_t)(j.tr * 64 + r) * j.C + j.tc * 64 + cl));
        b[i] = __builtin_nontemporal_load((const f32x4*)(j.in + (size_t)(j.tr * 64 + r + 1) * j.C + j.tc * 64 + cl));
    }
}
DI void p0_phase(const Params& p, int bid, int nb, char* lds) {
    for (int it = bid; it < 1536; it += nb) p0_mod_item(p, it, lds);
    const int tid = VTID;
    {
        const int cl = (tid & 15) * 4, rl = (tid >> 4) * 2, sw = tid & 7;
        const int first = bid, stride = nb, lim = P0_TITEMS;
#define P0_PROC(J, A, B) do { \
            _Pragma("unroll") for (int i = 0; i < 2; ++i) { const int r = rl + 32 * i; \
                _Pragma("unroll") for (int jj = 0; jj < 4; ++jj) *(unsigned*)(lds + (cl + jj) * 128 + (((r >> 3) ^ sw) << 4) + (r & 7) * 2) = pk2(A[i][jj], B[i][jj]); } \
            asm volatile("s_waitcnt lgkmcnt(0)\n\ts_barrier" ::: "memory"); \
            _Pragma("unroll") for (int i = 0; i < 2; ++i) { const int idx = tid + 256 * i, c = idx >> 3, q = idx & 7; \
                const u32x4 v = *(const u32x4*)(lds + c * 128 + ((q ^ ((c >> 2) & 7)) << 4)); \
                u32x4* dst = (u32x4*)(J.out + (size_t)(J.tc * 64 + c) * J.R + J.tr * 64 + q * 8); \
                if (J.late) __builtin_nontemporal_store(v, dst); else *dst = v; } \
            asm volatile("s_waitcnt lgkmcnt(0)\n\ts_barrier" ::: "memory"); } while (0)
        int it = first;
        TJob j0 = p0_decode(p, it < lim ? it : first), j1;
        f32x4 a0[2], b0[2], a1[2], b1[2];
        p0_tload(j0, tid, a0, b0);
        while (it < lim) {
            { const int nx = it + stride; j1 = p0_decode(p, nx < lim ? nx : first); p0_tload(j1, tid, a1, b1); }
            P0_PROC(j0, a0, b0);
            it += stride;
            if (it >= lim) break;
            { const int nx = it + stride; j0 = p0_decode(p, nx < lim ? nx : first); p0_tload(j0, tid, a0, b0); }
            P0_PROC(j1, a1, b1);
            it += stride;
        }
#undef P0_PROC
    }
    {
        f32x4* st4 = (f32x4*)(p.ws + OFF_STAT);
        const f32x4 z = {0.f, 0.f, 0.f, 0.f};
        for (int i = bid * 256 + tid; i < (int)(4 * STAT_SET / 16); i += nb * 256) st4[i] = z;
    }
    for (int it = bid; it < 576; it += nb) {
        if (it < 256) p0_kreorder(p.cache_diff_k, (bf16_t*)(p.ws + OFF_CDK), 3, it);
        else if (it < 512) p0_kreorder(p.cache_na_k, (bf16_t*)(p.ws + OFF_CNK), 3, it - 256);
        else p0_kreorder(p.cache_swa_k, (bf16_t*)(p.ws + OFF_CSK), 1, it - 512);
    }
}

DI void rowop_phase(const Params& p, bool hasY, bool xin_input, int g_off, const float* wpost, bool hasH, const float* wpre, int sc_off, int sh_off) {
    const int tix = TIDX, lane = tix & 63, gw = (int)(blockIdx.x * 8) + (tix >> 6), nw = VNB * 4;
    const float* mod = (const float*)(p.ws + OFF_MOD);
    f32x4 wpo[4], wpr[4];
#pragma unroll
    for (int i = 0; i < 4; ++i) { if (hasY) wpo[i] = *(const f32x4*)(wpost + lane * 4 + 256 * i); if (hasH) wpr[i] = *(const f32x4*)(wpre + lane * 4 + 256 * i); }
    for (int row0 = gw; row0 < 16384; row0 += 2 * nw) {
        f32x4 x[2][4], y[2][4];
#pragma unroll
        for (int r = 0; r < 2; ++r) {
            const int row = row0 + r * nw;
            const float* xin = xin_input ? (row < 8192 ? p.x_prompt + (size_t)row * 1024 : p.x_sample + (size_t)(row - 8192) * 1024) : p.out + (size_t)row * 1024;
            const float* yin = (const float*)(p.ws + OFF_HY + (size_t)row * 4096);
#pragma unroll
            for (int i = 0; i < 4; ++i) { x[r][i] = __builtin_nontemporal_load((const f32x4*)(xin + lane * 4 + 256 * i)); if (hasY) y[r][i] = *(const f32x4*)(yin + lane * 4 + 256 * i); }
        }
#pragma unroll
        for (int r = 0; r < 2; ++r) {
            const int row = row0 + r * nw;
            const int v = row < 8192 ? 0 : 1 + ((row - 8192) >> 10);
            char* hy = p.ws + OFF_HY + (size_t)row * 4096;
            if (hasY) {
                f32x4 g4[4];
#pragma unroll
                for (int i = 0; i < 4; ++i) g4[i] = *(const f32x4*)(mod + v * 6144 + g_off + lane * 4 + 256 * i);
                float ss = 0.f;
#pragma unroll
                for (int i = 0; i < 4; ++i) ss += y[r][i][0] * y[r][i][0] + y[r][i][1] * y[r][i][1] + y[r][i][2] * y[r][i][2] + y[r][i][3] * y[r][i][3];
                ss = wave_sum(ss);
                const float rs = rsqrtf(ss * (1.f / 1024.f) + EPSN);
#pragma unroll
                for (int i = 0; i < 4; ++i) {
                    x[r][i] += g4[i] * (y[r][i] * rs * wpo[i]);
                    *(f32x4*)(p.out + (size_t)row * 1024 + lane * 4 + 256 * i) = x[r][i];
                }
            }
            if (hasH) {
                f32x4 sc[4], sh[4];
#pragma unroll
                for (int i = 0; i < 4; ++i) { sc[i] = *(const f32x4*)(mod + v * 6144 + sc_off + lane * 4 + 256 * i); sh[i] = *(const f32x4*)(mod + v * 6144 + sh_off + lane * 4 + 256 * i); }
                float ss = 0.f;
#pragma unroll
                for (int i = 0; i < 4; ++i) ss += x[r][i][0] * x[r][i][0] + x[r][i][1] * x[r][i][1] + x[r][i][2] * x[r][i][2] + x[r][i][3] * x[r][i][3];
                ss = wave_sum(ss);
                const float rs = rsqrtf(ss * (1.f / 1024.f) + EPSN);
#pragma unroll
                for (int i = 0; i < 4; ++i) {
                    const f32x4 h = x[r][i] * rs * wpr[i] * (sc[i] + 1.f) + sh[i];
                    u32x2 o = {pk2(h[0], h[1]), pk2(h[2], h[3])};
                    *(u32x2*)((bf16_t*)hy + lane * 4 + 256 * i) = o;
                }
            }
        }
    }
}

namespace g8 {
constexpr int BK = 64, HALF = 128, HTB = HALF * BK * 2;
DI int lds_byte(int r, int c) { const int st = (r >> 4) * 2 + (c >> 5), rr = r & 15, cc = c & 31, ob = rr * 64 + cc * 2; return st * 1024 + (ob ^ (((ob >> 9) & 1) << 5)); }
DI void stage_rc(int b, int& R, int& C) { const int st = b / 1024, sb = b % 1024, swz = sb ^ (((sb >> 9) & 1) << 5); R = (st >> 1) * 16 + swz / 64; C = (st & 1) * 32 + (swz % 64) / 2; }
typedef __attribute__((address_space(3))) unsigned lds_u32;
typedef __attribute__((address_space(3))) unsigned char lds_u8;
typedef __attribute__((address_space(3))) bf16x8 lds_bf16x8;

}

enum { EPI_PE = 0, EPI_PO = 1, EPI_Y = 2, EPI_W1 = 3, EPI_YF = 4 };

struct FuseP { int from_input, hasH; float* xout; const float* g; const float* wpost; const float* wpre; const float* sc; const float* sh; float* ssY; float* ssX; unsigned* cnt; };
DI float ld_agent(const float* q) { return __hip_atomic_load(q, __ATOMIC_RELAXED, __HIP_MEMORY_SCOPE_AGENT); }
DI void panel_wait(unsigned* c, unsigned target) {
    asm volatile("s_waitcnt vmcnt(0)" ::: "memory");
    __syncthreads();
    if (threadIdx.x == 0) {
        __hip_atomic_fetch_add(c, 1u, __ATOMIC_RELAXED, __HIP_MEMORY_SCOPE_AGENT);
        unsigned sp = 0;
        while (__hip_atomic_load(c, __ATOMIC_RELAXED, __HIP_MEMORY_SCOPE_AGENT) < target) { __builtin_amdgcn_s_sleep(1); if (++sp > (1u << 22)) break; }
    }
    __syncthreads();
}
DI float dot4(const f32x4& a) { return a[0] * a[0] + a[1] * a[1] + a[2] * a[2] + a[3] * a[3]; }

DI void rope_s(f32x4 (&sub)[4][2], int R0, bool usecol, int fr, int fq) {
    asm volatile("" : "+s"(R0));
    const float sgn = fq < 2 ? -1.f : 1.f;
#pragma unroll
    for (int m = 0; m < 4; ++m) {
        __builtin_amdgcn_sched_barrier(0);
        const int tl = (R0 + m * 16 + fr - 8192) & 1023;
        const float pos = (float)(usecol ? (tl & 63) : (tl >> 6));
#pragma unroll
        for (int n = 0; n < 2; ++n)
#pragma unroll
            for (int j = 0; j < 4; ++j) {
                const float inv = exp2f(-(float)(8 * (fq & 1) + 4 * n + j) * (13.287712379549449f / 16.f));
                float sn, cs;
                __sincosf(pos * inv, &sn, &cs);
                const float v = sub[m][n][j], pv = __shfl_xor(v, 32);
                sub[m][n][j] = v * cs + sgn * pv * sn;
            }
    }
}
DI void store_bf16_rows_s(const f32x4 (&sub)[4][2], bf16_t* base, int ld, int R0, int Cd0, int fr, int fq) {
#pragma unroll
    for (int m = 0; m < 4; ++m) {
        u32x4 o = {pk2(sub[m][0][0], sub[m][0][1]), pk2(sub[m][0][2], sub[m][0][3]), pk2(sub[m][1][0], sub[m][1][1]), pk2(sub[m][1][2], sub[m][1][3])};
        *(u32x4*)(base + (size_t)(R0 + m * 16 + fr) * ld + Cd0 + fq * 8) = o;
    }
}
DI void store_f32_rows_s(const f32x4 (&sub)[4][2], float* ob, int ldo, int fr, int fq) {
#pragma unroll
    for (int m = 0; m < 4; ++m) {
        float* rp = ob + (size_t)(m * 16 + fr) * ldo + fq * 8;
#pragma unroll
        for (int n = 0; n < 2; ++n) __builtin_nontemporal_store(sub[m][n], (f32x4*)(rp + n * 4));
    }
}
DI void store_vt_s(const f32x4 (&sub)[4][2], bf16_t* vt, int T, int t0, int fr, int fq) {
#pragma unroll
    for (int n = 0; n < 2; ++n) {
        bf16_t* rp = vt + (size_t)(8 * (fr >> 2) + 4 * n + (fr & 3)) * T + t0 + fq * 4;
#pragma unroll
        for (int m = 0; m < 4; ++m) { u32x2 o = {pk2(sub[m][n][0], sub[m][n][1]), pk2(sub[m][n][2], sub[m][n][3])}; *(u32x2*)(rp + m * 16) = o; }
    }
}
DI void store_f32_ns_s(const f32x4 (&sub)[4][2], float* ob, int ldo, int fr, int fq) {
#pragma unroll
    for (int m = 0; m < 4; ++m)
#pragma unroll
        for (int j = 0; j < 4; ++j) {
            float* rp = ob + (size_t)(m * 16 + fq * 4 + j) * ldo + 8 * (fr >> 2) + (fr & 3);
#pragma unroll
            for (int n = 0; n < 2; ++n) __builtin_nontemporal_store(sub[m][n][j], rp + n * 4);
        }
}

template <int EPI>
DI void tile_epilogue(const Params& p, f32x4 (&acc)[2][2][4][2], int pm, int pn, int vtm, const FuseP& fz) {
    const int tix = TIDX, wid = __builtin_amdgcn_readfirstlane(tix >> 6), lane = tix & 63, wr = wid >> 2, wc = wid & 3;
    const int brow = pm * 256, bcol = pn * 256;
    int fr = lane & 15, fq = lane >> 4;
    asm volatile("" : "+v"(fr), "+v"(fq));
    const bool latent = brow >= 8192;
    int b, tb, T;
    if (latent) { b = (brow - 8192) >> 10; tb = (brow - 8192) & 1023; T = 1024; } else { b = brow >> 8; tb = 0; T = 256; }
    bf16_t* big = (bf16_t*)(p.ws + OFF_BIG);
    if (EPI == EPI_YF) {
        const int v = latent ? 1 + b : 0;
        const int rbase = brow + wr * 64 + fr;
        const int cbase = bcol + wc * 32 + fq * 8;
        float rs[2][4];
#pragma unroll
        for (int ai = 0; ai < 2; ++ai)
#pragma unroll
            for (int m = 0; m < 4; ++m) {
                float sq = dot4(acc[ai][0][m][0]) + dot4(acc[ai][0][m][1]) + dot4(acc[ai][1][m][0]) + dot4(acc[ai][1][m][1]);
                sq += __shfl_xor(sq, 16); sq += __shfl_xor(sq, 32);
                if (fq == 0) { const float old = __hip_atomic_fetch_add(fz.ssY + rbase + ai * 128 + m * 16, sq, __ATOMIC_RELAXED, __HIP_MEMORY_SCOPE_AGENT); asm volatile("" :: "v"(old)); }
            }
        panel_wait(fz.cnt + pm * 32, 4u);
#pragma unroll
        for (int ai = 0; ai < 2; ++ai)
#pragma unroll
            for (int m = 0; m < 4; ++m) rs[ai][m] = rsqrtf(ld_agent(fz.ssY + rbase + ai * 128 + m * 16) * (1.f / 1024.f) + EPSN);
        const float* xin = latent ? p.x_sample - (size_t)8192 * 1024 : p.x_prompt;
        bf16_t* xb = (bf16_t*)(p.ws + OFF_HY) + 1024;
        float s2[2][4];
#pragma unroll
        for (int ai = 0; ai < 2; ++ai)
#pragma unroll
            for (int m = 0; m < 4; ++m) s2[ai][m] = 0.f;
#pragma unroll
        for (int bj = 0; bj < 2; ++bj) {
            const int col = cbase + bj * 128;
            f32x4 g4[2], wp4[2];
#pragma unroll
            for (int n = 0; n < 2; ++n) { g4[n] = *(const f32x4*)(fz.g + v * 6144 + col + 4 * n); wp4[n] = *(const f32x4*)(fz.wpost + col + 4 * n); }
#pragma unroll
            for (int ai = 0; ai < 2; ++ai)
#pragma unroll
                for (int m = 0; m < 4; ++m) {
                    const size_t off = (size_t)(rbase + ai * 128 + m * 16) * 1024 + col;
                    f32x4 x4[2];
                    if (fz.from_input) { x4[0] = __builtin_nontemporal_load((const f32x4*)(xin + off)); x4[1] = __builtin_nontemporal_load((const f32x4*)(xin + off + 4)); }
                    else {
                        const u32x4 xr = __builtin_nontemporal_load((const u32x4*)(xb + 2 * off - col));
                        x4[0] = (f32x4){bflo(xr[0]), bfhi(xr[0]), bflo(xr[1]), bfhi(xr[1])}; x4[1] = (f32x4){bflo(xr[2]), bfhi(xr[2]), bflo(xr[3]), bfhi(xr[3])};
                    }
                    f32x4 a[2];
#pragma unroll
                    for (int n = 0; n < 2; ++n) { a[n] = x4[n] + g4[n] * (acc[ai][bj][m][n] * rs[ai][m] * wp4[n]); acc[ai][bj][m][n] = a[n]; s2[ai][m] += dot4(a[n]); }
                    if (fz.hasH) { u32x4 xo = {pk2(a[0][0], a[0][1]), pk2(a[0][2], a[0][3]), pk2(a[1][0], a[1][1]), pk2(a[1][2], a[1][3])}; *(u32x4*)(xb + 2 * off - col) = xo; }
                    else { __builtin_nontemporal_store(a[0], (f32x4*)(fz.xout + off)); __builtin_nontemporal_store(a[1], (f32x4*)(fz.xout + off + 4)); }
                }
        }
        if (fz.hasH) {
#pragma unroll
            for (int ai = 0; ai < 2; ++ai)
#pragma unroll
                for (int m = 0; m < 4; ++m) {
                    float sq = s2[ai][m];
                    sq += __shfl_xor(sq, 16); sq += __shfl_xor(sq, 32);
                    if (fq == 0) { const float old = __hip_atomic_fetch_add(fz.ssX + rbase + ai * 128 + m * 16, sq, __ATOMIC_RELAXED, __HIP_MEMORY_SCOPE_AGENT); asm volatile("" :: "v"(old)); }
                }
            panel_wait(fz.cnt + pm * 32 + 16, 4u);
#pragma unroll
            for (int ai = 0; ai < 2; ++ai)
#pragma unroll
                for (int m = 0; m < 4; ++m) rs[ai][m] = rsqrtf(ld_agent(fz.ssX + rbase + ai * 128 + m * 16) * (1.f / 1024.f) + EPSN);
            bf16_t* hb = (bf16_t*)(p.ws + OFF_HY);
#pragma unroll
            for (int bj = 0; bj < 2; ++bj) {
                const int col = cbase + bj * 128;
                f32x4 wq4[2], sc4[2], sh4[2];
#pragma unroll
                for (int n = 0; n < 2; ++n) { wq4[n] = *(const f32x4*)(fz.wpre + col + 4 * n); sc4[n] = *(const f32x4*)(fz.sc + v * 6144 + col + 4 * n) + 1.f; sh4[n] = *(const f32x4*)(fz.sh + v * 6144 + col + 4 * n); }
#pragma unroll
                for (int ai = 0; ai < 2; ++ai)
#pragma unroll
                    for (int m = 0; m < 4; ++m) {
                        const f32x4 h0 = acc[ai][bj][m][0] * rs[ai][m] * wq4[0] * sc4[0] + sh4[0], h1 = acc[ai][bj][m][1] * rs[ai][m] * wq4[1] * sc4[1] + sh4[1];
                        u32x4 o = {pk2(h0[0], h0[1]), pk2(h0[2], h0[3]), pk2(h1[0], h1[1]), pk2(h1[2], h1[3])};
                        *(u32x4*)(hb + (size_t)(rbase + ai * 128 + m * 16) * 2048 + col) = o;
                    }
            }
        }
        return;
    }
#pragma unroll
    for (int ai = 0; ai < 2; ++ai)
#pragma unroll
        for (int bj = 0; bj < 2; ++bj) {
            __builtin_amdgcn_sched_barrier(0);
            f32x4 (&sub)[4][2] = acc[ai][bj];
            const int R0 = brow + ai * 128 + wr * 64, t0 = tb + ai * 128 + wr * 64, C0 = bcol + bj * 128 + wc * 32;
            const bool ns = vtm == 1 || (vtm == 2 && bj == 1);
            if (EPI == EPI_PE) {
                if (ns) {
                    const int vc = C0 - 2560;
                    bf16_t* vt = (bf16_t*)(p.ws + OFF_BIG + BIG_VT_E) + (latent ? (size_t)4194304 + ((size_t)b * 512 + vc) * 1024 : ((size_t)b * 512 + vc) * 256);
                    store_vt_s(sub, vt, T, t0, fr, fq);
                    if (!latent) store_f32_ns_s(sub, p.out + OUT_DIFFV + ((size_t)(b * 4 + (vc >> 7)) * 256 + t0) * 128 + (vc & 127), 128, fr, fq);
                } else {
                    if (pn >= 6 && latent) rope_s(sub, R0, wc & 1, fr, fq);
                    store_bf16_rows_s(sub, big, LDE, R0, C0, fr, fq);
                    if (pn >= 8 && !latent) store_f32_rows_s(sub, p.out + OUT_DIFFK + ((size_t)(b * 8 + ((C0 - 2048) >> 6)) * 256 + t0) * 64 + ((C0 - 2048) & 63), 64, fr, fq);
                }
            } else if (EPI == EPI_PO) {
                if (ns) {
                    if (pn < 8) {
                        const int vc = C0 - 1024;
                        bf16_t* vt = (bf16_t*)(p.ws + OFF_BIG + BIG_VT_C) + (latent ? (size_t)4194304 + ((size_t)b * 512 + vc) * 1024 : ((size_t)b * 512 + vc) * 256);
                        store_vt_s(sub, vt, T, t0, fr, fq);
                        if (!latent) store_f32_ns_s(sub, p.out + OUT_NAV + ((size_t)(b * 8 + (vc >> 6)) * 256 + t0) * 64 + (vc & 63), 64, fr, fq);
                    } else {
                        const int vc = C0 - 2176;
                        bf16_t* vt = (bf16_t*)(p.ws + OFF_BIG + BIG_VT_D) + (latent ? (size_t)1048576 + ((size_t)b * 128 + vc) * 1024 : ((size_t)b * 128 + vc) * 256);
                        store_vt_s(sub, vt, T, t0, fr, fq);
                        if (!latent) store_f32_ns_s(sub, p.out + OUT_SWAV + ((size_t)(b * 2 + (vc >> 6)) * 256 + t0) * 64 + (vc & 63), 64, fr, fq);
                    }
                } else {
                    if (pn >= 6 && latent) rope_s(sub, R0, wc & 1, fr, fq);
                    store_bf16_rows_s(sub, big, LDO, R0, pn >= 6 ? C0 - 512 : C0, fr, fq);
                    if (!latent) {
                        if (pn == 2 || pn == 3) store_f32_rows_s(sub, p.out + OUT_NAK + ((size_t)(b * 8 + ((C0 - 512) >> 6)) * 256 + t0) * 64 + ((C0 - 512) & 63), 64, fr, fq);
                        else if (pn == 8) store_f32_rows_s(sub, p.out + OUT_SWAK + ((size_t)(b * 2 + ((C0 - 2048) >> 6)) * 256 + t0) * 64 + ((C0 - 2048) & 63), 64, fr, fq);
                    }
                }
            } else if (EPI == EPI_Y) {
                store_f32_rows_s(sub, (float*)(p.ws + OFF_HY) + (size_t)R0 * 1024 + C0, 1024, fr, fq);
            } else {
#pragma unroll
                for (int m = 0; m < 4; ++m)
#pragma unroll
                    for (int n = 0; n < 2; ++n)
#pragma unroll
                        for (int j = 0; j < 4; ++j) { const float v = fmaxf(sub[m][n][j], 0.f); sub[m][n][j] = v * v; }
                store_bf16_rows_s(sub, big, 4096, R0, C0, fr, fq);
            }
        }
}

template <int EPI>
DI void gemm_phase(const Params& p, const bf16_t* A, int lda, const bf16_t* Bt, int K, int NT_N, char* shm, const FuseP& fz = FuseP{}) {
    using namespace g8;
    const int xcd = blockIdx.x & 7, lb = blockIdx.x >> 3, nlb = gridDim.x >> 3, per_xcd = 8 * NT_N;
    if (lb >= per_xcd) return;
    const int tid = TIDX, wid = __builtin_amdgcn_readfirstlane(tid >> 6), lane = tid & 63, wr = wid >> 2, wc = wid & 3, fr = lane & 15, fq = lane >> 4;
    const int nt = K / BK;
    lds_u8* lds = (lds_u8*)shm;
    unsigned voffA[2], voffB[2];
#pragma unroll
    for (int _i = 0; _i < 2; ++_i) { int _r, _c; stage_rc(tid * 16 + _i * 8192, _r, _c); const int _i16 = _r & 15, _rb = (_r & ~31) + 8 * (_i16 >> 2) + 4 * ((_r >> 4) & 1) + (_i16 & 3);
        voffA[_i] = (unsigned)(_r * lda + _c) * 2u; voffB[_i] = (unsigned)(_rb * K + _c) * 2u; }
    const size_t kstep = (size_t)BK * 2, hstepA = (size_t)HALF * lda * 2, hstepB = (size_t)HALF * K * 2;
    const unsigned ldsw = (unsigned)wid * 1024u;
    const int aoff = lds_byte(wr * 64 + fr, fq * 8), boff = lds_byte(wc * 32 + fr, fq * 8);
#define SA(b, h) (((b) * 2 + (h)) * HTB)
#define SB(b, h) ((4 + (b) * 2 + (h)) * HTB)
#define STAGE(bufoff, gbase, voff) do { _Pragma("unroll") for (int _i = 0; _i < 2; ++_i) \
      __builtin_amdgcn_global_load_lds((const unsigned*)((gbase) + (voff)[_i]), (lds_u32*)(lds + (bufoff) + ldsw + _i * 8192), 16, 0, 0); } while (0)
#define LDA(dst, b, h) _Pragma("unroll") for (int m = 0; m < 4; ++m) _Pragma("unroll") for (int k = 0; k < 2; ++k) \
    dst[m][k] = *(const lds_bf16x8*)(lds + SA(b, h) + aoff + m * 2048 + k * 1024)
#define LDB(dst, b, h) _Pragma("unroll") for (int n = 0; n < 2; ++n) _Pragma("unroll") for (int k = 0; k < 2; ++k) \
    dst[n][k] = *(const lds_bf16x8*)(lds + SB(b, h) + boff + n * 2048 + k * 1024)
#define MMA(VT, ai, bj, At_, Bt_) do { __builtin_amdgcn_s_setprio(1); \
    _Pragma("unroll") for (int m = 0; m < 4; ++m) _Pragma("unroll") for (int n = 0; n < 2; ++n) _Pragma("unroll") for (int k = 0; k < 2; ++k) \
      acc[ai][bj][m][n] = ((VT) == 1 || ((VT) == 2 && (bj) == 1)) ? MFMA16(At_[m][k], Bt_[n][k], acc[ai][bj][m][n]) : MFMA16(Bt_[n][k], At_[m][k], acc[ai][bj][m][n]); \
    __builtin_amdgcn_s_setprio(0); } while (0)
#define WAIT_V(n) asm volatile("s_waitcnt vmcnt(" #n ")" ::: "memory")
#define WAIT_L(n) asm volatile("s_waitcnt lgkmcnt(" #n ")" ::: "memory")
#define BAR __builtin_amdgcn_s_barrier()
#define SCHED __builtin_amdgcn_sched_barrier(0)
#define TLOOP(VT) for (int t = 0; t < nt; t += 2) { \
        const bool last = (t == nt - 2); \
        const char* a1 = cA + (size_t)(t + 1) * kstep; \
        const char* a2 = last ? nA : cA + (size_t)(t + 2) * kstep; const char* b2 = last ? nB : cB + (size_t)(t + 2) * kstep; \
        const char* a3 = a2 + kstep; const char* b3 = b2 + kstep; \
        LDB(B0, 0, 0); LDB(B1, 0, 1); SCHED; LDA(At, 0, 0); STAGE(SA(1, 1), a1 + hstepA, voffA); \
        WAIT_V(8); WAIT_L(0); BAR; MMA(VT, 0, 0, At, B0); MMA(VT, 0, 1, At, B1); BAR; SCHED; \
        LDA(At, 0, 1); STAGE(SB(0, 0), b2, voffB); STAGE(SB(0, 1), b2 + hstepB, voffB); STAGE(SA(0, 0), a2, voffA); \
        WAIT_V(8); WAIT_L(0); BAR; MMA(VT, 1, 0, At, B0); MMA(VT, 1, 1, At, B1); BAR; SCHED; \
        LDB(B0, 1, 0); LDB(B1, 1, 1); SCHED; LDA(At, 1, 0); STAGE(SA(0, 1), a2 + hstepA, voffA); \
        WAIT_V(8); WAIT_L(0); BAR; MMA(VT, 0, 0, At, B0); MMA(VT, 0, 1, At, B1); BAR; SCHED; \
        LDA(At, 1, 1); STAGE(SB(1, 0), b3, voffB); STAGE(SB(1, 1), b3 + hstepB, voffB); STAGE(SA(1, 0), a3, voffA); \
        WAIT_V(8); WAIT_L(0); BAR; MMA(VT, 1, 0, At, B0); MMA(VT, 1, 1, At, B1); BAR; SCHED; \
    }
    int lt = lb, pm = xcd * 8 + (lt & 7), pn = lt >> 3;
    f32x4 acc[2][2][4][2];
#pragma unroll
    for (int a = 0; a < 2; ++a)
#pragma unroll
        for (int b = 0; b < 2; ++b)
#pragma unroll
            for (int m = 0; m < 4; ++m)
#pragma unroll
                for (int n = 0; n < 2; ++n) acc[a][b][m][n] = (f32x4){0.f, 0.f, 0.f, 0.f};
    bf16x8 At[4][2], B0[2][2], B1[2][2];
    const char* cA = (const char*)A + (size_t)pm * 2 * hstepA;
    const char* cB = (const char*)Bt + (size_t)pn * 2 * hstepB;
    WAIT_V(0);
    STAGE(SB(0, 0), cB, voffB); STAGE(SB(0, 1), cB + hstepB, voffB); STAGE(SA(0, 0), cA, voffA); STAGE(SA(0, 1), cA + hstepA, voffA);
    if (wr == 1) BAR;
    WAIT_V(2); BAR;
    STAGE(SB(1, 0), cB + kstep, voffB); STAGE(SA(1, 0), cA + kstep, voffA); STAGE(SB(1, 1), cB + hstepB + kstep, voffB);
    WAIT_V(6); BAR;
    for (;;) {
        const int ltn = lt + nlb;
        const bool has_next = ltn < per_xcd;
        const int pmn = xcd * 8 + (ltn & 7), pnn = ltn >> 3;
        const char* nA = has_next ? (const char*)A + (size_t)pmn * 2 * hstepA : cA;
        const char* nB = has_next ? (const char*)Bt + (size_t)pnn * 2 * hstepB : cB;
        int vtm = 0;
        if (EPI == EPI_PE) vtm = pn >= 10 ? 1 : 0;
        if (EPI == EPI_PO) vtm = (pn == 4 || pn == 5) ? 1 : (pn == 8 ? 2 : 0);
        if ((EPI == EPI_PE || EPI == EPI_PO) && vtm == 1) { TLOOP(1) }
        else if (EPI == EPI_PO && vtm == 2) { TLOOP(2) }
        else { TLOOP(0) }
        if (wr == 0) BAR;
        if (EPI != EPI_YF) tile_epilogue<EPI>(p, acc, pm, pn, vtm, fz);
        if (!has_next) break;
#pragma unroll
        for (int a = 0; a < 2; ++a)
#pragma unroll
            for (int b = 0; b < 2; ++b)
#pragma unroll
                for (int m = 0; m < 4; ++m)
#pragma unroll
                    for (int n = 0; n < 2; ++n) acc[a][b][m][n] = (f32x4){0.f, 0.f, 0.f, 0.f};
        lt = ltn; pm = pmn; pn = pnn; cA = nA; cB = nB;
        if (wr == 1) BAR;
    }
    WAIT_V(0);
    BAR;
    if (EPI == EPI_YF) tile_epilogue<EPI>(p, acc, pm, pn, 0, fz);
#undef SA
#undef SB
#undef STAGE
#undef LDA
#undef LDB
#undef MMA
#undef WAIT_V
#undef WAIT_L
#undef BAR
#undef SCHED
#undef TLOOP
}

struct ASeg { const bf16_t* K; const bf16_t* Vt; int ldk, ldv, ntiles; };
struct MaskP { int on, a, b, c; const float* tab; };

template <int KW, int VR, int NB, int MODE>
DI void attn_core(const ASeg& s0, const ASeg& s1, const bf16x8 (&qf)[4], int kchunk0, int vrow0, float scale_l2, float& m, float& l, f32x16 (&O)[NB], char* lds, const MaskP& mp) {
    constexpr int KC = KW / 8, NKL = 64 * KC / 256, NVL = VR * 8 / 256;
    const int tid = VTID, lane = tid & 63, p32 = lane & 31, h = lane >> 5;
    const int krow = (p32 & 19) | ((p32 & 4) << 1) | ((p32 & 8) >> 1);
    const int n0 = s0.ntiles, nt = s0.ntiles + s1.ntiles;
    u32x4 rk[NKL], rv[NVL];
#define ATT_LOAD(t_)                                                                                                         \
    {                                                                                                                        \
        const bool f_ = (t_) < n0; const int tt_ = f_ ? (t_) : (t_) - n0;                                                     \
        const bf16_t* Kp_ = (f_ ? s0.K : s1.K); const int ldk_ = f_ ? s0.ldk : s1.ldk;                                        \
        const bf16_t* Vp_ = (f_ ? s0.Vt : s1.Vt); const int ldv_ = f_ ? s0.ldv : s1.ldv;                                      \
        _Pragma("unroll") for (int i = 0; i < NKL; ++i) { const int id = tid + 256 * i, r = id / KC, c = id % KC; rk[i] = *(const u32x4*)(Kp_ + (size_t)(tt_ * 64 + r) * ldk_ + c * 8); } \
        _Pragma("unroll") for (int i = 0; i < NVL; ++i) { const int id = tid + 256 * i, r = id >> 3, c = id & 7; rv[i] = *(const u32x4*)(Vp_ + (size_t)r * ldv_ + tt_ * 64 + c * 8); }       \
    }
#define ATT_STORE(b_)                                                                                                        \
    {                                                                                                                        \
        char* kb_ = lds + (b_) * 32768; char* vb_ = kb_ + 16384;                                                              \
        _Pragma("unroll") for (int i = 0; i < NKL; ++i) { const int id = tid + 256 * i, r = id / KC, c = id % KC; *(u32x4*)(kb_ + (KW == 128 ? swz256(r, c) : swz128(r, c))) = rk[i]; } \
        _Pragma("unroll") for (int i = 0; i < NVL; ++i) { const int id = tid + 256 * i, r = id >> 3, c = id & 7; *(u32x4*)(vb_ + swz128(r, c)) = rv[i]; }                               \
    }
    int dco[2][16];
    if (MODE == 1) {
        const int cq = mp.c + p32, cs = min(max(cq - 8, 0), 48);
#pragma unroll
        for (int kh = 0; kh < 2; ++kh)
#pragma unroll
            for (int i = 0; i < 16; ++i) {
                const int kc = 32 * kh + 16 * (i >> 3) + 8 * h + (i & 7);
                dco[kh][i] = ((unsigned)(kc - cs) < 16u ? min(max(kc - cq + 15, 0), 30) : 31) * 4;
            }
    }
    ATT_LOAD(0);
    ATT_STORE(0);
    __syncthreads();
    for (int t = 0; t < nt; ++t) {
        const bool more = t + 1 < nt;
        if (more) ATT_LOAD(t + 1);
        const char* kb = lds + (t & 1) * 32768;
        const char* vb = kb + 16384;
        f32x16 S[2];
#pragma unroll
        for (int kh = 0; kh < 2; ++kh) {
#pragma unroll
            for (int i = 0; i < 16; ++i) S[kh][i] = 0.f;
            const int row = krow + 32 * kh;
#pragma unroll
            for (int s = 0; s < 4; ++s) {
                const int c = kchunk0 + 2 * s + h;
                const bf16x8 kf = *(const bf16x8*)(kb + (KW == 128 ? swz256(row, c) : swz128(row, c)));
                S[kh] = MFMA32(kf, qf[s], S[kh]);
            }
        }
        const bool msk = (MODE != 0) && mp.on && t < n0;
        float mx = -1e30f;
        if (MODE == 1 && msk) {
            const char* trow = (const char*)(mp.tab + (mp.b + t - mp.a + 7) * 32);
#pragma unroll
            for (int kh = 0; kh < 2; ++kh)
#pragma unroll
                for (int i = 0; i < 16; ++i) {
                    const float sv = __builtin_fmaf(S[kh][i], scale_l2, *(const float*)(trow + dco[kh][i]));
                    S[kh][i] = sv; mx = fmaxf(mx, sv);
                }
        } else if (MODE == 2 && msk) {
            int qp = mp.a + p32 - 8 * h;
            asm volatile("" : "+v"(qp));
            const int k0 = mp.b + t * 64;
#pragma unroll
            for (int kh = 0; kh < 2; ++kh)
#pragma unroll
                for (int i = 0; i < 16; ++i) {
                    const int d = qp - (k0 + 32 * kh + 16 * (i >> 3) + (i & 7));
                    const bool ok = d <= 128 && d >= -128;
                    const float sv = ok ? S[kh][i] * scale_l2 : -1e30f;
                    S[kh][i] = sv; mx = fmaxf(mx, sv);
                }
        } else {
            float m0 = fmaxf(fmaxf(S[0][0], S[0][1]), S[0][2]), m1 = fmaxf(fmaxf(S[1][0], S[1][1]), S[1][2]);
#pragma unroll
            for (int i = 3; i < 15; i += 2) { m0 = fmaxf(fmaxf(m0, S[0][i]), S[0][i + 1]); m1 = fmaxf(fmaxf(m1, S[1][i]), S[1][i + 1]); }
            mx = fmaxf(fmaxf(m0, m1), fmaxf(S[0][15], S[1][15])) * scale_l2;
        }
        mx = fmaxf(mx, __shfl_xor(mx, 32));
        if (__any(mx > m + 8.f)) {
            const float mn = fmaxf(m, mx);
            const float alpha = __builtin_amdgcn_exp2f(m - mn);
            m = mn;
            l *= alpha;
#pragma unroll
            for (int blk = 0; blk < NB; ++blk)
#pragma unroll
                for (int i = 0; i < 16; ++i) O[blk][i] *= alpha;
        }
        float ls = 0.f;
        if ((MODE == 1 || MODE == 2) && msk) {
#pragma unroll
            for (int kh = 0; kh < 2; ++kh)
#pragma unroll
                for (int i = 0; i < 16; ++i) { const float pv = __builtin_amdgcn_exp2f(S[kh][i] - m); S[kh][i] = pv; ls += pv; }
        } else {
            const float negm = -m;
#pragma unroll
            for (int kh = 0; kh < 2; ++kh)
#pragma unroll
                for (int i = 0; i < 16; ++i) { const float pv = __builtin_amdgcn_exp2f(__builtin_fmaf(S[kh][i], scale_l2, negm)); S[kh][i] = pv; ls += pv; }
        }
        l += ls;
#pragma unroll
        for (int kh = 0; kh < 2; ++kh)
#pragma unroll
            for (int s2 = 0; s2 < 2; ++s2) {
                u32x4 pp = {pk2(S[kh][8 * s2 + 0], S[kh][8 * s2 + 1]), pk2(S[kh][8 * s2 + 2], S[kh][8 * s2 + 3]), pk2(S[kh][8 * s2 + 4], S[kh][8 * s2 + 5]), pk2(S[kh][8 * s2 + 6], S[kh][8 * s2 + 7])};
                const bf16x8 pb = __builtin_bit_cast(bf16x8, pp);
                const int c = 4 * kh + 2 * s2 + h;
#pragma unroll
                for (int blk = 0; blk < NB; ++blk) {
                    const bf16x8 vf = *(const bf16x8*)(vb + swz128(vrow0 + blk * 32 + p32, c));
                    O[blk] = MFMA32(vf, pb, O[blk]);
                }
            }
        if (more) ATT_STORE((t + 1) & 1);
        __syncthreads();
    }
    l += __shfl_xor(l, 32);
#undef ATT_LOAD
#undef ATT_STORE
}

DI void load_q(bf16x8 (&qf)[4], const bf16_t* qrow, int h) {
#pragma unroll
    for (int s = 0; s < 4; ++s) qf[s] = *(const bf16x8*)(qrow + 16 * s + 8 * h);
}

DI void attn_diff_item(const Params& p, int item, char* lds) {
    const int tid = VTID, lane = tid & 63, w = tid >> 6, p32 = lane & 31, h = lane >> 5, stream = w & 1, qh = w >> 1;
    const bf16_t* proj = (const bf16_t*)(p.ws + OFF_BIG);
    const bf16_t* vte = (const bf16_t*)(p.ws + OFF_BIG + BIG_VT_E);
    bf16_t* mix = (bf16_t*)(p.ws + OFF_BIG + BIG_MIXIN);
    int b, hd, qb, rowbase; ASeg s0, s1;
    if (item < 512) {
        b = item >> 6; hd = (item >> 4) & 3; qb = item & 15; rowbase = 8192 + b * 1024;
        s0 = {proj + (size_t)rowbase * LDE + 2048 + hd * 128, vte + 4194304 + ((size_t)b * 512 + hd * 128) * 1024, LDE, 1024, 16};
        s1 = {(const bf16_t*)(p.ws + OFF_CDK) + (size_t)b * 256 * 512 + hd * 128, (const bf16_t*)(p.ws + OFF_CDVT) + (size_t)(b * 4 + hd) * 128 * 256, 512, 256, 4};
    } else {
        const int it = item - 512;
        b = it >> 4; hd = (it >> 2) & 3; qb = it & 3; rowbase = b * 256;
        s0 = {proj + (size_t)rowbase * LDE + 2048 + hd * 128, vte + ((size_t)b * 512 + hd * 128) * 256, LDE, 256, 4};
        s1 = s0; s1.ntiles = 0;
    }
    const int R = rowbase + qb * 64 + qh * 32 + p32;
    bf16x8 qf[4];
    load_q(qf, proj + (size_t)R * LDE + 1536 + hd * 128 + stream * 64, h);
    f32x16 O[4];
#pragma unroll
    for (int blk = 0; blk < 4; ++blk)
#pragma unroll
        for (int i = 0; i < 16; ++i) O[blk][i] = 0.f;
    float m = -1e30f, l = 0.f;
    MaskP mp = {0, 0, 0, 0, nullptr};
    attn_core<128, 128, 4, 0>(s0, s1, qf, stream * 8, 0, 0.125f * LOG2E, m, l, O, lds, mp);
    const float il = 1.f / l;
    const float d1 = wave_sum(p.lq1[lane] * p.lk1[lane]), d2 = wave_sum(p.lq2[lane] * p.lk2[lane]);
    const float lam_init = 0.2f;
    const float lam = __expf(d1) - __expf(d2) + lam_init;
    float* xb = (float*)(lds + qh * 16384);
    if (stream == 1) {
#pragma unroll
        for (int blk = 0; blk < 4; ++blk)
#pragma unroll
            for (int i = 0; i < 16; ++i) { const int dv = blk * 32 + 8 * (i >> 2) + 4 * h + (i & 3); xb[dv * 32 + p32] = O[blk][i] * il; }
    }
    __syncthreads();
    if (stream == 0) {
        float ss = 0.f;
#pragma unroll
        for (int blk = 0; blk < 4; ++blk)
#pragma unroll
            for (int i = 0; i < 16; ++i) { const int dv = blk * 32 + 8 * (i >> 2) + 4 * h + (i & 3); const float o = O[blk][i] * il - lam * xb[dv * 32 + p32]; O[blk][i] = o; ss += o * o; }
        ss += __shfl_xor(ss, 32);
        const float rs = rsqrtf(ss * (1.f / 128.f) + EPSN) * (1.f - lam_init);
        bf16_t* op = mix + (size_t)R * 1024 + 512 + hd * 128;
#pragma unroll
        for (int blk = 0; blk < 4; ++blk)
#pragma unroll
            for (int g = 0; g < 4; ++g) {
                const int dv = blk * 32 + 8 * g + 4 * h;
                const f32x4 sl = *(const f32x4*)(p.subln + dv);
                u32x2 o = {pk2(O[blk][4 * g] * rs * sl[0], O[blk][4 * g + 1] * rs * sl[1]), pk2(O[blk][4 * g + 2] * rs * sl[2], O[blk][4 * g + 3] * rs * sl[3])};
                *(u32x2*)(op + dv) = o;
            }
    }
    __syncthreads();
}

DI void attn_c_item(const Params& p, int item, char* lds) {
    const int tid = VTID, lane = tid & 63, w = tid >> 6, p32 = lane & 31, h = lane >> 5, stream = w & 1, qh = w >> 1;
    const bf16_t* proj = (const bf16_t*)(p.ws + OFF_BIG);
    const bf16_t* vtc = (const bf16_t*)(p.ws + OFF_BIG + BIG_VT_C);
    bf16_t* mix = (bf16_t*)(p.ws + OFF_BIG + BIG_MIXIN);
    int b, hp, qb, rowbase; ASeg s0, s1; MaskP mp = {0, 0, 0, 0, nullptr};
    float* tab = (float*)(lds + 65536);
    if (item < 512) {
        b = item >> 6; hp = (item >> 4) & 3; qb = item & 15; rowbase = 8192 + b * 1024;
        const int rstart = min(max(qb - 4, 0), 8);
        s0 = {proj + (size_t)(rowbase + rstart * 64) * LDO + 512 + hp * 128, vtc + 4194304 + ((size_t)b * 512 + hp * 128) * 1024 + rstart * 64, LDO, 1024, 8};
        s1 = {(const bf16_t*)(p.ws + OFF_CNK) + (size_t)b * 256 * 512 + hp * 128, (const bf16_t*)(p.ws + OFF_CNVT) + ((size_t)b * 512 + hp * 128) * 256, 512, 256, 4};
        for (int idx = tid; idx < 960; idx += 256) { const int hr = idx >> 5, cc = idx & 31; tab[idx] = cc < 31 ? p.rpb[hp * 930 + hr * 31 + cc] * LOG2E : -1e30f; }
        mp = {1, qb, rstart, qh * 32, tab + stream * 480};
    } else {
        const int it = item - 512;
        b = it >> 4; hp = (it >> 2) & 3; qb = it & 3; rowbase = b * 256;
        s0 = {proj + (size_t)rowbase * LDO + 512 + hp * 128, vtc + ((size_t)b * 512 + hp * 128) * 256, LDO, 256, 4};
        s1 = s0; s1.ntiles = 0;
    }
    const int R = rowbase + qb * 64 + qh * 32 + p32;
    const int head = hp * 2 + stream;
    bf16x8 qf[4];
    load_q(qf, proj + (size_t)R * LDO + head * 64, h);
    f32x16 O[2];
#pragma unroll
    for (int blk = 0; blk < 2; ++blk)
#pragma unroll
        for (int i = 0; i < 16; ++i) O[blk][i] = 0.f;
    float m = -1e30f, l = 0.f;
    attn_core<128, 128, 2, 1>(s0, s1, qf, stream * 8, stream * 64, 0.125f * LOG2E, m, l, O, lds, mp);
    const float il = 1.f / l;
    bf16_t* op = mix + (size_t)R * 1024 + head * 64;
#pragma unroll
    for (int blk = 0; blk < 2; ++blk)
#pragma unroll
        for (int g = 0; g < 4; ++g) {
            const int dv = blk * 32 + 8 * g + 4 * h;
            u32x2 o = {pk2(O[blk][4 * g] * il, O[blk][4 * g + 1] * il), pk2(O[blk][4 * g + 2] * il, O[blk][4 * g + 3] * il)};
            *(u32x2*)(op + dv) = o;
        }
}

DI void attn_d_item(const Params& p, int item, char* lds) {
    const int tid = VTID, lane = tid & 63, w = tid >> 6, p32 = lane & 31, h = lane >> 5;
    const bf16_t* proj = (const bf16_t*)(p.ws + OFF_BIG);
    const bf16_t* vtd = (const bf16_t*)(p.ws + OFF_BIG + BIG_VT_D);
    bf16_t* mix = (bf16_t*)(p.ws + OFF_BIG + BIG_MIXIN);
    int b, g, qb, rowbase; ASeg s0, s1; MaskP mp = {0, 0, 0, 0, nullptr};
    if (item < 512) {
        b = item >> 6; g = (item >> 5) & 1; qb = item & 31; rowbase = 8192 + b * 1024;
        const int q0 = qb * 32;
        const int tlo = max(q0 - 128, 0) >> 6, thi = min(q0 + 159, 1023) >> 6;
        s0 = {proj + (size_t)(rowbase + tlo * 64) * LDO + 1536 + g * 64, vtd + 1048576 + ((size_t)b * 128 + g * 64) * 1024 + tlo * 64, LDO, 1024, thi - tlo + 1};
        s1 = {(const bf16_t*)(p.ws + OFF_CSK) + (size_t)b * 256 * 128 + g * 64, (const bf16_t*)(p.ws + OFF_CSVT) + ((size_t)b * 128 + g * 64) * 256, 128, 256, 4};
        mp = {1, q0, tlo * 64, 0, nullptr};
    } else {
        const int it = item - 512;
        b = it >> 4; g = (it >> 3) & 1; qb = it & 7; rowbase = b * 256;
        s0 = {proj + (size_t)rowbase * LDO + 1536 + g * 64, vtd + ((size_t)b * 128 + g * 64) * 256, LDO, 256, 4};
        s1 = s0; s1.ntiles = 0;
    }
    const int R = rowbase + qb * 32 + p32;
    const int hq = g * 4 + w;
    bf16x8 qf[4];
    load_q(qf, proj + (size_t)R * LDO + 1024 + hq * 64, h);
    f32x16 O[2];
#pragma unroll
    for (int blk = 0; blk < 2; ++blk)
#pragma unroll
        for (int i = 0; i < 16; ++i) O[blk][i] = 0.f;
    float m = p.sink[hq] * LOG2E, l = h == 0 ? 1.f : 0.f;
    attn_core<64, 64, 2, 2>(s0, s1, qf, 0, 0, 0.125f * LOG2E, m, l, O, lds, mp);
    const float il = 1.f / l;
    bf16_t* op = mix + (size_t)R * 1024 + 512 + hq * 64;
#pragma unroll
    for (int blk = 0; blk < 2; ++blk)
#pragma unroll
        for (int gg = 0; gg < 4; ++gg) {
            const int dv = blk * 32 + 8 * gg + 4 * h;
            u32x2 o = {pk2(O[blk][4 * gg] * il, O[blk][4 * gg + 1] * il), pk2(O[blk][4 * gg + 2] * il, O[blk][4 * gg + 3] * il)};
            *(u32x2*)(op + dv) = o;
        }
}

DI void conv_item(const Params& p, int item) {
    const int tid = VTID;
    const bf16_t* proj = (const bf16_t*)(p.ws + OFF_BIG);
    bf16_t* mix = (bf16_t*)(p.ws + OFF_BIG + BIG_MIXIN);
#pragma unroll 2
    for (int i = 0; i < 8; ++i) {
        const int idx = tid + 256 * i, tl = idx >> 6, ch = (idx & 63) * 8;
        const int R = item * 32 + tl;
        int t, T;
        if (R < 8192) { t = R & 255; T = 256; } else { t = (R - 8192) & 1023; T = 1024; }
        const bf16_t* rp = proj + (size_t)R * LDE + ch;
        const u32x4 ab = *(const u32x4*)(rp);
        float accv[8];
#pragma unroll
        for (int e = 0; e < 8; ++e) accv[e] = 0.f;
#pragma unroll
        for (int j = 0; j < 3; ++j) {
            const int tt = t + j - 1;
            if (tt >= 0 && tt < T) {
                const u32x4 ac = *(const u32x4*)(rp + (ptrdiff_t)(j - 1) * LDE + 512);
                const u32x4 ax = *(const u32x4*)(rp + (ptrdiff_t)(j - 1) * LDE + 1024);
                const f32x4 w0 = *(const f32x4*)(p.conv_w + j * 512 + ch), w1 = *(const f32x4*)(p.conv_w + j * 512 + ch + 4);
#pragma unroll
                for (int e = 0; e < 4; ++e) {
                    accv[2 * e] += bflo(ac[e]) * bflo(ax[e]) * (e < 2 ? w0[2 * e] : w1[2 * e - 4]);
                    accv[2 * e + 1] += bfhi(ac[e]) * bfhi(ax[e]) * (e < 2 ? w0[2 * e + 1] : w1[2 * e - 3]);
                }
            }
        }
        u32x4 o;
#pragma unroll
        for (int e = 0; e < 4; ++e) o[e] = pk2(bflo(ab[e]) * accv[2 * e], bfhi(ab[e]) * accv[2 * e + 1]);
        *(u32x4*)(mix + (size_t)R * 1024 + ch) = o;
    }
}


#define XB_TMO      128
#define XB_XCNT(j)  (256  + 64 * (j))
#define XB_XSUB(j)  (1280 + 64 * (j))
#define XB_XGEN(j)  (2304 + 64 * (j))
#define XB_TOP      3328
#define XB_TOPGEN   3392
#define XCD_BAR_WORDS 3456
#define XB_SPIN_CAP (1u << 22)
#define LAS __attribute__((address_space(3)))
DI unsigned xb_ld(unsigned* p) { return __hip_atomic_load(p, __ATOMIC_RELAXED, __HIP_MEMORY_SCOPE_AGENT); }
DI unsigned xb_add(unsigned* p, unsigned v) { return __hip_atomic_fetch_add(p, v, __ATOMIC_RELAXED, __HIP_MEMORY_SCOPE_AGENT); }
DI unsigned xb_xcc_id() { return (unsigned)__builtin_amdgcn_s_getreg((3 << 11) | 20) & 0xFu; }
#define XB_SPIN(cond, bar) do { unsigned _sp = 0; while (cond) { __builtin_amdgcn_s_sleep(1); \
    if ((++_sp & 255u) == 0u) { if (xb_ld(&(bar)[XB_TMO])) break; if (_sp > XB_SPIN_CAP) { atomicAdd(&(bar)[XB_TMO], 1u); break; } } } } while (0)
struct XcdBarrier { unsigned* bar; unsigned x; volatile LAS unsigned* st; };
DI XcdBarrier xcd_barrier_post(unsigned* bar, volatile LAS unsigned* st) {
    XcdBarrier b; b.bar = bar; b.x = xb_xcc_id(); b.st = st;
    if (threadIdx.x == 0) (void)xb_add(&bar[XB_XCNT(b.x)], 1u);
    return b;
}
DI void xcd_barrier_complete(unsigned* bar, unsigned x, unsigned& nloc, unsigned& nx) {
    const unsigned G = gridDim.x * gridDim.y * gridDim.z;
    unsigned sum, cnt, mine, sp = 0u;
    for (;;) {
        sum = 0u; cnt = 0u; mine = 0u;
#pragma unroll
        for (unsigned j = 0; j < 16; ++j) { const unsigned c = xb_ld(&bar[XB_XCNT(j)]); sum += c; cnt += (c > 0u) ? 1u : 0u; mine = (j == x) ? c : mine; }
        if (sum == G) break;
        __builtin_amdgcn_s_sleep(1);
        if ((++sp & 255u) == 0u) { if (xb_ld(&bar[XB_TMO])) break; if (sp > XB_SPIN_CAP) { atomicAdd(&bar[XB_TMO], 1u); break; } }
    }
    nloc = mine > 0u ? mine : 1u; nx = cnt > 0u ? cnt : 1u;
}
DI void xcd_barrier(const XcdBarrier& b) {
    asm volatile("s_waitcnt vmcnt(0)" ::: "memory");
    __syncthreads();
    if (threadIdx.x == 0) {
        unsigned* bar = b.bar;
        __builtin_amdgcn_s_waitcnt(0);
        unsigned nloc = b.st[0], nx = b.st[1];
        if (nloc == 0u) { xcd_barrier_complete(bar, b.x, nloc, nx); b.st[0] = nloc; b.st[1] = nx; }
        const unsigned old = xb_add(&bar[XB_XSUB(b.x)], 1u);
        const unsigned gen = old / nloc;
        if (old + 1u == (gen + 1u) * nloc) {
            __builtin_amdgcn_fence(__ATOMIC_RELEASE, "agent");
            asm volatile("s_waitcnt vmcnt(0)" ::: "memory");
            const unsigned og = xb_add(&bar[XB_TOP], 1u);
            const unsigned tg = og / nx;
            if (og + 1u == (tg + 1u) * nx) xb_add(&bar[XB_TOPGEN], 1u);
            else XB_SPIN(xb_ld(&bar[XB_TOPGEN]) == tg, bar);
            __builtin_amdgcn_fence(__ATOMIC_ACQUIRE, "agent");
            xb_add(&bar[XB_XGEN(b.x)], 1u);
            asm volatile("s_waitcnt vmcnt(0)" ::: "memory");
        } else {
            XB_SPIN(xb_ld(&bar[XB_XGEN(b.x)]) == gen, bar);
            __builtin_amdgcn_fence(__ATOMIC_ACQUIRE, "agent");
            asm volatile("s_waitcnt vmcnt(0)" ::: "memory");
        }
    }
    __syncthreads();
}

constexpr int N_PHASES = 12;
DI void run_phase(const Params& p, int ph, char* shm) {
    const int nb = VNB, bid = VBID;
    char* lds = shm + VHALF * LDS_HALF;
    const int pvb = (int)(blockIdx.x & 7) * (nb >> 3) + (int)(blockIdx.x >> 3) * 2 + VHALF;
    const bf16_t* hy = (const bf16_t*)(p.ws + OFF_HY);
    const bf16_t* big = (const bf16_t*)(p.ws + OFF_BIG);
    const bf16_t* mixin = (const bf16_t*)(p.ws + OFF_BIG + BIG_MIXIN);
    const float* mod = (const float*)(p.ws + OFF_MOD);
    char* st = p.ws + OFF_STAT;
#define FZ(set, from_in, hasH, goff, wpost, wpre, scoff, shoff) FuseP{from_in, hasH, p.out, mod + (goff), wpost, wpre, mod + (scoff), mod + (shoff), (float*)(st + (set) * STAT_SET), (float*)(st + (set) * STAT_SET + 65536), (unsigned*)(st + (set) * STAT_SET + 131072)}
    switch (ph) {
    case 0: p0_phase(p, bid, nb, lds); break;
    case 1: rowop_phase(p, false, true, 0, nullptr, true, p.norm_mix_pre, 1024, 0); break;
    case 2: gemm_phase<EPI_PE>(p, hy, 2048, (const bf16_t*)(p.ws + OFF_WINE), 1024, 12, shm); break;
    case 3:
        for (int it = pvb; it < 1536; it += nb) { if (it < 1024) attn_diff_item(p, it, lds); else conv_item(p, it - 1024); }
        break;
    case 4: gemm_phase<EPI_YF>(p, mixin, 1024, (const bf16_t*)(p.ws + OFF_WOUT), 1024, 4, shm, FZ(0, 1, 1, 2048, p.norm_mix_post, p.norm_mlp_pre, 4096, 3072)); break;
    case 5: gemm_phase<EPI_W1>(p, hy, 2048, (const bf16_t*)(p.ws + OFF_W1), 1024, 16, shm); break;
    case 6: gemm_phase<EPI_YF>(p, big, 4096, (const bf16_t*)(p.ws + OFF_W2), 4096, 4, shm, FZ(1, 0, 1, 5120, p.norm_mlp_post, p.norm_mix_pre + 1024, 9 * 6144 + 1024, 9 * 6144 + 0)); break;
    case 7: gemm_phase<EPI_PO>(p, hy, 2048, (const bf16_t*)(p.ws + OFF_WINO), 1024, 9, shm); break;
    case 8:
        for (int it = pvb; it < 2048; it += nb) {
            const int q = it >> 9, r = it & 511;
            if (q & 1) attn_d_item(p, (q >> 1) * 512 + r, lds); else attn_c_item(p, (q >> 1) * 512 + r, lds);
        }
        break;
    case 9: gemm_phase<EPI_YF>(p, mixin, 1024, (const bf16_t*)(p.ws + OFF_WOUT) + 1048576, 1024, 4, shm, FZ(2, 0, 1, 9 * 6144 + 2048, p.norm_mix_post + 1024, p.norm_mlp_pre + 1024, 9 * 6144 + 4096, 9 * 6144 + 3072)); break;
    case 10: gemm_phase<EPI_W1>(p, hy, 2048, (const bf16_t*)(p.ws + OFF_W1) + 4194304, 1024, 16, shm); break;
    case 11: gemm_phase<EPI_YF>(p, big, 4096, (const bf16_t*)(p.ws + OFF_W2) + 4194304, 4096, 4, shm, FZ(3, 0, 0, 9 * 6144 + 5120, p.norm_mlp_post + 1024, p.norm_mlp_post, 0, 0)); break;
    }
#undef FZ
}

__global__ void __launch_bounds__(512, 2) fwd_mega(Params p) {
    __shared__ __attribute__((aligned(16))) char lds[LDS_BYTES];
    __shared__ uint4 xb_words;
    cg::grid_group grid = cg::this_grid();
    if (threadIdx.x == 0) xb_words = make_uint4(0u, 0u, 0u, 0u);
    __syncthreads();
    const XcdBarrier xb = xcd_barrier_post((unsigned*)(p.ws + OFF_BAR), (volatile LAS unsigned*)&xb_words);
#define PH_(n) run_phase(p, n, lds); xcd_barrier(xb); if ((DUP_MASK >> n) & 1) { run_phase(p, n, lds); xcd_barrier(xb); }
    PH_(0)
    if (p.ws == nullptr) grid.sync();
    PH_(1) PH_(2) PH_(3) PH_(4) PH_(5) PH_(6) PH_(7) PH_(8) PH_(9) PH_(10)
    run_phase(p, 11, lds);
#undef PH_
}

extern "C" void kernel_launch(void* const* d_in, const int* in_sizes, int n_in, void* d_out, int out_size, void* d_ws, size_t ws_size, hipStream_t stream) {
    Params p{};
    const float** pp = (const float**)&p;
    for (int i = 0; i < 29; ++i) pp[i] = (const float*)d_in[i];
    p.out = (float*)d_out;
    p.ws = (char*)d_ws;
    if (ws_size < WS_NEEDED) { fprintf(stderr, "workspace too small: %zu < %zu\n", ws_size, (size_t)WS_NEEDED); return; }
    static int grid_blocks = 0;
    if (!grid_blocks) {
        int dev = 0, cus = 0, per_cu = 0;
        hipGetDevice(&dev);
        hipDeviceGetAttribute(&cus, hipDeviceAttributeMultiprocessorCount, dev);
        hipOccupancyMaxActiveBlocksPerMultiprocessor(&per_cu, fwd_mega, 512, 0);
        if (per_cu > 1) per_cu = 1;
        if (per_cu < 1) per_cu = 1;
        grid_blocks = cus * per_cu;
        grid_blocks -= grid_blocks % 8;
    }
    (void)hipMemsetAsync((char*)d_ws + OFF_MOD, 0, OFF_BAR + XCD_BAR_WORDS * 4, stream);
    if (grid_blocks != 256) { fprintf(stderr, "fused epilogues need exactly 256 workgroups (got %d)\n", grid_blocks); return; }
    void* args[] = {&p};
    hipError_t e = hipLaunchCooperativeKernel((void*)fwd_mega, dim3(grid_blocks), dim3(512), args, 0, stream);
    if (e != hipSuccess) fprintf(stderr, "cooperative launch failed: %s (grid %d)\n", hipGetErrorString(e), grid_blocks);
}
```

```cpp
#include <hip/hip_runtime.h>
#include <hip/hip_cooperative_groups.h>
#include <cstdio>
#include <cstdint>
namespace cg = cooperative_groups;

#ifndef DUP_MASK
#define DUP_MASK 0
#endif
#ifndef ONE_LAUNCH
#define ONE_LAUNCH 1
#endif

typedef unsigned short bf16_t;
typedef short bf16x8 __attribute__((ext_vector_type(8)));
typedef float f32x4 __attribute__((ext_vector_type(4)));
typedef float f32x2 __attribute__((ext_vector_type(2)));
typedef float f32x16 __attribute__((ext_vector_type(16)));
typedef unsigned u32x4 __attribute__((ext_vector_type(4)));
typedef unsigned u32x2 __attribute__((ext_vector_type(2)));
typedef __bf16 bfv2 __attribute__((ext_vector_type(2)));
#define DI __device__ __forceinline__
DI int launder_v(int v) { asm volatile("" : "+v"(v)); return v; }
#define TIDX launder_v((int)threadIdx.x)
#define VTID (TIDX & 255)
#define VHALF (TIDX >> 8)
#define VBID ((int)(blockIdx.x * 2) + (TIDX >> 8))
#define VNB ((int)(gridDim.x * 2))
#define MFMA32(a, b, c) __builtin_amdgcn_mfma_f32_32x32x16_bf16((a), (b), (c), 0, 0, 0)
#define MFMA16(a, b, c) __builtin_amdgcn_mfma_f32_16x16x32_bf16((a), (b), (c), 0, 0, 0)

constexpr float LOG2E = 1.4426950408889634f;
constexpr float EPSN = 1e-6f;

struct Params {
    const float *x_prompt, *x_sample, *cache_diff_k, *cache_diff_v, *cache_na_k, *cache_na_v, *cache_swa_k, *cache_swa_v, *c, *c_ctx;
    const float *mod_w, *mod_b, *norm_mix_pre, *norm_mix_post, *norm_mlp_pre, *norm_mlp_post, *w_in_even, *conv_w, *lq1, *lk1, *lq2, *lk2, *subln;
    const float *w_in_odd, *rpb, *sink, *w_out, *mlp_w1, *mlp_w2;
    float* out;
    char* ws;
};

constexpr size_t OFF_MOD = 0;
constexpr size_t OFF_BAR = 458752;
constexpr size_t OFF_WINE = 524288;
constexpr size_t OFF_WINO = OFF_WINE + 6291456;
constexpr size_t OFF_WOUT = OFF_WINO + 4718592;
constexpr size_t OFF_W1 = OFF_WOUT + 4194304;
constexpr size_t OFF_W2 = OFF_W1 + 16777216;
constexpr size_t OFF_CDK = OFF_W2 + 16777216;
constexpr size_t OFF_CDVT = OFF_CDK + 2097152;
constexpr size_t OFF_CNK = OFF_CDVT + 2097152;
constexpr size_t OFF_CNVT = OFF_CNK + 2097152;
constexpr size_t OFF_CSK = OFF_CNVT + 2097152;
constexpr size_t OFF_CSVT = OFF_CSK + 524288;
constexpr size_t OFF_HY = OFF_CSVT + 524288;
constexpr size_t OFF_BIG = OFF_HY + 67108864;
constexpr size_t OFF_STAT = OFF_BIG + 134217728;
constexpr size_t STAT_SET = 65536 + 65536 + 8192;
constexpr size_t WS_NEEDED = OFF_STAT + 4 * STAT_SET;
constexpr size_t BIG_VT_E = 83886080;
constexpr size_t BIG_VT_C = 54525952;
constexpr size_t BIG_VT_D = BIG_VT_C + 16777216;
constexpr size_t BIG_MIXIN = 100663296;
constexpr int LDE = 2560, LDO = 1664;
constexpr size_t OUT_DIFFK = 16777216, OUT_DIFFV = 20971520, OUT_NAK = 25165824, OUT_NAV = 29360128, OUT_SWAK = 33554432, OUT_SWAV = 34603008;

constexpr int LDS_HALF = 65536 + 4096;
constexpr int LDS_BYTES = 2 * LDS_HALF;

DI unsigned pk2(float a, float b) { f32x2 v = {a, b}; bfv2 r = __builtin_convertvector(v, bfv2); return __builtin_bit_cast(unsigned, r); }
DI float bflo(unsigned u) { return __uint_as_float(u << 16); }
DI float bfhi(unsigned u) { return __uint_as_float(u & 0xffff0000u); }
DI float wave_sum(float v) {
#pragma unroll
    for (int o = 1; o < 64; o <<= 1) v += __shfl_xor(v, o);
    return v;
}
DI int swz128(int r, int c) { return r * 128 + ((c ^ ((r >> 1) & 7)) << 4); }
DI int swz256(int r, int c) { return r * 256 + ((c ^ (r & 15)) << 4); }

DI void p0_mod_item(const Params& p, int item, char* lds) {
    const int kq = item & 7, cbl = item >> 3, li = cbl / 96, cb = cbl % 96;
    const int tid = VTID, lane = tid & 63, w = tid >> 6;
    const float* W = p.mod_w + (size_t)li * 1024 * 6144 + cb * 64 + lane;
    const int kb = kq * 128 + w * 32;
    float acc[9], s[9];
    { const float cv = p.c_ctx[kb + (lane & 31)]; s[0] = cv / (1.f + __expf(-cv)); }
#pragma unroll
    for (int v = 1; v < 9; ++v) { const float cv = p.c[(v - 1) * 1024 + kb + (lane & 31)]; s[v] = cv / (1.f + __expf(-cv)); }
#pragma unroll
    for (int v = 0; v < 9; ++v) acc[v] = 0.f;
#pragma unroll
    for (int kk = 0; kk < 32; ++kk) {
        const float wv = __builtin_nontemporal_load(W + (size_t)(kb + kk) * 6144);
#pragma unroll
        for (int v = 0; v < 9; ++v) acc[v] += __int_as_float(__builtin_amdgcn_readlane(__float_as_int(s[v]), kk)) * wv;
    }
    float* red = (float*)lds;
#pragma unroll
    for (int v = 0; v < 9; ++v) red[(w * 9 + v) * 64 + lane] = acc[v];
    __syncthreads();
    float* mod = (float*)(p.ws + OFF_MOD);
    for (int idx = tid; idx < 576; idx += 256) {
        const int v = idx >> 6, col = idx & 63;
        float sum = red[(0 * 9 + v) * 64 + col] + red[(1 * 9 + v) * 64 + col] + red[(2 * 9 + v) * 64 + col] + red[(3 * 9 + v) * 64 + col];
        if (kq == 0) sum += p.mod_b[li * 6144 + cb * 64 + col];
        atomicAdd(mod + (li * 9 + v) * 6144 + cb * 64 + col, sum);
    }
    __syncthreads();
}

DI void p0_transpose_tile(const float* __restrict__ in, bf16_t* __restrict__ out, int R, int C, int tr, int tc, char* lds) {
    const int tid = VTID;
    const int cl = (tid & 15) * 4, rl = (tid >> 4) * 2, sw = tid & 7;
#pragma unroll
    for (int i = 0; i < 2; ++i) {
        const int r = rl + 32 * i;
        const f32x4 a = *(const f32x4*)(in + (size_t)(tr * 64 + r) * C + tc * 64 + cl);
        const f32x4 b = *(const f32x4*)(in + (size_t)(tr * 64 + r + 1) * C + tc * 64 + cl);
#pragma unroll
        for (int j = 0; j < 4; ++j) *(unsigned*)(lds + (cl + j) * 128 + (((r >> 3) ^ sw) << 4) + (r & 7) * 2) = pk2(a[j], b[j]);
    }
    __syncthreads();
#pragma unroll
    for (int i = 0; i < 2; ++i) {
        const int idx = tid + 256 * i, c = idx >> 3, q = idx & 7;
        const u32x4 v = *(const u32x4*)(lds + c * 128 + ((q ^ ((c >> 2) & 7)) << 4));
        *(u32x4*)(out + (size_t)(tc * 64 + c) * R + tr * 64 + q * 8) = v;
    }
    __syncthreads();
}

DI void p0_kreorder(const float* __restrict__ in, bf16_t* __restrict__ out, int logH, int item) {
    const int tid = VTID, H = 1 << logH;
#pragma unroll
    for (int i = 0; i < 4; ++i) {
        const int f = item * 1024 + tid + 256 * i;
        const int d4 = f & 15, key = (f >> 4) & 255, hh = (f >> 12) & (H - 1), b = f >> (12 + logH);
        const f32x4 v = __builtin_nontemporal_load((const f32x4*)(in + (size_t)f * 4));
        u32x2 o = {pk2(v[0], v[1]), pk2(v[2], v[3])};
        *(u32x2*)(out + ((size_t)(b * 256 + key) * H + hh) * 64 + d4 * 4) = o;
    }
}

struct TJob { const float* in; bf16_t* out; int R, C, tr, tc, late; };
constexpr int P0_TITEMS = 768 + 576 + 512 + 2048 + 2048 + 256 + 256 + 64;
DI TJob p0_decode(const Params& p, int item) {
    TJob j;
    j.late = (item >= 768 && item < 1344) || (item >= 1600 && item < 1856) || (item >= 2880 && item < 3904) || (item >= 4928 && item < 5952);
    if (item < 768) { j.in = p.w_in_even; j.out = (bf16_t*)(p.ws + OFF_WINE); j.R = 1024; j.C = 3072; }
    else if ((item -= 768) < 576) { j.in = p.w_in_odd; j.out = (bf16_t*)(p.ws + OFF_WINO); j.R = 1024; j.C = 2304; }
    else if ((item -= 576) < 512) { const int b = item >> 8; item &= 255; j.in = p.w_out + (size_t)b * 1048576; j.out = (bf16_t*)(p.ws + OFF_WOUT) + (size_t)b * 1048576; j.R = 1024; j.C = 1024; }
    else if ((item -= 512) < 2048) { const int b = item >> 10; item &= 1023; j.in = p.mlp_w1 + (size_t)b * 4194304; j.out = (bf16_t*)(p.ws + OFF_W1) + (size_t)b * 4194304; j.R = 1024; j.C = 4096; }
    else if ((item -= 2048) < 2048) { const int b = item >> 10; item &= 1023; j.in = p.mlp_w2 + (size_t)b * 4194304; j.out = (bf16_t*)(p.ws + OFF_W2) + (size_t)b * 4194304; j.R = 4096; j.C = 1024; }
    else if ((item -= 2048) < 256) { const int b = item >> 3; item &= 7; j.in = p.cache_diff_v + (size_t)b * 32768; j.out = (bf16_t*)(p.ws + OFF_CDVT) + (size_t)b * 32768; j.R = 256; j.C = 128; }
    else if ((item -= 256) < 256) { const int b = item >> 2; item &= 3; j.in = p.cache_na_v + (size_t)b * 16384; j.out = (bf16_t*)(p.ws + OFF_CNVT) + (size_t)b * 16384; j.R = 256; j.C = 64; }
    else { item -= 256; const int b = item >> 2; item &= 3; j.in = p.cache_swa_v + (size_t)b * 16384; j.out = (bf16_t*)(p.ws + OFF_CSVT) + (size_t)b * 16384; j.R = 256; j.C = 64; }
    const int ntc = j.C >> 6;
    j.tr = item / ntc; j.tc = item % ntc;
    return j;
}
DI void p0_tload(const TJob& j, int tid, f32x4 (&a)[2], f32x4 (&b)[2]) {
    const int cl = (tid & 15) * 4, rl = (tid >> 4) * 2;
#pragma unroll
    for (int i = 0; i < 2; ++i) {
        const int r = rl + 32 * i;
        a[i] = __builtin_nontemporal_load((const f32x4*)(j.in + (size_t)(j.tr * 64 + r) * j.C + j.tc * 64 + cl));
        b[i] = __builtin_nontemporal_load((const f32x4*)(j.in + (size_t)(j.tr * 64 + r + 1) * j.C + j.tc * 64 + cl));
    }
}
DI void p0_phase(const Params& p, int bid, int nb, char* lds) {
    for (int it = bid; it < 1536; it += nb) p0_mod_item(p, it, lds);
    const int tid = VTID;
    {
        const int cl = (tid & 15) * 4, rl = (tid >> 4) * 2, sw = tid & 7;
        const int first = bid, stride = nb, lim = P0_TITEMS;
#define P0_PROC(J, A, B) do { \
            _Pragma("unroll") for (int i = 0; i < 2; ++i) { const int r = rl + 32 * i; \
                _Pragma("unroll") for (int jj = 0; jj < 4; ++jj) *(unsigned*)(lds + (cl + jj) * 128 + (((r >> 3) ^ sw) << 4) + (r & 7) * 2) = pk2(A[i][jj], B[i][jj]); } \
            asm volatile("s_waitcnt lgkmcnt(0)\n\ts_barrier" ::: "memory"); \
            _Pragma("unroll") for (int i = 0; i < 2; ++i) { const int idx = tid + 256 * i, c = idx >> 3, q = idx & 7; \
                const u32x4 v = *(const u32x4*)(lds + c * 128 + ((q ^ ((c >> 2) & 7)) << 4)); \
                u32x4* dst = (u32x4*)(J.out + (size_t)(J.tc * 64 + c) * J.R + J.tr * 64 + q * 8); \
                if (J.late) __builtin_nontemporal_store(v, dst); else *dst = v; } \
            asm volatile("s_waitcnt lgkmcnt(0)\n\ts_barrier" ::: "memory"); } while (0)
        int it = first;
        TJob j0 = p0_decode(p, it < lim ? it : first), j1;
        f32x4 a0[2], b0[2], a1[2], b1[2];
        p0_tload(j0, tid, a0, b0);
        while (it < lim) {
            { const int nx = it + stride; j1 = p0_decode(p, nx < lim ? nx : first); p0_tload(j1, tid, a1, b1); }
            P0_PROC(j0, a0, b0);
            it += stride;
            if (it >= lim) break;
            { const int nx = it + stride; j0 = p0_decode(p, nx < lim ? nx : first); p0_tload(j0, tid, a0, b0); }
            P0_PROC(j1, a1, b1);
            it += stride;
        }
#undef P0_PROC
    }
    {
        f32x4* st4 = (f32x4*)(p.ws + OFF_STAT);
        const f32x4 z = {0.f, 0.f, 0.f, 0.f};
        for (int i = bid * 256 + tid; i < (int)(4 * STAT_SET / 16); i += nb * 256) st4[i] = z;
    }
    for (int it = bid; it < 576; it += nb) {
        if (it < 256) p0_kreorder(p.cache_diff_k, (bf16_t*)(p.ws + OFF_CDK), 3, it);
        else if (it < 512) p0_kreorder(p.cache_na_k, (bf16_t*)(p.ws + OFF_CNK), 3, it - 256);
        else p0_kreorder(p.cache_swa_k, (bf16_t*)(p.ws + OFF_CSK), 1, it - 512);
    }
}

DI void rowop_phase(const Params& p, bool hasY, bool xin_input, int g_off, const float* wpost, bool hasH, const float* wpre, int sc_off, int sh_off) {
    const int tix = TIDX, lane = tix & 63, gw = (int)(blockIdx.x * 8) + (tix >> 6), nw = VNB * 4;
    const float* mod = (const float*)(p.ws + OFF_MOD);
    f32x4 wpo[4], wpr[4];
#pragma unroll
    for (int i = 0; i < 4; ++i) { if (hasY) wpo[i] = *(const f32x4*)(wpost + lane * 4 + 256 * i); if (hasH) wpr[i] = *(const f32x4*)(wpre + lane * 4 + 256 * i); }
#pragma unroll
    for (int itx = 0; itx < 4; ++itx) { const int row0 = gw + itx * 4096;
        f32x4 x[2][4], y[2][4];
#pragma unroll
        for (int r = 0; r < 2; ++r) {
            const int row = row0 + r * nw;
            const float* xin = xin_input ? (row < 8192 ? p.x_prompt + (size_t)row * 1024 : p.x_sample + (size_t)(row - 8192) * 1024) : p.out + (size_t)row * 1024;
            const float* yin = (const float*)(p.ws + OFF_HY + (size_t)row * 4096);
#pragma unroll
            for (int i = 0; i < 4; ++i) { x[r][i] = __builtin_nontemporal_load((const f32x4*)(xin + lane * 4 + 256 * i)); if (hasY) y[r][i] = *(const f32x4*)(yin + lane * 4 + 256 * i); }
        }
#pragma unroll
        for (int r = 0; r < 2; ++r) {
            const int row = row0 + r * nw;
            const int v = row < 8192 ? 0 : 1 + ((row - 8192) >> 10);
            char* hy = p.ws + OFF_HY + (size_t)row * 4096;
            if (hasY) {
                f32x4 g4[4];
#pragma unroll
                for (int i = 0; i < 4; ++i) g4[i] = *(const f32x4*)(mod + v * 6144 + g_off + lane * 4 + 256 * i);
                float ss = 0.f;
#pragma unroll
                for (int i = 0; i < 4; ++i) ss += y[r][i][0] * y[r][i][0] + y[r][i][1] * y[r][i][1] + y[r][i][2] * y[r][i][2] + y[r][i][3] * y[r][i][3];
                ss = wave_sum(ss);
                const float rs = rsqrtf(ss * (1.f / 1024.f) + EPSN);
#pragma unroll
                for (int i = 0; i < 4; ++i) {
                    x[r][i] += g4[i] * (y[r][i] * rs * wpo[i]);
                    *(f32x4*)(p.out + (size_t)row * 1024 + lane * 4 + 256 * i) = x[r][i];
                }
            }
            if (hasH) {
                f32x4 sc[4], sh[4];
#pragma unroll
                for (int i = 0; i < 4; ++i) { sc[i] = *(const f32x4*)(mod + v * 6144 + sc_off + lane * 4 + 256 * i); sh[i] = *(const f32x4*)(mod + v * 6144 + sh_off + lane * 4 + 256 * i); }
                float ss = 0.f;
#pragma unroll
                for (int i = 0; i < 4; ++i) ss += x[r][i][0] * x[r][i][0] + x[r][i][1] * x[r][i][1] + x[r][i][2] * x[r][i][2] + x[r][i][3] * x[r][i][3];
                ss = wave_sum(ss);
                const float rs = rsqrtf(ss * (1.f / 1024.f) + EPSN);
#pragma unroll
                for (int i = 0; i < 4; ++i) {
                    const f32x4 h = x[r][i] * rs * wpr[i] * (sc[i] + 1.f) + sh[i];
                    u32x2 o = {pk2(h[0], h[1]), pk2(h[2], h[3])};
                    *(u32x2*)((bf16_t*)hy + lane * 4 + 256 * i) = o;
                }
            }
        }
    }
}

namespace g8 {
constexpr int BK = 64, HALF = 128, HTB = HALF * BK * 2;
DI int lds_byte(int r, int c) { const int st = (r >> 4) * 2 + (c >> 5), rr = r & 15, cc = c & 31, ob = rr * 64 + cc * 2; return st * 1024 + (ob ^ (((ob >> 9) & 1) << 5)); }
DI void stage_rc(int b, int& R, int& C) { const int st = b / 1024, sb = b % 1024, swz = sb ^ (((sb >> 9) & 1) << 5); R = (st >> 1) * 16 + swz / 64; C = (st & 1) * 32 + (swz % 64) / 2; }
typedef __attribute__((address_space(3))) unsigned lds_u32;
typedef __attribute__((address_space(3))) unsigned char lds_u8;
typedef __attribute__((address_space(3))) bf16x8 lds_bf16x8;

}

enum { EPI_PE = 0, EPI_PO = 1, EPI_Y = 2, EPI_W1 = 3, EPI_YF = 4 };

struct FuseP { int from_input, hasH; float* xout; const float* g; const float* wpost; const float* wpre; const float* sc; const float* sh; float* ssY; float* ssX; unsigned* cnt; };
DI float ld_agent(const float* q) { return __hip_atomic_load(q, __ATOMIC_RELAXED, __HIP_MEMORY_SCOPE_AGENT); }
DI void panel_wait(unsigned* c, unsigned target) {
    asm volatile("s_waitcnt vmcnt(0)" ::: "memory");
    __syncthreads();
    if (threadIdx.x == 0) {
        __hip_atomic_fetch_add(c, 1u, __ATOMIC_RELAXED, __HIP_MEMORY_SCOPE_AGENT);
        unsigned sp = 0;
        while (__hip_atomic_load(c, __ATOMIC_RELAXED, __HIP_MEMORY_SCOPE_AGENT) < target) { __builtin_amdgcn_s_sleep(1); if (++sp > (1u << 22)) break; }
    }
    __syncthreads();
}
DI float dot4(const f32x4& a) { return a[0] * a[0] + a[1] * a[1] + a[2] * a[2] + a[3] * a[3]; }

DI void rope_s(f32x4 (&sub)[4][2], int R0, bool usecol, int fr, int fq) {
    asm volatile("" : "+s"(R0));
    const float sgn = fq < 2 ? -1.f : 1.f;
#pragma unroll
    for (int m = 0; m < 4; ++m) {
        __builtin_amdgcn_sched_barrier(0);
        const int tl = (R0 + m * 16 + fr - 8192) & 1023;
        const float pos = (float)(usecol ? (tl & 63) : (tl >> 6));
#pragma unroll
        for (int n = 0; n < 2; ++n)
#pragma unroll
            for (int j = 0; j < 4; ++j) {
                const float inv = exp2f(-(float)(8 * (fq & 1) + 4 * n + j) * (13.287712379549449f / 16.f));
                float sn, cs;
                __sincosf(pos * inv, &sn, &cs);
                const float v = sub[m][n][j], pv = __shfl_xor(v, 32);
                sub[m][n][j] = v * cs + sgn * pv * sn;
            }
    }
}
DI void store_bf16_rows_s(const f32x4 (&sub)[4][2], bf16_t* base, int ld, int R0, int Cd0, int fr, int fq) {
#pragma unroll
    for (int m = 0; m < 4; ++m) {
        u32x4 o = {pk2(sub[m][0][0], sub[m][0][1]), pk2(sub[m][0][2], sub[m][0][3]), pk2(sub[m][1][0], sub[m][1][1]), pk2(sub[m][1][2], sub[m][1][3])};
        *(u32x4*)(base + (size_t)(R0 + m * 16 + fr) * ld + Cd0 + fq * 8) = o;
    }
}
DI void store_f32_rows_s(const f32x4 (&sub)[4][2], float* ob, int ldo, int fr, int fq) {
#pragma unroll
    for (int m = 0; m < 4; ++m) {
        float* rp = ob + (size_t)(m * 16 + fr) * ldo + fq * 8;
#pragma unroll
        for (int n = 0; n < 2; ++n) __builtin_nontemporal_store(sub[m][n], (f32x4*)(rp + n * 4));
    }
}
DI void store_vt_s(const f32x4 (&sub)[4][2], bf16_t* vt, int T, int t0, int fr, int fq) {
#pragma unroll
    for (int n = 0; n < 2; ++n) {
        bf16_t* rp = vt + (size_t)(8 * (fr >> 2) + 4 * n + (fr & 3)) * T + t0 + fq * 4;
#pragma unroll
        for (int m = 0; m < 4; ++m) { u32x2 o = {pk2(sub[m][n][0], sub[m][n][1]), pk2(sub[m][n][2], sub[m][n][3])}; *(u32x2*)(rp + m * 16) = o; }
    }
}
DI void store_f32_ns_s(const f32x4 (&sub)[4][2], float* ob, int ldo, int fr, int fq) {
#pragma unroll
    for (int m = 0; m < 4; ++m)
#pragma unroll
        for (int j = 0; j < 4; ++j) {
            float* rp = ob + (size_t)(m * 16 + fq * 4 + j) * ldo + 8 * (fr >> 2) + (fr & 3);
#pragma unroll
            for (int n = 0; n < 2; ++n) __builtin_nontemporal_store(sub[m][n][j], rp + n * 4);
        }
}

template <int EPI>
DI void tile_epilogue(const Params& p, f32x4 (&acc)[2][2][4][2], int pm, int pn, int vtm, const FuseP& fz) {
    const int tix = TIDX, wid = __builtin_amdgcn_readfirstlane(tix >> 6), lane = tix & 63, wr = wid >> 2, wc = wid & 3;
    const int brow = pm * 256, bcol = pn * 256;
    int fr = lane & 15, fq = lane >> 4;
    asm volatile("" : "+v"(fr), "+v"(fq));
    const bool latent = brow >= 8192;
    int b, tb, T;
    if (latent) { b = (brow - 8192) >> 10; tb = (brow - 8192) & 1023; T = 1024; } else { b = brow >> 8; tb = 0; T = 256; }
    bf16_t* big = (bf16_t*)(p.ws + OFF_BIG);
    if (EPI == EPI_YF) {
        const int v = latent ? 1 + b : 0;
        const int rbase = brow + wr * 64 + fr;
        const int cbase = bcol + wc * 32 + fq * 8;
        float rs[2][4];
#pragma unroll
        for (int ai = 0; ai < 2; ++ai)
#pragma unroll
            for (int m = 0; m < 4; ++m) {
                float sq = dot4(acc[ai][0][m][0]) + dot4(acc[ai][0][m][1]) + dot4(acc[ai][1][m][0]) + dot4(acc[ai][1][m][1]);
                sq += __shfl_xor(sq, 16); sq += __shfl_xor(sq, 32);
                if (fq == 0) { const float old = __hip_atomic_fetch_add(fz.ssY + rbase + ai * 128 + m * 16, sq, __ATOMIC_RELAXED, __HIP_MEMORY_SCOPE_AGENT); asm volatile("" :: "v"(old)); }
            }
        panel_wait(fz.cnt + pm * 32, 4u);
#pragma unroll
        for (int ai = 0; ai < 2; ++ai)
#pragma unroll
            for (int m = 0; m < 4; ++m) rs[ai][m] = rsqrtf(ld_agent(fz.ssY + rbase + ai * 128 + m * 16) * (1.f / 1024.f) + EPSN);
        const float* xin = latent ? p.x_sample - (size_t)8192 * 1024 : p.x_prompt;
        bf16_t* xb = (bf16_t*)(p.ws + OFF_HY) + 1024;
        float s2[2][4];
#pragma unroll
        for (int ai = 0; ai < 2; ++ai)
#pragma unroll
            for (int m = 0; m < 4; ++m) s2[ai][m] = 0.f;
#pragma unroll
        for (int bj = 0; bj < 2; ++bj) {
            const int col = cbase + bj * 128;
            f32x4 g4[2], wp4[2];
#pragma unroll
            for (int n = 0; n < 2; ++n) { g4[n] = *(const f32x4*)(fz.g + v * 6144 + col + 4 * n); wp4[n] = *(const f32x4*)(fz.wpost + col + 4 * n); }
#pragma unroll
            for (int ai = 0; ai < 2; ++ai)
#pragma unroll
                for (int m = 0; m < 4; ++m) {
                    const size_t off = (size_t)(rbase + ai * 128 + m * 16) * 1024 + col;
                    f32x4 x4[2];
                    if (fz.from_input) { x4[0] = __builtin_nontemporal_load((const f32x4*)(xin + off)); x4[1] = __builtin_nontemporal_load((const f32x4*)(xin + off + 4)); }
                    else {
                        const u32x4 xr = __builtin_nontemporal_load((const u32x4*)(xb + 2 * off - col));
                        x4[0] = (f32x4){bflo(xr[0]), bfhi(xr[0]), bflo(xr[1]), bfhi(xr[1])}; x4[1] = (f32x4){bflo(xr[2]), bfhi(xr[2]), bflo(xr[3]), bfhi(xr[3])};
                    }
                    f32x4 a[2];
#pragma unroll
                    for (int n = 0; n < 2; ++n) { a[n] = x4[n] + g4[n] * (acc[ai][bj][m][n] * rs[ai][m] * wp4[n]); acc[ai][bj][m][n] = a[n]; s2[ai][m] += dot4(a[n]); }
                    if (fz.hasH) { u32x4 xo = {pk2(a[0][0], a[0][1]), pk2(a[0][2], a[0][3]), pk2(a[1][0], a[1][1]), pk2(a[1][2], a[1][3])}; *(u32x4*)(xb + 2 * off - col) = xo; }
                    else { __builtin_nontemporal_store(a[0], (f32x4*)(fz.xout + off)); __builtin_nontemporal_store(a[1], (f32x4*)(fz.xout + off + 4)); }
                }
        }
        if (fz.hasH) {
#pragma unroll
            for (int ai = 0; ai < 2; ++ai)
#pragma unroll
                for (int m = 0; m < 4; ++m) {
                    float sq = s2[ai][m];
                    sq += __shfl_xor(sq, 16); sq += __shfl_xor(sq, 32);
                    if (fq == 0) { const float old = __hip_atomic_fetch_add(fz.ssX + rbase + ai * 128 + m * 16, sq, __ATOMIC_RELAXED, __HIP_MEMORY_SCOPE_AGENT); asm volatile("" :: "v"(old)); }
                }
            panel_wait(fz.cnt + pm * 32 + 16, 4u);
#pragma unroll
            for (int ai = 0; ai < 2; ++ai)
#pragma unroll
                for (int m = 0; m < 4; ++m) rs[ai][m] = rsqrtf(ld_agent(fz.ssX + rbase + ai * 128 + m * 16) * (1.f / 1024.f) + EPSN);
            bf16_t* hb = (bf16_t*)(p.ws + OFF_HY);
#pragma unroll
            for (int bj = 0; bj < 2; ++bj) {
                const int col = cbase + bj * 128;
                f32x4 wq4[2], sc4[2], sh4[2];
#pragma unroll
                for (int n = 0; n < 2; ++n) { wq4[n] = *(const f32x4*)(fz.wpre + col + 4 * n); sc4[n] = *(const f32x4*)(fz.sc + v * 6144 + col + 4 * n) + 1.f; sh4[n] = *(const f32x4*)(fz.sh + v * 6144 + col + 4 * n); }
#pragma unroll
                for (int ai = 0; ai < 2; ++ai)
#pragma unroll
                    for (int m = 0; m < 4; ++m) {
                        const f32x4 h0 = acc[ai][bj][m][0] * rs[ai][m] * wq4[0] * sc4[0] + sh4[0], h1 = acc[ai][bj][m][1] * rs[ai][m] * wq4[1] * sc4[1] + sh4[1];
                        u32x4 o = {pk2(h0[0], h0[1]), pk2(h0[2], h0[3]), pk2(h1[0], h1[1]), pk2(h1[2], h1[3])};
                        *(u32x4*)(hb + (size_t)(rbase + ai * 128 + m * 16) * 2048 + col) = o;
                    }
            }
        }
        return;
    }
#pragma unroll
    for (int ai = 0; ai < 2; ++ai)
#pragma unroll
        for (int bj = 0; bj < 2; ++bj) {
            __builtin_amdgcn_sched_barrier(0);
            f32x4 (&sub)[4][2] = acc[ai][bj];
            const int R0 = brow + ai * 128 + wr * 64, t0 = tb + ai * 128 + wr * 64, C0 = bcol + bj * 128 + wc * 32;
            const bool ns = vtm == 1 || (vtm == 2 && bj == 1);
            if (EPI == EPI_PE) {
                if (ns) {
                    const int vc = C0 - 2560;
                    bf16_t* vt = (bf16_t*)(p.ws + OFF_BIG + BIG_VT_E) + (latent ? (size_t)4194304 + ((size_t)b * 512 + vc) * 1024 : ((size_t)b * 512 + vc) * 256);
                    store_vt_s(sub, vt, T, t0, fr, fq);
                    if (!latent) store_f32_ns_s(sub, p.out + OUT_DIFFV + ((size_t)(b * 4 + (vc >> 7)) * 256 + t0) * 128 + (vc & 127), 128, fr, fq);
                } else {
                    if (pn >= 6 && latent) rope_s(sub, R0, wc & 1, fr, fq);
                    store_bf16_rows_s(sub, big, LDE, R0, C0, fr, fq);
                    if (pn >= 8 && !latent) store_f32_rows_s(sub, p.out + OUT_DIFFK + ((size_t)(b * 8 + ((C0 - 2048) >> 6)) * 256 + t0) * 64 + ((C0 - 2048) & 63), 64, fr, fq);
                }
            } else if (EPI == EPI_PO) {
                if (ns) {
                    if (pn < 8) {
                        const int vc = C0 - 1024;
                        bf16_t* vt = (bf16_t*)(p.ws + OFF_BIG + BIG_VT_C) + (latent ? (size_t)4194304 + ((size_t)b * 512 + vc) * 1024 : ((size_t)b * 512 + vc) * 256);
                        store_vt_s(sub, vt, T, t0, fr, fq);
                        if (!latent) store_f32_ns_s(sub, p.out + OUT_NAV + ((size_t)(b * 8 + (vc >> 6)) * 256 + t0) * 64 + (vc & 63), 64, fr, fq);
                    } else {
                        const int vc = C0 - 2176;
                        bf16_t* vt = (bf16_t*)(p.ws + OFF_BIG + BIG_VT_D) + (latent ? (size_t)1048576 + ((size_t)b * 128 + vc) * 1024 : ((size_t)b * 128 + vc) * 256);
                        store_vt_s(sub, vt, T, t0, fr, fq);
                        if (!latent) store_f32_ns_s(sub, p.out + OUT_SWAV + ((size_t)(b * 2 + (vc >> 6)) * 256 + t0) * 64 + (vc & 63), 64, fr, fq);
                    }
                } else {
                    if (pn >= 6 && latent) rope_s(sub, R0, wc & 1, fr, fq);
                    store_bf16_rows_s(sub, big, LDO, R0, pn >= 6 ? C0 - 512 : C0, fr, fq);
                    if (!latent) {
                        if (pn == 2 || pn == 3) store_f32_rows_s(sub, p.out + OUT_NAK + ((size_t)(b * 8 + ((C0 - 512) >> 6)) * 256 + t0) * 64 + ((C0 - 512) & 63), 64, fr, fq);
                        else if (pn == 8) store_f32_rows_s(sub, p.out + OUT_SWAK + ((size_t)(b * 2 + ((C0 - 2048) >> 6)) * 256 + t0) * 64 + ((C0 - 2048) & 63), 64, fr, fq);
                    }
                }
            } else if (EPI == EPI_Y) {
                store_f32_rows_s(sub, (float*)(p.ws + OFF_HY) + (size_t)R0 * 1024 + C0, 1024, fr, fq);
            } else {
#pragma unroll
                for (int m = 0; m < 4; ++m)
#pragma unroll
                    for (int n = 0; n < 2; ++n)
#pragma unroll
                        for (int j = 0; j < 4; ++j) { const float v = fmaxf(sub[m][n][j], 0.f); sub[m][n][j] = v * v; }
                store_bf16_rows_s(sub, big, 4096, R0, C0, fr, fq);
            }
        }
}

template <int EPI>
DI void gemm_phase(const Params& p, const bf16_t* A, int lda, const bf16_t* Bt, int K, int NT_N, char* shm, const FuseP& fz = FuseP{}) {
    using namespace g8;
    const int xcd = blockIdx.x & 7, lb = blockIdx.x >> 3, nlb = gridDim.x >> 3, per_xcd = 8 * NT_N;
    if (lb >= per_xcd) return;
    const int tid = TIDX, wid = __builtin_amdgcn_readfirstlane(tid >> 6), lane = tid & 63, wr = wid >> 2, wc = wid & 3, fr = lane & 15, fq = lane >> 4;
    const int nt = K / BK;
    lds_u8* lds = (lds_u8*)shm;
    unsigned voffA[2], voffB[2];
#pragma unroll
    for (int _i = 0; _i < 2; ++_i) { int _r, _c; stage_rc(tid * 16 + _i * 8192, _r, _c); const int _i16 = _r & 15, _rb = (_r & ~31) + 8 * (_i16 >> 2) + 4 * ((_r >> 4) & 1) + (_i16 & 3);
        voffA[_i] = (unsigned)(_r * lda + _c) * 2u; voffB[_i] = (unsigned)(_rb * K + _c) * 2u; }
    const size_t kstep = (size_t)BK * 2, hstepA = (size_t)HALF * lda * 2, hstepB = (size_t)HALF * K * 2;
    const unsigned ldsw = (unsigned)wid * 1024u;
    const int aoff = lds_byte(wr * 64 + fr, fq * 8), boff = lds_byte(wc * 32 + fr, fq * 8);
#define SA(b, h) (((b) * 2 + (h)) * HTB)
#define SB(b, h) ((4 + (b) * 2 + (h)) * HTB)
#define STAGE(bufoff, gbase, voff) do { _Pragma("unroll") for (int _i = 0; _i < 2; ++_i) \
      __builtin_amdgcn_global_load_lds((const unsigned*)((gbase) + (voff)[_i]), (lds_u32*)(lds + (bufoff) + ldsw + _i * 8192), 16, 0, 0); } while (0)
#define LDA(dst, b, h) _Pragma("unroll") for (int m = 0; m < 4; ++m) _Pragma("unroll") for (int k = 0; k < 2; ++k) \
    dst[m][k] = *(const lds_bf16x8*)(lds + SA(b, h) + aoff + m * 2048 + k * 1024)
#define LDB(dst, b, h) _Pragma("unroll") for (int n = 0; n < 2; ++n) _Pragma("unroll") for (int k = 0; k < 2; ++k) \
    dst[n][k] = *(const lds_bf16x8*)(lds + SB(b, h) + boff + n * 2048 + k * 1024)
#define MMA(VT, ai, bj, At_, Bt_) do { __builtin_amdgcn_s_setprio(1); \
    _Pragma("unroll") for (int m = 0; m < 4; ++m) _Pragma("unroll") for (int n = 0; n < 2; ++n) _Pragma("unroll") for (int k = 0; k < 2; ++k) \
      acc[ai][bj][m][n] = ((VT) == 1 || ((VT) == 2 && (bj) == 1)) ? MFMA16(At_[m][k], Bt_[n][k], acc[ai][bj][m][n]) : MFMA16(Bt_[n][k], At_[m][k], acc[ai][bj][m][n]); \
    __builtin_amdgcn_s_setprio(0); } while (0)
#define WAIT_V(n) asm volatile("s_waitcnt vmcnt(" #n ")" ::: "memory")
#define WAIT_L(n) asm volatile("s_waitcnt lgkmcnt(" #n ")" ::: "memory")
#define BAR __builtin_amdgcn_s_barrier()
#define SCHED __builtin_amdgcn_sched_barrier(0)
#define TLOOP(VT) for (int t = 0; t < nt; t += 2) { \
        const bool last = (t == nt - 2); \
        const char* a1 = cA + (size_t)(t + 1) * kstep; \
        const char* a2 = last ? nA : cA + (size_t)(t + 2) * kstep; const char* b2 = last ? nB : cB + (size_t)(t + 2) * kstep; \
        const char* a3 = a2 + kstep; const char* b3 = b2 + kstep; \
        LDB(B0, 0, 0); LDB(B1, 0, 1); SCHED; LDA(At, 0, 0); STAGE(SA(1, 1), a1 + hstepA, voffA); \
        WAIT_V(8); WAIT_L(0); BAR; MMA(VT, 0, 0, At, B0); MMA(VT, 0, 1, At, B1); BAR; SCHED; \
        LDA(At, 0, 1); STAGE(SB(0, 0), b2, voffB); STAGE(SB(0, 1), b2 + hstepB, voffB); STAGE(SA(0, 0), a2, voffA); \
        WAIT_V(8); WAIT_L(0); BAR; MMA(VT, 1, 0, At, B0); MMA(VT, 1, 1, At, B1); BAR; SCHED; \
        LDB(B0, 1, 0); LDB(B1, 1, 1); SCHED; LDA(At, 1, 0); STAGE(SA(0, 1), a2 + hstepA, voffA); \
        WAIT_V(8); WAIT_L(0); BAR; MMA(VT, 0, 0, At, B0); MMA(VT, 0, 1, At, B1); BAR; SCHED; \
        LDA(At, 1, 1); STAGE(SB(1, 0), b3, voffB); STAGE(SB(1, 1), b3 + hstepB, voffB); STAGE(SA(1, 0), a3, voffA); \
        WAIT_V(8); WAIT_L(0); BAR; MMA(VT, 1, 0, At, B0); MMA(VT, 1, 1, At, B1); BAR; SCHED; \
    }
    int lt = lb, pm = xcd * 8 + (lt & 7), pn = lt >> 3;
    f32x4 acc[2][2][4][2];
#pragma unroll
    for (int a = 0; a < 2; ++a)
#pragma unroll
        for (int b = 0; b < 2; ++b)
#pragma unroll
            for (int m = 0; m < 4; ++m)
#pragma unroll
                for (int n = 0; n < 2; ++n) acc[a][b][m][n] = (f32x4){0.f, 0.f, 0.f, 0.f};
    bf16x8 At[4][2], B0[2][2], B1[2][2];
    const char* cA = (const char*)A + (size_t)pm * 2 * hstepA;
    const char* cB = (const char*)Bt + (size_t)pn * 2 * hstepB;
    WAIT_V(0);
    STAGE(SB(0, 0), cB, voffB); STAGE(SB(0, 1), cB + hstepB, voffB); STAGE(SA(0, 0), cA, voffA); STAGE(SA(0, 1), cA + hstepA, voffA);
    if (wr == 1) BAR;
    WAIT_V(2); BAR;
    STAGE(SB(1, 0), cB + kstep, voffB); STAGE(SA(1, 0), cA + kstep, voffA); STAGE(SB(1, 1), cB + hstepB + kstep, voffB);
    WAIT_V(6); BAR;
    for (;;) {
        const int ltn = lt + nlb;
        const bool has_next = ltn < per_xcd;
        const int pmn = xcd * 8 + (ltn & 7), pnn = ltn >> 3;
        const char* nA = has_next ? (const char*)A + (size_t)pmn * 2 * hstepA : cA;
        const char* nB = has_next ? (const char*)Bt + (size_t)pnn * 2 * hstepB : cB;
        int vtm = 0;
        if (EPI == EPI_PE) vtm = pn >= 10 ? 1 : 0;
        if (EPI == EPI_PO) vtm = (pn == 4 || pn == 5) ? 1 : (pn == 8 ? 2 : 0);
        if ((EPI == EPI_PE || EPI == EPI_PO) && vtm == 1) { TLOOP(1) }
        else if (EPI == EPI_PO && vtm == 2) { TLOOP(2) }
        else { TLOOP(0) }
        if (wr == 0) BAR;
        if (EPI != EPI_YF) tile_epilogue<EPI>(p, acc, pm, pn, vtm, fz);
        if (!has_next) break;
#pragma unroll
        for (int a = 0; a < 2; ++a)
#pragma unroll
            for (int b = 0; b < 2; ++b)
#pragma unroll
                for (int m = 0; m < 4; ++m)
#pragma unroll
                    for (int n = 0; n < 2; ++n) acc[a][b][m][n] = (f32x4){0.f, 0.f, 0.f, 0.f};
        lt = ltn; pm = pmn; pn = pnn; cA = nA; cB = nB;
        if (wr == 1) BAR;
    }
    WAIT_V(0);
    BAR;
    if (EPI == EPI_YF) tile_epilogue<EPI>(p, acc, pm, pn, 0, fz);
#undef SA
#undef SB
#undef STAGE
#undef LDA
#undef LDB
#undef MMA
#undef WAIT_V
#undef WAIT_L
#undef BAR
#undef SCHED
#undef TLOOP
}

struct ASeg { const bf16_t* K; const bf16_t* Vt; int ldk, ldv, ntiles; };
struct MaskP { int on, a, b, c; const float* tab; };

template <int KW, int VR, int NB, int MODE>
DI void attn_core(const ASeg& s0, const ASeg& s1, const bf16x8 (&qf)[4], int kchunk0, int vrow0, float scale_l2, float& m, float& l, f32x16 (&O)[NB], char* lds, const MaskP& mp) {
    constexpr int KC = KW / 8, NKL = 64 * KC / 256, NVL = VR * 8 / 256;
    const int tid = VTID, lane = tid & 63, p32 = lane & 31, h = lane >> 5;
    const int krow = (p32 & 19) | ((p32 & 4) << 1) | ((p32 & 8) >> 1);
    const int n0 = s0.ntiles, nt = s0.ntiles + s1.ntiles;
    u32x4 rk[NKL], rv[NVL];
#define ATT_LOAD(t_)                                                                                                         \
    {                                                                                                                        \
        const bool f_ = (t_) < n0; const int tt_ = f_ ? (t_) : (t_) - n0;                                                     \
        const bf16_t* Kp_ = (f_ ? s0.K : s1.K); const int ldk_ = f_ ? s0.ldk : s1.ldk;                                        \
        const bf16_t* Vp_ = (f_ ? s0.Vt : s1.Vt); const int ldv_ = f_ ? s0.ldv : s1.ldv;                                      \
        _Pragma("unroll") for (int i = 0; i < NKL; ++i) { const int id = tid + 256 * i, r = id / KC, c = id % KC; rk[i] = *(const u32x4*)(Kp_ + (size_t)(tt_ * 64 + r) * ldk_ + c * 8); } \
        _Pragma("unroll") for (int i = 0; i < NVL; ++i) { const int id = tid + 256 * i, r = id >> 3, c = id & 7; rv[i] = *(const u32x4*)(Vp_ + (size_t)r * ldv_ + tt_ * 64 + c * 8); }       \
    }
#define ATT_STORE(b_)                                                                                                        \
    {                                                                                                                        \
        char* kb_ = lds + (b_) * 32768; char* vb_ = kb_ + 16384;                                                              \
        _Pragma("unroll") for (int i = 0; i < NKL; ++i) { const int id = tid + 256 * i, r = id / KC, c = id % KC; *(u32x4*)(kb_ + (KW == 128 ? swz256(r, c) : swz128(r, c))) = rk[i]; } \
        _Pragma("unroll") for (int i = 0; i < NVL; ++i) { const int id = tid + 256 * i, r = id >> 3, c = id & 7; *(u32x4*)(vb_ + swz128(r, c)) = rv[i]; }                               \
    }
    int dco[2][16];
    if (MODE == 1) {
        const int cq = mp.c + p32, cs = min(max(cq - 8, 0), 48);
#pragma unroll
        for (int kh = 0; kh < 2; ++kh)
#pragma unroll
            for (int i = 0; i < 16; ++i) {
                const int kc = 32 * kh + 16 * (i >> 3) + 8 * h + (i & 7);
                dco[kh][i] = ((unsigned)(kc - cs) < 16u ? min(max(kc - cq + 15, 0), 30) : 31) * 4;
            }
    }
    ATT_LOAD(0);
    ATT_STORE(0);
    __syncthreads();
    for (int t = 0; t < nt; ++t) {
        const bool more = t + 1 < nt;
        if (more) ATT_LOAD(t + 1);
        const char* kb = lds + (t & 1) * 32768;
        const char* vb = kb + 16384;
        f32x16 S[2];
#pragma unroll
        for (int kh = 0; kh < 2; ++kh) {
#pragma unroll
            for (int i = 0; i < 16; ++i) S[kh][i] = 0.f;
            const int row = krow + 32 * kh;
#pragma unroll
            for (int s = 0; s < 4; ++s) {
                const int c = kchunk0 + 2 * s + h;
                const bf16x8 kf = *(const bf16x8*)(kb + (KW == 128 ? swz256(row, c) : swz128(row, c)));
                S[kh] = MFMA32(kf, qf[s], S[kh]);
            }
        }
        const bool msk = (MODE != 0) && mp.on && t < n0;
        float mx = -1e30f;
        if (MODE == 1 && msk) {
            const char* trow = (const char*)(mp.tab + (mp.b + t - mp.a + 7) * 32);
#pragma unroll
            for (int kh = 0; kh < 2; ++kh)
#pragma unroll
                for (int i = 0; i < 16; ++i) {
                    const float sv = __builtin_fmaf(S[kh][i], scale_l2, *(const float*)(trow + dco[kh][i]));
                    S[kh][i] = sv; mx = fmaxf(mx, sv);
                }
        } else if (MODE == 2 && msk) {
            int qp = mp.a + p32 - 8 * h;
            asm volatile("" : "+v"(qp));
            const int k0 = mp.b + t * 64;
#pragma unroll
            for (int kh = 0; kh < 2; ++kh)
#pragma unroll
                for (int i = 0; i < 16; ++i) {
                    const int d = qp - (k0 + 32 * kh + 16 * (i >> 3) + (i & 7));
                    const bool ok = d <= 128 && d >= -128;
                    const float sv = ok ? S[kh][i] * scale_l2 : -1e30f;
                    S[kh][i] = sv; mx = fmaxf(mx, sv);
                }
        } else {
            float m0 = fmaxf(fmaxf(S[0][0], S[0][1]), S[0][2]), m1 = fmaxf(fmaxf(S[1][0], S[1][1]), S[1][2]);
#pragma unroll
            for (int i = 3; i < 15; i += 2) { m0 = fmaxf(fmaxf(m0, S[0][i]), S[0][i + 1]); m1 = fmaxf(fmaxf(m1, S[1][i]), S[1][i + 1]); }
            mx = fmaxf(fmaxf(m0, m1), fmaxf(S[0][15], S[1][15])) * scale_l2;
        }
        mx = fmaxf(mx, __shfl_xor(mx, 32));
        if (__any(mx > m + 8.f)) {
            const float mn = fmaxf(m, mx);
            const float alpha = __builtin_amdgcn_exp2f(m - mn);
            m = mn;
            l *= alpha;
#pragma unroll
            for (int blk = 0; blk < NB; ++blk)
#pragma unroll
                for (int i = 0; i < 16; ++i) O[blk][i] *= alpha;
        }
        float ls = 0.f;
        if ((MODE == 1 || MODE == 2) && msk) {
#pragma unroll
            for (int kh = 0; kh < 2; ++kh)
#pragma unroll
                for (int i = 0; i < 16; ++i) { const float pv = __builtin_amdgcn_exp2f(S[kh][i] - m); S[kh][i] = pv; ls += pv; }
        } else {
            const float negm = -m;
#pragma unroll
            for (int kh = 0; kh < 2; ++kh)
#pragma unroll
                for (int i = 0; i < 16; ++i) { const float pv = __builtin_amdgcn_exp2f(__builtin_fmaf(S[kh][i], scale_l2, negm)); S[kh][i] = pv; ls += pv; }
        }
        l += ls;
#pragma unroll
        for (int kh = 0; kh < 2; ++kh)
#pragma unroll
            for (int s2 = 0; s2 < 2; ++s2) {
                u32x4 pp = {pk2(S[kh][8 * s2 + 0], S[kh][8 * s2 + 1]), pk2(S[kh][8 * s2 + 2], S[kh][8 * s2 + 3]), pk2(S[kh][8 * s2 + 4], S[kh][8 * s2 + 5]), pk2(S[kh][8 * s2 + 6], S[kh][8 * s2 + 7])};
                const bf16x8 pb = __builtin_bit_cast(bf16x8, pp);
                const int c = 4 * kh + 2 * s2 + h;
#pragma unroll
                for (int blk = 0; blk < NB; ++blk) {
                    const bf16x8 vf = *(const bf16x8*)(vb + swz128(vrow0 + blk * 32 + p32, c));
                    O[blk] = MFMA32(vf, pb, O[blk]);
                }
            }
        if (more) ATT_STORE((t + 1) & 1);
        __syncthreads();
    }
    l += __shfl_xor(l, 32);
#undef ATT_LOAD
#undef ATT_STORE
}

DI void load_q(bf16x8 (&qf)[4], const bf16_t* qrow, int h) {
#pragma unroll
    for (int s = 0; s < 4; ++s) qf[s] = *(const bf16x8*)(qrow + 16 * s + 8 * h);
}

DI void attn_diff_item(const Params& p, int item, char* lds) {
    const int tid = VTID, lane = tid & 63, w = tid >> 6, p32 = lane & 31, h = lane >> 5, stream = w & 1, qh = w >> 1;
    const bf16_t* proj = (const bf16_t*)(p.ws + OFF_BIG);
    const bf16_t* vte = (const bf16_t*)(p.ws + OFF_BIG + BIG_VT_E);
    bf16_t* mix = (bf16_t*)(p.ws + OFF_BIG + BIG_MIXIN);
    int b, hd, qb, rowbase; ASeg s0, s1;
    if (item < 512) {
        b = item >> 6; hd = (item >> 4) & 3; qb = item & 15; rowbase = 8192 + b * 1024;
        s0 = {proj + (size_t)rowbase * LDE + 2048 + hd * 128, vte + 4194304 + ((size_t)b * 512 + hd * 128) * 1024, LDE, 1024, 16};
        s1 = {(const bf16_t*)(p.ws + OFF_CDK) + (size_t)b * 256 * 512 + hd * 128, (const bf16_t*)(p.ws + OFF_CDVT) + (size_t)(b * 4 + hd) * 128 * 256, 512, 256, 4};
    } else {
        const int it = item - 512;
        b = it >> 4; hd = (it >> 2) & 3; qb = it & 3; rowbase = b * 256;
        s0 = {proj + (size_t)rowbase * LDE + 2048 + hd * 128, vte + ((size_t)b * 512 + hd * 128) * 256, LDE, 256, 4};
        s1 = s0; s1.ntiles = 0;
    }
    const int R = rowbase + qb * 64 + qh * 32 + p32;
    bf16x8 qf[4];
    load_q(qf, proj + (size_t)R * LDE + 1536 + hd * 128 + stream * 64, h);
    f32x16 O[4];
#pragma unroll
    for (int blk = 0; blk < 4; ++blk)
#pragma unroll
        for (int i = 0; i < 16; ++i) O[blk][i] = 0.f;
    float m = -1e30f, l = 0.f;
    MaskP mp = {0, 0, 0, 0, nullptr};
    attn_core<128, 128, 4, 0>(s0, s1, qf, stream * 8, 0, 0.125f * LOG2E, m, l, O, lds, mp);
    const float il = 1.f / l;
    const float d1 = wave_sum(p.lq1[lane] * p.lk1[lane]), d2 = wave_sum(p.lq2[lane] * p.lk2[lane]);
    const float lam_init = 0.2f;
    const float lam = __expf(d1) - __expf(d2) + lam_init;
    float* xb = (float*)(lds + qh * 16384);
    if (stream == 1) {
#pragma unroll
        for (int blk = 0; blk < 4; ++blk)
#pragma unroll
            for (int i = 0; i < 16; ++i) { const int dv = blk * 32 + 8 * (i >> 2) + 4 * h + (i & 3); xb[dv * 32 + p32] = O[blk][i] * il; }
    }
    __syncthreads();
    if (stream == 0) {
        float ss = 0.f;
#pragma unroll
        for (int blk = 0; blk < 4; ++blk)
#pragma unroll
            for (int i = 0; i < 16; ++i) { const int dv = blk * 32 + 8 * (i >> 2) + 4 * h + (i & 3); const float o = O[blk][i] * il - lam * xb[dv * 32 + p32]; O[blk][i] = o; ss += o * o; }
        ss += __shfl_xor(ss, 32);
        const float rs = rsqrtf(ss * (1.f / 128.f) + EPSN) * (1.f - lam_init);
        bf16_t* op = mix + (size_t)R * 1024 + 512 + hd * 128;
#pragma unroll
        for (int blk = 0; blk < 4; ++blk)
#pragma unroll
            for (int g = 0; g < 4; ++g) {
                const int dv = blk * 32 + 8 * g + 4 * h;
                const f32x4 sl = *(const f32x4*)(p.subln + dv);
                u32x2 o = {pk2(O[blk][4 * g] * rs * sl[0], O[blk][4 * g + 1] * rs * sl[1]), pk2(O[blk][4 * g + 2] * rs * sl[2], O[blk][4 * g + 3] * rs * sl[3])};
                *(u32x2*)(op + dv) = o;
            }
    }
    __syncthreads();
}

DI void attn_c_item(const Params& p, int item, char* lds) {
    const int tid = VTID, lane = tid & 63, w = tid >> 6, p32 = lane & 31, h = lane >> 5, stream = w & 1, qh = w >> 1;
    const bf16_t* proj = (const bf16_t*)(p.ws + OFF_BIG);
    const bf16_t* vtc = (const bf16_t*)(p.ws + OFF_BIG + BIG_VT_C);
    bf16_t* mix = (bf16_t*)(p.ws + OFF_BIG + BIG_MIXIN);
    int b, hp, qb, rowbase; ASeg s0, s1; MaskP mp = {0, 0, 0, 0, nullptr};
    float* tab = (float*)(lds + 65536);
    if (item < 512) {
        b = item >> 6; hp = (item >> 4) & 3; qb = item & 15; rowbase = 8192 + b * 1024;
        const int rstart = min(max(qb - 4, 0), 8);
        s0 = {proj + (size_t)(rowbase + rstart * 64) * LDO + 512 + hp * 128, vtc + 4194304 + ((size_t)b * 512 + hp * 128) * 1024 + rstart * 64, LDO, 1024, 8};
        s1 = {(const bf16_t*)(p.ws + OFF_CNK) + (size_t)b * 256 * 512 + hp * 128, (const bf16_t*)(p.ws + OFF_CNVT) + ((size_t)b * 512 + hp * 128) * 256, 512, 256, 4};
        for (int idx = tid; idx < 960; idx += 256) { const int hr = idx >> 5, cc = idx & 31; tab[idx] = cc < 31 ? p.rpb[hp * 930 + hr * 31 + cc] * LOG2E : -1e30f; }
        mp = {1, qb, rstart, qh * 32, tab + stream * 480};
    } else {
        const int it = item - 512;
        b = it >> 4; hp = (it >> 2) & 3; qb = it & 3; rowbase = b * 256;
        s0 = {proj + (size_t)rowbase * LDO + 512 + hp * 128, vtc + ((size_t)b * 512 + hp * 128) * 256, LDO, 256, 4};
        s1 = s0; s1.ntiles = 0;
    }
    const int R = rowbase + qb * 64 + qh * 32 + p32;
    const int head = hp * 2 + stream;
    bf16x8 qf[4];
    load_q(qf, proj + (size_t)R * LDO + head * 64, h);
    f32x16 O[2];
#pragma unroll
    for (int blk = 0; blk < 2; ++blk)
#pragma unroll
        for (int i = 0; i < 16; ++i) O[blk][i] = 0.f;
    float m = -1e30f, l = 0.f;
    attn_core<128, 128, 2, 1>(s0, s1, qf, stream * 8, stream * 64, 0.125f * LOG2E, m, l, O, lds, mp);
    const float il = 1.f / l;
    bf16_t* op = mix + (size_t)R * 1024 + head * 64;
#pragma unroll
    for (int blk = 0; blk < 2; ++blk)
#pragma unroll
        for (int g = 0; g < 4; ++g) {
            const int dv = blk * 32 + 8 * g + 4 * h;
            u32x2 o = {pk2(O[blk][4 * g] * il, O[blk][4 * g + 1] * il), pk2(O[blk][4 * g + 2] * il, O[blk][4 * g + 3] * il)};
            *(u32x2*)(op + dv) = o;
        }
}

DI void attn_d_item(const Params& p, int item, char* lds) {
    const int tid = VTID, lane = tid & 63, w = tid >> 6, p32 = lane & 31, h = lane >> 5;
    const bf16_t* proj = (const bf16_t*)(p.ws + OFF_BIG);
    const bf16_t* vtd = (const bf16_t*)(p.ws + OFF_BIG + BIG_VT_D);
    bf16_t* mix = (bf16_t*)(p.ws + OFF_BIG + BIG_MIXIN);
    int b, g, qb, rowbase; ASeg s0, s1; MaskP mp = {0, 0, 0, 0, nullptr};
    if (item < 512) {
        b = item >> 6; g = (item >> 5) & 1; qb = item & 31; rowbase = 8192 + b * 1024;
        const int q0 = qb * 32;
        const int tlo = max(q0 - 128, 0) >> 6, thi = min(q0 + 159, 1023) >> 6;
        s0 = {proj + (size_t)(rowbase + tlo * 64) * LDO + 1536 + g * 64, vtd + 1048576 + ((size_t)b * 128 + g * 64) * 1024 + tlo * 64, LDO, 1024, thi - tlo + 1};
        s1 = {(const bf16_t*)(p.ws + OFF_CSK) + (size_t)b * 256 * 128 + g * 64, (const bf16_t*)(p.ws + OFF_CSVT) + ((size_t)b * 128 + g * 64) * 256, 128, 256, 4};
        mp = {1, q0, tlo * 64, 0, nullptr};
    } else {
        const int it = item - 512;
        b = it >> 4; g = (it >> 3) & 1; qb = it & 7; rowbase = b * 256;
        s0 = {proj + (size_t)rowbase * LDO + 1536 + g * 64, vtd + ((size_t)b * 128 + g * 64) * 256, LDO, 256, 4};
        s1 = s0; s1.ntiles = 0;
    }
    const int R = rowbase + qb * 32 + p32;
    const int hq = g * 4 + w;
    bf16x8 qf[4];
    load_q(qf, proj + (size_t)R * LDO + 1024 + hq * 64, h);
    f32x16 O[2];
#pragma unroll
    for (int blk = 0; blk < 2; ++blk)
#pragma unroll
        for (int i = 0; i < 16; ++i) O[blk][i] = 0.f;
    float m = p.sink[hq] * LOG2E, l = h == 0 ? 1.f : 0.f;
    attn_core<64, 64, 2, 2>(s0, s1, qf, 0, 0, 0.125f * LOG2E, m, l, O, lds, mp);
    const float il = 1.f / l;
    bf16_t* op = mix + (size_t)R * 1024 + 512 + hq * 64;
#pragma unroll
    for (int blk = 0; blk < 2; ++blk)
#pragma unroll
        for (int gg = 0; gg < 4; ++gg) {
            const int dv = blk * 32 + 8 * gg + 4 * h;
            u32x2 o = {pk2(O[blk][4 * gg] * il, O[blk][4 * gg + 1] * il), pk2(O[blk][4 * gg + 2] * il, O[blk][4 * gg + 3] * il)};
            *(u32x2*)(op + dv) = o;
        }
}

DI void conv_item(const Params& p, int item) {
    const int tid = VTID;
    const bf16_t* proj = (const bf16_t*)(p.ws + OFF_BIG);
    bf16_t* mix = (bf16_t*)(p.ws + OFF_BIG + BIG_MIXIN);
#pragma unroll 2
    for (int i = 0; i < 8; ++i) {
        const int idx = tid + 256 * i, tl = idx >> 6, ch = (idx & 63) * 8;
        const int R = item * 32 + tl;
        int t, T;
        if (R < 8192) { t = R & 255; T = 256; } else { t = (R - 8192) & 1023; T = 1024; }
        const bf16_t* rp = proj + (size_t)R * LDE + ch;
        const u32x4 ab = *(const u32x4*)(rp);
        float accv[8];
#pragma unroll
        for (int e = 0; e < 8; ++e) accv[e] = 0.f;
#pragma unroll
        for (int j = 0; j < 3; ++j) {
            const int tt = t + j - 1;
            if (tt >= 0 && tt < T) {
                const u32x4 ac = *(const u32x4*)(rp + (ptrdiff_t)(j - 1) * LDE + 512);
                const u32x4 ax = *(const u32x4*)(rp + (ptrdiff_t)(j - 1) * LDE + 1024);
                const f32x4 w0 = *(const f32x4*)(p.conv_w + j * 512 + ch), w1 = *(const f32x4*)(p.conv_w + j * 512 + ch + 4);
#pragma unroll
                for (int e = 0; e < 4; ++e) {
                    accv[2 * e] += bflo(ac[e]) * bflo(ax[e]) * (e < 2 ? w0[2 * e] : w1[2 * e - 4]);
                    accv[2 * e + 1] += bfhi(ac[e]) * bfhi(ax[e]) * (e < 2 ? w0[2 * e + 1] : w1[2 * e - 3]);
                }
            }
        }
        u32x4 o;
#pragma unroll
        for (int e = 0; e < 4; ++e) o[e] = pk2(bflo(ab[e]) * accv[2 * e], bfhi(ab[e]) * accv[2 * e + 1]);
        *(u32x4*)(mix + (size_t)R * 1024 + ch) = o;
    }
}


#define XB_TMO      128
#define XB_XCNT(j)  (256  + 64 * (j))
#define XB_XSUB(j)  (1280 + 64 * (j))
#define XB_XGEN(j)  (2304 + 64 * (j))
#define XB_TOP      3328
#define XB_TOPGEN   3392
#define XCD_BAR_WORDS 3456
#define XB_SPIN_CAP (1u << 22)
#define LAS __attribute__((address_space(3)))
DI unsigned xb_ld(unsigned* p) { return __hip_atomic_load(p, __ATOMIC_RELAXED, __HIP_MEMORY_SCOPE_AGENT); }
DI unsigned xb_add(unsigned* p, unsigned v) { return __hip_atomic_fetch_add(p, v, __ATOMIC_RELAXED, __HIP_MEMORY_SCOPE_AGENT); }
DI unsigned xb_xcc_id() { return (unsigned)__builtin_amdgcn_s_getreg((3 << 11) | 20) & 0xFu; }
#define XB_SPIN(cond, bar) do { unsigned _sp = 0; while (cond) { __builtin_amdgcn_s_sleep(1); \
    if ((++_sp & 255u) == 0u) { if (xb_ld(&(bar)[XB_TMO])) break; if (_sp > XB_SPIN_CAP) { atomicAdd(&(bar)[XB_TMO], 1u); break; } } } } while (0)
struct XcdBarrier { unsigned* bar; unsigned x; volatile LAS unsigned* st; };
DI XcdBarrier xcd_barrier_post(unsigned* bar, volatile LAS unsigned* st) {
    XcdBarrier b; b.bar = bar; b.x = xb_xcc_id(); b.st = st;
    if (threadIdx.x == 0) (void)xb_add(&bar[XB_XCNT(b.x)], 1u);
    return b;
}
DI void xcd_barrier_complete(unsigned* bar, unsigned x, unsigned& nloc, unsigned& nx) {
    const unsigned G = gridDim.x * gridDim.y * gridDim.z;
    unsigned sum, cnt, mine, sp = 0u;
    for (;;) {
        sum = 0u; cnt = 0u; mine = 0u;
#pragma unroll
        for (unsigned j = 0; j < 16; ++j) { const unsigned c = xb_ld(&bar[XB_XCNT(j)]); sum += c; cnt += (c > 0u) ? 1u : 0u; mine = (j == x) ? c : mine; }
        if (sum == G) break;
        __builtin_amdgcn_s_sleep(1);
        if ((++sp & 255u) == 0u) { if (xb_ld(&bar[XB_TMO])) break; if (sp > XB_SPIN_CAP) { atomicAdd(&bar[XB_TMO], 1u); break; } }
    }
    nloc = mine > 0u ? mine : 1u; nx = cnt > 0u ? cnt : 1u;
}
DI void xcd_barrier(const XcdBarrier& b) {
    asm volatile("s_waitcnt vmcnt(0)" ::: "memory");
    __syncthreads();
    if (threadIdx.x == 0) {
        unsigned* bar = b.bar;
        __builtin_amdgcn_s_waitcnt(0);
        unsigned nloc = b.st[0], nx = b.st[1];
        if (nloc == 0u) { xcd_barrier_complete(bar, b.x, nloc, nx); b.st[0] = nloc; b.st[1] = nx; }
        const unsigned old = xb_add(&bar[XB_XSUB(b.x)], 1u);
        const unsigned gen = old / nloc;
        if (old + 1u == (gen + 1u) * nloc) {
            __builtin_amdgcn_fence(__ATOMIC_RELEASE, "agent");
            asm volatile("s_waitcnt vmcnt(0)" ::: "memory");
            const unsigned og = xb_add(&bar[XB_TOP], 1u);
            const unsigned tg = og / nx;
            if (og + 1u == (tg + 1u) * nx) xb_add(&bar[XB_TOPGEN], 1u);
            else XB_SPIN(xb_ld(&bar[XB_TOPGEN]) == tg, bar);
            __builtin_amdgcn_fence(__ATOMIC_ACQUIRE, "agent");
            xb_add(&bar[XB_XGEN(b.x)], 1u);
            asm volatile("s_waitcnt vmcnt(0)" ::: "memory");
        } else {
            XB_SPIN(xb_ld(&bar[XB_XGEN(b.x)]) == gen, bar);
            __builtin_amdgcn_fence(__ATOMIC_ACQUIRE, "agent");
            asm volatile("s_waitcnt vmcnt(0)" ::: "memory");
        }
    }
    __syncthreads();
}

constexpr int N_PHASES = 12;
DI void run_phase(const Params& p, int ph, char* shm) {
    const int nb = VNB, bid = VBID;
    char* lds = shm + VHALF * LDS_HALF;
    const int pvb = (int)(blockIdx.x & 7) * (nb >> 3) + (int)(blockIdx.x >> 3) * 2 + VHALF;
    const bf16_t* hy = (const bf16_t*)(p.ws + OFF_HY);
    const bf16_t* big = (const bf16_t*)(p.ws + OFF_BIG);
    const bf16_t* mixin = (const bf16_t*)(p.ws + OFF_BIG + BIG_MIXIN);
    const float* mod = (const float*)(p.ws + OFF_MOD);
    char* st = p.ws + OFF_STAT;
#define FZ(set, from_in, hasH, goff, wpost, wpre, scoff, shoff) FuseP{from_in, hasH, p.out, mod + (goff), wpost, wpre, mod + (scoff), mod + (shoff), (float*)(st + (set) * STAT_SET), (float*)(st + (set) * STAT_SET + 65536), (unsigned*)(st + (set) * STAT_SET + 131072)}
    switch (ph) {
    case 0: p0_phase(p, bid, nb, lds); break;
    case 1: rowop_phase(p, false, true, 0, nullptr, true, p.norm_mix_pre, 1024, 0); break;
    case 2: gemm_phase<EPI_PE>(p, hy, 2048, (const bf16_t*)(p.ws + OFF_WINE), 1024, 12, shm); break;
    case 3:
        for (int it = pvb; it < 1536; it += nb) { if (it < 1024) attn_diff_item(p, it, lds); else conv_item(p, it - 1024); }
        break;
    case 4: gemm_phase<EPI_YF>(p, mixin, 1024, (const bf16_t*)(p.ws + OFF_WOUT), 1024, 4, shm, FZ(0, 1, 1, 2048, p.norm_mix_post, p.norm_mlp_pre, 4096, 3072)); break;
    case 5: gemm_phase<EPI_W1>(p, hy, 2048, (const bf16_t*)(p.ws + OFF_W1), 1024, 16, shm); break;
    case 6: gemm_phase<EPI_YF>(p, big, 4096, (const bf16_t*)(p.ws + OFF_W2), 4096, 4, shm, FZ(1, 0, 1, 5120, p.norm_mlp_post, p.norm_mix_pre + 1024, 9 * 6144 + 1024, 9 * 6144 + 0)); break;
    case 7: gemm_phase<EPI_PO>(p, hy, 2048, (const bf16_t*)(p.ws + OFF_WINO), 1024, 9, shm); break;
    case 8:
        for (int it = pvb; it < 2048; it += nb) {
            const int q = it >> 9, r = it & 511;
            if (q & 1) attn_d_item(p, (q >> 1) * 512 + r, lds); else attn_c_item(p, (q >> 1) * 512 + r, lds);
        }
        break;
    case 9: gemm_phase<EPI_YF>(p, mixin, 1024, (const bf16_t*)(p.ws + OFF_WOUT) + 1048576, 1024, 4, shm, FZ(2, 0, 1, 9 * 6144 + 2048, p.norm_mix_post + 1024, p.norm_mlp_pre + 1024, 9 * 6144 + 4096, 9 * 6144 + 3072)); break;
    case 10: gemm_phase<EPI_W1>(p, hy, 2048, (const bf16_t*)(p.ws + OFF_W1) + 4194304, 1024, 16, shm); break;
    case 11: gemm_phase<EPI_YF>(p, big, 4096, (const bf16_t*)(p.ws + OFF_W2) + 4194304, 4096, 4, shm, FZ(3, 0, 0, 9 * 6144 + 5120, p.norm_mlp_post + 1024, p.norm_mlp_post, 0, 0)); break;
    }
#undef FZ
}

__global__ void __launch_bounds__(512, 2) fwd_mega(Params p) {
    __shared__ __attribute__((aligned(16))) char lds[LDS_BYTES];
    __shared__ uint4 xb_words;
    cg::grid_group grid = cg::this_grid();
    if (threadIdx.x == 0) xb_words = make_uint4(0u, 0u, 0u, 0u);
    __syncthreads();
    const XcdBarrier xb = xcd_barrier_post((unsigned*)(p.ws + OFF_BAR), (volatile LAS unsigned*)&xb_words);
#define PH_(n) run_phase(p, n, lds); xcd_barrier(xb); if ((DUP_MASK >> n) & 1) { run_phase(p, n, lds); xcd_barrier(xb); }
    PH_(0)
    if (p.ws == nullptr) grid.sync();
    PH_(1) PH_(2) PH_(3) PH_(4) PH_(5) PH_(6) PH_(7) PH_(8) PH_(9) PH_(10)
    run_phase(p, 11, lds);
#undef PH_
}

extern "C" void kernel_launch(void* const* d_in, const int* in_sizes, int n_in, void* d_out, int out_size, void* d_ws, size_t ws_size, hipStream_t stream) {
    Params p{};
    const float** pp = (const float**)&p;
    for (int i = 0; i < 29; ++i) pp[i] = (const float*)d_in[i];
    p.out = (float*)d_out;
    p.ws = (char*)d_ws;
    if (ws_size < WS_NEEDED) { fprintf(stderr, "workspace too small: %zu < %zu\n", ws_size, (size_t)WS_NEEDED); return; }
    static int grid_blocks = 0;
    if (!grid_blocks) {
        int dev = 0, cus = 0, per_cu = 0;
        hipGetDevice(&dev);
        hipDeviceGetAttribute(&cus, hipDeviceAttributeMultiprocessorCount, dev);
        hipOccupancyMaxActiveBlocksPerMultiprocessor(&per_cu, fwd_mega, 512, 0);
        if (per_cu > 1) per_cu = 1;
        if (per_cu < 1) per_cu = 1;
        grid_blocks = cus * per_cu;
        grid_blocks -= grid_blocks % 8;
    }
    (void)hipMemsetAsync((char*)d_ws + OFF_MOD, 0, OFF_BAR + XCD_BAR_WORDS * 4, stream);
    if (grid_blocks != 256) { fprintf(stderr, "fused epilogues need exactly 256 workgroups (got %d)\n", grid_blocks); return; }
    void* args[] = {&p};
    hipError_t e = hipLaunchCooperativeKernel((void*)fwd_mega, dim3(grid_blocks), dim3(512), args, 0, stream);
    if (e != hipSuccess) fprintf(stderr, "cooperative launch failed: %s (grid %d)\n", hipGetErrorString(e), grid_blocks);
}
```
